# Optimizing an MI355X kernel written in HIP

```python
import math
import jax
import jax.numpy as jnp
from jax import lax
import numpy as np

D_MODEL = 1024
BATCH = 8
SEQ = 4096
DEPTH = 1

D_MIX = D_MODEL
D_ATTN = D_MIX // 2
D_SSM = D_MIX - D_ATTN
ATTN_HEADS = 4
ATTN_QK_DIM = D_ATTN // (2 * ATTN_HEADS)
ATTN_V_DIM = D_ATTN // ATTN_HEADS
SSM_GROUP_WIDTH = 16
SSM_GROUPS = D_SSM // SSM_GROUP_WIDTH
SSM_STATE = 64
D_IN_PROJ = 3 * D_ATTN + D_SSM
N_EXPERTS = 32
TOP_K = 4
D_FF = D_MODEL
SWIGLU_LIMIT = 7.0
SWIGLU_ALPHA = 1.702
Q_BLOCK = 128
MOE_BLOCK = 128
RMS_EPS = 1e-6
DT_MIN = 1e-3
DT_MAX = 1e-1
MASK_VALUE = -1e30

kernel_name = 'hybrid_diffattn_s5_moe_block'


def _rmsnorm(x, g):
    xf = x.astype(jnp.float32)
    y = xf * lax.rsqrt(jnp.mean(xf * xf, axis=-1, keepdims=True) + RMS_EPS)
    return (y * g.astype(jnp.float32)).astype(x.dtype)


def _modulate(h, shift, scale):
    return h * (1.0 + scale[:, None, :]) + shift[:, None, :]


def _diff_attention(q, k, v, lam, lambda_init, subln_g):
    b, s, h, _, dk = q.shape
    dv = v.shape[-1]
    n_blk = s // Q_BLOCK
    q_blocks = q.reshape(b, n_blk, Q_BLOCK, h, 2, dk).transpose(1, 0, 2, 3, 4, 5)
    key_pos = jnp.arange(s)
    scale = dk ** -0.5

    def one_block(args):
        q_blk, i = args
        sc = jnp.einsum('bqhmd,bkhmd->bhmqk', q_blk, k).astype(jnp.float32) * scale
        q_pos = i * Q_BLOCK + jnp.arange(Q_BLOCK)
        causal = key_pos[None, :] <= q_pos[:, None]
        p = jax.nn.softmax(jnp.where(causal, sc, MASK_VALUE), axis=-1)
        att = p[:, :, 0] - lam * p[:, :, 1]
        return jnp.einsum('bhqk,bkhe->bqhe', att.astype(v.dtype), v)

    out = lax.map(one_block, (q_blocks, jnp.arange(n_blk)))
    out = out.transpose(1, 0, 2, 3, 4).reshape(b, s, h, dv)
    out = _rmsnorm(out, subln_g) * (1.0 - lambda_init)
    return out.reshape(b, s, h * dv)


def _s5(u, a_re, a_im, log_dt, b_re, b_im, c_re, c_im, d_skip, w_glu, b_glu):
    bsz, s, _ = u.shape
    f32 = jnp.float32
    ug = u.reshape(bsz, s, SSM_GROUPS, SSM_GROUP_WIDTH).astype(f32)
    dt = jnp.exp(log_dt.astype(f32))[:, None]
    lam = lax.complex(jnp.minimum(a_re.astype(f32), -1e-4), a_im.astype(f32))
    lam_bar = jnp.exp(lam * dt)
    b_cplx = lax.complex(b_re.astype(f32), b_im.astype(f32))
    b_bar = ((lam_bar - 1.0) / lam)[..., None] * b_cplx
    bu = jnp.einsum('bsgc,gpc->bsgp', ug.astype(jnp.complex64), b_bar)
    a = jnp.broadcast_to(lam_bar[None, None], (1, s, SSM_GROUPS, SSM_STATE))

    def combine(e_i, e_j):
        a_i, x_i = e_i
        a_j, x_j = e_j
        return a_j * a_i, a_j * x_i + x_j

    _, states = lax.associative_scan(combine, (a, bu), axis=1)
    c_cplx = lax.complex(c_re.astype(f32), c_im.astype(f32))
    y = jnp.einsum('bsgp,gcp->bsgc', states, c_cplx).real
    y = y + d_skip.astype(f32).reshape(SSM_GROUPS, SSM_GROUP_WIDTH) * ug
    y = y.reshape(bsz, s, D_SSM).astype(u.dtype)
    z = jax.nn.gelu(y)
    return z * jax.nn.sigmoid(z @ w_glu + b_glu)


def _moe(h, w_router, b_router, w1, b1, w2, b2):
    bsz, s, d = h.shape
    n_tok = bsz * s
    hf = h.reshape(n_tok, d)
    logits = (hf @ w_router + b_router).astype(jnp.float32)
    top_val, top_idx = lax.top_k(logits, TOP_K)
    gates = jax.nn.softmax(top_val, axis=-1)
    m = n_tok * TOP_K
    flat_e = top_idx.reshape(m)
    flat_tok = jnp.arange(m, dtype=jnp.int32) // TOP_K
    flat_gate = gates.reshape(m)
    order = jnp.argsort(flat_e)
    sorted_e = flat_e[order]
    counts = jnp.bincount(flat_e, length=N_EXPERTS)
    padded = ((counts + MOE_BLOCK - 1) // MOE_BLOCK) * MOE_BLOCK
    pend = jnp.cumsum(padded)
    pstart = pend - padded
    ustart = jnp.cumsum(counts) - counts
    dest = pstart[sorted_e] + (jnp.arange(m) - ustart[sorted_e])
    n_blocks = -(-m // MOE_BLOCK) + N_EXPERTS
    n_rows = n_blocks * MOE_BLOCK
    row_tok = jnp.zeros((n_rows,), jnp.int32).at[dest].set(flat_tok[order])
    row_gate = jnp.zeros((n_rows,), jnp.float32).at[dest].set(flat_gate[order])
    block_e = jnp.minimum(
        jnp.searchsorted(pend, jnp.arange(n_blocks) * MOE_BLOCK, side='right'),
        N_EXPERTS - 1)
    x_blocks = hf[row_tok].reshape(n_blocks, MOE_BLOCK, d)

    def expert_block(args):
        xb, e = args
        gu = xb @ w1[e] + b1[e]
        gate, up = jnp.split(gu, 2, axis=-1)
        gate = jnp.minimum(gate, SWIGLU_LIMIT)
        up = jnp.clip(up, -SWIGLU_LIMIT, SWIGLU_LIMIT)
        glu = gate * jax.nn.sigmoid(SWIGLU_ALPHA * gate)
        return ((up + 1.0) * glu) @ w2[e] + b2[e]

    y_rows = lax.map(expert_block, (x_blocks, block_e)).reshape(n_rows, d)
    y_rows = y_rows * row_gate[:, None].astype(y_rows.dtype)
    y = jnp.zeros((n_tok, d), h.dtype).at[row_tok].add(y_rows.astype(h.dtype))
    return y.reshape(bsz, s, d)


def setup_inputs(seed: int = 0) -> dict:
    key = jax.random.key(seed)
    ks = jax.random.split(key, 32)
    f32 = jnp.float32
    L, D, G, P, W = DEPTH, D_MODEL, SSM_GROUPS, SSM_STATE, SSM_GROUP_WIDTH

    def nrm(k, shape, std):
        return jax.random.normal(k, shape, f32) * std

    a_im_base = jnp.pi * jnp.arange(P, dtype=f32)[None, None, :]
    return {
        'x': nrm(ks[0], (BATCH, SEQ, D), 1.0),
        'c': nrm(ks[1], (BATCH, D), 1.0),
        'w_ada': nrm(ks[2], (L, D, 6 * D), 0.5 * D ** -0.5),
        'b_ada': nrm(ks[3], (L, 6 * D), 0.01),
        'norm1_g': 1.0 + nrm(ks[4], (L, D), 0.01),
        'w_in': nrm(ks[5], (L, D, D_IN_PROJ), D ** -0.5),
        'lq1': nrm(ks[6], (L, ATTN_QK_DIM), 0.1),
        'lk1': nrm(ks[7], (L, ATTN_QK_DIM), 0.1),
        'lq2': nrm(ks[8], (L, ATTN_QK_DIM), 0.1),
        'lk2': nrm(ks[9], (L, ATTN_QK_DIM), 0.1),
        'subln_g': 1.0 + nrm(ks[10], (L, ATTN_V_DIM), 0.01),
        'ssm_a_re': -0.5 + nrm(ks[11], (L, G, P), 0.01),
        'ssm_a_im': a_im_base + nrm(ks[12], (L, G, P), 0.01),
        'ssm_log_dt': jax.random.uniform(ks[13], (L, G), f32,
                                         minval=math.log(DT_MIN), maxval=math.log(DT_MAX)),
        'ssm_b_re': nrm(ks[14], (L, G, P, W), (2 * W) ** -0.5),
        'ssm_b_im': nrm(ks[15], (L, G, P, W), (2 * W) ** -0.5),
        'ssm_c_re': nrm(ks[16], (L, G, W, P), (2 * P) ** -0.5),
        'ssm_c_im': nrm(ks[17], (L, G, W, P), (2 * P) ** -0.5),
        'ssm_d': nrm(ks[18], (L, D_SSM), 1.0),
        'w_glu': nrm(ks[19], (L, D_SSM, D_SSM), D_SSM ** -0.5),
        'b_glu': nrm(ks[20], (L, D_SSM), 0.01),
        'w_out': nrm(ks[21], (L, D_MIX, D), D_MIX ** -0.5),
        'norm2_g': 1.0 + nrm(ks[22], (L, D), 0.01),
        'w_router': nrm(ks[23], (L, D, N_EXPERTS), D ** -0.5),
        'b_router': nrm(ks[24], (L, N_EXPERTS), 0.01),
        'w1': nrm(ks[25], (L, N_EXPERTS, D, 2 * D_FF), D ** -0.5),
        'b1': nrm(ks[26], (L, N_EXPERTS, 2 * D_FF), 0.01),
        'w2': nrm(ks[27], (L, N_EXPERTS, D_FF, D), D_FF ** -0.5),
        'b2': nrm(ks[28], (L, N_EXPERTS, D), 0.01),
        'final_g': 1.0 + nrm(ks[29], (D,), 0.01),
    }


def reference(x, c, w_ada, b_ada, norm1_g, w_in, lq1, lk1, lq2, lk2, subln_g,
              ssm_a_re, ssm_a_im, ssm_log_dt, ssm_b_re, ssm_b_im, ssm_c_re, ssm_c_im,
              ssm_d, w_glu, b_glu, w_out, norm2_g, w_router, b_router, w1, b1, w2, b2,
              final_g):
    bsz, s, _ = x.shape
    c_act = jax.nn.silu(c)
    for l in range(DEPTH):
        lambda_init = 0.8 - 0.6 * math.exp(-0.3 * l)
        mod = c_act @ w_ada[l] + b_ada[l]
        sh1, sc1, g1, sh2, sc2, g2 = jnp.split(mod, 6, axis=-1)

        h = _modulate(_rmsnorm(x, norm1_g[l]), sh1, sc1)
        proj = h @ w_in[l]
        q, k, v, u = jnp.split(proj, [D_ATTN, 2 * D_ATTN, 3 * D_ATTN], axis=-1)
        q = q.reshape(bsz, s, ATTN_HEADS, 2, ATTN_QK_DIM)
        k = k.reshape(bsz, s, ATTN_HEADS, 2, ATTN_QK_DIM)
        v = v.reshape(bsz, s, ATTN_HEADS, ATTN_V_DIM)
        lam = (jnp.exp(jnp.sum(lq1[l].astype(jnp.float32) * lk1[l].astype(jnp.float32)))
               - jnp.exp(jnp.sum(lq2[l].astype(jnp.float32) * lk2[l].astype(jnp.float32)))
               + lambda_init)
        attn_out = _diff_attention(q, k, v, lam, lambda_init, subln_g[l])
        ssm_out = _s5(u, ssm_a_re[l], ssm_a_im[l], ssm_log_dt[l], ssm_b_re[l], ssm_b_im[l],
                      ssm_c_re[l], ssm_c_im[l], ssm_d[l], w_glu[l], b_glu[l])
        mix = jnp.concatenate([attn_out, ssm_out.astype(attn_out.dtype)], axis=-1) @ w_out[l]
        x = x + g1[:, None, :] * mix

        h = _modulate(_rmsnorm(x, norm2_g[l]), sh2, sc2)
        x = x + g2[:, None, :] * _moe(h, w_router[l], b_router[l], w1[l], b1[l], w2[l], b2[l])
    return _rmsnorm(x, final_g)
```

```cpp
#include <hip/hip_runtime.h>
#include <hip/hip_bf16.h>
#include <cstdio>
#include <cstdint>
#include <cmath>

#ifndef MK_PER_PHASE
#define MK_PER_PHASE 0
#endif

#ifdef MK_EPI2
#define MK_EPI2V MK_EPI2
#else
#define MK_EPI2V (-1)
#endif
#ifndef MK_DUP
#define MK_DUP (-1)
#endif

#define LAS __attribute__((address_space(3)))
#define GAS __attribute__((address_space(1)))

__device__ __forceinline__ int lane_id_opaque() { int l = (int)__builtin_amdgcn_mbcnt_hi(~0u, __builtin_amdgcn_mbcnt_lo(~0u, 0u)); asm volatile("" : "+v"(l)); return l; }

namespace pg8 {
typedef unsigned short bf16_t;
typedef short bf16x8 __attribute__((ext_vector_type(8)));
typedef float f32x4 __attribute__((ext_vector_type(4)));
typedef unsigned u32x4 __attribute__((ext_vector_type(4)));
typedef float f32x2 __attribute__((ext_vector_type(2)));
typedef int i32x4 __attribute__((ext_vector_type(4)));
typedef int i32x8 __attribute__((ext_vector_type(8)));
typedef int i32x2 __attribute__((ext_vector_type(2)));
constexpr int BM = 256, BK = 64, HALF = 128, HTB = HALF * BK * 2, STAGE_BYTES = 8 * HTB, NXCD = 8, WGM = 8;

__host__ __device__ __forceinline__ int lds_byte(int r, int c) { const int st = (r >> 4) * 2 + (c >> 5), rr = r & 15, cc = c & 31, ob = rr * 64 + cc * 2; return st * 1024 + (ob ^ (((ob >> 9) & 1) << 5)); }
__host__ __device__ __forceinline__ void stage_rc(int b, int& R, int& C) { const int st = b / 1024, sb = b % 1024, swz = sb ^ (((sb >> 9) & 1) << 5); R = (st >> 1) * 16 + swz / 64; C = (st & 1) * 32 + (swz % 64) / 2; }
__host__ __device__ __forceinline__ int perm32(int rho) { const int n = rho >> 4, i = rho & 15; return 8 * (i >> 2) + 4 * n + (i & 3); }

struct Unit { int pm, pn, e; };
struct Gemm { const bf16_t* A; const bf16_t* Bt; int K, lda, ldb; };

struct StaticOrder {
    int nM, nN, nwg, G, c; size_t tA, tB;
    __device__ __forceinline__ void init(int M, int N, int G_, int c_, int lda, int ldb) { nM = M / BM; nN = N / BM; nwg = nM * nN; G = G_; c = c_; tA = (size_t)BM * lda * 2; tB = (size_t)BM * ldb * 2; }
    __device__ __forceinline__ bool next(int i, Unit& u) const {
        const long L = (long)i * G + c; if (L >= nwg) return false;
        int wgid = (int)L; { const int q = nwg / NXCD, r = nwg % NXCD, xcd = wgid % NXCD, off = wgid / NXCD; wgid = (xcd < r ? xcd * (q + 1) : r * (q + 1) + (xcd - r) * q) + off; }
        const int nig = WGM * nN, gid = wgid / nig, fm = gid * WGM, gsz = (nM - fm) < WGM ? (nM - fm) : WGM;
        u.pm = fm + ((wgid % nig) % gsz); u.pn = (wgid % nig) / gsz; u.e = 0; return true;
    }
    __device__ __forceinline__ size_t aoff(const Unit& u) const { return (size_t)u.pm * tA; }
    __device__ __forceinline__ size_t boff(const Unit& u) const { return (size_t)u.pn * tB; }
    __device__ __forceinline__ unsigned rowoff(int, int) const { return 0u; }
};
struct SingleUnit {
    __device__ __forceinline__ bool next(int i, Unit& u) const { if (i > 0) return false; u.pm = 0; u.pn = 0; u.e = 0; return true; }
    __device__ __forceinline__ size_t aoff(const Unit&) const { return 0; }
    __device__ __forceinline__ size_t boff(const Unit&) const { return 0; }
    __device__ __forceinline__ unsigned rowoff(int, int) const { return 0u; }
};

__device__ __forceinline__ unsigned cvt_pk_bf16(float lo, float hi) { unsigned r; asm volatile("v_cvt_pk_bf16_f32 %0, %1, %2" : "=v"(r) : "v"(lo), "v"(hi)); return r; }
__device__ __forceinline__ float sigm(float x) { return __builtin_amdgcn_rcpf(1.0f + __builtin_amdgcn_exp2f(-1.4426950408889634f * x)); }
__device__ __forceinline__ float gelu_tanh(float y) { return y * sigm(1.5957691216057308f * (y + 0.044715f * y * y * y)); }
__device__ __forceinline__ f32x2 gelu_tanh2(f32x2 y) {
    const f32x2 y2 = y * y, u = y * __builtin_elementwise_fma(y2, (f32x2){0.044715f, 0.044715f}, (f32x2){1.f, 1.f}), ea = u * (-1.5957691216057308f * 1.4426950408889634f);
    f32x2 d; d.x = __builtin_amdgcn_exp2f(ea.x); d.y = __builtin_amdgcn_exp2f(ea.y); d = d + 1.0f; f32x2 r; r.x = __builtin_amdgcn_rcpf(d.x); r.y = __builtin_amdgcn_rcpf(d.y); return y * r; }
__device__ __forceinline__ u32x4 pack8(const f32x4& a, const f32x4& b) { u32x4 w; w.x = cvt_pk_bf16(a[0], a[1]); w.y = cvt_pk_bf16(a[2], a[3]); w.z = cvt_pk_bf16(b[0], b[1]); w.w = cvt_pk_bf16(b[2], b[3]); return w; }
__device__ __forceinline__ float clamp_fp8(float v) { return __builtin_amdgcn_fmed3f(v, -448.0f, 448.0f); }
__device__ __forceinline__ i32x2 pack8_fp8(const f32x4& a, const f32x4& c) {
    int w0 = __builtin_amdgcn_cvt_pk_fp8_f32(clamp_fp8(a[0]), clamp_fp8(a[1]), 0, false); w0 = __builtin_amdgcn_cvt_pk_fp8_f32(clamp_fp8(a[2]), clamp_fp8(a[3]), w0, true);
    int w1 = __builtin_amdgcn_cvt_pk_fp8_f32(clamp_fp8(c[0]), clamp_fp8(c[1]), 0, false); w1 = __builtin_amdgcn_cvt_pk_fp8_f32(clamp_fp8(c[2]), clamp_fp8(c[3]), w1, true);
    return (i32x2){w0, w1};
}

struct EpiQKVU {
    static constexpr bool PERM = true, AFTER_DRAIN = false, PROBE2 = (MK_EPI2V == 2);
    bf16_t* QKV; size_t stride; bf16_t* UA; float scale0;
    __device__ __forceinline__ void operator()(const f32x4 (&acc)[2][2][4][2], const Unit& u, int wr, int wc, int fr, int fq) const {
        const int t = u.pn >> 1, colt = (u.pn & 1) * 256 + wc * 32 + 8 * fq, row0 = u.pm * BM + wr * 64 + fr;
        if (t < 3) {
            bf16_t* base = QKV + (size_t)t * stride; const float sc = (t == 0) ? scale0 : 1.f;
#pragma unroll
            for (int ai = 0; ai < 2; ++ai)
#pragma unroll
                for (int m = 0; m < 4; ++m) { bf16_t* rowp = base + (size_t)(row0 + ai * HALF + m * 16) * 512 + colt;
#pragma unroll
                    for (int bj = 0; bj < 2; ++bj) *(u32x4*)(rowp + bj * HALF) = pack8(acc[ai][bj][m][0] * sc, acc[ai][bj][m][1] * sc); }
        } else {
#pragma unroll
            for (int ai = 0; ai < 2; ++ai)
#pragma unroll
                for (int m = 0; m < 4; ++m) { const int r = row0 + ai * HALF + m * 16, b = r >> 12, tt = r & 4095, chunk = tt >> 4, j = tt & 15;
#pragma unroll
                    for (int bj = 0; bj < 2; ++bj) { const int cu = colt + bj * HALF, g = cu >> 4, c0 = cu & 15;
                        *(u32x4*)(UA + ((size_t)((g * 8 + b) * 256 + chunk)) * 384 + j * 16 + c0) = pack8(acc[ai][bj][m][0], acc[ai][bj][m][1]); } }
        }
    }
};
constexpr int XS = 132;
struct EpiX {
    static constexpr bool PERM = false, AFTER_DRAIN = true, PROBE2 = false, HALF_N = true;
    __device__ __forceinline__ void fused(const f32x4 (&acc)[2][2][4][2], const Unit&, int wr, int wc, int fr, int fq, LAS unsigned char* lds, int, int) const {
        LAS float* X = (LAS float*)lds;
#pragma unroll
        for (int ai = 0; ai < 2; ++ai)
#pragma unroll
            for (int m = 0; m < 4; ++m) { const int row = ai * HALF + wr * 64 + m * 16 + fr;
#pragma unroll
                for (int n = 0; n < 2; ++n) *(LAS f32x4*)(X + row * XS + wc * 32 + n * 16 + 4 * fq) = acc[ai][0][m][n]; }
    }
};
struct EpiY {
    static constexpr bool PERM = true, AFTER_DRAIN = false, PROBE2 = false;
    bf16_t* Z; int g, b;
    __device__ __forceinline__ void operator()(const f32x4 (&acc)[2][2][4][2], const Unit&, int wr, int wc, int fr, int fq) const {
#pragma unroll
        for (int ai = 0; ai < 2; ++ai)
#pragma unroll
            for (int m = 0; m < 4; ++m) { const int chunk = ai * HALF + wr * 64 + m * 16 + fr;
#pragma unroll
                for (int bj = 0; bj < 2; ++bj) { const int col0 = bj * HALF + wc * 32 + 8 * fq, s = col0 >> 4, c0 = col0 & 15;
                    f32x4 v0 = acc[ai][bj][m][0], v1 = acc[ai][bj][m][1];
#pragma unroll
                    for (int q = 0; q < 4; q += 2) { const f32x2 a = gelu_tanh2((f32x2){v0[q], v0[q + 1]}), c = gelu_tanh2((f32x2){v1[q], v1[q + 1]}); v0[q] = a.x; v0[q + 1] = a.y; v1[q] = c.x; v1[q + 1] = c.y; }
                    *(u32x4*)(Z + (size_t)(b * 4096 + chunk * 16 + s) * 512 + g * 16 + c0) = pack8(v0, v1); }
                __builtin_amdgcn_sched_barrier(0); }
    }
};
__device__ __forceinline__ float bf_lo(unsigned w) { return __uint_as_float(w << 16); }
__device__ __forceinline__ float bf_hi(unsigned w) { return __uint_as_float(w & 0xffff0000u); }
struct EpiGLU {
    static constexpr bool PERM = true, AFTER_DRAIN = false, PROBE2 = false;
    const bf16_t* Z; bf16_t* MIX; const float* bias;
    __device__ __forceinline__ void operator()(const f32x4 (&acc)[2][2][4][2], const Unit& u, int wr, int wc, int fr, int fq) const {
        const int row0 = u.pm * BM + wr * 64 + fr, col0 = u.pn * BM + wc * 32 + 8 * fq;
        f32x4 bv[2][2];
#pragma unroll
        for (int bj = 0; bj < 2; ++bj)
#pragma unroll
            for (int n = 0; n < 2; ++n) bv[bj][n] = *(const f32x4*)(bias + col0 + bj * HALF + 4 * n);
#pragma unroll
        for (int ai = 0; ai < 2; ++ai)
#pragma unroll
            for (int m = 0; m < 4; ++m) { const size_t row = (size_t)(row0 + ai * HALF + m * 16);
#pragma unroll
                for (int bj = 0; bj < 2; ++bj) { const int col = col0 + bj * HALF; const u32x4 zz = *(const u32x4*)(Z + row * 512 + col);
                    const f32x4 a0 = acc[ai][bj][m][0] + bv[bj][0], a1 = acc[ai][bj][m][1] + bv[bj][1];
                    f32x4 o0, o1;
                    o0[0] = bf_lo(zz.x) * sigm(a0[0]); o0[1] = bf_hi(zz.x) * sigm(a0[1]); o0[2] = bf_lo(zz.y) * sigm(a0[2]); o0[3] = bf_hi(zz.y) * sigm(a0[3]);
                    o1[0] = bf_lo(zz.z) * sigm(a1[0]); o1[1] = bf_hi(zz.z) * sigm(a1[1]); o1[2] = bf_lo(zz.w) * sigm(a1[2]); o1[3] = bf_hi(zz.w) * sigm(a1[3]);
                    *(u32x4*)(MIX + row * 1024 + 512 + col) = pack8(o0, o1); }
                __builtin_amdgcn_sched_barrier(0); }
    }
};
struct EpiOut {
    static constexpr bool PERM = true, AFTER_DRAIN = false, PROBE2 = (MK_EPI2V == 5);
    const float* X; bf16_t* X1; const float* g1; LAS unsigned char* stg;
    __device__ __forceinline__ void operator()(const f32x4 (&acc)[2][2][4][2], const Unit& u, int wr, int wc, int fr, int fq) const {
        const int col0 = wc * 32 + 8 * fq, b = (u.pm * BM) >> 12, t = (wr * 4 + wc) * 64 + fq * 16 + fr, rs = t >> 4, ch = t & 15;
        f32x4 gv[2][2];
#pragma unroll
        for (int bj = 0; bj < 2; ++bj)
#pragma unroll
            for (int n = 0; n < 2; ++n) gv[bj][n] = *(const f32x4*)(g1 + (size_t)b * 6144 + u.pn * BM + col0 + bj * HALF + 4 * n);
        LAS unsigned char* wp = stg + (16 * wr + fr) * 528 + col0 * 2; const LAS unsigned char* rp = stg + rs * 528 + ch * 32;
        const size_t off0 = (size_t)(u.pm * BM + 64 * (rs >> 4) + (rs & 15)) * 1024 + u.pn * BM + 16 * ch;
        f32x4 xv[4], xn[4];
#pragma unroll
        for (int q = 0; q < 4; ++q) xv[q] = *(const f32x4*)(X + off0 + 4 * q);
#pragma unroll
        for (int sidx = 0; sidx < 8; ++sidx) { const int ai = sidx >> 2, m = sidx & 3; const size_t off = off0 + (size_t)(ai * HALF + 16 * m) * 1024;
            if (sidx < 7) { const size_t offn = off0 + (size_t)(((sidx + 1) >> 2) * HALF + 16 * ((sidx + 1) & 3)) * 1024;
#pragma unroll
                for (int q = 0; q < 4; ++q) xn[q] = *(const f32x4*)(X + offn + 4 * q); }
#pragma unroll
            for (int bj = 0; bj < 2; ++bj) *(LAS u32x4*)(wp + bj * 256) = pack8(gv[bj][0] * acc[ai][bj][m][0], gv[bj][1] * acc[ai][bj][m][1]);
            asm volatile("s_waitcnt lgkmcnt(0)" ::: "memory"); __builtin_amdgcn_s_barrier(); asm volatile("" ::: "memory");
            const u32x4 m0 = *(const LAS u32x4*)(rp), m1 = *(const LAS u32x4*)(rp + 16);
            f32x4 o0, o1, o2, o3;
            o0 = xv[0] + (f32x4){bf_lo(m0.x), bf_hi(m0.x), bf_lo(m0.y), bf_hi(m0.y)}; o1 = xv[1] + (f32x4){bf_lo(m0.z), bf_hi(m0.z), bf_lo(m0.w), bf_hi(m0.w)};
            o2 = xv[2] + (f32x4){bf_lo(m1.x), bf_hi(m1.x), bf_lo(m1.y), bf_hi(m1.y)}; o3 = xv[3] + (f32x4){bf_lo(m1.z), bf_hi(m1.z), bf_lo(m1.w), bf_hi(m1.w)};
            *(u32x4*)(X1 + off) = pack8(o0, o1); *(u32x4*)(X1 + off + 8) = pack8(o2, o3);
            asm volatile("s_waitcnt lgkmcnt(0)" ::: "memory"); __builtin_amdgcn_s_barrier(); asm volatile("" ::: "memory");
#pragma unroll
            for (int q = 0; q < 4; ++q) xv[q] = xn[q]; }
    }
};
constexpr float F8_ACT = 4.0f, F8_W = 32.0f, F8_UNDO = 1.0f / (4.0f * 32.0f);
struct EpiMoe1 {
    static constexpr bool PERM = true, AFTER_DRAIN = false, PROBE2 = (MK_EPI2V == 7);
    unsigned char* A2; const float* b1;
    __device__ __forceinline__ void operator()(const f32x4 (&acc)[2][2][4][2], const Unit& u, int wr, int wc, int fr, int fq) const {
        asm volatile("" : "+v"(fr), "+v"(fq));
        const int row0 = u.pm * BM + wr * 64 + fr, jc = u.pn * 128 + wc * 32 + 8 * fq;
        f32x4 bg[2], bu[2];
#pragma unroll
        for (int n = 0; n < 2; ++n) { bg[n] = *(const f32x4*)(b1 + (size_t)u.e * 2048 + jc + 4 * n); bu[n] = *(const f32x4*)(b1 + (size_t)u.e * 2048 + 1024 + jc + 4 * n); }
#pragma unroll
        for (int ai = 0; ai < 2; ++ai)
#pragma unroll
            for (int m = 0; m < 4; ++m) { f32x4 o[2];
#pragma unroll
                for (int n = 0; n < 2; ++n) {
#pragma unroll
                    for (int hq = 0; hq < 2; ++hq) { const f32x2 ag = {acc[ai][0][m][n][2 * hq], acc[ai][0][m][n][2 * hq + 1]}, au = {acc[ai][1][m][n][2 * hq], acc[ai][1][m][n][2 * hq + 1]};
                        const f32x2 vbg = {bg[n][2 * hq], bg[n][2 * hq + 1]}, vbu = {bu[n][2 * hq], bu[n][2 * hq + 1]}, k7 = {7.0f, 7.0f}, km7 = {-7.0f, -7.0f}, kund = {F8_UNDO, F8_UNDO};
                        const f32x2 g = __builtin_elementwise_min(__builtin_elementwise_fma(ag, kund, vbg), k7), uu = __builtin_elementwise_min(__builtin_elementwise_max(__builtin_elementwise_fma(au, kund, vbu), km7), k7);
                        const f32x2 ea = g * (-1.702f * 1.4426950408889634f); f32x2 den; den.x = __builtin_amdgcn_exp2f(ea.x); den.y = __builtin_amdgcn_exp2f(ea.y); den = den + 1.0f;
                        f32x2 sg; sg.x = __builtin_amdgcn_rcpf(den.x); sg.y = __builtin_amdgcn_rcpf(den.y);
                        const f32x2 r = __builtin_elementwise_fma(uu, (f32x2){F8_ACT, F8_ACT}, (f32x2){F8_ACT, F8_ACT}) * (g * sg); o[n][2 * hq] = r.x; o[n][2 * hq + 1] = r.y; } }
                *(i32x2*)(A2 + (size_t)(row0 + ai * HALF + m * 16) * 1024 + jc) = pack8_fp8(o[0], o[1]);
                __builtin_amdgcn_sched_barrier(0); }
    }
};
struct EpiMoe2 {
    static constexpr bool PERM = true, AFTER_DRAIN = false, PROBE2 = (MK_EPI2V == 8);
    unsigned char* Y2; const float* b2; int pm_mask;
    __device__ __forceinline__ void operator()(const f32x4 (&acc)[2][2][4][2], const Unit& u, int wr, int wc, int fr, int fq) const {
        asm volatile("" : "+v"(fr), "+v"(fq));
        const int row0 = (u.pm & pm_mask) * BM + wr * 64 + fr, col0 = u.pn * BM + wc * 32 + 8 * fq;
        f32x4 bv[2][2];
#pragma unroll
        for (int bj = 0; bj < 2; ++bj)
#pragma unroll
            for (int n = 0; n < 2; ++n) bv[bj][n] = *(const f32x4*)(b2 + (size_t)u.e * 1024 + col0 + bj * HALF + 4 * n);
#pragma unroll
        for (int ai = 0; ai < 2; ++ai)
#pragma unroll
            for (int m = 0; m < 4; ++m) { unsigned char* rowp = Y2 + (size_t)(row0 + ai * HALF + m * 16) * 1024 + col0;
#pragma unroll
                for (int bj = 0; bj < 2; ++bj) *(i32x2*)(rowp + bj * HALF) = pack8_fp8((acc[ai][bj][m][0] * F8_UNDO + bv[bj][0]) * 8.0f, (acc[ai][bj][m][1] * F8_UNDO + bv[bj][1]) * 8.0f); }
    }
};

template <class E, class = void> struct epi_half_n { static constexpr bool value = false; };
template <class E> struct epi_half_n<E, decltype((void)E::HALF_N)> { static constexpr bool value = E::HALF_N; };
template <class Epi, class Sched, bool ALIGN_EPI, bool GATHER, bool F8 = false>
__device__ __forceinline__ void gemm_phase(LAS unsigned char* lds, const Gemm g, const Sched& S, const Epi& E, const int wave) {
    const int tid = wave * 64 + lane_id_opaque(), wid = __builtin_amdgcn_readfirstlane(tid >> 6), lane = tid & 63,
              wr = wid >> 2, wc = wid & 3, fr = lane & 15, fq = lane >> 4;
    const int nt = g.K / BK; constexpr bool HN = epi_half_n<Epi>::value;
    unsigned voffB[2], vA[2][2];
#pragma unroll
    for (int i = 0; i < 2; ++i) { int R, C; stage_rc(tid * 16 + i * 8192, R, C); const int Rb = Epi::PERM ? ((R & ~31) + perm32(R & 31)) : R;
        voffB[i] = (unsigned)(Rb * g.ldb + C) * 2u;
#pragma unroll
        for (int h = 0; h < 2; ++h) vA[h][i] = (unsigned)((R + h * HALF) * g.lda + C) * 2u; }
    const size_t kstep = (size_t)(BK * 2);
    const size_t hstepB = (size_t)HALF * g.ldb * 2;
    const unsigned ldsw = (unsigned)wid * 1024u;
    const unsigned ldsbase = (unsigned)__builtin_amdgcn_readfirstlane((int)((unsigned)(uintptr_t)lds + ldsw));
    const int aoff = lds_byte(wr * 64 + fr, fq * 8), boff = lds_byte(wc * 32 + fr, fq * 8);
#define PG8_SA(b, h) (((b) * 2 + (h)) * HTB)
#define PG8_SB(b, h) ((4 + (b) * 2 + (h)) * HTB)
#define PG8_STAGE(bufoff, gbase, voff) do { if constexpr (F8) { _Pragma("unroll") for (int _i = 0; _i < 2; ++_i) { unsigned keep_; \
            asm volatile("s_mov_b32 %0, m0\n\ts_mov_b32 m0, %3\n\ts_nop 0\n\tglobal_load_lds_dwordx4 %1, %2\n\ts_mov_b32 m0, %0" : "=&s"(keep_) : "v"((voff)[_i]), "s"((const char*)(gbase)), "s"(ldsbase + (unsigned)((bufoff) + _i * 8192)) : "memory"); } } \
        else { _Pragma("unroll") for (int _i = 0; _i < 2; ++_i) \
        __builtin_amdgcn_global_load_lds((const unsigned*)((const char*)(gbase) + (voff)[_i]), (LAS unsigned*)(lds + (bufoff) + ldsw + _i * 8192), 16, 0, 0); } } while (0)
#define PG8_LDA(dst, b, h) do { if constexpr (F8) { _Pragma("unroll") for (int m = 0; m < 4; ++m) dst##8[m] = PG8_F8CAT(*(const LAS bf16x8*)(lds + PG8_SA(b, h) + aoff + m * 2048), *(const LAS bf16x8*)(lds + PG8_SA(b, h) + aoff + m * 2048 + 1024)); } \
        else { _Pragma("unroll") for (int m = 0; m < 4; ++m) _Pragma("unroll") for (int k = 0; k < 2; ++k) dst[m][k] = *(const LAS bf16x8*)(lds + PG8_SA(b, h) + aoff + m * 2048 + k * 1024); } } while (0)
#define PG8_LDB(dst, b, h) do { if constexpr (F8) { _Pragma("unroll") for (int n = 0; n < 2; ++n) dst##8[n] = PG8_F8CAT(*(const LAS bf16x8*)(lds + PG8_SB(b, h) + boff + n * 2048), *(const LAS bf16x8*)(lds + PG8_SB(b, h) + boff + n * 2048 + 1024)); } \
        else { _Pragma("unroll") for (int n = 0; n < 2; ++n) _Pragma("unroll") for (int k = 0; k < 2; ++k) dst[n][k] = *(const LAS bf16x8*)(lds + PG8_SB(b, h) + boff + n * 2048 + k * 1024); } } while (0)
#define PG8_F8CAT(lo, hi) __builtin_shufflevector(__builtin_bit_cast(i32x4, (lo)), __builtin_bit_cast(i32x4, (hi)), 0, 1, 2, 3, 4, 5, 6, 7)
#define PG8_MMA(ai, bj, At, Bt) do { __builtin_amdgcn_s_setprio(1); \
        if constexpr (F8) { _Pragma("unroll") for (int m = 0; m < 4; ++m) _Pragma("unroll") for (int n = 0; n < 2; ++n) \
            acc[ai][bj][m][n] = __builtin_amdgcn_mfma_scale_f32_16x16x128_f8f6f4(Bt##8[n], At##8[m], acc[ai][bj][m][n], 0, 0, 0, 0x7F7F7F7F, 0, 0x7F7F7F7F); } \
        else { _Pragma("unroll") for (int m = 0; m < 4; ++m) _Pragma("unroll") for (int n = 0; n < 2; ++n) _Pragma("unroll") for (int k = 0; k < 2; ++k) \
            acc[ai][bj][m][n] = __builtin_amdgcn_mfma_f32_16x16x32_bf16(Bt[n][k], At[m][k], acc[ai][bj][m][n], 0, 0, 0); } \
        __builtin_amdgcn_s_setprio(0); } while (0)
#define PG8_WAIT_V(n) asm volatile("s_waitcnt vmcnt(" #n ")" ::: "memory")
#define PG8_WAIT_L(n) asm volatile("s_waitcnt lgkmcnt(" #n ")" ::: "memory")
#define PG8_BAR __builtin_amdgcn_s_barrier()
#define PG8_SCHED __builtin_amdgcn_sched_barrier(0)
#define PG8_GOFF(u_, h, i) ({ const int tq_ = wid * 64 + lane_id_opaque(); int R_, C_; stage_rc(tq_ * 16 + (i) * 8192, R_, C_); S.rowoff((u_), (h) * HALF + R_) + (unsigned)C_ * 2u; })
    Unit cur, nxt; int ui = 0;
    if (!S.next(0, cur)) return;
    if constexpr (GATHER) {
#pragma unroll
        for (int h = 0; h < 2; ++h)
#pragma unroll
            for (int i = 0; i < 2; ++i) vA[h][i] = PG8_GOFF(0, h, i);
    }
    f32x4 acc[2][2][4][2];
#pragma unroll
    for (int a = 0; a < 2; ++a)
#pragma unroll
        for (int b = 0; b < 2; ++b)
#pragma unroll
            for (int m = 0; m < 4; ++m)
#pragma unroll
                for (int n = 0; n < 2; ++n) acc[a][b][m][n] = (f32x4){0.f, 0.f, 0.f, 0.f};
    bf16x8 At[4][2], B0[2][2], B1[2][2]; i32x8 At8[4], B08[2], B18[2];
    const char* cA = (const char*)g.A + S.aoff(cur); const char* cB = (const char*)g.Bt + S.boff(cur);
    PG8_STAGE(PG8_SB(0, 0), cB, voffB); PG8_STAGE(PG8_SB(0, 1), cB + hstepB, voffB); PG8_STAGE(PG8_SA(0, 0), cA, vA[0]); PG8_STAGE(PG8_SA(0, 1), cA, vA[1]);
    if (wr == 1) PG8_BAR;
    PG8_WAIT_V(2); PG8_BAR;
    PG8_STAGE(PG8_SB(1, 0), cB + kstep, voffB); PG8_STAGE(PG8_SA(1, 0), cA + kstep, vA[0]); PG8_STAGE(PG8_SB(1, 1), cB + hstepB + kstep, voffB);
    PG8_WAIT_V(6); PG8_BAR;
    for (;;) {
        const bool has_next = S.next(ui + 1, nxt);
        const char* nA = has_next ? (const char*)g.A + S.aoff(nxt) : cA; const char* nB = has_next ? (const char*)g.Bt + S.boff(nxt) : cB;
#pragma unroll 1
        for (int t = 0; t < nt; t += 2) {
            const bool last = (t == nt - 2);
            const char* a1 = cA + (size_t)(t + 1) * kstep;
            const char* a2 = last ? nA : cA + (size_t)(t + 2) * kstep; const char* b2 = last ? nB : cB + (size_t)(t + 2) * kstep;
            const char* a3 = a2 + kstep; const char* b3 = b2 + kstep;
            unsigned w0[2], w1[2];
            if constexpr (GATHER) { const bool nx_ = last && has_next;
                if (nx_) { w0[0] = PG8_GOFF(ui + 1, 0, 0); w0[1] = PG8_GOFF(ui + 1, 0, 1); w1[0] = PG8_GOFF(ui + 1, 1, 0); w1[1] = PG8_GOFF(ui + 1, 1, 1); }
                else { w0[0] = vA[0][0]; w0[1] = vA[0][1]; w1[0] = vA[1][0]; w1[1] = vA[1][1]; } }
            else { w0[0] = vA[0][0]; w0[1] = vA[0][1]; w1[0] = vA[1][0]; w1[1] = vA[1][1]; }
            PG8_LDB(B0, 0, 0); if constexpr (!HN) PG8_LDB(B1, 0, 1); PG8_SCHED; PG8_LDA(At, 0, 0); PG8_STAGE(PG8_SA(1, 1), a1, vA[1]);
            PG8_WAIT_V(8); PG8_WAIT_L(0); PG8_BAR; PG8_MMA(0, 0, At, B0); if constexpr (!HN) PG8_MMA(0, 1, At, B1); PG8_BAR; PG8_SCHED;
            PG8_LDA(At, 0, 1); PG8_STAGE(PG8_SB(0, 0), b2, voffB); PG8_STAGE(PG8_SB(0, 1), b2 + hstepB, voffB); PG8_STAGE(PG8_SA(0, 0), a2, w0);
            PG8_WAIT_V(8); PG8_WAIT_L(0); PG8_BAR; PG8_MMA(1, 0, At, B0); if constexpr (!HN) PG8_MMA(1, 1, At, B1); PG8_BAR; PG8_SCHED;
            PG8_LDB(B0, 1, 0); if constexpr (!HN) PG8_LDB(B1, 1, 1); PG8_SCHED; PG8_LDA(At, 1, 0); PG8_STAGE(PG8_SA(0, 1), a2, w1);
            PG8_WAIT_V(8); PG8_WAIT_L(0); PG8_BAR; PG8_MMA(0, 0, At, B0); if constexpr (!HN) PG8_MMA(0, 1, At, B1); PG8_BAR; PG8_SCHED;
            PG8_LDA(At, 1, 1); PG8_STAGE(PG8_SB(1, 0), b3, voffB); PG8_STAGE(PG8_SB(1, 1), b3 + hstepB, voffB); PG8_STAGE(PG8_SA(1, 0), a3, w0);
            PG8_WAIT_V(8); PG8_WAIT_L(0); PG8_BAR; PG8_MMA(1, 0, At, B0); if constexpr (!HN) PG8_MMA(1, 1, At, B1); PG8_BAR; PG8_SCHED;
        }
        if constexpr (ALIGN_EPI) { if (wr == 0) PG8_BAR; }
        if constexpr (!Epi::AFTER_DRAIN) { const int te_ = lane_id_opaque(); const int fre = te_ & 15, fqe = (te_ >> 4) & 3;
            E(acc, cur, wr, wc, fre, fqe);
#ifdef MK_EPI2
            if constexpr (Epi::PROBE2) { asm volatile("" ::: "memory"); E(acc, cur, wr, wc, fr, fq); }
#endif
        }
        if (!has_next) break;
#pragma unroll
        for (int a = 0; a < 2; ++a)
#pragma unroll
            for (int b = 0; b < 2; ++b)
#pragma unroll
                for (int m = 0; m < 4; ++m)
#pragma unroll
                    for (int n = 0; n < 2; ++n) acc[a][b][m][n] = (f32x4){0.f, 0.f, 0.f, 0.f};
        cur = nxt; cA = nA; cB = nB; ++ui;
        if constexpr (GATHER) {
#pragma unroll
            for (int h = 0; h < 2; ++h)
#pragma unroll
                for (int i = 0; i < 2; ++i) vA[h][i] = PG8_GOFF(ui, h, i);
        }
        if constexpr (ALIGN_EPI) { if (wr == 1) PG8_BAR; }
    }
    PG8_WAIT_V(0);
    if constexpr (!ALIGN_EPI) { if (wr == 0) PG8_BAR; }
    PG8_BAR;
    if constexpr (Epi::AFTER_DRAIN) { E.fused(acc, cur, wr, wc, fr, fq, lds, wid, lane); }
#undef PG8_SA
#undef PG8_SB
#undef PG8_STAGE
#undef PG8_LDA
#undef PG8_LDB
#undef PG8_MMA
#undef PG8_GOFF
#undef PG8_F8CAT
#undef PG8_WAIT_V
#undef PG8_WAIT_L
#undef PG8_BAR
#undef PG8_SCHED
}
}

namespace attn_body {
using bf16=__hip_bfloat16;
using bf16x8=__attribute__((ext_vector_type(8)))short;
using s16x4=__attribute__((ext_vector_type(4)))short;
using f32x16=__attribute__((ext_vector_type(16)))float;
using u32x4=__attribute__((ext_vector_type(4)))unsigned;
constexpr int SEQ=4096,D=64,DMI=512,DMO=1024;
constexpr int NW=8,QBLK=32,QB=QBLK*NW,KVBLK=64,NQB=SEQ/QB;
__device__ __forceinline__ int crow(int r,int hi){return (r&3)+8*(r>>2)+4*hi;}
#define SBAR() __builtin_amdgcn_sched_barrier(0)
__device__ __forceinline__ void cmask(f32x16&p0,f32x16&p1,int jb,int qrel,int hi){
  const float NEG=-INFINITY; int kb=64*jb+4*hi;
  #pragma unroll
  for(int r=0;r<16;++r){int kv=kb+(r&3)+8*(r>>2); if(kv>qrel)p0[r]=NEG; if(kv+32>qrel)p1[r]=NEG;}
}
constexpr int NSLOT=3, SLOTB=8192;
constexpr int LDS_K=0, LDS_V=NSLOT*SLOTB, LDS_WS=2*NSLOT*SLOTB, LDS_OST=LDS_WS+NW*64*4, LDS_BYTES=LDS_OST+NW*4096;
constexpr float C2=0.125f*1.4426950408889634f;
__device__ __forceinline__ void glds16(const void*gsrc,unsigned lds_dst){unsigned keep;
  asm volatile("s_mov_b32 %0, m0\n\ts_mov_b32 m0, %2\n\ts_nop 0\n\tglobal_load_lds_dwordx4 %1, off\n\ts_mov_b32 m0, %0":"=&s"(keep):"v"(gsrc),"s"(lds_dst):"memory");}
__device__ __forceinline__ float max3f(float a,float b,float c){float r;asm("v_max3_f32 %0, %1, %2, %3":"=v"(r):"v"(a),"v"(b),"v"(c));return r;}
__device__ __forceinline__ float max2f(float a,float b){float r;asm("v_max_f32_e32 %0, %1, %2":"=v"(r):"v"(a),"v"(b));return r;}
__device__ __forceinline__ float fadd_s(float a,float b){float r;asm("v_add_f32_e32 %0, %1, %2":"=v"(r):"v"(a),"v"(b));return r;}
__device__ __forceinline__ float fsub_s(float a,float b){float r;asm("v_sub_f32_e32 %0, %1, %2":"=v"(r):"v"(a),"v"(b));return r;}
typedef float f32x2_t __attribute__((ext_vector_type(2))); typedef __bf16 bf16x2_t __attribute__((ext_vector_type(2)));
__device__ __forceinline__ unsigned cvtpk_s(float lo,float hi){f32x2_t v={lo,hi};bf16x2_t b=__builtin_convertvector(v,bf16x2_t);return __builtin_bit_cast(unsigned,b);}
#define WAIT_BAR(N) asm volatile("s_waitcnt vmcnt(" #N ") lgkmcnt(0)\n\ts_barrier":::"memory")

__device__ __forceinline__ void qkt(f32x16&p0,f32x16&p1,const char*Kslot,const bf16x8*qr,const f32x16&negm,int r32,int hi){
  const char*kb=Kslot+hi*1024+r32*16;
  #pragma unroll
  for(int d0=0;d0<4;++d0){
    const bf16x8 b0=*reinterpret_cast<const bf16x8*>(kb+d0*2048);
    const bf16x8 b1=*reinterpret_cast<const bf16x8*>(kb+d0*2048+512);
    if(d0==0){p0=__builtin_amdgcn_mfma_f32_32x32x16_bf16(b0,qr[0],negm,0,0,0);p1=__builtin_amdgcn_mfma_f32_32x32x16_bf16(b1,qr[0],negm,0,0,0);}
    else{p0=__builtin_amdgcn_mfma_f32_32x32x16_bf16(b0,qr[d0],p0,0,0,0);p1=__builtin_amdgcn_mfma_f32_32x32x16_bf16(b1,qr[d0],p1,0,0,0);}}
}
typedef __attribute__((address_space(3))) const char* lds_cptr;
typedef short v4i16_t __attribute__((ext_vector_type(4)));
__device__ __forceinline__ void kload8(bf16x8*kf,lds_cptr kp){
  kf[0]=*(const __attribute__((address_space(3))) bf16x8*)(kp);      kf[1]=*(const __attribute__((address_space(3))) bf16x8*)(kp+512);
  kf[2]=*(const __attribute__((address_space(3))) bf16x8*)(kp+2048); kf[3]=*(const __attribute__((address_space(3))) bf16x8*)(kp+2560);
  kf[4]=*(const __attribute__((address_space(3))) bf16x8*)(kp+4096); kf[5]=*(const __attribute__((address_space(3))) bf16x8*)(kp+4608);
  kf[6]=*(const __attribute__((address_space(3))) bf16x8*)(kp+6144); kf[7]=*(const __attribute__((address_space(3))) bf16x8*)(kp+6656);
}
__device__ __forceinline__ void kload2(bf16x8*kf,lds_cptr kp,int j){ kf[2*j]=*(const __attribute__((address_space(3))) bf16x8*)(kp+j*2048); kf[2*j+1]=*(const __attribute__((address_space(3))) bf16x8*)(kp+j*2048+512); }
__device__ __forceinline__ s16x4 vtr(lds_cptr p){ return __builtin_bit_cast(s16x4,__builtin_amdgcn_ds_read_tr16_b64_v4i16((__attribute__((address_space(3))) v4i16_t*)p)); }
__device__ __forceinline__ float rowmax(const f32x16&p0,const f32x16&p1){
  float a=max3f(p0[0],p0[1],p1[0]),b=max3f(p0[2],p0[3],p1[1]);a=max3f(a,p1[2],p1[3]);
  #pragma unroll
  for(int r=4;r<16;r+=4){a=max3f(a,p0[r],p0[r+1]);b=max3f(b,p0[r+2],p0[r+3]);a=max3f(a,p1[r],p1[r+1]);b=max3f(b,p1[r+2],p1[r+3]);}
  const float m=max2f(a,b);
  auto rr=__builtin_amdgcn_permlane32_swap(__float_as_uint(m),__float_as_uint(m),false,false);
  return max2f(__uint_as_float(rr[0]),__uint_as_float(rr[1]));
}
__device__ __forceinline__ void pv(f32x16*o,int vb,bf16x8 pa0,bf16x8 pa1,bf16x8 pa2,bf16x8 pa3){
  #pragma unroll
  for(int d0=0;d0<2;++d0){s16x4 lo[4],hi[4];
    #pragma unroll
    for(int ks=0;ks<4;++ks){
      asm volatile("ds_read_b64_tr_b16 %0,%1 offset:%c2":"=&v"(lo[ks]):"v"(vb),"i"(d0*4096+ks*1024):"memory");
      asm volatile("ds_read_b64_tr_b16 %0,%1 offset:%c2":"=&v"(hi[ks]):"v"(vb),"i"(d0*4096+ks*1024+512):"memory");}
    asm volatile("s_waitcnt lgkmcnt(0)":::"memory");SBAR();
    #define PK(k) (bf16x8){lo[k][0],lo[k][1],lo[k][2],lo[k][3],hi[k][0],hi[k][1],hi[k][2],hi[k][3]}
    o[d0]=__builtin_amdgcn_mfma_f32_32x32x16_bf16(pa0,PK(0),o[d0],0,0,0);
    o[d0]=__builtin_amdgcn_mfma_f32_32x32x16_bf16(pa1,PK(1),o[d0],0,0,0);
    o[d0]=__builtin_amdgcn_mfma_f32_32x32x16_bf16(pa2,PK(2),o[d0],0,0,0);
    o[d0]=__builtin_amdgcn_mfma_f32_32x32x16_bf16(pa3,PK(3),o[d0],0,0,0);
    #undef PK
  }
}
#define ATTN_STORE16(p,v) (*(u32x4*)(p)=(v))
template<int THRL> __device__ __forceinline__ void attn_unit(int qb,const bf16*Qh,const bf16*__restrict__ Kh,const bf16*__restrict__ Vh,bf16*Oh,char*shm){
  int tid_=threadIdx.x; asm volatile("":"+v"(tid_));
  const int tid=tid_,lane=tid&63,r32=lane&31,hi=lane>>5; const int wid=__builtin_amdgcn_readfirstlane(tid>>6);
  const int q0=qb*QB;
  const bf16*Qw=Qh+(long)(q0+wid*QBLK)*DMI;
  const unsigned lds0=(unsigned)(uintptr_t)shm;
  float*wsf=(float*)(shm+LDS_WS)+wid*64;
  const bf16*ksrc=Kh+(long)lane*DMI+wid*8;
  const bf16*vsrc=Vh+(long)(16*(wid&3)+(lane>>2))*DMI+(wid>>2)*32+(lane&3)*8;
  const unsigned kdst=lds0+LDS_K+wid*1024, vdst=lds0+LDS_V+wid*1024;
  #define DMA_K(t,slot) glds16(ksrc+(long)(t)*KVBLK*DMI,(unsigned)__builtin_amdgcn_readfirstlane(kdst+(slot)))
  #define DMA_V(t,slot) glds16(vsrc+(long)(t)*KVBLK*DMI,(unsigned)__builtin_amdgcn_readfirstlane(vdst+(slot)))
  const int vb0=(int)(lds0+LDS_V)+((lane>>4)&1)*32+(lane&3)*8+(4*hi+((lane&15)>>2))*64;
  const char*Kbase=shm+LDS_K; bf16x8 kf[8];
  const lds_cptr shm3=(lds_cptr)shm; const lds_cptr kp0=shm3+LDS_K+hi*1024+r32*16; const lds_cptr vp0=shm3+LDS_V+((lane>>4)&1)*32+(lane&3)*8+(4*hi+((lane&15)>>2))*64;
  const int NT=(q0+QB)/KVBLK;
  DMA_K(0,0);DMA_V(0,0);DMA_K(1,SLOTB);
  bf16x8 qr[4];
  #pragma unroll
  for(int d0=0;d0<4;++d0)qr[d0]=*reinterpret_cast<const bf16x8*>(&Qw[(long)r32*DMI+d0*16+hi*8]);
  float mhat=0.f,l_reg=0.f;f32x16 o[2];o[0]=f32x16{};o[1]=f32x16{};f32x16 negm=f32x16{};asm volatile("":"+v"(negm));
  const int qrel=wid*QBLK+r32;
  #define CMASK(P0,P1,t) do{int jb_=(t)-(NT-4); if(jb_>=0)cmask(P0,P1,jb_,qrel,hi);}while(0)
  bool resc=false;
  #define START(P0,P1) do{ const float rm=rowmax(P0,P1); resc=false; \
    { const float dl=rm; mhat=fadd_s(mhat,dl); \
      _Pragma("unroll") for(int r=0;r<16;++r){P0[r]=fsub_s(P0[r],dl);P1[r]=fsub_s(P1[r],dl);} \
      _Pragma("unroll") for(int r=0;r<16;++r)negm[r]=-mhat; asm volatile("":"+v"(negm)); } \
    _Pragma("unroll") for(int r=0;r<16;++r)P0[r]=__builtin_amdgcn_exp2f(P0[r]); }while(0)
  #define RESC() do{ if(resc){ asm volatile("s_waitcnt lgkmcnt(0)":::"memory"); \
      _Pragma("unroll") for(int d_=0;d_<2;++d_) _Pragma("unroll") for(int r=0;r<16;++r)o[d_][r]*=wsf[crow(r,hi)]; } }while(0)
  f32x16 pA0,pA1,pB0,pB1;
  int sl_prev=0,sl_cur=0,sl_next=SLOTB;
  #define ROT() do{sl_prev=sl_cur;sl_cur=sl_next;sl_next=(sl_next==(NSLOT-1)*SLOTB)?0:sl_next+SLOTB;}while(0)
  DMA_K(2,2*SLOTB);
  WAIT_BAR(3);
  qkt(pA0,pA1,Kbase,qr,negm,r32,hi);asm volatile("s_nop 15\n\ts_nop 7":"+v"(pA0),"+v"(pA1));CMASK(pA0,pA1,0);
  START(pA0,pA1);
  _Pragma("unroll") for(int r=0;r<16;++r)pA1[r]=__builtin_amdgcn_exp2f(pA1[r]);
  WAIT_BAR(0);
  DMA_K(3,0);DMA_V(1,SLOTB);
  ROT();
  kload8(kf,kp0+sl_cur);
  WAIT_BAR(2);
  s16x4 vlo[8],vhi[8]; u32x4 pw0,pw1,pw2,pw3;
  #define PKW(P,B) cvtpk_s(P[B],P[B+1])
  #define PAF(k) __builtin_bit_cast(bf16x8,pw##k)
  #define VFR(i) (bf16x8){vlo[i][0],vlo[i][1],vlo[i][2],vlo[i][3],vhi[i][0],vhi[i][1],vhi[i][2],vhi[i][3]}
  #define PIN(x) asm volatile("":"+v"(x))
  #define MX3(a,b,c) __builtin_fmaxf(__builtin_fmaxf((a),(b)),(c))
  #define GAPA(MF,A0,A1,A2,A3,W0,W1,PW) do{ MF; sacc+=A0; sacc+=A1; sacc+=A2; sacc+=A3; PIN(sacc); W0; W1; PIN(PW); SBAR(); }while(0)
  #define EX(v) __builtin_amdgcn_exp2f(v)
  #define GAPB(MF,X,B) do{ MF; X[B]=EX(X[B]); X[B+1]=EX(X[B+1]); X[B+2]=EX(X[B+2]); X[B+3]=EX(X[B+3]); PIN(X); SBAR(); }while(0)
  #define VRD(i) do{ vlo[i]=vtr(vp_+(((i)>>2)*4096+((i)&3)*1024)); vhi[i]=vtr(vp_+(((i)>>2)*4096+((i)&3)*1024+512)); }while(0)
  #define KRD(G,j) do{ if(G){ kload2(kf,kp0+sl_next,j); SBAR(); } }while(0)
  #define STEP(C0,C1,P0,P1,t,GK,GV,GL) do{ SBAR(); \
    const lds_cptr vp_=vp0+sl_prev; \
    VRD(0); SBAR(); float sacc=(P0[0]+P0[1]); \
    GAPA(C0=__builtin_amdgcn_mfma_f32_32x32x16_bf16(kf[0],qr[0],negm,0,0,0), P0[2],P0[3],P0[4],P0[5],     pw0[0]=PKW(P0,0), pw0[1]=PKW(P0,2), pw0); \
    VRD(4); SBAR(); GAPA(C1=__builtin_amdgcn_mfma_f32_32x32x16_bf16(kf[1],qr[0],negm,0,0,0), P0[6],P0[7],P0[8],P0[9],     pw0[2]=PKW(P0,4), pw0[3]=PKW(P0,6), pw0); \
    VRD(1); SBAR(); GAPA(C0=__builtin_amdgcn_mfma_f32_32x32x16_bf16(kf[2],qr[1],C0,0,0,0),   P0[10],P0[11],P0[12],P0[13], pw1[0]=PKW(P0,8), pw1[1]=PKW(P0,10), pw1); \
    VRD(5); SBAR(); GAPA(C1=__builtin_amdgcn_mfma_f32_32x32x16_bf16(kf[3],qr[1],C1,0,0,0),   P0[14],P0[15],P1[0],P1[1],   pw1[2]=PKW(P0,12),pw1[3]=PKW(P0,14), pw1); \
    VRD(2); SBAR(); GAPA(C0=__builtin_amdgcn_mfma_f32_32x32x16_bf16(kf[4],qr[2],C0,0,0,0),   P1[2],P1[3],P1[4],P1[5],     pw2[0]=PKW(P1,0), pw2[1]=PKW(P1,2), pw2); \
    VRD(6); SBAR(); GAPA(C1=__builtin_amdgcn_mfma_f32_32x32x16_bf16(kf[5],qr[2],C1,0,0,0),   P1[6],P1[7],P1[8],P1[9],     pw2[2]=PKW(P1,4), pw2[3]=PKW(P1,6), pw2); \
    VRD(3); SBAR(); GAPA(C0=__builtin_amdgcn_mfma_f32_32x32x16_bf16(kf[6],qr[3],C0,0,0,0),   P1[10],P1[11],P1[12],P1[13], pw3[0]=PKW(P1,8), pw3[1]=PKW(P1,10), pw3); \
    VRD(7); SBAR(); GAPA(C1=__builtin_amdgcn_mfma_f32_32x32x16_bf16(kf[7],qr[3],C1,0,0,0),   P1[14],P1[15],0.f,0.f,       pw3[2]=PKW(P1,12),pw3[3]=PKW(P1,14), pw3); \
    l_reg+=sacc; \
    if(GK){DMA_K((t)+3,sl_cur);} if(GV){DMA_V((t)+1,sl_next);} \
    CMASK(C0,C1,t); \
    { float a=MX3(C0[0],C0[1],C1[0]),b=MX3(C0[2],C0[3],C1[1]); a=MX3(a,C1[2],C1[3]); \
      _Pragma("unroll") for(int r=4;r<16;r+=4){a=MX3(a,C0[r],C0[r+1]);b=MX3(b,C0[r+2],C0[r+3]);a=MX3(a,C1[r],C1[r+1]);b=MX3(b,C1[r+2],C1[r+3]);} \
      float rm=__builtin_fmaxf(a,b); { auto rr=__builtin_amdgcn_permlane32_swap(__float_as_uint(rm),__float_as_uint(rm),false,false); rm=__builtin_fmaxf(__uint_as_float(rr[0]),__uint_as_float(rr[1])); } \
      resc=false; \
      if(__builtin_expect(__any(rm>(float)THRL),0)){ const float dl=__builtin_fmaxf(rm,0.f); mhat+=dl; \
        _Pragma("unroll") for(int r=0;r<16;++r){C0[r]-=dl;C1[r]-=dl;} \
        _Pragma("unroll") for(int r=0;r<16;++r)negm[r]=-mhat; asm volatile("":"+v"(negm)); \
        const float f=__builtin_amdgcn_exp2f(-dl); l_reg*=f; if(hi==0)wsf[r32]=f; resc=true; } } \
    SBAR(); \
    GAPB(o[0]=__builtin_amdgcn_mfma_f32_32x32x16_bf16(PAF(0),VFR(0),o[0],0,0,0), C0,0); \
    GAPB(o[1]=__builtin_amdgcn_mfma_f32_32x32x16_bf16(PAF(0),VFR(4),o[1],0,0,0), C0,4); \
    KRD(GL,0); GAPB(o[0]=__builtin_amdgcn_mfma_f32_32x32x16_bf16(PAF(1),VFR(1),o[0],0,0,0), C0,8); \
    KRD(GL,1); GAPB(o[1]=__builtin_amdgcn_mfma_f32_32x32x16_bf16(PAF(1),VFR(5),o[1],0,0,0), C0,12); \
    KRD(GL,2); GAPB(o[0]=__builtin_amdgcn_mfma_f32_32x32x16_bf16(PAF(2),VFR(2),o[0],0,0,0), C1,0); \
    KRD(GL,3); GAPB(o[1]=__builtin_amdgcn_mfma_f32_32x32x16_bf16(PAF(2),VFR(6),o[1],0,0,0), C1,4); \
    GAPB(o[0]=__builtin_amdgcn_mfma_f32_32x32x16_bf16(PAF(3),VFR(3),o[0],0,0,0), C1,8); \
    GAPB(o[1]=__builtin_amdgcn_mfma_f32_32x32x16_bf16(PAF(3),VFR(7),o[1],0,0,0), C1,12); \
    }while(0)
  int t=1;
  #undef CMASK
  #define CMASK(P0,P1,t) do{}while(0)
  for(;t+5<NT;t+=2){
    STEP(pB0,pB1,pA0,pA1,t,true,true,true);     WAIT_BAR(2); RESC(); ROT();
    STEP(pA0,pA1,pB0,pB1,t+1,true,true,true);   WAIT_BAR(2); RESC(); ROT();
  }
  #undef CMASK
  #define CMASK(P0,P1,t) do{int jb_=(t)-(NT-4); if(jb_>=0)cmask(P0,P1,jb_,qrel,hi);}while(0)
  #define ENDW(tt) do{ if((tt)+3<NT){WAIT_BAR(2);} else if((tt)+2<NT){WAIT_BAR(1);} else {WAIT_BAR(0);} }while(0)
  for(;t+1<NT;t+=2){
    STEP(pB0,pB1,pA0,pA1,t,(t+3<NT),(t+1<NT),(t+1<NT));       ENDW(t);   RESC(); ROT();
    STEP(pA0,pA1,pB0,pB1,t+1,(t+4<NT),(t+2<NT),(t+2<NT));     ENDW(t+1); RESC(); ROT();
  }
  STEP(pB0,pB1,pA0,pA1,NT-1,false,false,false); RESC();
  { float sacc=pB0[0]+pB0[1]; _Pragma("unroll") for(int r=2;r<16;++r)sacc+=pB0[r]; _Pragma("unroll") for(int r=0;r<16;++r)sacc+=pB1[r]; l_reg+=sacc;
    pw0=(u32x4){PKW(pB0,0),PKW(pB0,2),PKW(pB0,4),PKW(pB0,6)};pw1=(u32x4){PKW(pB0,8),PKW(pB0,10),PKW(pB0,12),PKW(pB0,14)};pw2=(u32x4){PKW(pB1,0),PKW(pB1,2),PKW(pB1,4),PKW(pB1,6)};pw3=(u32x4){PKW(pB1,8),PKW(pB1,10),PKW(pB1,12),PKW(pB1,14)};
    SBAR(); pv(o,vb0+sl_cur,PAF(0),PAF(1),PAF(2),PAF(3)); }
  #undef PKW
  #undef PAF
  #undef VFR
  #undef PIN
  #undef MX3
  #undef GAPA
  #undef GAPB
  #undef EX
  #undef VRD
  #undef KRD
  #undef STEP
  #undef ENDW
  {auto rr=__builtin_amdgcn_permlane32_swap(__float_as_uint(l_reg),__float_as_uint(l_reg),false,false);l_reg=__uint_as_float(rr[0])+__uint_as_float(rr[1]);}
  if(hi==0)wsf[32+r32]=l_reg;asm volatile("s_waitcnt lgkmcnt(0)":::"memory");
  float rli[16];
  #pragma unroll
  for(int r=0;r<16;++r)rli[r]=__builtin_amdgcn_rcpf(wsf[32+crow(r,hi)]);
  bf16*Ow=Oh+(long)(q0+wid*QBLK)*DMO;
  { bf16*stg=(bf16*)(shm+LDS_OST)+wid*2048;
    #pragma unroll
    for(int r=0;r<16;++r){const int orow=crow(r,hi);
      #pragma unroll
      for(int d0=0;d0<2;++d0)stg[orow*64+d0*32+r32]=__float2bfloat16(o[d0][r]*rli[r]);}
    asm volatile("s_waitcnt lgkmcnt(0)":::"memory");
    #pragma unroll
    for(int i=0;i<4;++i){const int row=i*8+(lane>>3),ch=lane&7; const u32x4 v=*(const u32x4*)(stg+row*64+ch*8); ATTN_STORE16(Ow+(long)row*DMO+ch*8,v);} }
  asm volatile("s_waitcnt lgkmcnt(0)\n\ts_barrier":::"memory");
  #undef DMA_K
  #undef DMA_V
  #undef CMASK
  #undef START
  #undef RESC
  #undef ROT
}
constexpr int LDS2_K=0, LDS2_V=4*SLOTB, LDS2_WS=LDS2_V+NSLOT*2*SLOTB, LDS2_OST=LDS2_WS+NW*64*4, LDS2_BYTES=LDS2_OST+NW*8192;
__device__ __forceinline__ void pv4(f32x16*o,int vb,bf16x8 pa0,bf16x8 pa1,bf16x8 pa2,bf16x8 pa3){
  #pragma unroll
  for(int d0=0;d0<4;++d0){s16x4 lo[4],hi[4];
    #pragma unroll
    for(int ks=0;ks<4;++ks){
      asm volatile("ds_read_b64_tr_b16 %0,%1 offset:%c2":"=&v"(lo[ks]):"v"(vb),"i"(d0*4096+ks*1024):"memory");
      asm volatile("ds_read_b64_tr_b16 %0,%1 offset:%c2":"=&v"(hi[ks]):"v"(vb),"i"(d0*4096+ks*1024+512):"memory");}
    asm volatile("s_waitcnt lgkmcnt(0)":::"memory");SBAR();
    #define PK(k) (bf16x8){lo[k][0],lo[k][1],lo[k][2],lo[k][3],hi[k][0],hi[k][1],hi[k][2],hi[k][3]}
    o[d0]=__builtin_amdgcn_mfma_f32_32x32x16_bf16(pa0,PK(0),o[d0],0,0,0);
    o[d0]=__builtin_amdgcn_mfma_f32_32x32x16_bf16(pa1,PK(1),o[d0],0,0,0);
    o[d0]=__builtin_amdgcn_mfma_f32_32x32x16_bf16(pa2,PK(2),o[d0],0,0,0);
    o[d0]=__builtin_amdgcn_mfma_f32_32x32x16_bf16(pa3,PK(3),o[d0],0,0,0);
    #undef PK
  }
}
template<int THRL> __device__ __forceinline__ void attn_unit2(int qb,const bf16*Qh,const bf16*__restrict__ Kh,const bf16*__restrict__ Vh,bf16*Oh,char*shm,const int wave){
  const int tid=wave*64+lane_id_opaque(),lane=tid&63,r32=lane&31,hi=lane>>5; const int wid=__builtin_amdgcn_readfirstlane(tid>>6);
  const int q0=qb*QB;
  const bf16*Qw=Qh+(long)(q0+wid*QBLK)*DMI;
  const unsigned lds0=(unsigned)(uintptr_t)shm;
  float*wsf=(float*)(shm+LDS2_WS)+wid*64;
  const bf16*ksrc=Kh+(long)lane*DMI+wid*8;
  const bf16*vsrc=Vh+(long)(16*(wid&3)+(lane>>2))*DMI+(wid>>2)*32+(lane&3)*8;
  const unsigned kdst=lds0+LDS2_K+wid*1024, vdst=lds0+LDS2_V+(wid>>2)*4096+(wid&3)*1024;
  #define DMA_K(t,slot) glds16(ksrc+(long)(t)*KVBLK*DMI,(unsigned)__builtin_amdgcn_readfirstlane(kdst+(slot)))
  #define DMA_V(t,slot) do{ glds16(vsrc+(long)(t)*KVBLK*DMI,(unsigned)__builtin_amdgcn_readfirstlane(vdst+2*(slot))); glds16(vsrc+(long)(t)*KVBLK*DMI+64,(unsigned)__builtin_amdgcn_readfirstlane(vdst+2*(slot)+8192)); }while(0)
  const int vb0=(int)(lds0+LDS2_V)+((lane>>4)&1)*32+(lane&3)*8+(4*hi+((lane&15)>>2))*64;
  const char*Kbase=shm+LDS2_K; bf16x8 kf[8];
  const lds_cptr shm3=(lds_cptr)shm; const lds_cptr kp0=shm3+LDS2_K+hi*1024+r32*16; const lds_cptr vp0=shm3+LDS2_V+((lane>>4)&1)*32+(lane&3)*8+(4*hi+((lane&15)>>2))*64;
  const int NT=(q0+QB)/KVBLK;
  DMA_K(0,0);DMA_V(0,0);DMA_K(1,SLOTB);DMA_K(2,2*SLOTB);
  bf16x8 qr[4];
  #pragma unroll
  for(int d0=0;d0<4;++d0)qr[d0]=*reinterpret_cast<const bf16x8*>(&Qw[(long)r32*DMI+d0*16+hi*8]);
  float zf_=0.f; asm volatile("":"+v"(zf_)); f32x16 zz_; _Pragma("unroll") for(int r=0;r<16;++r)zz_[r]=zf_;
  float mhat=0.f,l_reg=0.f;f32x16 o[4];o[0]=zz_;o[1]=zz_;o[2]=zz_;o[3]=zz_;f32x16 negm=zz_;asm volatile("":"+v"(negm));
  const int qrel=wid*QBLK+r32;
  #define CMASK(P0,P1,t) do{int jb_=(t)-(NT-4); if(jb_>=0)cmask(P0,P1,jb_,qrel,hi);}while(0)
  bool resc=false;
  #define START(P0,P1) do{ const float rm=rowmax(P0,P1); resc=false; \
    { const float dl=rm; mhat=fadd_s(mhat,dl); \
      _Pragma("unroll") for(int r=0;r<16;++r){P0[r]=fsub_s(P0[r],dl);P1[r]=fsub_s(P1[r],dl);} \
      _Pragma("unroll") for(int r=0;r<16;++r)negm[r]=-mhat; asm volatile("":"+v"(negm)); } \
    _Pragma("unroll") for(int r=0;r<16;++r)P0[r]=__builtin_amdgcn_exp2f(P0[r]); }while(0)
  #define RESC() do{ if(resc){ asm volatile("s_waitcnt lgkmcnt(0)":::"memory"); \
      _Pragma("unroll") for(int d_=0;d_<4;++d_) _Pragma("unroll") for(int r=0;r<16;++r)o[d_][r]*=wsf[crow(r,hi)]; } }while(0)
  f32x16 pA0,pA1,pB0,pB1;
  int sl_prev=0,sl_cur=0,sl_next=SLOTB;
  int kc=0,kn=SLOTB,kp=3*SLOTB;
  #define ROT() do{sl_prev=sl_cur;sl_cur=sl_next;sl_next=(sl_next==(NSLOT-1)*SLOTB)?0:sl_next+SLOTB; kp=kc;kc=kn;kn=(kn==3*SLOTB)?0:kn+SLOTB;}while(0)
  WAIT_BAR(4);
  qkt(pA0,pA1,Kbase,qr,negm,r32,hi);asm volatile("s_nop 15\n\ts_nop 7":"+v"(pA0),"+v"(pA1));CMASK(pA0,pA1,0);
  START(pA0,pA1);
  _Pragma("unroll") for(int r=0;r<16;++r)pA1[r]=__builtin_amdgcn_exp2f(pA1[r]);
  DMA_K(3,3*SLOTB);DMA_V(1,SLOTB);
  WAIT_BAR(3);
  ROT();
  kload2(kf,kp0+kc,0); kload2(kf,kp0+kc,1);
  s16x4 vlo[16],vhi[16]; u32x4 pw0,pw1,pw2,pw3;
  #define PKW(P,B) cvtpk_s(P[B],P[B+1])
  #define PAF(k) __builtin_bit_cast(bf16x8,pw##k)
  #define VFR(i) (bf16x8){vlo[i][0],vlo[i][1],vlo[i][2],vlo[i][3],vhi[i][0],vhi[i][1],vhi[i][2],vhi[i][3]}
  #define PIN(x) asm volatile("":"+v"(x))
  #define MX3(a,b,c) __builtin_fmaxf(__builtin_fmaxf((a),(b)),(c))
  #define GAPA(MF,A0,A1,A2,A3,W0,W1,PW) do{ MF; sacc+=A0; sacc+=A1; sacc+=A2; sacc+=A3; PIN(sacc); W0; W1; PIN(PW); SBAR(); }while(0)
  #define EX(v) __builtin_amdgcn_exp2f(v)
  #define GAPB(MF,X,B) do{ MF; X[B]=EX(X[B]); X[B+1]=EX(X[B+1]); PIN(X); SBAR(); }while(0)
  #define VRD(i) do{ vlo[i]=vtr(vp_+(((i)>>2)*4096+((i)&3)*1024)); vhi[i]=vtr(vp_+(((i)>>2)*4096+((i)&3)*1024+512)); }while(0)
  #define STEP(C0,C1,P0,P1,t,GK,GV,GL) do{ SBAR(); \
    const lds_cptr vp_=vp0+2*sl_prev; \
    VRD(0); SBAR(); float sacc=(P0[0]+P0[1]); \
    GAPA(C0=__builtin_amdgcn_mfma_f32_32x32x16_bf16(kf[0],qr[0],negm,0,0,0), P0[2],P0[3],P0[4],P0[5],     pw0[0]=PKW(P0,0), pw0[1]=PKW(P0,2), pw0); \
    VRD(4); kload2(kf,kp0+kc,2); SBAR(); GAPA(C1=__builtin_amdgcn_mfma_f32_32x32x16_bf16(kf[1],qr[0],negm,0,0,0), P0[6],P0[7],P0[8],P0[9],     pw0[2]=PKW(P0,4), pw0[3]=PKW(P0,6), pw0); \
    VRD(1); SBAR(); GAPA(C0=__builtin_amdgcn_mfma_f32_32x32x16_bf16(kf[2],qr[1],C0,0,0,0),   P0[10],P0[11],P0[12],P0[13], pw1[0]=PKW(P0,8), pw1[1]=PKW(P0,10), pw1); \
    VRD(5); kload2(kf,kp0+kc,3); SBAR(); GAPA(C1=__builtin_amdgcn_mfma_f32_32x32x16_bf16(kf[3],qr[1],C1,0,0,0),   P0[14],P0[15],P1[0],P1[1],   pw1[2]=PKW(P0,12),pw1[3]=PKW(P0,14), pw1); \
    VRD(2); SBAR(); GAPA(C0=__builtin_amdgcn_mfma_f32_32x32x16_bf16(kf[4],qr[2],C0,0,0,0),   P1[2],P1[3],P1[4],P1[5],     pw2[0]=PKW(P1,0), pw2[1]=PKW(P1,2), pw2); \
    VRD(6); SBAR(); GAPA(C1=__builtin_amdgcn_mfma_f32_32x32x16_bf16(kf[5],qr[2],C1,0,0,0),   P1[6],P1[7],P1[8],P1[9],     pw2[2]=PKW(P1,4), pw2[3]=PKW(P1,6), pw2); \
    VRD(3); SBAR(); GAPA(C0=__builtin_amdgcn_mfma_f32_32x32x16_bf16(kf[6],qr[3],C0,0,0,0),   P1[10],P1[11],P1[12],P1[13], pw3[0]=PKW(P1,8), pw3[1]=PKW(P1,10), pw3); \
    VRD(7); SBAR(); GAPA(C1=__builtin_amdgcn_mfma_f32_32x32x16_bf16(kf[7],qr[3],C1,0,0,0),   P1[14],P1[15],0.f,0.f,       pw3[2]=PKW(P1,12),pw3[3]=PKW(P1,14), pw3); \
    l_reg+=sacc; \
    if(GK){DMA_K((t)+3,kp);} if(GV){DMA_V((t)+1,sl_next);} \
    CMASK(C0,C1,t); \
    { float a=MX3(C0[0],C0[1],C1[0]),b=MX3(C0[2],C0[3],C1[1]); a=MX3(a,C1[2],C1[3]); \
      _Pragma("unroll") for(int r=4;r<16;r+=4){a=MX3(a,C0[r],C0[r+1]);b=MX3(b,C0[r+2],C0[r+3]);a=MX3(a,C1[r],C1[r+1]);b=MX3(b,C1[r+2],C1[r+3]);} \
      float rm=__builtin_fmaxf(a,b); { auto rr=__builtin_amdgcn_permlane32_swap(__float_as_uint(rm),__float_as_uint(rm),false,false); rm=__builtin_fmaxf(__uint_as_float(rr[0]),__uint_as_float(rr[1])); } \
      resc=false; \
      if(__builtin_expect(__any(rm>(float)THRL),0)){ const float dl=__builtin_fmaxf(rm,0.f); mhat+=dl; \
        _Pragma("unroll") for(int r=0;r<16;++r){C0[r]-=dl;C1[r]-=dl;} \
        _Pragma("unroll") for(int r=0;r<16;++r)negm[r]=-mhat; asm volatile("":"+v"(negm)); \
        const float f=__builtin_amdgcn_exp2f(-dl); l_reg*=f; if(hi==0)wsf[r32]=f; resc=true; } } \
    SBAR(); \
    VRD(8);  SBAR(); GAPB(o[0]=__builtin_amdgcn_mfma_f32_32x32x16_bf16(PAF(0),VFR(0),o[0],0,0,0), C0,0); \
    VRD(12); SBAR(); GAPB(o[1]=__builtin_amdgcn_mfma_f32_32x32x16_bf16(PAF(0),VFR(4),o[1],0,0,0), C0,2); \
    VRD(9);  SBAR(); GAPB(o[0]=__builtin_amdgcn_mfma_f32_32x32x16_bf16(PAF(1),VFR(1),o[0],0,0,0), C0,4); \
    VRD(13); SBAR(); GAPB(o[1]=__builtin_amdgcn_mfma_f32_32x32x16_bf16(PAF(1),VFR(5),o[1],0,0,0), C0,6); \
    VRD(10); SBAR(); GAPB(o[0]=__builtin_amdgcn_mfma_f32_32x32x16_bf16(PAF(2),VFR(2),o[0],0,0,0), C0,8); \
    VRD(14); SBAR(); GAPB(o[1]=__builtin_amdgcn_mfma_f32_32x32x16_bf16(PAF(2),VFR(6),o[1],0,0,0), C0,10); \
    VRD(11); SBAR(); GAPB(o[0]=__builtin_amdgcn_mfma_f32_32x32x16_bf16(PAF(3),VFR(3),o[0],0,0,0), C0,12); \
    VRD(15); SBAR(); GAPB(o[1]=__builtin_amdgcn_mfma_f32_32x32x16_bf16(PAF(3),VFR(7),o[1],0,0,0), C0,14); \
    GAPB(o[2]=__builtin_amdgcn_mfma_f32_32x32x16_bf16(PAF(0),VFR(8),o[2],0,0,0),  C1,0); \
    GAPB(o[3]=__builtin_amdgcn_mfma_f32_32x32x16_bf16(PAF(0),VFR(12),o[3],0,0,0), C1,2); \
    GAPB(o[2]=__builtin_amdgcn_mfma_f32_32x32x16_bf16(PAF(1),VFR(9),o[2],0,0,0),  C1,4); \
    GAPB(o[3]=__builtin_amdgcn_mfma_f32_32x32x16_bf16(PAF(1),VFR(13),o[3],0,0,0), C1,6); \
    GAPB(o[2]=__builtin_amdgcn_mfma_f32_32x32x16_bf16(PAF(2),VFR(10),o[2],0,0,0), C1,8); \
    GAPB(o[3]=__builtin_amdgcn_mfma_f32_32x32x16_bf16(PAF(2),VFR(14),o[3],0,0,0), C1,10); \
    GAPB(o[2]=__builtin_amdgcn_mfma_f32_32x32x16_bf16(PAF(3),VFR(11),o[2],0,0,0), C1,12); \
    GAPB(o[3]=__builtin_amdgcn_mfma_f32_32x32x16_bf16(PAF(3),VFR(15),o[3],0,0,0), C1,14); \
    if(GL){ kload2(kf,kp0+kn,0); kload2(kf,kp0+kn,1); SBAR(); } \
    }while(0)
  int t=1;
  #undef CMASK
  #define CMASK(P0,P1,t) do{}while(0)
  for(;t+5<NT;t+=2){
    STEP(pB0,pB1,pA0,pA1,t,true,true,true);     WAIT_BAR(3); RESC(); ROT();
    STEP(pA0,pA1,pB0,pB1,t+1,true,true,true);   WAIT_BAR(3); RESC(); ROT();
  }
  #undef CMASK
  #define CMASK(P0,P1,t) do{int jb_=(t)-(NT-4); if(jb_>=0)cmask(P0,P1,jb_,qrel,hi);}while(0)
  #define ENDW(tt) do{ if((tt)+3<NT){WAIT_BAR(3);} else if((tt)+2<NT){WAIT_BAR(2);} else {WAIT_BAR(0);} }while(0)
  for(;t+1<NT;t+=2){
    STEP(pB0,pB1,pA0,pA1,t,(t+3<NT),(t+1<NT),(t+1<NT));       ENDW(t);   RESC(); ROT();
    STEP(pA0,pA1,pB0,pB1,t+1,(t+4<NT),(t+2<NT),(t+2<NT));     ENDW(t+1); RESC(); ROT();
  }
  STEP(pB0,pB1,pA0,pA1,NT-1,false,false,false); RESC();
  { float sacc=pB0[0]+pB0[1]; _Pragma("unroll") for(int r=2;r<16;++r)sacc+=pB0[r]; _Pragma("unroll") for(int r=0;r<16;++r)sacc+=pB1[r]; l_reg+=sacc;
    pw0=(u32x4){PKW(pB0,0),PKW(pB0,2),PKW(pB0,4),PKW(pB0,6)};pw1=(u32x4){PKW(pB0,8),PKW(pB0,10),PKW(pB0,12),PKW(pB0,14)};pw2=(u32x4){PKW(pB1,0),PKW(pB1,2),PKW(pB1,4),PKW(pB1,6)};pw3=(u32x4){PKW(pB1,8),PKW(pB1,10),PKW(pB1,12),PKW(pB1,14)};
    SBAR(); pv4(o,vb0+2*sl_cur,PAF(0),PAF(1),PAF(2),PAF(3)); }
  #undef PKW
  #undef PAF
  #undef VFR
  #undef PIN
  #undef MX3
  #undef GAPA
  #undef GAPB
  #undef EX
  #undef VRD
  #undef STEP
  #undef ENDW
  {auto rr=__builtin_amdgcn_permlane32_swap(__float_as_uint(l_reg),__float_as_uint(l_reg),false,false);l_reg=__uint_as_float(rr[0])+__uint_as_float(rr[1]);}
  if(hi==0)wsf[32+r32]=l_reg;asm volatile("s_waitcnt lgkmcnt(0)":::"memory");
  float rli[16];
  #pragma unroll
  for(int r=0;r<16;++r)rli[r]=__builtin_amdgcn_rcpf(wsf[32+crow(r,hi)]);
  bf16*Ow=Oh+(long)(q0+wid*QBLK)*DMO;
  { bf16*stg=(bf16*)(shm+LDS2_OST)+wid*4096;
    #pragma unroll
    for(int r=0;r<16;++r){const int orow=crow(r,hi);
      #pragma unroll
      for(int d0=0;d0<4;++d0)stg[orow*128+d0*32+r32]=__float2bfloat16(o[d0][r]*rli[r]);}
    asm volatile("s_waitcnt lgkmcnt(0)":::"memory");
    #pragma unroll
    for(int i=0;i<8;++i){const int row=i*4+(lane>>4),ch=lane&15; const u32x4 v=*(const u32x4*)(stg+row*128+ch*8); ATTN_STORE16(Ow+(long)row*DMO+ch*8,v);} }
  asm volatile("s_waitcnt lgkmcnt(0)\n\ts_barrier":::"memory");
  #undef DMA_K
  #undef DMA_V
  #undef CMASK
  #undef START
  #undef RESC
  #undef ROT
}
constexpr int ATTN_LDS_BYTES=LDS_BYTES;
#undef SBAR
#undef WAIT_BAR
}

constexpr int NWAVES = 8;
constexpr int NTOK = 32768, DM = 1024, SEQ = 4096, NB = 8, NEXP = 32, TOPK = 4;
constexpr int N_PHASES = 10;
constexpr size_t MiB = 1u << 20;
constexpr size_t WS_CTL = 0, CTL_ZERO_BYTES = 32768;
constexpr size_t WS_MODP = 864 * MiB;
constexpr size_t WS_MODF = 3 * MiB;
constexpr size_t WS_LAM16 = 3 * MiB + 512 * 1024;
constexpr size_t WS_WRH = 3 * MiB + 640 * 1024, WS_WRL = 3 * MiB + 704 * 1024;
constexpr size_t WS_WIN = 4 * MiB;
constexpr size_t WS_WOUT = 8 * MiB;
constexpr size_t WS_WGLU = 10 * MiB;
constexpr size_t WS_WM = 11 * MiB;
constexpr size_t WS_TV = 15 * MiB;
constexpr size_t WS_W1T = 22 * MiB;
constexpr size_t WS_W2T = 150 * MiB;
constexpr size_t WS_H = 214 * MiB;
constexpr size_t WS_Q = 278 * MiB, WS_K = 310 * MiB, WS_V = 342 * MiB;
constexpr size_t WS_UA = 374 * MiB;
constexpr size_t WS_Z = 422 * MiB;
constexpr size_t WS_OB = 454 * MiB;
constexpr size_t WS_MIX = 518 * MiB;
constexpr size_t WS_PTOK = 582 * MiB;
constexpr size_t WS_SLOT = 586 * MiB;
constexpr size_t WS_GATE = 587 * MiB;
constexpr size_t WS_A2 = 278 * MiB;
constexpr size_t WS_Y2 = 590 * MiB;
constexpr size_t WS_X1B = 872 * MiB;
constexpr size_t WS_END = 936 * MiB;
constexpr int MAXTILES = 544;
static_assert(WS_A2 + (size_t)MAXTILES * 256 * 1024 * 2 <= WS_PTOK && WS_Y2 + (size_t)MAXTILES * 256 * 1024 * 2 <= WS_MODP, "ws map");
constexpr int CW_TMO = 0, CW_CNT = 1024  , CW_BAR = 4096;
constexpr int CW_DEP0 = 7680  , CW_DEPB = 7744  ;
constexpr int RING_OFF = 0, RING_BYTES = 131072;
constexpr int VEC_OFF = 132096;
constexpr int TILE_E_OFF = 140288;
constexpr int TILE0_OFF = 140928;
constexpr int CNTL_OFF = 141056;
constexpr int MOE_T_OFF = 141184;
constexpr int ROWTAB_OFF = 141312;
constexpr int LDSCTL_OFF = 159744, MISC_OFF = LDSCTL_OFF;
constexpr int LDS_BYTES = 163840;

typedef unsigned short bf16;
typedef unsigned v4u __attribute__((ext_vector_type(4)));
typedef unsigned v2u __attribute__((ext_vector_type(2)));
typedef float f32x4 __attribute__((ext_vector_type(4)));
typedef GAS unsigned gu32;
#define RLX_AGENT __ATOMIC_RELAXED, __HIP_MEMORY_SCOPE_AGENT
#define LDS_WAIT() asm volatile("s_waitcnt lgkmcnt(0)" ::: "memory")
#define VM_WAIT() asm volatile("s_waitcnt vmcnt(0)" ::: "memory")
__device__ __forceinline__ unsigned f2bf(float f) { unsigned u = __builtin_bit_cast(unsigned, f); return (u + 0x7fffu + ((u >> 16) & 1u)) >> 16; }
__device__ __forceinline__ unsigned pk2(float lo, float hi) { return f2bf(lo) | (f2bf(hi) << 16); }

#define XB_TMO      128
#define XB_XCNT(j)  (256  + 64 * (j))
#define XB_XSUB(j)  (1280 + 64 * (j))
#define XB_XGEN(j)  (2304 + 64 * (j))
#define XB_TOP      3328
#define XB_TOPGEN   3392
#define XCD_BAR_WORDS 3456
#define XB_SPIN_CAP (1u << 18)
__device__ __forceinline__ unsigned xb_ld(unsigned* p)              { return __hip_atomic_load(p, __ATOMIC_RELAXED, __HIP_MEMORY_SCOPE_AGENT); }
__device__ __forceinline__ unsigned xb_add(unsigned* p, unsigned v) { return __hip_atomic_fetch_add(p, v, __ATOMIC_RELAXED, __HIP_MEMORY_SCOPE_AGENT); }
__device__ __forceinline__ unsigned xb_xcc_id() { return (unsigned)__builtin_amdgcn_s_getreg((3 << 11) | 20) & 0xFu; }
#define XB_SPIN(cond, bar) do { unsigned _sp = 0; while (cond) { __builtin_amdgcn_s_sleep(1); \
    if ((++_sp & 255u) == 0u) { if (xb_ld(&(bar)[XB_TMO])) break; if (_sp > XB_SPIN_CAP) { atomicAdd(&(bar)[XB_TMO], 1u); break; } } } } while (0)
struct XcdBarrier { unsigned* bar; unsigned x; volatile LAS unsigned* st; };
__device__ __forceinline__ XcdBarrier xcd_barrier_post(unsigned* bar, volatile LAS unsigned* st) {
    XcdBarrier b; b.bar = bar; b.x = xb_xcc_id(); b.st = st;
    if (threadIdx.x == 0) (void)xb_add(&bar[XB_XCNT(b.x)], 1u);
    return b;
}
__device__ __forceinline__ void xcd_barrier_complete(unsigned* bar, unsigned x, unsigned& nloc, unsigned& nx) {
    const unsigned G = gridDim.x * gridDim.y * gridDim.z;
    unsigned sum, cnt, mine, sp = 0u;
    for (;;) {
        sum = 0u; cnt = 0u; mine = 0u;
#pragma unroll
        for (unsigned j = 0; j < 16; ++j) { const unsigned c = xb_ld(&bar[XB_XCNT(j)]); sum += c; cnt += (c > 0u) ? 1u : 0u; mine = (j == x) ? c : mine; }
        if (sum == G) break;
        __builtin_amdgcn_s_sleep(1);
        if ((++sp & 255u) == 0u) { if (xb_ld(&bar[XB_TMO])) break; if (sp > XB_SPIN_CAP) { atomicAdd(&bar[XB_TMO], 1u); break; } }
    }
    nloc = mine > 0u ? mine : 1u; nx = cnt > 0u ? cnt : 1u;
}
__device__ __forceinline__ void xcd_barrier(const XcdBarrier& b, const int wave) {
    asm volatile("s_waitcnt vmcnt(0)" ::: "memory");
    __syncthreads();
    if (wave == 0 && lane_id_opaque() == 0) {
        unsigned* bar = b.bar;
        __builtin_amdgcn_s_waitcnt(0);
        unsigned nloc = b.st[0], nx = b.st[1];
        if (nloc == 0u) { xcd_barrier_complete(bar, b.x, nloc, nx); b.st[0] = nloc; b.st[1] = nx; }
        const unsigned old = xb_add(&bar[XB_XSUB(b.x)], 1u);
        const unsigned gen = old / nloc;
        if (old + 1u == (gen + 1u) * nloc) {
            __builtin_amdgcn_fence(__ATOMIC_RELEASE, "agent");
            asm volatile("s_waitcnt vmcnt(0)" ::: "memory");
            const unsigned og = xb_add(&bar[XB_TOP], 1u);
            const unsigned tg = og / nx;
            if (og + 1u == (tg + 1u) * nx) xb_add(&bar[XB_TOPGEN], 1u);
            else XB_SPIN(xb_ld(&bar[XB_TOPGEN]) == tg, bar);
            __builtin_amdgcn_fence(__ATOMIC_ACQUIRE, "agent");
            xb_add(&bar[XB_XGEN(b.x)], 1u);
            asm volatile("s_waitcnt vmcnt(0)" ::: "memory");
        } else {
            XB_SPIN(xb_ld(&bar[XB_XGEN(b.x)]) == gen, bar);
            __builtin_amdgcn_fence(__ATOMIC_ACQUIRE, "agent");
            asm volatile("s_waitcnt vmcnt(0)" ::: "memory");
        }
    }
    __syncthreads();
}

struct Frame {
    LAS unsigned char* lds;
    gu32* ctl;
    int tid, lane, wave, vcu, G;
    float* out; unsigned char* ws;
};
typedef const float* cfptr_t;
__device__ __forceinline__ const float* inp(int i) { const __attribute__((address_space(4))) cfptr_t* kp = (const __attribute__((address_space(4))) cfptr_t*)__builtin_amdgcn_kernarg_segment_ptr(); asm volatile("" : "+s"(kp)); return kp[i]; }
__device__ __forceinline__ float wave_sum(float v) {
#pragma unroll
    for (int o = 1; o < 64; o <<= 1) v += __shfl_xor(v, o);
    return v;
}
__device__ __forceinline__ float wave_max(float v) {
#pragma unroll
    for (int o = 1; o < 64; o <<= 1) v = fmaxf(v, __shfl_xor(v, o));
    return v;
}
__device__ __forceinline__ int wave_min_i(int v) {
#pragma unroll
    for (int o = 1; o < 64; o <<= 1) { const int w = __shfl_xor(v, o); v = w < v ? w : v; }
    return v;
}

#define DPP_F(v, ctrl) __builtin_bit_cast(float, __builtin_amdgcn_update_dpp(__builtin_bit_cast(int, (v)), __builtin_bit_cast(int, (v)), (ctrl), 0xF, 0xF, false))
#define DPP_I(v, ctrl) __builtin_amdgcn_update_dpp((v), (v), (ctrl), 0xF, 0xF, false)
__device__ __forceinline__ float wave_max_u(float v) {
    v = fmaxf(v, DPP_F(v, 0xB1)); v = fmaxf(v, DPP_F(v, 0x4E)); v = fmaxf(v, DPP_F(v, 0x141)); v = fmaxf(v, DPP_F(v, 0x140));
    const int b = __builtin_bit_cast(int, v);
    return fmaxf(fmaxf(__builtin_bit_cast(float, __builtin_amdgcn_readlane(b, 15)), __builtin_bit_cast(float, __builtin_amdgcn_readlane(b, 31))), fmaxf(__builtin_bit_cast(float, __builtin_amdgcn_readlane(b, 47)), __builtin_bit_cast(float, __builtin_amdgcn_readlane(b, 63))));
}
__device__ __forceinline__ int wave_min_iu(int v) {
    int w;
    w = DPP_I(v, 0xB1); v = w < v ? w : v; w = DPP_I(v, 0x4E); v = w < v ? w : v; w = DPP_I(v, 0x141); v = w < v ? w : v; w = DPP_I(v, 0x140); v = w < v ? w : v;
    const int a = __builtin_amdgcn_readlane(v, 15), b = __builtin_amdgcn_readlane(v, 31), c = __builtin_amdgcn_readlane(v, 47), d = __builtin_amdgcn_readlane(v, 63);
    const int ab = a < b ? a : b, cd = c < d ? c : d; return ab < cd ? ab : cd;
}
__device__ __forceinline__ float wave_sum_u(float v) {
    v += DPP_F(v, 0xB1); v += DPP_F(v, 0x4E); v += DPP_F(v, 0x141); v += DPP_F(v, 0x140);
    const int b = __builtin_bit_cast(int, v);
    return (__builtin_bit_cast(float, __builtin_amdgcn_readlane(b, 15)) + __builtin_bit_cast(float, __builtin_amdgcn_readlane(b, 31))) + (__builtin_bit_cast(float, __builtin_amdgcn_readlane(b, 47)) + __builtin_bit_cast(float, __builtin_amdgcn_readlane(b, 63)));
}
struct TrItem { const float* W; bf16* WT; int ldw, ldt; };
__device__ __forceinline__ void tr_dma(const TrItem& d, LAS float* buf, int lane) {
    const int kr = lane >> 3, q = lane & 7;
#pragma unroll
    for (int i = 0; i < 8; ++i) __builtin_amdgcn_global_load_lds((const unsigned*)(d.W + (size_t)(8 * i + kr) * d.ldw + 4 * ((q - i) & 7)), (LAS unsigned*)(buf + i * 256), 16, 0, 2);
}
__device__ __forceinline__ void tr_out(const TrItem& d, const LAS float* buf, int lane) {
    const int c = lane & 7;
#pragma unroll
    for (int j = 0; j < 4; ++j) { const int n = (lane >> 3) + 8 * j; const LAS float* s = buf + (8 * c) * 32 + 4 * (((n >> 2) + c) & 7) + (n & 3);
        if (d.ldt < 0) { const f32x4 a = (f32x4){s[0 * 32], s[1 * 32], s[2 * 32], s[3 * 32]} * pg8::F8_W, e = (f32x4){s[4 * 32], s[5 * 32], s[6 * 32], s[7 * 32]} * pg8::F8_W;
            __builtin_nontemporal_store(pg8::pack8_fp8(a, e), (pg8::i32x2*)((unsigned char*)d.WT + (size_t)n * (size_t)(-d.ldt) + 8 * c)); }
        else { v4u o; o.x = pg8::cvt_pk_bf16(s[0 * 32], s[1 * 32]); o.y = pg8::cvt_pk_bf16(s[2 * 32], s[3 * 32]); o.z = pg8::cvt_pk_bf16(s[4 * 32], s[5 * 32]); o.w = pg8::cvt_pk_bf16(s[6 * 32], s[7 * 32]);
            *(GAS v4u*)(d.WT + (size_t)n * d.ldt + 8 * c) = o; } }
}
__device__ __forceinline__ void dsincos(double x, double& s, double& c) {
    const double k = rint(x * 0.63661977236758134308);
    double r = fma(-k, 1.57079632673412561417e+00, x); r = fma(-k, 6.07710050650619224932e-11, r);
    const int q = ((int)k) & 3; const double r2 = r * r;
    const double sp = r + r * r2 * (-1.66666666666666324348e-01 + r2 * (8.33333333332248946124e-03 + r2 * (-1.98412698298579493134e-04 + r2 * (2.75573137070700676789e-06 + r2 * (-2.50507602534068634195e-08 + r2 * 1.58969099521155010221e-10)))));
    const double cp = 1.0 - 0.5 * r2 + r2 * r2 * (4.16666666666666019037e-02 + r2 * (-1.38888888888741095749e-03 + r2 * (2.48015872894767294178e-05 + r2 * (-2.75573143513906633035e-07 + r2 * (2.08757232129817482790e-09 + r2 * -1.13596475577881948265e-11)))));
    s = (q == 0) ? sp : (q == 1) ? cp : (q == 2) ? -sp : -cp;
    c = (q == 0) ? cp : (q == 1) ? -sp : (q == 2) ? -cp : sp;
}
__device__ __forceinline__ double dexp(double x) {
    const double k = rint(x * 1.44269504088896340736); const double r = fma(-k, 6.93147180369123816490e-01, x) - k * 1.90821492927058770002e-10;
    double p = 1.0 / 6227020800.0;
    p = p * r + 1.0 / 479001600.0; p = p * r + 1.0 / 39916800.0; p = p * r + 1.0 / 3628800.0; p = p * r + 1.0 / 362880.0; p = p * r + 1.0 / 40320.0; p = p * r + 1.0 / 5040.0;
    p = p * r + 1.0 / 720.0; p = p * r + 1.0 / 120.0; p = p * r + 1.0 / 24.0; p = p * r + 1.0 / 6.0; p = p * r + 0.5; p = p * r + 1.0; p = p * r + 1.0;
    return ldexp(p, (int)k);
}
__device__ __forceinline__ void ssm_tables_item(Frame& F, int g, int r) {
    LAS float* pwr = (LAS float*)(F.lds); LAS float* pwi = pwr + 17 * 64;
    LAS float* ccr = pwi + 17 * 64; LAS float* cci = ccr + 1040;
    LAS float* bbr = cci + 1040; LAS float* bbi = bbr + 1024;
    LAS float* kt = bbi + 1024;
    LAS double* lb1 = (LAS double*)(kt + 4096);
    const float* a_re = inp(11); const float* a_im = inp(12); const float* log_dt = inp(13);
    const float* b_re = inp(14); const float* b_im = inp(15); const float* c_re = inp(16); const float* c_im = inp(17); const float* dsk = inp(18);
    const int tid = F.tid;
    const double dtv = dexp((double)log_dt[g]);
    for (int idx = tid; idx < 17 * 64; idx += 512) { const int t = idx >> 6, p = idx & 63;
        const double re = fmin((double)a_re[g * 64 + p], -1e-4), im = (double)a_im[g * 64 + p];
        const double mag = dexp(re * dtv * (double)t); double s, c; dsincos(im * dtv * (double)t, s, c);
        pwr[idx] = (float)(mag * c); pwi[idx] = (float)(mag * s); if (t == 1) { lb1[2 * p] = mag * c - 1.0; lb1[2 * p + 1] = mag * s; } }
    for (int idx = tid; idx < 1024; idx += 512) { const int c = idx >> 6, p = idx & 63; ccr[c * 65 + p] = c_re[(g * 16 + c) * 64 + p]; cci[c * 65 + p] = c_im[(g * 16 + c) * 64 + p]; }
    __syncthreads();
    for (int idx = tid; idx < 1024; idx += 512) { const int p = idx >> 4, c1 = idx & 15;
        const double re = fmin((double)a_re[g * 64 + p], -1e-4), im = (double)a_im[g * 64 + p];
        const double nr = lb1[2 * p], ni = lb1[2 * p + 1], den = re * re + im * im;
        const double qr = (nr * re + ni * im) / den, qi = (ni * re - nr * im) / den;
        const double br = (double)b_re[(g * 64 + p) * 16 + c1], bi = (double)b_im[(g * 64 + p) * 16 + c1];
        bbr[idx] = (float)(qr * br - qi * bi); bbi[idx] = (float)(qr * bi + qi * br); }
    __syncthreads();
    { const int t = tid >> 5, c = (tid >> 1) & 15, h8 = (tid & 1) * 8; float acc[8];
#pragma unroll
      for (int q = 0; q < 8; ++q) acc[q] = 0.f;
      for (int p = 0; p < 64; ++p) { const float cr = ccr[c * 65 + p], ci = cci[c * 65 + p], pr = pwr[t * 64 + p], pi = pwi[t * 64 + p]; const float mr = cr * pr - ci * pi, mi = cr * pi + ci * pr;
          const f32x4 r0 = *(const LAS f32x4*)(bbr + p * 16 + h8), r1 = *(const LAS f32x4*)(bbr + p * 16 + h8 + 4), i0 = *(const LAS f32x4*)(bbi + p * 16 + h8), i1 = *(const LAS f32x4*)(bbi + p * 16 + h8 + 4);
          acc[0] += mr * r0.x - mi * i0.x; acc[1] += mr * r0.y - mi * i0.y; acc[2] += mr * r0.z - mi * i0.z; acc[3] += mr * r0.w - mi * i0.w;
          acc[4] += mr * r1.x - mi * i1.x; acc[5] += mr * r1.y - mi * i1.y; acc[6] += mr * r1.z - mi * i1.z; acc[7] += mr * r1.w - mi * i1.w; }
#pragma unroll
      for (int q = 0; q < 8; ++q) kt[(t * 16 + c) * 16 + h8 + q] = acc[q]; }
    __syncthreads();
    bf16* TV = (bf16*)(F.ws + WS_TV) + (size_t)g * 256 * 384; bf16* WM = (bf16*)(F.ws + WS_WM) + (size_t)g * 256 * 256;
    for (int idx = tid; idx < 32 * 192; idx += 512) { const int row = 32 * r + idx / 192, col = 2 * (idx % 192), s = row >> 4, c = row & 15; float v[2];
#pragma unroll
        for (int q = 0; q < 2; ++q) { const int cq = col + q;
            if (cq < 256) { const int j = cq >> 4, c1 = cq & 15; v[q] = (j <= s) ? kt[((s - j) * 16 + c) * 16 + c1] : 0.f; if (j == s && c == c1) v[q] += dsk[g * 16 + c]; }
            else { const int p = (cq - 256) & 63; const float cr = ccr[c * 65 + p], ci = cci[c * 65 + p], pr = pwr[(s + 1) * 64 + p], pi = pwi[(s + 1) * 64 + p];
                v[q] = (cq < 320) ? (cr * pr - ci * pi) : -(cr * pi + ci * pr); } }
        *(unsigned*)(TV + (size_t)row * 384 + col) = pk2(v[0], v[1]); }
    for (int idx = tid; idx < 16 * 128; idx += 512) { const int row = 16 * r + (idx >> 7), col = 2 * (idx & 127), p = row & 63, ri = row >> 6, j = col >> 4, c1 = col & 15;
        const float pr = pwr[(15 - j) * 64 + p], pi = pwi[(15 - j) * 64 + p]; float v[2];
#pragma unroll
        for (int q = 0; q < 2; ++q) { const float br = bbr[p * 16 + c1 + q], bi = bbi[p * 16 + c1 + q]; v[q] = ri == 0 ? (pr * br - pi * bi) : (pr * bi + pi * br); }
        *(unsigned*)(WM + (size_t)row * 256 + col) = pk2(v[0], v[1]); *(unsigned*)(WM + (size_t)(128 + row) * 256 + col) = 0u; }
    if (r == 0 && tid < 64) { float* L16 = (float*)(F.ws + WS_LAM16) + (g * 64 + tid) * 2; L16[0] = pwr[16 * 64 + tid]; L16[1] = pwi[16 * 64 + tid]; }
    __syncthreads();
}
constexpr int MOD_NKS = 32;
__device__ __forceinline__ void modp_item(Frame& F, int it) {
    const int ng = it % 6, ks = it / 6, tid = F.tid;
    LAS float* cact = (LAS float*)F.lds;
    LAS f32x4* red = (LAS f32x4*)(cact + 256);
    const float* cin = inp(1); const float* w = inp(2);
    if (tid < 256) { const int b = tid >> 5, kk = tid & 31; const float c = cin[b * 1024 + ks * 32 + kk]; cact[tid] = c / (1.0f + __expf(-c)); }
    __syncthreads();
    const int c4 = tid & 255, kq = tid >> 8, col = ng * 1024 + 4 * c4; f32x4 wv[16], acc[8];
#pragma unroll
    for (int i = 0; i < 16; ++i) wv[i] = *(const GAS f32x4*)(w + (size_t)(ks * 32 + kq * 16 + i) * 6144 + col);
#pragma unroll
    for (int b = 0; b < 8; ++b) { acc[b] = (f32x4){0.f, 0.f, 0.f, 0.f};
#pragma unroll
        for (int i = 0; i < 16; ++i) acc[b] += wv[i] * cact[b * 32 + kq * 16 + i]; }
    if (kq == 1) {
#pragma unroll
        for (int b = 0; b < 8; ++b) red[b * 256 + c4] = acc[b]; }
    __syncthreads();
    if (kq == 0) { float* mp = (float*)(F.ws + WS_MODP);
#pragma unroll
        for (int b = 0; b < 8; ++b) *(GAS f32x4*)(mp + (size_t)(ks * 8 + b) * 6144 + col) = acc[b] + red[b * 256 + c4]; }
    __syncthreads();
}
__device__ __forceinline__ float mod_value(Frame& F, const float* b_ada, int b, int n) {
    const float* mp = (const float*)(F.ws + WS_MODP); float v = b_ada[n];
    float t[MOD_NKS];
#pragma unroll
    for (int ks = 0; ks < MOD_NKS; ++ks) t[ks] = mp[(size_t)(ks * 8 + b) * 6144 + n];
#pragma unroll
    for (int ks = 0; ks < MOD_NKS; ++ks) v += t[ks];
    return v;
}
#ifndef TR_HOSTED
#define TR_HOSTED 32768
#endif
constexpr int TR_I_W1 = 32 * 16 * 64, TR_I_W2 = 32 * 16 * 32, TR_I_IN = 16 * 64, TR_I_OUT = 16 * 32, TR_I_GLU = 8 * 16, TR_NITEMS = TR_I_W1 + TR_I_W2 + TR_I_IN + TR_I_OUT + TR_I_GLU;
__device__ __forceinline__ void tr_run(Frame& F, const int lo, const int hi, const int gw, const int NGW) {
    LAS float* scr = (LAS float*)(F.lds + RING_OFF + F.wave * 16384);
    constexpr int I_W1 = TR_I_W1, I_W2 = TR_I_W2, I_IN = TR_I_IN, I_OUT = TR_I_OUT;
    const int NITEMS = hi;
    const float* w1p = inp(25); const float* w2p = inp(27); const float* winp = inp(5); const float* woutp = inp(21); const float* wglup = inp(19);
    bf16* w1t = (bf16*)(F.ws + WS_W1T); bf16* w2t = (bf16*)(F.ws + WS_W2T); bf16* wint = (bf16*)(F.ws + WS_WIN); bf16* woutt = (bf16*)(F.ws + WS_WOUT); bf16* wglut = (bf16*)(F.ws + WS_WGLU);
#define TR_DESC(d, item) do { int r = (item); \
        if (r < I_W1) { const int e = r >> 10, rr = r & 1023, kb = rr >> 6, nb = rr & 63, n0 = 32 * nb, bj = n0 >> 10, rem = n0 & 1023, pn = rem >> 7, jj = rem & 127; \
            d.W = w1p + (size_t)e * 1024 * 2048 + (size_t)(64 * kb) * 2048 + n0; d.WT = (bf16*)((unsigned char*)w1t + (size_t)e * 2048 * 1024 + (size_t)(pn * 256 + bj * 128 + jj) * 1024 + 64 * kb); d.ldw = 2048; d.ldt = -1024; } \
        else if ((r -= I_W1) < I_W2) { const int e = r >> 9, rr = r & 511, kb = rr >> 5, nb = rr & 31; \
            d.W = w2p + (size_t)e * 1024 * 1024 + (size_t)(64 * kb) * 1024 + 32 * nb; d.WT = (bf16*)((unsigned char*)w2t + (size_t)e * 1024 * 1024 + (size_t)(32 * nb) * 1024 + 64 * kb); d.ldw = 1024; d.ldt = -1024; } \
        else if ((r -= I_W2) < I_IN) { const int kb = r >> 6, nb = r & 63; d.W = winp + (size_t)(64 * kb) * 2048 + 32 * nb; d.WT = wint + (size_t)(32 * nb) * 1024 + 64 * kb; d.ldw = 2048; d.ldt = 1024; } \
        else if ((r -= I_IN) < I_OUT) { const int kb = r >> 5, nb = r & 31; d.W = woutp + (size_t)(64 * kb) * 1024 + 32 * nb; d.WT = woutt + (size_t)(32 * nb) * 1024 + 64 * kb; d.ldw = 1024; d.ldt = 1024; } \
        else { r -= I_OUT; const int kb = r >> 4, nb = r & 15; d.W = wglup + (size_t)(64 * kb) * 512 + 32 * nb; d.WT = wglut + (size_t)(32 * nb) * 512 + 64 * kb; d.ldw = 512; d.ldt = 512; } } while (0)
    { TrItem dc, dn; int it = lo + gw, par = 0;
      if (it < NITEMS) { TR_DESC(dc, it); tr_dma(dc, scr, F.lane); }
      while (it < NITEMS) { const int nx = it + NGW;
          if (nx < NITEMS) { TR_DESC(dn, nx); tr_dma(dn, scr + (par ^ 1) * 2048, F.lane); asm volatile("s_waitcnt vmcnt(8)" ::: "memory"); }
          else { asm volatile("s_waitcnt vmcnt(0)" ::: "memory"); }
          tr_out(dc, scr + par * 2048, F.lane);
          LDS_WAIT(); asm volatile("" ::: "memory");
          dc = dn; it = nx; par ^= 1; }
      asm volatile("s_waitcnt vmcnt(0)" ::: "memory"); }
}
__device__ __forceinline__ void trq_load(v4u (&r)[8], const TrItem& d, int lane) {
    const int kr = lane >> 3, q = lane & 7;
#pragma unroll
    for (int i = 0; i < 8; ++i) { const float* p = d.W + (size_t)(8 * i) * d.ldw; const unsigned voff = (unsigned)(kr * d.ldw + 4 * ((q - i) & 7)) * 4u;
        asm volatile("global_load_dwordx4 %0, %1, %2 nt" : "=v"(r[i]) : "v"(voff), "s"(p) : "memory"); }
}
__device__ __forceinline__ void tr_run_deep(Frame& F, const int lo, const int hi, const int gw, const int NGW) {
    LAS float* scr = (LAS float*)(F.lds + RING_OFF + F.wave * 16384);
    constexpr int I_W1 = TR_I_W1, I_W2 = TR_I_W2, I_IN = TR_I_IN, I_OUT = TR_I_OUT;
    const float* w1p = inp(25); const float* w2p = inp(27); const float* winp = inp(5); const float* woutp = inp(21); const float* wglup = inp(19);
    bf16* w1t = (bf16*)(F.ws + WS_W1T); bf16* w2t = (bf16*)(F.ws + WS_W2T); bf16* wint = (bf16*)(F.ws + WS_WIN); bf16* woutt = (bf16*)(F.ws + WS_WOUT); bf16* wglut = (bf16*)(F.ws + WS_WGLU);
    if (lo + gw >= hi) return;
    const int n_it = (hi - lo - gw + NGW - 1) / NGW;
#define TRQ_DESC(d, j) do { const int jc_ = (j) < n_it ? (j) : n_it - 1; TR_DESC(d, lo + gw + jc_ * NGW); } while (0)
#define TRQ_STEP(r, d, j, par) do { \
        asm volatile("s_waitcnt vmcnt(16)" : "+v"(r[0]), "+v"(r[1]), "+v"(r[2]), "+v"(r[3]), "+v"(r[4]), "+v"(r[5]), "+v"(r[6]), "+v"(r[7]) :: "memory"); \
        LAS float* buf_ = scr + (par) * 2048; const bool live_ = (j) < n_it; \
        if (live_) { _Pragma("unroll") for (int i_ = 0; i_ < 8; ++i_) *(LAS v4u*)(buf_ + i_ * 256 + F.lane * 4) = r[i_]; } \
        LDS_WAIT(); TrItem dn_; TRQ_DESC(dn_, (j) + 3); trq_load(r, dn_, F.lane); \
        if (live_) tr_out(d, buf_, F.lane); \
        d = dn_; } while (0)
    v4u r0[8], r1[8], r2[8]; TrItem d0, d1, d2;
    TRQ_DESC(d0, 0); trq_load(r0, d0, F.lane); TRQ_DESC(d1, 1); trq_load(r1, d1, F.lane); TRQ_DESC(d2, 2); trq_load(r2, d2, F.lane);
    for (int j = 0; j < n_it; j += 6) {
        TRQ_STEP(r0, d0, j, 0); TRQ_STEP(r1, d1, j + 1, 1); TRQ_STEP(r2, d2, j + 2, 0);
        TRQ_STEP(r0, d0, j + 3, 1); TRQ_STEP(r1, d1, j + 4, 0); TRQ_STEP(r2, d2, j + 5, 1); }
    asm volatile("s_waitcnt vmcnt(0)" : "+v"(r0[0]), "+v"(r0[1]), "+v"(r0[2]), "+v"(r0[3]), "+v"(r0[4]), "+v"(r0[5]), "+v"(r0[6]), "+v"(r0[7]) :: "memory");
    asm volatile("" : "+v"(r1[0]), "+v"(r1[1]), "+v"(r1[2]), "+v"(r1[3]), "+v"(r1[4]), "+v"(r1[5]), "+v"(r1[6]), "+v"(r1[7]) :: "memory");
    asm volatile("" : "+v"(r2[0]), "+v"(r2[1]), "+v"(r2[2]), "+v"(r2[3]), "+v"(r2[4]), "+v"(r2[5]), "+v"(r2[6]), "+v"(r2[7]) :: "memory");
#undef TRQ_STEP
#undef TRQ_DESC
}
#undef TR_DESC
__device__ __forceinline__ void dep_signal(Frame& F, int word);
__device__ __forceinline__ void p0_prologue(Frame& F, int mode = 0) {
    { const float* wr = inp(23); bf16* wh = (bf16*)(F.ws + WS_WRH); bf16* wl = (bf16*)(F.ws + WS_WRL);
      for (int idx = F.vcu * 512 + F.tid; idx < 32768; idx += F.G * 512) { const int k = idx >> 5, e = idx & 31; const float w = wr[idx]; const unsigned hi = f2bf(w);
          wh[e * 1024 + k] = (bf16)hi; wl[e * 1024 + k] = (bf16)f2bf(w - __builtin_bit_cast(float, hi << 16)); } }
    const bool tab_last = (mode == 0) && !(F.vcu & 1);
    if (mode != 2 && mode != 4 && !tab_last) { for (int it = F.vcu; it < 256; it += F.G) ssm_tables_item(F, it >> 3, it & 7); }
    if (mode != 2 && mode != 3) { for (int it = F.vcu; it < 192; it += F.G) modp_item(F, it); }
    if (mode == 0) dep_signal(F, CW_DEP0);
    if (mode == 1 || mode == 3 || mode == 4) return;
    if (F.G == 256) tr_run(F, TR_HOSTED, TR_NITEMS, F.vcu * NWAVES + F.wave, F.G * NWAVES);
    else tr_run(F, 0, TR_NITEMS, F.vcu * NWAVES + F.wave, F.G * NWAVES);
    if (tab_last) { LDS_WAIT(); __syncthreads(); for (int it = F.vcu; it < 256; it += F.G) ssm_tables_item(F, it >> 3, it & 7); }
}
__device__ __forceinline__ void p1_h1(Frame& F) {
    const int bx = blockIdx.x, rows_per = NTOK / F.G, row_base = bx * rows_per, b = row_base >> 12;
    LAS float* vec = (LAS float*)(F.lds + VEC_OFF);
    const float* b_ada = inp(3); const float* n1g = inp(4); const float* xin = inp(0);
    for (int n = F.tid; n < 2048; n += 512) { float v = mod_value(F, b_ada, b, n); if (n >= 1024) v = (1.0f + v) * n1g[n - 1024]; vec[n] = v; }
    { const int per = (NB * 6144) / F.G; float* mf = (float*)(F.ws + WS_MODF);
      for (int i = F.tid; i < per; i += 512) { const int idx = bx * per + i; mf[idx] = mod_value(F, b_ada, idx / 6144, idx % 6144); } }
    __syncthreads();
    bf16* H = (bf16*)(F.ws + WS_H);
    for (int r = F.wave; r < rows_per; r += NWAVES) { const size_t row = (size_t)(row_base + r);
        const GAS f32x4* xr = (const GAS f32x4*)(xin + row * DM) + F.lane; f32x4 v[4]; float s = 0.f;
#pragma unroll
        for (int j = 0; j < 4; ++j) { v[j] = __builtin_nontemporal_load((const f32x4*)(xr + 64 * j)); s += (v[j].x * v[j].x + v[j].y * v[j].y) + (v[j].z * v[j].z + v[j].w * v[j].w); }
        const float rs = 1.0f / sqrtf(wave_sum_u(s) * (1.f / DM) + 1e-6f);
        GAS v2u* o8 = (GAS v2u*)(H + row * DM) + F.lane;
#pragma unroll
        for (int j = 0; j < 4; ++j) { const int c = 256 * j + 4 * F.lane; const f32x4 sh = *(LAS f32x4*)(vec + c), sc = *(LAS f32x4*)(vec + 1024 + c); const f32x4 h = v[j] * rs * sc + sh;
            v2u w; w.x = pk2(h.x, h.y); w.y = pk2(h.z, h.w); o8[64 * j] = w; } }
}
__device__ __forceinline__ void p4_combine(Frame& F) {
    const float lam = __expf(wave_sum(inp(6)[F.lane] * inp(7)[F.lane])) - __expf(wave_sum(inp(8)[F.lane] * inp(9)[F.lane])) + 0.2f;
    const bf16* OB = (const bf16*)(F.ws + WS_OB); bf16* MIX = (bf16*)(F.ws + WS_MIX);
    const int h = F.lane >> 4, d0 = (F.lane & 15) * 8; const float* sg = inp(10) + d0;
    float gs[8];
#pragma unroll
    for (int j = 0; j < 8; ++j) gs[j] = sg[j] * 0.8f;
    const int gw = F.vcu * NWAVES + F.wave, NGW = F.G * NWAVES;
    for (int tok = gw; tok < NTOK; tok += NGW) {
        const v4u a0 = *(const GAS v4u*)(OB + (size_t)tok * 1024 + (h * 2) * 128 + d0), a1 = *(const GAS v4u*)(OB + (size_t)tok * 1024 + (h * 2 + 1) * 128 + d0);
        float a[8];
        a[0] = pg8::bf_lo(a0.x) - lam * pg8::bf_lo(a1.x); a[1] = pg8::bf_hi(a0.x) - lam * pg8::bf_hi(a1.x); a[2] = pg8::bf_lo(a0.y) - lam * pg8::bf_lo(a1.y); a[3] = pg8::bf_hi(a0.y) - lam * pg8::bf_hi(a1.y);
        a[4] = pg8::bf_lo(a0.z) - lam * pg8::bf_lo(a1.z); a[5] = pg8::bf_hi(a0.z) - lam * pg8::bf_hi(a1.z); a[6] = pg8::bf_lo(a0.w) - lam * pg8::bf_lo(a1.w); a[7] = pg8::bf_hi(a0.w) - lam * pg8::bf_hi(a1.w);
        float ss = 0.f;
#pragma unroll
        for (int j = 0; j < 8; ++j) ss += a[j] * a[j];
        ss += __shfl_xor(ss, 1); ss += __shfl_xor(ss, 2); ss += __shfl_xor(ss, 4); ss += __shfl_xor(ss, 8);
        const float rs = 1.0f / sqrtf(ss * (1.f / 128.f) + 1e-6f);
        v4u o; o.x = pk2(a[0] * rs * gs[0], a[1] * rs * gs[1]); o.y = pk2(a[2] * rs * gs[2], a[3] * rs * gs[3]); o.z = pk2(a[4] * rs * gs[4], a[5] * rs * gs[5]); o.w = pk2(a[6] * rs * gs[6], a[7] * rs * gs[7]);
        *(GAS v4u*)(MIX + (size_t)tok * 1024 + h * 128 + d0) = o;
    }
}
constexpr int WRB = 2064;
constexpr int SEL_OFF = 140288;
static_assert(4 * 16 * WRB <= VEC_OFF, "router weights in LDS");
__device__ __forceinline__ void ins4(float v, int i, float (&tv)[4], int (&ti)[4]) {
#pragma unroll
    for (int k = 0; k < 4; ++k) { const bool better = v > tv[k] || (v == tv[k] && i < ti[k]); const float ov = tv[k]; const int oi = ti[k]; tv[k] = better ? v : ov; ti[k] = better ? i : oi; v = better ? ov : v; i = better ? oi : i; }
}
__device__ __forceinline__ void p6_fill(Frame& F) {
    const int bx = blockIdx.x, rows_per = NTOK / F.G, row_base = bx * rows_per, b = row_base >> 12;
    LAS float* vec = (LAS float*)(F.lds + VEC_OFF);
    LAS unsigned* hist = (LAS unsigned*)(F.lds + SEL_OFF) + 1536;
    const float* n2g = inp(22); const float* mf = (const float*)(F.ws + WS_MODF) + (size_t)b * 6144;
    __syncthreads();
    { const unsigned char* wsrc = F.ws + WS_WRH;
      for (int c = F.tid; c < 8192; c += 512) { const int row = c >> 7, col = c & 127; *(LAS v4u*)(F.lds + RING_OFF + row * WRB + col * 16) = *(const GAS v4u*)(wsrc + (size_t)row * 2048 + col * 16); } }
    for (int n = F.tid; n < 1024; n += 512) { vec[n] = mf[3072 + n]; vec[1024 + n] = (1.0f + mf[4096 + n]) * n2g[n]; }
    if (F.tid < 32) hist[F.tid] = 0u;
    __syncthreads();
}
__device__ __forceinline__ void p6_router(Frame& F, bool dummy = false, bool filled = false) {
    const int bx = blockIdx.x, rows_per = NTOK / F.G, row_base = bx * rows_per;
    LAS float* vec = (LAS float*)(F.lds + VEC_OFF);
    LAS unsigned* sel_e = (LAS unsigned*)(F.lds + SEL_OFF); LAS unsigned* sel_r = sel_e + 512; LAS float* sel_g = (LAS float*)(sel_r + 512); LAS unsigned* hist = (LAS unsigned*)(sel_g + 512); LAS unsigned* base = hist + 32;
    if (!filled) p6_fill(F);
    unsigned char* H = (unsigned char*)(F.ws + WS_H); const bf16* X1 = (const bf16*)(F.ws + WS_X1B);
    int* ptok = (int*)(F.ws + (dummy ? WS_Q : WS_PTOK)); unsigned* slot = (unsigned*)(F.ws + (dummy ? WS_Q + 8 * MiB : WS_SLOT)); float* gate = (float*)(F.ws + (dummy ? WS_Q + 16 * MiB : WS_GATE));
    const int cwc = dummy ? CW_CNT + 2048 : CW_CNT;
    const int t = F.lane & 15, kg = F.lane >> 4;
    for (int r0 = 16 * F.wave; r0 < rows_per; r0 += 16 * NWAVES) { const int tok = row_base + r0 + t;
        const GAS v4u* xp = (const GAS v4u*)(X1 + (size_t)tok * DM + 8 * kg);
        v4u xr[32]; float ss = 0.f;
#pragma unroll
        for (int s = 0; s < 32; ++s) xr[s] = xp[4 * s];
#pragma unroll
        for (int s = 0; s < 32; ++s) { const float x0 = pg8::bf_lo(xr[s].x), x1 = pg8::bf_hi(xr[s].x), x2 = pg8::bf_lo(xr[s].y), x3 = pg8::bf_hi(xr[s].y), x4 = pg8::bf_lo(xr[s].z), x5 = pg8::bf_hi(xr[s].z), x6 = pg8::bf_lo(xr[s].w), x7 = pg8::bf_hi(xr[s].w);
            ss += ((x0 * x0 + x1 * x1) + (x2 * x2 + x3 * x3)) + ((x4 * x4 + x5 * x5) + (x6 * x6 + x7 * x7)); }
        ss += __shfl_xor(ss, 16); ss += __shfl_xor(ss, 32);
        const float rs = 1.0f / sqrtf(ss * (1.f / DM) + 1e-6f);
        f32x4 acc0 = {0.f, 0.f, 0.f, 0.f}, acc1 = {0.f, 0.f, 0.f, 0.f};
        GAS unsigned char* hp = (GAS unsigned char*)(H + (size_t)tok * DM + 8 * kg);
        const LAS unsigned char* wa = F.lds + RING_OFF + t * WRB + 16 * kg;
        const LAS float* vp = vec + 8 * kg;
#pragma unroll
        for (int s = 0; s < 32; ++s) {
            const f32x4 sh0 = *(const LAS f32x4*)(vp), sh1 = *(const LAS f32x4*)(vp + 4), sc0 = *(const LAS f32x4*)(vp + 1024), sc1 = *(const LAS f32x4*)(vp + 1024 + 4);
            v4u xs = xr[s]; asm volatile("" : "+v"(xs));
            const f32x4 xa = {pg8::bf_lo(xs.x), pg8::bf_hi(xs.x), pg8::bf_lo(xs.y), pg8::bf_hi(xs.y)}, xb = {pg8::bf_lo(xs.z), pg8::bf_hi(xs.z), pg8::bf_lo(xs.w), pg8::bf_hi(xs.w)};
            const f32x4 h0 = xa * rs * sc0 + sh0, h1 = xb * rs * sc1 + sh1;
            const pg8::u32x4 bh = pg8::pack8(h0, h1);
            const f32x4 d0 = h0 - (f32x4){pg8::bf_lo(bh.x), pg8::bf_hi(bh.x), pg8::bf_lo(bh.y), pg8::bf_hi(bh.y)}, d1 = h1 - (f32x4){pg8::bf_lo(bh.z), pg8::bf_hi(bh.z), pg8::bf_lo(bh.w), pg8::bf_hi(bh.w)};
            const pg8::u32x4 bl = pg8::pack8(d0, d1);
            *(GAS pg8::i32x2*)(hp + 32 * s) = pg8::pack8_fp8(h0 * pg8::F8_ACT, h1 * pg8::F8_ACT);
            const pg8::bf16x8 Bh = __builtin_bit_cast(pg8::bf16x8, bh), Bl = __builtin_bit_cast(pg8::bf16x8, bl);
            const pg8::bf16x8 Ah0 = *(const LAS pg8::bf16x8*)(wa), Ah1 = *(const LAS pg8::bf16x8*)(wa + 16 * WRB), Al0 = *(const LAS pg8::bf16x8*)(wa + 32 * WRB), Al1 = *(const LAS pg8::bf16x8*)(wa + 48 * WRB);
            acc0 = __builtin_amdgcn_mfma_f32_16x16x32_bf16(Ah0, Bh, acc0, 0, 0, 0); acc1 = __builtin_amdgcn_mfma_f32_16x16x32_bf16(Ah1, Bh, acc1, 0, 0, 0);
            acc0 = __builtin_amdgcn_mfma_f32_16x16x32_bf16(Ah0, Bl, acc0, 0, 0, 0); acc1 = __builtin_amdgcn_mfma_f32_16x16x32_bf16(Ah1, Bl, acc1, 0, 0, 0);
            acc0 = __builtin_amdgcn_mfma_f32_16x16x32_bf16(Al0, Bh, acc0, 0, 0, 0); acc1 = __builtin_amdgcn_mfma_f32_16x16x32_bf16(Al1, Bh, acc1, 0, 0, 0);
            wa += 64; vp += 32;
            asm volatile("" : "+v"(wa), "+v"(vp), "+v"(acc0), "+v"(acc1)); }
        const float* br = inp(24) + 4 * kg;
        float tv[4] = {-INFINITY, -INFINITY, -INFINITY, -INFINITY}; int ti[4] = {99, 99, 99, 99};
#pragma unroll
        for (int r = 0; r < 4; ++r) ins4(acc0[r] + br[r], 4 * kg + r, tv, ti);
#pragma unroll
        for (int r = 0; r < 4; ++r) ins4(acc1[r] + br[16 + r], 16 + 4 * kg + r, tv, ti);
#pragma unroll
        for (int xr_ = 16; xr_ <= 32; xr_ <<= 1) { float ov[4]; int oi[4];
#pragma unroll
            for (int k = 0; k < 4; ++k) { ov[k] = __shfl_xor(tv[k], xr_); oi[k] = __shfl_xor(ti[k], xr_); }
#pragma unroll
            for (int k = 0; k < 4; ++k) ins4(ov[k], oi[k], tv, ti); }
        { const int k = kg;
          const float e1 = __expf(tv[1] - tv[0]), e2 = __expf(tv[2] - tv[0]), e3 = __expf(tv[3] - tv[0]); const float inv = 1.0f / (1.0f + e1 + e2 + e3);
          const int ek = k == 0 ? ti[0] : k == 1 ? ti[1] : k == 2 ? ti[2] : ti[3]; const float gk = (k == 0 ? 1.0f : k == 1 ? e1 : k == 2 ? e2 : e3) * inv;
          const unsigned rank = __hip_atomic_fetch_add(hist + ek, 1u, __ATOMIC_RELAXED, __HIP_MEMORY_SCOPE_WORKGROUP);
          const int q = (r0 + t) * 4 + k; sel_e[q] = (unsigned)ek; sel_r[q] = rank; sel_g[q] = gk; }
    }
    LDS_WAIT(); __syncthreads();
    if (F.tid < 32) base[F.tid] = __hip_atomic_fetch_add((unsigned*)(F.ctl + cwc + 64 * F.tid), hist[F.tid], RLX_AGENT);
    LDS_WAIT(); __syncthreads();
    { const int q = F.tid, tok = row_base + (q >> 2), k = q & 3; const unsigned ek = sel_e[q], pos = base[ek] + sel_r[q];
      ptok[(size_t)ek * NTOK + pos] = tok; slot[(size_t)tok * 4 + k] = (ek << 16) | pos; gate[(size_t)tok * 4 + k] = sel_g[q]; }
}
__device__ __forceinline__ void moe_tables(Frame& F) {
    LAS unsigned char* tile_e = (LAS unsigned char*)(F.lds + TILE_E_OFF); LAS int* tile0 = (LAS int*)(F.lds + TILE0_OFF); LAS int* cntl = (LAS int*)(F.lds + CNTL_OFF); LAS int* Tp = (LAS int*)(F.lds + MOE_T_OFF);
    if (F.tid < 32) { const int c = (int)__hip_atomic_load((unsigned*)(F.ctl + CW_CNT + 64 * F.tid), RLX_AGENT); const int nt = (c + 255) >> 8; int incl = nt;
#pragma unroll
        for (int o = 1; o < 32; o <<= 1) { const int w = __shfl_up(incl, o); if (F.tid >= o) incl += w; }
        const int excl = incl - nt; tile0[F.tid] = excl; cntl[F.tid] = c; if (F.tid == 31) Tp[0] = incl;
        for (int k = 0; k < nt; ++k) tile_e[excl + k] = (unsigned char)F.tid; }
    __syncthreads();
}
struct MoeSched {
    const LAS unsigned char* tile_e; const LAS int* tile0; const LAS unsigned* rowtab; int T, nN, G, c, rev, a_mask, e_mask; size_t tA, tBe, tB;
    __device__ __forceinline__ bool next(int i, pg8::Unit& u) const { const int x = c & 7, y = c >> 3, tpx = 32 / nN, t = (i * 8 + x) * tpx + (y % tpx); if (t >= T) return false; u.pm = rev ? T - 1 - t : t; u.pn = y / tpx; u.e = __builtin_amdgcn_readfirstlane((int)tile_e[u.pm]); return true; }
    __device__ __forceinline__ size_t aoff(const pg8::Unit& u) const { return (size_t)(u.pm & a_mask) * tA; }
    __device__ __forceinline__ size_t boff(const pg8::Unit& u) const { return (size_t)(u.e & e_mask) * tBe + (size_t)u.pn * tB; }
    __device__ __forceinline__ unsigned rowoff(int i, int r) const { return rowtab[i * 256 + r]; }
};
__device__ __forceinline__ void p9_final(Frame& F, bool dummy = false) {
    const int bx = blockIdx.x, rows_per = NTOK / F.G, row_base = bx * rows_per, b = row_base >> 12;
    moe_tables(F);
    const LAS int* tile0 = (const LAS int*)(F.lds + TILE0_OFF);
    const float* g2 = (const float*)(F.ws + WS_MODF) + (size_t)b * 6144 + 5120; const float* fg = inp(29);
    const unsigned char* Y2 = (const unsigned char*)(F.ws + WS_Y2); const unsigned* slot = (const unsigned*)(F.ws + WS_SLOT); const float* gate = (const float*)(F.ws + WS_GATE);
    f32x4 g2v[4], fgv[4];
#pragma unroll
    for (int j = 0; j < 4; ++j) { g2v[j] = *(const f32x4*)(g2 + 256 * j + 4 * F.lane); fgv[j] = *(const f32x4*)(fg + 256 * j + 4 * F.lane); }
    for (int r = F.wave; r < rows_per; r += NWAVES) { const int tok = row_base + r;
        f32x4 acc[4];
#pragma unroll
        for (int j = 0; j < 4; ++j) acc[j] = (f32x4){0.f, 0.f, 0.f, 0.f};
#pragma unroll
        for (int k = 0; k < 4; ++k) { const unsigned sw = slot[(size_t)tok * 4 + k]; const float gk = gate[(size_t)tok * 4 + k]; const size_t p = (size_t)tile0[sw >> 16] * 256 + (sw & 0xffffu);
            const GAS int* yr = (const GAS int*)(Y2 + p * 1024) + F.lane; const float g8 = gk * 0.125f; typedef float f32x2 __attribute__((ext_vector_type(2)));
#pragma unroll
            for (int j = 0; j < 4; ++j) { const int w = yr[64 * j]; const f32x2 lo = __builtin_amdgcn_cvt_pk_f32_fp8(w, false), hi = __builtin_amdgcn_cvt_pk_f32_fp8(w, true);
                acc[j].x += g8 * lo.x; acc[j].y += g8 * lo.y; acc[j].z += g8 * hi.x; acc[j].w += g8 * hi.y; } }
        const GAS v2u* xr = (const GAS v2u*)((const bf16*)(F.ws + WS_X1B) + (size_t)tok * DM) + F.lane;
        GAS f32x4* xw = (GAS f32x4*)((dummy ? (float*)(F.ws + WS_A2) : F.out) + (size_t)tok * DM) + F.lane; f32x4 v[4]; float s = 0.f;
#pragma unroll
        for (int j = 0; j < 4; ++j) { const v2u wx = xr[64 * j]; v[j] = (f32x4){pg8::bf_lo(wx.x), pg8::bf_hi(wx.x), pg8::bf_lo(wx.y), pg8::bf_hi(wx.y)} + g2v[j] * acc[j]; s += (v[j].x * v[j].x + v[j].y * v[j].y) + (v[j].z * v[j].z + v[j].w * v[j].w); }
        const float rs = 1.0f / sqrtf(wave_sum_u(s) * (1.f / DM) + 1e-6f);
#pragma unroll
        for (int j = 0; j < 4; ++j) __builtin_nontemporal_store(v[j] * rs * fgv[j], (f32x4*)(xw + 64 * j));
    }
}

__device__ __forceinline__ void dep_signal(Frame& F, int word) {
    asm volatile("s_waitcnt vmcnt(0)" ::: "memory"); __syncthreads();
    if (F.wave == 0 && lane_id_opaque() == 0) { __builtin_amdgcn_fence(__ATOMIC_RELEASE, "agent"); asm volatile("s_waitcnt vmcnt(0)" ::: "memory"); (void)xb_add((unsigned*)(F.ctl + word), 1u); }
}
__device__ __forceinline__ void dep_wait(Frame& F, int word, unsigned need) {
    if (F.wave == 0 && lane_id_opaque() == 0) { unsigned* p = (unsigned*)(F.ctl + word); unsigned* bar = (unsigned*)(F.ctl + CW_BAR); XB_SPIN(xb_ld(p) < need, bar);
        __builtin_amdgcn_fence(__ATOMIC_ACQUIRE, "agent"); asm volatile("s_waitcnt vmcnt(0)" ::: "memory"); }
    __syncthreads();
}
#ifndef P2_NG
#define P2_NG 176
#endif
__device__ __forceinline__ void phase0(Frame& F, unsigned char* lds, unsigned char* ws) { p0_prologue(F);  }
__device__ __forceinline__ void phase1(Frame& F, unsigned char* lds, unsigned char* ws) { dep_wait(F, CW_DEP0, (unsigned)F.G); p1_h1(F);  }
__device__ __forceinline__ void phase2(Frame& F, unsigned char* lds, unsigned char* ws) {
        pg8::Gemm g{(const bf16*)(ws + WS_H), (const bf16*)(ws + WS_WIN), 1024, 1024, 1024}; const bool hosted = (F.G == 256); const int ng = hosted ? P2_NG : F.G;
        pg8::StaticOrder S; S.init(NTOK, 2048, ng, (int)blockIdx.x, 1024, 1024);
        pg8::EpiQKVU E{(bf16*)(ws + WS_Q), (size_t)(WS_K - WS_Q) / 2, (bf16*)(ws + WS_UA), attn_body::C2};
        if ((int)blockIdx.x < ng) pg8::gemm_phase<pg8::EpiQKVU, pg8::StaticOrder, true, false>(F.lds + RING_OFF, g, S, E, F.wave);
        else tr_run(F, 0, TR_HOSTED, ((int)blockIdx.x - ng) * NWAVES + F.wave, (F.G - ng) * NWAVES);

    }
__device__ __forceinline__ void phase4_glu(Frame& F, unsigned char* ws) {
        pg8::Gemm g{(const bf16*)(ws + WS_Z), (const bf16*)(ws + WS_WGLU), 512, 512, 512}; pg8::StaticOrder S; S.init(NTOK, 512, F.G, (int)blockIdx.x, 512, 512);
        { pg8::Unit u; const bool one = (F.G == 256) && S.next(0, u);
          if (one) dep_wait(F, CW_DEPB + 16 * (u.pm >> 4), 32u);
          else { for (int bb = 0; bb < NB; ++bb) dep_wait(F, CW_DEPB + 16 * bb, 32u); } }
        pg8::EpiGLU E{(const bf16*)(ws + WS_Z), (bf16*)(ws + WS_MIX), inp(20)};
        pg8::gemm_phase<pg8::EpiGLU, pg8::StaticOrder, true, false>(F.lds + RING_OFF, g, S, E, F.wave);
        __syncthreads();
    }
__device__ __forceinline__ void phase3(Frame& F, unsigned char* lds, unsigned char* ws) {
        for (int it = F.vcu; it < 256; it += F.G) { const int g = it >> 3, b = it & 7;
            bf16* UAgb = (bf16*)(ws + WS_UA) + (size_t)((g * 8 + b) * 256) * 384;
            { pg8::Gemm gx{UAgb, (const bf16*)(ws + WS_WM) + (size_t)g * 256 * 256, 256, 384, 256}; pg8::SingleUnit S; pg8::EpiX E;
              pg8::gemm_phase<pg8::EpiX, pg8::SingleUnit, false, false>(F.lds + RING_OFF, gx, S, E, F.wave); }
            LDS_WAIT(); __syncthreads();
            {
                const int p = lane_id_opaque(), c0 = F.wave * 32; const float* L16 = (const float*)(ws + WS_LAM16) + (g * 64 + p) * 2; const float lr = L16[0], li = L16[1];
                LAS float* X = (LAS float*)(F.lds + RING_OFF); LAS float* EW = X + 256 * pg8::XS;
                float hr = 0.f, hi2 = 0.f;
#pragma unroll 8
                for (int k = 0; k < 32; ++k) { LAS float* xc = X + (c0 + k) * pg8::XS + p; const float xr = xc[0], xi = xc[64]; xc[0] = hr; xc[64] = hi2;
                    const float nr = lr * hr - li * hi2 + xr, ni = lr * hi2 + li * hr + xi; hr = nr; hi2 = ni; }
                EW[F.wave * 128 + p] = hr; EW[F.wave * 128 + 64 + p] = hi2;
                float qr = lr, qi = li;
#pragma unroll
                for (int sq = 0; sq < 5; ++sq) { const float t = qr * qr - qi * qi; qi = 2.f * qr * qi; qr = t; }
                LDS_WAIT(); __syncthreads();
                float cr = 0.f, ci = 0.f;
                for (int v = 0; v < F.wave; ++v) { const float er = EW[v * 128 + p], ei = EW[v * 128 + 64 + p]; const float nr = qr * cr - qi * ci + er, ni = qr * ci + qi * cr + ei; cr = nr; ci = ni; }
                bf16* hrow = UAgb + (size_t)c0 * 384 + 256 + p; float pr = 1.f, pi = 0.f;
#pragma unroll 8
                for (int k = 0; k < 32; ++k) { const LAS float* xc = X + (c0 + k) * pg8::XS + p; const float hr2 = xc[0] + (pr * cr - pi * ci), hi3 = xc[64] + (pr * ci + pi * cr);
                    hrow[(size_t)k * 384] = (bf16)f2bf(hr2); hrow[(size_t)k * 384 + 64] = (bf16)f2bf(hi3);
                    const float t = pr * lr - pi * li; pi = pr * li + pi * lr; pr = t; }
                VM_WAIT(); if (F.wave == 0) { __builtin_amdgcn_fence(__ATOMIC_ACQUIRE, "agent"); VM_WAIT(); } }
            LDS_WAIT(); __syncthreads();
            { pg8::Gemm gy{UAgb, (const bf16*)(ws + WS_TV) + (size_t)g * 256 * 384, 384, 384, 384}; pg8::SingleUnit S; pg8::EpiY E{(bf16*)(ws + WS_Z), g, b};
              pg8::gemm_phase<pg8::EpiY, pg8::SingleUnit, false, false>(F.lds + RING_OFF, gy, S, E, F.wave); }
            dep_signal(F, CW_DEPB + 16 * b);
        }
        phase4_glu(F, ws);
        static_assert(attn_body::LDS2_BYTES <= LDSCTL_OFF, "attention LDS vs control words");
        for (int it = F.vcu; it < 256; it += F.G) { const int bh = it >> 3, sdx = it & 7, b = bh >> 2, h = bh & 3;
            for (int i4 = 0; i4 < 4; ++i4) { const int qb = (i4 >> 1) ? 15 - sdx : sdx;
                { const int m = i4 & 1, hm = h * 2 + m;
                    const attn_body::bf16* q_ = (const attn_body::bf16*)(ws + WS_Q) + (size_t)b * SEQ * 512 + hm * 64; const attn_body::bf16* k_ = (const attn_body::bf16*)(ws + WS_K) + (size_t)b * SEQ * 512 + hm * 64;
                    const attn_body::bf16* v_ = (const attn_body::bf16*)(ws + WS_V) + (size_t)b * SEQ * 512 + h * 128; attn_body::bf16* o_ = (attn_body::bf16*)(ws + WS_OB) + (size_t)b * SEQ * 1024 + hm * 128;
                    asm volatile("" : "+s"(q_), "+s"(k_), "+s"(v_), "+s"(o_));
                    attn_body::attn_unit2<8>(qb, q_, k_, v_, o_, (char*)lds + RING_OFF, F.wave); }
                if (i4 & 1) { VM_WAIT(); __syncthreads();
 const int ln = lane_id_opaque(), t16 = F.wave * 4 + (ln >> 4), d0 = (ln & 15) * 8; const float* sg = inp(10) + d0;
                  const float lam = __expf(wave_sum(inp(6)[ln] * inp(7)[ln])) - __expf(wave_sum(inp(8)[ln] * inp(9)[ln])) + 0.2f;
                  const bf16* OB = (const bf16*)(ws + WS_OB); bf16* MIX = (bf16*)(ws + WS_MIX);
                  for (int p = 0; p < 8; ++p) { const size_t tok = (size_t)b * SEQ + qb * 256 + p * 32 + t16;
                      const v4u a0 = *(const GAS v4u*)(OB + tok * 1024 + (h * 2) * 128 + d0), a1 = *(const GAS v4u*)(OB + tok * 1024 + (h * 2 + 1) * 128 + d0);
                      float a[8];
                      a[0] = pg8::bf_lo(a0.x) - lam * pg8::bf_lo(a1.x); a[1] = pg8::bf_hi(a0.x) - lam * pg8::bf_hi(a1.x); a[2] = pg8::bf_lo(a0.y) - lam * pg8::bf_lo(a1.y); a[3] = pg8::bf_hi(a0.y) - lam * pg8::bf_hi(a1.y);
                      a[4] = pg8::bf_lo(a0.z) - lam * pg8::bf_lo(a1.z); a[5] = pg8::bf_hi(a0.z) - lam * pg8::bf_hi(a1.z); a[6] = pg8::bf_lo(a0.w) - lam * pg8::bf_lo(a1.w); a[7] = pg8::bf_hi(a0.w) - lam * pg8::bf_hi(a1.w);
                      float ss = 0.f;
#pragma unroll
                      for (int j = 0; j < 8; ++j) ss += a[j] * a[j];
                      ss += __shfl_xor(ss, 1); ss += __shfl_xor(ss, 2); ss += __shfl_xor(ss, 4); ss += __shfl_xor(ss, 8);
                      const float rs = 0.8f / sqrtf(ss * (1.f / 128.f) + 1e-6f);
                      v4u o; o.x = pk2(a[0] * rs * sg[0], a[1] * rs * sg[1]); o.y = pk2(a[2] * rs * sg[2], a[3] * rs * sg[3]); o.z = pk2(a[4] * rs * sg[4], a[5] * rs * sg[5]); o.w = pk2(a[6] * rs * sg[6], a[7] * rs * sg[7]);
                      *(GAS v4u*)(MIX + tok * 1024 + h * 128 + d0) = o; } }
            }
        }
}
__device__ __forceinline__ void phase4(Frame& F, unsigned char* lds, unsigned char* ws) { }
__device__ __forceinline__ void phase5(Frame& F, unsigned char* lds, unsigned char* ws) {
        pg8::Gemm g{(const bf16*)(ws + WS_MIX), (const bf16*)(ws + WS_WOUT), 1024, 1024, 1024}; pg8::StaticOrder S; S.init(NTOK, 1024, F.G, (int)blockIdx.x, 1024, 1024);
        pg8::EpiOut E{inp(0), (bf16*)(ws + WS_X1B), (const float*)(ws + WS_MODF) + 2048, F.lds + VEC_OFF};
        pg8::gemm_phase<pg8::EpiOut, pg8::StaticOrder, true, false>(F.lds + RING_OFF, g, S, E, F.wave);

    }
__device__ __forceinline__ void phase6(Frame& F, unsigned char* lds, unsigned char* ws) { p6_router(F, false, !MK_PER_PHASE);  }
__device__ __forceinline__ void phase7(Frame& F, unsigned char* lds, unsigned char* ws) {
        moe_tables(F);
        MoeSched S; S.tile_e = (const LAS unsigned char*)(F.lds + TILE_E_OFF); S.tile0 = (const LAS int*)(F.lds + TILE0_OFF); S.rowtab = (const LAS unsigned*)(F.lds + ROWTAB_OFF);
        S.T = __builtin_amdgcn_readfirstlane(((const LAS int*)(F.lds + MOE_T_OFF))[0]); S.nN = 8; S.G = F.G; S.c = (int)blockIdx.x; S.rev = 0; S.a_mask = -1; S.e_mask = -1; S.tA = 0; S.tBe = (size_t)2048 * 1024; S.tB = (size_t)256 * 1024;
        { const LAS int* cntl = (const LAS int*)(F.lds + CNTL_OFF); LAS unsigned* rt = (LAS unsigned*)(F.lds + ROWTAB_OFF); const int* ptok = (const int*)(ws + WS_PTOK);
          int tokv[18]; bool live[18];
#pragma unroll
          for (int i = 0; i < 18; ++i) { pg8::Unit u; live[i] = S.next(i, u); tokv[i] = 0;
              if (live[i] && F.tid < 256) { const int e = u.e, pos = (u.pm - S.tile0[e]) * 256 + F.tid; tokv[i] = ptok[(size_t)e * NTOK + (pos < cntl[e] ? pos : 0)]; } }
#pragma unroll
          for (int i = 0; i < 18; ++i) if (live[i] && F.tid < 256) rt[i * 256 + F.tid] = (unsigned)tokv[i] * 1024u; }
        VM_WAIT(); LDS_WAIT(); __syncthreads();
        pg8::Gemm g{(const bf16*)(ws + WS_H), (const bf16*)(ws + WS_W1T), 512, 512, 512};
        pg8::EpiMoe1 E{(unsigned char*)(ws + WS_A2), inp(26)};
        pg8::gemm_phase<pg8::EpiMoe1, MoeSched, true, true, true>(F.lds + RING_OFF, g, S, E, F.wave);

    }
__device__ __forceinline__ void phase8(Frame& F, unsigned char* lds, unsigned char* ws) {
        moe_tables(F);
        MoeSched S; S.tile_e = (const LAS unsigned char*)(F.lds + TILE_E_OFF); S.tile0 = (const LAS int*)(F.lds + TILE0_OFF); S.rowtab = (const LAS unsigned*)(F.lds + ROWTAB_OFF);
        S.T = __builtin_amdgcn_readfirstlane(((const LAS int*)(F.lds + MOE_T_OFF))[0]); S.nN = 4; S.G = F.G; S.c = (int)blockIdx.x; S.rev = 1; S.a_mask = -1; S.e_mask = -1; S.tA = (size_t)256 * 1024; S.tBe = (size_t)1024 * 1024; S.tB = (size_t)256 * 1024;
        pg8::Gemm g{(const bf16*)(ws + WS_A2), (const bf16*)(ws + WS_W2T), 512, 512, 512};
        pg8::EpiMoe2 E{(unsigned char*)(ws + WS_Y2), inp(28), -1};
        pg8::gemm_phase<pg8::EpiMoe2, MoeSched, true, false, true>(F.lds + RING_OFF, g, S, E, F.wave);

    }
__device__ __forceinline__ void phase9(Frame& F, unsigned char* lds, unsigned char* ws) { p9_final(F); }
__device__ __forceinline__ bool relaunder(Frame& F) { F.lane = lane_id_opaque(); F.tid = F.wave * 64 + F.lane; return true; }
struct Args { const float* in[30]; float* out; unsigned char* ws; int ph_lo, ph_hi; };
__global__ void __launch_bounds__(NWAVES * 64, 2) mega_fwd(Args args) {
    extern __shared__ __attribute__((aligned(16))) unsigned char lds[];
    Frame F;
    F.lds = (LAS unsigned char*)lds;
    F.tid = threadIdx.x; F.lane = F.tid & 63; F.wave = __builtin_amdgcn_readfirstlane(F.tid >> 6);
    F.G = gridDim.x; { const int bx = blockIdx.x; F.vcu = (F.G % 8 == 0) ? (bx % 8) * (F.G / 8) + bx / 8 : bx; }
    F.ws = args.ws; F.out = args.out; F.ctl = (gu32*)(args.ws + WS_CTL);
    volatile LAS unsigned* MISC = (volatile LAS unsigned*)(F.lds + MISC_OFF);
    for (int u = F.tid; u < (LDS_BYTES - LDSCTL_OFF) / 4; u += NWAVES * 64) ((LAS unsigned*)(F.lds + LDSCTL_OFF))[u] = 0u;
    __syncthreads();
    XcdBarrier bar; bar.bar = (unsigned*)(F.ctl + CW_BAR); bar.x = 0; bar.st = nullptr;
    if (!MK_PER_PHASE) bar = xcd_barrier_post((unsigned*)(F.ctl + CW_BAR), MISC + 8);
    const int lo = args.ph_lo, hi = args.ph_hi;
#ifndef MK_MASK
#define MK_MASK 0x3ff
#endif
#define IN(k) (((MK_MASK >> (k)) & 1) && lo <= (k) && (k) < hi && relaunder(F))
#define SEAM(k) do { if (IN(k) && IN((k) + 1)) xcd_barrier(bar, F.wave); } while (0)
    unsigned char* ws = args.ws;

    if (IN(0)) { phase0(F, lds, ws); }
#if MK_DUP == 0
    if (IN(0)) { phase0(F, lds, ws); SEAM(0); }
#endif
    if (IN(1)) { phase1(F, lds, ws); SEAM(1); }
#if MK_DUP == 1
    if (IN(1)) { phase1(F, lds, ws); SEAM(1); }
#endif
    if (IN(2)) { phase2(F, lds, ws); SEAM(2); }
#if MK_DUP == 2
    if (IN(2)) { phase2(F, lds, ws); SEAM(2); }
#endif
#if MK_DUP == 18
    if (IN(2)) { for (int rr = 0; rr < 8; ++rr) { phase2(F, lds, ws); xcd_barrier(bar, F.wave); } }
#endif
    if (IN(3)) { phase3(F, lds, ws); }
#if MK_DUP == 3
    if (IN(3)) { phase3(F, lds, ws); SEAM(3); }
#endif
    if (IN(4)) { phase4(F, lds, ws); SEAM(4); }
#if MK_DUP == 4
    if (IN(4)) { phase4(F, lds, ws); SEAM(4); }
#endif
    if (IN(5)) { phase5(F, lds, ws); if (!MK_PER_PHASE && IN(6)) p6_fill(F); SEAM(5); }
#if MK_DUP == 5
    if (IN(5)) { phase5(F, lds, ws); SEAM(5); }
#endif
#if MK_DUP == 6
    if (IN(6)) { p6_router(F, true); xcd_barrier(bar, F.wave); }
#endif
    if (IN(6)) { phase6(F, lds, ws); SEAM(6); }
    if (IN(7)) { phase7(F, lds, ws); SEAM(7); }
#if MK_DUP == 7
    if (IN(7)) { phase7(F, lds, ws); SEAM(7); }
#endif
    if (IN(8)) { phase8(F, lds, ws); SEAM(8); }
#if MK_DUP == 8
    if (IN(8)) { phase8(F, lds, ws); SEAM(8); }
#endif
#if MK_DUP == 9
    if (IN(9)) { p9_final(F, true); xcd_barrier(bar, F.wave); }
#endif
#if MK_DUP == 16 || MK_DUP == 17
    if (IN(8)) {
        moe_tables(F);
        MoeSched S; S.tile_e = (const LAS unsigned char*)(F.lds + TILE_E_OFF); S.tile0 = (const LAS int*)(F.lds + TILE0_OFF); S.rowtab = (const LAS unsigned*)(F.lds + ROWTAB_OFF);
        S.T = __builtin_amdgcn_readfirstlane(((const LAS int*)(F.lds + MOE_T_OFF))[0]); S.nN = 4; S.G = F.G; S.c = (int)blockIdx.x; S.rev = 1; S.e_mask = (MK_DUP == 16) ? 0 : -1; S.a_mask = (MK_DUP == 16) ? 0 : -1; S.tA = (size_t)256 * 1024; S.tBe = (size_t)1024 * 1024; S.tB = (size_t)256 * 1024;
        pg8::Gemm g{(const bf16*)(ws + WS_A2), (const bf16*)(ws + WS_W2T), 512, 512, 512};
        pg8::EpiMoe2 E{(unsigned char*)(ws + WS_W1T), inp(28), 127};
        pg8::gemm_phase<pg8::EpiMoe2, MoeSched, true, false, true>(F.lds + RING_OFF, g, S, E, F.wave);
        xcd_barrier(bar, F.wave);
    }
#endif
    if (IN(9)) { phase9(F, lds, ws); }
#if MK_DUP == 19
    if (IN(9)) { xcd_barrier(bar, F.wave); phase7(F, lds, ws); }
#endif
#if MK_DUP == 20
    if (IN(9)) { xcd_barrier(bar, F.wave); phase8(F, lds, ws); }
#endif
#if MK_DUP == 10
    if (IN(9)) { xcd_barrier(bar, F.wave); phase0(F, lds, ws); }
#endif
#if MK_DUP == 11
    if (IN(9)) { xcd_barrier(bar, F.wave); p0_prologue(F, 1); }
#endif
#if MK_DUP == 13
    if (IN(9)) { xcd_barrier(bar, F.wave); p0_prologue(F, 3); }
#endif
#if MK_DUP == 14
    if (IN(9)) { xcd_barrier(bar, F.wave); p0_prologue(F, 4); }
#endif
#if MK_DUP == 15
    if (IN(9)) { xcd_barrier(bar, F.wave); }
#endif
#if MK_DUP == 12
    if (IN(9)) { xcd_barrier(bar, F.wave); p0_prologue(F, 2); }
#endif
#undef IN
#undef SEAM
}

extern "C" void kernel_launch(void* const* d_in, const int* in_sizes, int n_in, void* d_out, int out_size, void* d_ws, size_t ws_size, hipStream_t stream) {
    static int grid = 0;
    if (grid == 0) {
        if (n_in != 30 || in_sizes[0] != NTOK * DM || out_size != NTOK * DM || ws_size < WS_END) { fprintf(stderr, "kernel_launch: unexpected shapes (n_in %d, in0 %d, out %d, ws %zu); nothing launched\n", n_in, n_in > 0 ? in_sizes[0] : -1, out_size, ws_size); grid = -1; return; }
        int dev = 0, cus = 0;
        if (hipGetDevice(&dev) != hipSuccess || hipDeviceGetAttribute(&cus, hipDeviceAttributeMultiprocessorCount, dev) != hipSuccess) { fprintf(stderr, "kernel_launch: device query failed\n"); grid = -1; return; }
        if (hipFuncSetAttribute((const void*)mega_fwd, hipFuncAttributeMaxDynamicSharedMemorySize, LDS_BYTES) != hipSuccess) { fprintf(stderr, "kernel_launch: hipFuncSetAttribute failed\n"); grid = -1; return; }
        (void)hipGetLastError();
        grid = cus;
        if (grid != 256) { fprintf(stderr, "kernel_launch: built for a 256-CU device, found %d CUs; nothing launched\n", grid); grid = -1; return; }
    }
    if (grid < 0) return;
    if (hipMemsetAsync((char*)d_ws + WS_CTL, 0, CTL_ZERO_BYTES, stream) != hipSuccess) { fprintf(stderr, "kernel_launch: memset failed\n"); return; }
    Args a{};
    for (int i = 0; i < 30; ++i) a.in[i] = (const float*)d_in[i];
    a.out = (float*)d_out; a.ws = (unsigned char*)d_ws;
#if MK_PER_PHASE
    for (int p = 0; p < N_PHASES; ++p) { a.ph_lo = p; a.ph_hi = p + 1; hipLaunchKernelGGL(mega_fwd, dim3(grid), dim3(NWAVES * 64), LDS_BYTES, stream, a); }
#else
    a.ph_lo = 0; a.ph_hi = N_PHASES; hipLaunchKernelGGL(mega_fwd, dim3(grid), dim3(NWAVES * 64), LDS_BYTES, stream, a);
#endif
    const hipError_t le = hipPeekAtLastError();
    if (le != hipSuccess) fprintf(stderr, "kernel_launch: launch failed: %s\n", hipGetErrorName(le));
}
```

```cpp
#include <hip/hip_runtime.h>
#include <hip/hip_bf16.h>
#include <cstdio>
#include <cstdint>
#include <cmath>

#ifndef MK_PER_PHASE
#define MK_PER_PHASE 0
#endif

#ifdef MK_EPI2
#define MK_EPI2V MK_EPI2
#else
#define MK_EPI2V (-1)
#endif
#ifndef MK_DUP
#define MK_DUP (-1)
#endif

#define LAS __attribute__((address_space(3)))
#define GAS __attribute__((address_space(1)))

__device__ __forceinline__ int lane_id_opaque() { int l = (int)__builtin_amdgcn_mbcnt_hi(~0u, __builtin_amdgcn_mbcnt_lo(~0u, 0u)); asm volatile("" : "+v"(l)); return l; }

namespace pg8 {
typedef unsigned short bf16_t;
typedef short bf16x8 __attribute__((ext_vector_type(8)));
typedef float f32x4 __attribute__((ext_vector_type(4)));
typedef unsigned u32x4 __attribute__((ext_vector_type(4)));
typedef float f32x2 __attribute__((ext_vector_type(2)));
typedef int i32x4 __attribute__((ext_vector_type(4)));
typedef int i32x8 __attribute__((ext_vector_type(8)));
typedef int i32x2 __attribute__((ext_vector_type(2)));
constexpr int BM = 256, BK = 64, HALF = 128, HTB = HALF * BK * 2, STAGE_BYTES = 8 * HTB, NXCD = 8, WGM = 8;

__host__ __device__ __forceinline__ int lds_byte(int r, int c) { const int st = (r >> 4) * 2 + (c >> 5), rr = r & 15, cc = c & 31, ob = rr * 64 + cc * 2; return st * 1024 + (ob ^ (((ob >> 9) & 1) << 5)); }
__host__ __device__ __forceinline__ void stage_rc(int b, int& R, int& C) { const int st = b / 1024, sb = b % 1024, swz = sb ^ (((sb >> 9) & 1) << 5); R = (st >> 1) * 16 + swz / 64; C = (st & 1) * 32 + (swz % 64) / 2; }
__host__ __device__ __forceinline__ int perm32(int rho) { const int n = rho >> 4, i = rho & 15; return 8 * (i >> 2) + 4 * n + (i & 3); }

struct Unit { int pm, pn, e; };
struct Gemm { const bf16_t* A; const bf16_t* Bt; int K, lda, ldb; };

struct StaticOrder {
    int nM, nN, nwg, G, c; size_t tA, tB;
    __device__ __forceinline__ void init(int M, int N, int G_, int c_, int lda, int ldb) { nM = M / BM; nN = N / BM; nwg = nM * nN; G = G_; c = c_; tA = (size_t)BM * lda * 2; tB = (size_t)BM * ldb * 2; }
    __device__ __forceinline__ bool next(int i, Unit& u) const {
        const long L = (long)i * G + c; if (L >= nwg) return false;
        int wgid = (int)L; { const int q = nwg / NXCD, r = nwg % NXCD, xcd = wgid % NXCD, off = wgid / NXCD; wgid = (xcd < r ? xcd * (q + 1) : r * (q + 1) + (xcd - r) * q) + off; }
        const int nig = WGM * nN, gid = wgid / nig, fm = gid * WGM, gsz = (nM - fm) < WGM ? (nM - fm) : WGM;
        u.pm = fm + ((wgid % nig) % gsz); u.pn = (wgid % nig) / gsz; u.e = 0; return true;
    }
    __device__ __forceinline__ size_t aoff(const Unit& u) const { return (size_t)u.pm * tA; }
    __device__ __forceinline__ size_t boff(const Unit& u) const { return (size_t)u.pn * tB; }
    __device__ __forceinline__ unsigned rowoff(int, int) const { return 0u; }
};
struct SingleUnit {
    __device__ __forceinline__ bool next(int i, Unit& u) const { if (i > 0) return false; u.pm = 0; u.pn = 0; u.e = 0; return true; }
    __device__ __forceinline__ size_t aoff(const Unit&) const { return 0; }
    __device__ __forceinline__ size_t boff(const Unit&) const { return 0; }
    __device__ __forceinline__ unsigned rowoff(int, int) const { return 0u; }
};

__device__ __forceinline__ unsigned cvt_pk_bf16(float lo, float hi) { unsigned r; asm volatile("v_cvt_pk_bf16_f32 %0, %1, %2" : "=v"(r) : "v"(lo), "v"(hi)); return r; }
__device__ __forceinline__ float sigm(float x) { return __builtin_amdgcn_rcpf(1.0f + __builtin_amdgcn_exp2f(-1.4426950408889634f * x)); }
__device__ __forceinline__ float gelu_tanh(float y) { return y * sigm(1.5957691216057308f * (y + 0.044715f * y * y * y)); }
__device__ __forceinline__ f32x2 gelu_tanh2(f32x2 y) {
    const f32x2 y2 = y * y, u = y * __builtin_elementwise_fma(y2, (f32x2){0.044715f, 0.044715f}, (f32x2){1.f, 1.f}), ea = u * (-1.5957691216057308f * 1.4426950408889634f);
    f32x2 d; d.x = __builtin_amdgcn_exp2f(ea.x); d.y = __builtin_amdgcn_exp2f(ea.y); d = d + 1.0f; f32x2 r; r.x = __builtin_amdgcn_rcpf(d.x); r.y = __builtin_amdgcn_rcpf(d.y); return y * r; }
__device__ __forceinline__ u32x4 pack8(const f32x4& a, const f32x4& b) { u32x4 w; w.x = cvt_pk_bf16(a[0], a[1]); w.y = cvt_pk_bf16(a[2], a[3]); w.z = cvt_pk_bf16(b[0], b[1]); w.w = cvt_pk_bf16(b[2], b[3]); return w; }
__device__ __forceinline__ float clamp_fp8(float v) { return __builtin_amdgcn_fmed3f(v, -448.0f, 448.0f); }
__device__ __forceinline__ i32x2 pack8_fp8(const f32x4& a, const f32x4& c) {
    int w0 = __builtin_amdgcn_cvt_pk_fp8_f32(clamp_fp8(a[0]), clamp_fp8(a[1]), 0, false); w0 = __builtin_amdgcn_cvt_pk_fp8_f32(clamp_fp8(a[2]), clamp_fp8(a[3]), w0, true);
    int w1 = __builtin_amdgcn_cvt_pk_fp8_f32(clamp_fp8(c[0]), clamp_fp8(c[1]), 0, false); w1 = __builtin_amdgcn_cvt_pk_fp8_f32(clamp_fp8(c[2]), clamp_fp8(c[3]), w1, true);
    return (i32x2){w0, w1};
}

struct EpiQKVU {
    static constexpr bool PERM = true, AFTER_DRAIN = false, PROBE2 = (MK_EPI2V == 2);
    bf16_t* QKV; size_t stride; bf16_t* UA; float scale0;
    __device__ __forceinline__ void operator()(const f32x4 (&acc)[2][2][4][2], const Unit& u, int wr, int wc, int fr, int fq) const {
        const int t = u.pn >> 1, colt = (u.pn & 1) * 256 + wc * 32 + 8 * fq, row0 = u.pm * BM + wr * 64 + fr;
        if (t < 3) {
            bf16_t* base = QKV + (size_t)t * stride; const float sc = (t == 0) ? scale0 : 1.f;
#pragma unroll
            for (int ai = 0; ai < 2; ++ai)
#pragma unroll
                for (int m = 0; m < 4; ++m) { bf16_t* rowp = base + (size_t)(row0 + ai * HALF + m * 16) * 512 + colt;
#pragma unroll
                    for (int bj = 0; bj < 2; ++bj) *(u32x4*)(rowp + bj * HALF) = pack8(acc[ai][bj][m][0] * sc, acc[ai][bj][m][1] * sc); }
        } else {
#pragma unroll
            for (int ai = 0; ai < 2; ++ai)
#pragma unroll
                for (int m = 0; m < 4; ++m) { const int r = row0 + ai * HALF + m * 16, b = r >> 12, tt = r & 4095, chunk = tt >> 4, j = tt & 15;
#pragma unroll
                    for (int bj = 0; bj < 2; ++bj) { const int cu = colt + bj * HALF, g = cu >> 4, c0 = cu & 15;
                        *(u32x4*)(UA + ((size_t)((g * 8 + b) * 256 + chunk)) * 384 + j * 16 + c0) = pack8(acc[ai][bj][m][0], acc[ai][bj][m][1]); } }
        }
    }
};
constexpr int XS = 132;
struct EpiX {
    static constexpr bool PERM = false, AFTER_DRAIN = true, PROBE2 = false, HALF_N = true;
    __device__ __forceinline__ void fused(const f32x4 (&acc)[2][2][4][2], const Unit&, int wr, int wc, int fr, int fq, LAS unsigned char* lds, int, int) const {
        LAS float* X = (LAS float*)lds;
#pragma unroll
        for (int ai = 0; ai < 2; ++ai)
#pragma unroll
            for (int m = 0; m < 4; ++m) { const int row = ai * HALF + wr * 64 + m * 16 + fr;
#pragma unroll
                for (int n = 0; n < 2; ++n) *(LAS f32x4*)(X + row * XS + wc * 32 + n * 16 + 4 * fq) = acc[ai][0][m][n]; }
    }
};
struct EpiY {
    static constexpr bool PERM = true, AFTER_DRAIN = false, PROBE2 = false;
    bf16_t* Z; int g, b;
    __device__ __forceinline__ void operator()(const f32x4 (&acc)[2][2][4][2], const Unit&, int wr, int wc, int fr, int fq) const {
#pragma unroll
        for (int ai = 0; ai < 2; ++ai)
#pragma unroll
            for (int m = 0; m < 4; ++m) { const int chunk = ai * HALF + wr * 64 + m * 16 + fr;
#pragma unroll
                for (int bj = 0; bj < 2; ++bj) { const int col0 = bj * HALF + wc * 32 + 8 * fq, s = col0 >> 4, c0 = col0 & 15;
                    f32x4 v0 = acc[ai][bj][m][0], v1 = acc[ai][bj][m][1];
#pragma unroll
                    for (int q = 0; q < 4; q += 2) { const f32x2 a = gelu_tanh2((f32x2){v0[q], v0[q + 1]}), c = gelu_tanh2((f32x2){v1[q], v1[q + 1]}); v0[q] = a.x; v0[q + 1] = a.y; v1[q] = c.x; v1[q + 1] = c.y; }
                    *(u32x4*)(Z + (size_t)(b * 4096 + chunk * 16 + s) * 512 + g * 16 + c0) = pack8(v0, v1); }
                __builtin_amdgcn_sched_barrier(0); }
    }
};
__device__ __forceinline__ float bf_lo(unsigned w) { return __uint_as_float(w << 16); }
__device__ __forceinline__ float bf_hi(unsigned w) { return __uint_as_float(w & 0xffff0000u); }
struct EpiGLU {
    static constexpr bool PERM = true, AFTER_DRAIN = false, PROBE2 = false;
    const bf16_t* Z; bf16_t* MIX; const float* bias;
    __device__ __forceinline__ void operator()(const f32x4 (&acc)[2][2][4][2], const Unit& u, int wr, int wc, int fr, int fq) const {
        const int row0 = u.pm * BM + wr * 64 + fr, col0 = u.pn * BM + wc * 32 + 8 * fq;
        f32x4 bv[2][2];
#pragma unroll
        for (int bj = 0; bj < 2; ++bj)
#pragma unroll
            for (int n = 0; n < 2; ++n) bv[bj][n] = *(const f32x4*)(bias + col0 + bj * HALF + 4 * n);
#pragma unroll
        for (int ai = 0; ai < 2; ++ai)
#pragma unroll
            for (int m = 0; m < 4; ++m) { const size_t row = (size_t)(row0 + ai * HALF + m * 16);
#pragma unroll
                for (int bj = 0; bj < 2; ++bj) { const int col = col0 + bj * HALF; const u32x4 zz = *(const u32x4*)(Z + row * 512 + col);
                    const f32x4 a0 = acc[ai][bj][m][0] + bv[bj][0], a1 = acc[ai][bj][m][1] + bv[bj][1];
                    f32x4 o0, o1;
                    o0[0] = bf_lo(zz.x) * sigm(a0[0]); o0[1] = bf_hi(zz.x) * sigm(a0[1]); o0[2] = bf_lo(zz.y) * sigm(a0[2]); o0[3] = bf_hi(zz.y) * sigm(a0[3]);
                    o1[0] = bf_lo(zz.z) * sigm(a1[0]); o1[1] = bf_hi(zz.z) * sigm(a1[1]); o1[2] = bf_lo(zz.w) * sigm(a1[2]); o1[3] = bf_hi(zz.w) * sigm(a1[3]);
                    *(i32x2*)((unsigned char*)MIX + row * 1024 + 512 + col) = pack8_fp8(o0 * 4.0f, o1 * 4.0f); }
                __builtin_amdgcn_sched_barrier(0); }
    }
};
struct EpiOut {
    static constexpr bool PERM = true, AFTER_DRAIN = false, PROBE2 = (MK_EPI2V == 5);
    const float* X; bf16_t* X1; const float* g1; LAS unsigned char* stg;
    __device__ __forceinline__ void operator()(const f32x4 (&acc)[2][2][4][2], const Unit& u, int wr, int wc, int fr, int fq) const {
        const int col0 = wc * 32 + 8 * fq, b = (u.pm * BM) >> 12, t = (wr * 4 + wc) * 64 + fq * 16 + fr, rs = t >> 4, ch = t & 15;
        f32x4 gv[2][2];
#pragma unroll
        for (int bj = 0; bj < 2; ++bj)
#pragma unroll
            for (int n = 0; n < 2; ++n) gv[bj][n] = *(const f32x4*)(g1 + (size_t)b * 6144 + u.pn * BM + col0 + bj * HALF + 4 * n) * (1.0f / 128.0f);
        LAS unsigned char* wp = stg + (16 * wr + fr) * 528 + col0 * 2; const LAS unsigned char* rp = stg + rs * 528 + ch * 32;
        const size_t off0 = (size_t)(u.pm * BM + 64 * (rs >> 4) + (rs & 15)) * 1024 + u.pn * BM + 16 * ch;
        f32x4 xv[4], xn[4];
#pragma unroll
        for (int q = 0; q < 4; ++q) xv[q] = *(const f32x4*)(X + off0 + 4 * q);
#pragma unroll
        for (int sidx = 0; sidx < 8; ++sidx) { const int ai = sidx >> 2, m = sidx & 3; const size_t off = off0 + (size_t)(ai * HALF + 16 * m) * 1024;
            if (sidx < 7) { const size_t offn = off0 + (size_t)(((sidx + 1) >> 2) * HALF + 16 * ((sidx + 1) & 3)) * 1024;
#pragma unroll
                for (int q = 0; q < 4; ++q) xn[q] = *(const f32x4*)(X + offn + 4 * q); }
#pragma unroll
            for (int bj = 0; bj < 2; ++bj) *(LAS u32x4*)(wp + bj * 256) = pack8(gv[bj][0] * acc[ai][bj][m][0], gv[bj][1] * acc[ai][bj][m][1]);
            asm volatile("s_waitcnt lgkmcnt(0)" ::: "memory"); __builtin_amdgcn_s_barrier(); asm volatile("" ::: "memory");
            const u32x4 m0 = *(const LAS u32x4*)(rp), m1 = *(const LAS u32x4*)(rp + 16);
            f32x4 o0, o1, o2, o3;
            o0 = xv[0] + (f32x4){bf_lo(m0.x), bf_hi(m0.x), bf_lo(m0.y), bf_hi(m0.y)}; o1 = xv[1] + (f32x4){bf_lo(m0.z), bf_hi(m0.z), bf_lo(m0.w), bf_hi(m0.w)};
            o2 = xv[2] + (f32x4){bf_lo(m1.x), bf_hi(m1.x), bf_lo(m1.y), bf_hi(m1.y)}; o3 = xv[3] + (f32x4){bf_lo(m1.z), bf_hi(m1.z), bf_lo(m1.w), bf_hi(m1.w)};
            *(u32x4*)(X1 + off) = pack8(o0, o1); *(u32x4*)(X1 + off + 8) = pack8(o2, o3);
            asm volatile("s_waitcnt lgkmcnt(0)" ::: "memory"); __builtin_amdgcn_s_barrier(); asm volatile("" ::: "memory");
#pragma unroll
            for (int q = 0; q < 4; ++q) xv[q] = xn[q]; }
    }
};
constexpr float F8_ACT = 4.0f, F8_W = 32.0f, F8_UNDO = 1.0f / (4.0f * 32.0f);
struct EpiMoe1 {
    static constexpr bool PERM = true, AFTER_DRAIN = false, PROBE2 = (MK_EPI2V == 7);
    unsigned char* A2; const float* b1;
    __device__ __forceinline__ void operator()(const f32x4 (&acc)[2][2][4][2], const Unit& u, int wr, int wc, int fr, int fq) const {
        asm volatile("" : "+v"(fr), "+v"(fq));
        const int row0 = u.pm * BM + wr * 64 + fr, jc = u.pn * 128 + wc * 32 + 8 * fq;
        f32x4 bg[2], bu[2];
#pragma unroll
        for (int n = 0; n < 2; ++n) { bg[n] = *(const f32x4*)(b1 + (size_t)u.e * 2048 + jc + 4 * n); bu[n] = *(const f32x4*)(b1 + (size_t)u.e * 2048 + 1024 + jc + 4 * n); }
#pragma unroll
        for (int ai = 0; ai < 2; ++ai)
#pragma unroll
            for (int m = 0; m < 4; ++m) { f32x4 o[2];
#pragma unroll
                for (int n = 0; n < 2; ++n) {
#pragma unroll
                    for (int hq = 0; hq < 2; ++hq) { const f32x2 ag = {acc[ai][0][m][n][2 * hq], acc[ai][0][m][n][2 * hq + 1]}, au = {acc[ai][1][m][n][2 * hq], acc[ai][1][m][n][2 * hq + 1]};
                        const f32x2 vbg = {bg[n][2 * hq], bg[n][2 * hq + 1]}, vbu = {bu[n][2 * hq], bu[n][2 * hq + 1]}, k7 = {7.0f, 7.0f}, km7 = {-7.0f, -7.0f}, kund = {F8_UNDO, F8_UNDO};
                        const f32x2 g = __builtin_elementwise_min(__builtin_elementwise_fma(ag, kund, vbg), k7), uu = __builtin_elementwise_min(__builtin_elementwise_max(__builtin_elementwise_fma(au, kund, vbu), km7), k7);
                        const f32x2 ea = g * (-1.702f * 1.4426950408889634f); f32x2 den; den.x = __builtin_amdgcn_exp2f(ea.x); den.y = __builtin_amdgcn_exp2f(ea.y); den = den + 1.0f;
                        f32x2 sg; sg.x = __builtin_amdgcn_rcpf(den.x); sg.y = __builtin_amdgcn_rcpf(den.y);
                        const f32x2 r = __builtin_elementwise_fma(uu, (f32x2){F8_ACT, F8_ACT}, (f32x2){F8_ACT, F8_ACT}) * (g * sg); o[n][2 * hq] = r.x; o[n][2 * hq + 1] = r.y; } }
                *(i32x2*)(A2 + (size_t)(row0 + ai * HALF + m * 16) * 1024 + jc) = pack8_fp8(o[0], o[1]);
                __builtin_amdgcn_sched_barrier(0); }
    }
};
struct EpiMoe2 {
    static constexpr bool PERM = true, AFTER_DRAIN = false, PROBE2 = (MK_EPI2V == 8);
    unsigned char* Y2; const float* b2; int pm_mask;
    __device__ __forceinline__ void operator()(const f32x4 (&acc)[2][2][4][2], const Unit& u, int wr, int wc, int fr, int fq) const {
        asm volatile("" : "+v"(fr), "+v"(fq));
        const int row0 = (u.pm & pm_mask) * BM + wr * 64 + fr, col0 = u.pn * BM + wc * 32 + 8 * fq;
        f32x4 bv[2][2];
#pragma unroll
        for (int bj = 0; bj < 2; ++bj)
#pragma unroll
            for (int n = 0; n < 2; ++n) bv[bj][n] = *(const f32x4*)(b2 + (size_t)u.e * 1024 + col0 + bj * HALF + 4 * n);
#pragma unroll
        for (int ai = 0; ai < 2; ++ai)
#pragma unroll
            for (int m = 0; m < 4; ++m) { unsigned char* rowp = Y2 + (size_t)(row0 + ai * HALF + m * 16) * 1024 + col0;
#pragma unroll
                for (int bj = 0; bj < 2; ++bj) *(i32x2*)(rowp + bj * HALF) = pack8_fp8((acc[ai][bj][m][0] * F8_UNDO + bv[bj][0]) * 8.0f, (acc[ai][bj][m][1] * F8_UNDO + bv[bj][1]) * 8.0f); }
    }
};

template <class E, class = void> struct epi_half_n { static constexpr bool value = false; };
template <class E> struct epi_half_n<E, decltype((void)E::HALF_N)> { static constexpr bool value = E::HALF_N; };
template <class Epi, class Sched, bool ALIGN_EPI, bool GATHER, bool F8 = false>
__device__ __forceinline__ void gemm_phase(LAS unsigned char* lds, const Gemm g, const Sched& S, const Epi& E, const int wave) {
    const int tid = wave * 64 + lane_id_opaque(), wid = __builtin_amdgcn_readfirstlane(tid >> 6), lane = tid & 63,
              wr = wid >> 2, wc = wid & 3, fr = lane & 15, fq = lane >> 4;
    const int nt = g.K / BK; constexpr bool HN = epi_half_n<Epi>::value;
    unsigned voffB[2], vA[2][2];
#pragma unroll
    for (int i = 0; i < 2; ++i) { int R, C; stage_rc(tid * 16 + i * 8192, R, C); const int Rb = Epi::PERM ? ((R & ~31) + perm32(R & 31)) : R;
        voffB[i] = (unsigned)(Rb * g.ldb + C) * 2u;
#pragma unroll
        for (int h = 0; h < 2; ++h) vA[h][i] = (unsigned)((R + h * HALF) * g.lda + C) * 2u; }
    const size_t kstep = (size_t)(BK * 2);
    const size_t hstepB = (size_t)HALF * g.ldb * 2;
    const unsigned ldsw = (unsigned)wid * 1024u;
    const unsigned ldsbase = (unsigned)__builtin_amdgcn_readfirstlane((int)((unsigned)(uintptr_t)lds + ldsw));
    const int aoff = lds_byte(wr * 64 + fr, fq * 8), boff = lds_byte(wc * 32 + fr, fq * 8);
#define PG8_SA(b, h) (((b) * 2 + (h)) * HTB)
#define PG8_SB(b, h) ((4 + (b) * 2 + (h)) * HTB)
#define PG8_STAGE(bufoff, gbase, voff) do { if constexpr (F8) { _Pragma("unroll") for (int _i = 0; _i < 2; ++_i) { unsigned keep_; \
            asm volatile("s_mov_b32 %0, m0\n\ts_mov_b32 m0, %3\n\ts_nop 0\n\tglobal_load_lds_dwordx4 %1, %2\n\ts_mov_b32 m0, %0" : "=&s"(keep_) : "v"((voff)[_i]), "s"((const char*)(gbase)), "s"(ldsbase + (unsigned)((bufoff) + _i * 8192)) : "memory"); } } \
        else { _Pragma("unroll") for (int _i = 0; _i < 2; ++_i) \
        __builtin_amdgcn_global_load_lds((const unsigned*)((const char*)(gbase) + (voff)[_i]), (LAS unsigned*)(lds + (bufoff) + ldsw + _i * 8192), 16, 0, 0); } } while (0)
#define PG8_LDA(dst, b, h) do { if constexpr (F8) { _Pragma("unroll") for (int m = 0; m < 4; ++m) dst##8[m] = PG8_F8CAT(*(const LAS bf16x8*)(lds + PG8_SA(b, h) + aoff + m * 2048), *(const LAS bf16x8*)(lds + PG8_SA(b, h) + aoff + m * 2048 + 1024)); } \
        else { _Pragma("unroll") for (int m = 0; m < 4; ++m) _Pragma("unroll") for (int k = 0; k < 2; ++k) dst[m][k] = *(const LAS bf16x8*)(lds + PG8_SA(b, h) + aoff + m * 2048 + k * 1024); } } while (0)
#define PG8_LDB(dst, b, h) do { if constexpr (F8) { _Pragma("unroll") for (int n = 0; n < 2; ++n) dst##8[n] = PG8_F8CAT(*(const LAS bf16x8*)(lds + PG8_SB(b, h) + boff + n * 2048), *(const LAS bf16x8*)(lds + PG8_SB(b, h) + boff + n * 2048 + 1024)); } \
        else { _Pragma("unroll") for (int n = 0; n < 2; ++n) _Pragma("unroll") for (int k = 0; k < 2; ++k) dst[n][k] = *(const LAS bf16x8*)(lds + PG8_SB(b, h) + boff + n * 2048 + k * 1024); } } while (0)
#define PG8_F8CAT(lo, hi) __builtin_shufflevector(__builtin_bit_cast(i32x4, (lo)), __builtin_bit_cast(i32x4, (hi)), 0, 1, 2, 3, 4, 5, 6, 7)
#define PG8_MMA(ai, bj, At, Bt) do { __builtin_amdgcn_s_setprio(1); \
        if constexpr (F8) { _Pragma("unroll") for (int m = 0; m < 4; ++m) _Pragma("unroll") for (int n = 0; n < 2; ++n) \
            acc[ai][bj][m][n] = __builtin_amdgcn_mfma_scale_f32_16x16x128_f8f6f4(Bt##8[n], At##8[m], acc[ai][bj][m][n], 0, 0, 0, 0x7F7F7F7F, 0, 0x7F7F7F7F); } \
        else { _Pragma("unroll") for (int m = 0; m < 4; ++m) _Pragma("unroll") for (int n = 0; n < 2; ++n) _Pragma("unroll") for (int k = 0; k < 2; ++k) \
            acc[ai][bj][m][n] = __builtin_amdgcn_mfma_f32_16x16x32_bf16(Bt[n][k], At[m][k], acc[ai][bj][m][n], 0, 0, 0); } \
        __builtin_amdgcn_s_setprio(0); } while (0)
#define PG8_WAIT_V(n) asm volatile("s_waitcnt vmcnt(" #n ")" ::: "memory")
#define PG8_WAIT_L(n) asm volatile("s_waitcnt lgkmcnt(" #n ")" ::: "memory")
#define PG8_BAR __builtin_amdgcn_s_barrier()
#define PG8_SCHED __builtin_amdgcn_sched_barrier(0)
#define PG8_GOFF(u_, h, i) ({ const int tq_ = wid * 64 + lane_id_opaque(); int R_, C_; stage_rc(tq_ * 16 + (i) * 8192, R_, C_); S.rowoff((u_), (h) * HALF + R_) + (unsigned)C_ * 2u; })
    Unit cur, nxt; int ui = 0;
    if (!S.next(0, cur)) return;
    if constexpr (GATHER) {
#pragma unroll
        for (int h = 0; h < 2; ++h)
#pragma unroll
            for (int i = 0; i < 2; ++i) vA[h][i] = PG8_GOFF(0, h, i);
    }
    f32x4 acc[2][2][4][2];
#pragma unroll
    for (int a = 0; a < 2; ++a)
#pragma unroll
        for (int b = 0; b < 2; ++b)
#pragma unroll
            for (int m = 0; m < 4; ++m)
#pragma unroll
                for (int n = 0; n < 2; ++n) acc[a][b][m][n] = (f32x4){0.f, 0.f, 0.f, 0.f};
    bf16x8 At[4][2], B0[2][2], B1[2][2]; i32x8 At8[4], B08[2], B18[2];
    const char* cA = (const char*)g.A + S.aoff(cur); const char* cB = (const char*)g.Bt + S.boff(cur);
    PG8_STAGE(PG8_SB(0, 0), cB, voffB); PG8_STAGE(PG8_SB(0, 1), cB + hstepB, voffB); PG8_STAGE(PG8_SA(0, 0), cA, vA[0]); PG8_STAGE(PG8_SA(0, 1), cA, vA[1]);
    if (wr == 1) PG8_BAR;
    PG8_WAIT_V(2); PG8_BAR;
    PG8_STAGE(PG8_SB(1, 0), cB + kstep, voffB); PG8_STAGE(PG8_SA(1, 0), cA + kstep, vA[0]); PG8_STAGE(PG8_SB(1, 1), cB + hstepB + kstep, voffB);
    PG8_WAIT_V(6); PG8_BAR;
    for (;;) {
        const bool has_next = S.next(ui + 1, nxt);
        const char* nA = has_next ? (const char*)g.A + S.aoff(nxt) : cA; const char* nB = has_next ? (const char*)g.Bt + S.boff(nxt) : cB;
#pragma unroll 1
        for (int t = 0; t < nt; t += 2) {
            const bool last = (t == nt - 2);
            const char* a1 = cA + (size_t)(t + 1) * kstep;
            const char* a2 = last ? nA : cA + (size_t)(t + 2) * kstep; const char* b2 = last ? nB : cB + (size_t)(t + 2) * kstep;
            const char* a3 = a2 + kstep; const char* b3 = b2 + kstep;
            unsigned w0[2], w1[2];
            if constexpr (GATHER) { const bool nx_ = last && has_next;
                if (nx_) { w0[0] = PG8_GOFF(ui + 1, 0, 0); w0[1] = PG8_GOFF(ui + 1, 0, 1); w1[0] = PG8_GOFF(ui + 1, 1, 0); w1[1] = PG8_GOFF(ui + 1, 1, 1); }
                else { w0[0] = vA[0][0]; w0[1] = vA[0][1]; w1[0] = vA[1][0]; w1[1] = vA[1][1]; } }
            else { w0[0] = vA[0][0]; w0[1] = vA[0][1]; w1[0] = vA[1][0]; w1[1] = vA[1][1]; }
            PG8_LDB(B0, 0, 0); if constexpr (!HN) PG8_LDB(B1, 0, 1); PG8_SCHED; PG8_LDA(At, 0, 0); PG8_STAGE(PG8_SA(1, 1), a1, vA[1]);
            PG8_WAIT_V(8); PG8_WAIT_L(0); PG8_BAR; PG8_MMA(0, 0, At, B0); if constexpr (!HN) PG8_MMA(0, 1, At, B1); PG8_BAR; PG8_SCHED;
            PG8_LDA(At, 0, 1); PG8_STAGE(PG8_SB(0, 0), b2, voffB); PG8_STAGE(PG8_SB(0, 1), b2 + hstepB, voffB); PG8_STAGE(PG8_SA(0, 0), a2, w0);
            PG8_WAIT_V(8); PG8_WAIT_L(0); PG8_BAR; PG8_MMA(1, 0, At, B0); if constexpr (!HN) PG8_MMA(1, 1, At, B1); PG8_BAR; PG8_SCHED;
            PG8_LDB(B0, 1, 0); if constexpr (!HN) PG8_LDB(B1, 1, 1); PG8_SCHED; PG8_LDA(At, 1, 0); PG8_STAGE(PG8_SA(0, 1), a2, w1);
            PG8_WAIT_V(8); PG8_WAIT_L(0); PG8_BAR; PG8_MMA(0, 0, At, B0); if constexpr (!HN) PG8_MMA(0, 1, At, B1); PG8_BAR; PG8_SCHED;
            PG8_LDA(At, 1, 1); PG8_STAGE(PG8_SB(1, 0), b3, voffB); PG8_STAGE(PG8_SB(1, 1), b3 + hstepB, voffB); PG8_STAGE(PG8_SA(1, 0), a3, w0);
            PG8_WAIT_V(8); PG8_WAIT_L(0); PG8_BAR; PG8_MMA(1, 0, At, B0); if constexpr (!HN) PG8_MMA(1, 1, At, B1); PG8_BAR; PG8_SCHED;
        }
        if constexpr (ALIGN_EPI) { if (wr == 0) PG8_BAR; }
        if constexpr (!Epi::AFTER_DRAIN) { const int te_ = lane_id_opaque(); const int fre = te_ & 15, fqe = (te_ >> 4) & 3;
            E(acc, cur, wr, wc, fre, fqe);
#ifdef MK_EPI2
            if constexpr (Epi::PROBE2) { asm volatile("" ::: "memory"); E(acc, cur, wr, wc, fr, fq); }
#endif
        }
        if (!has_next) break;
#pragma unroll
        for (int a = 0; a < 2; ++a)
#pragma unroll
            for (int b = 0; b < 2; ++b)
#pragma unroll
                for (int m = 0; m < 4; ++m)
#pragma unroll
                    for (int n = 0; n < 2; ++n) acc[a][b][m][n] = (f32x4){0.f, 0.f, 0.f, 0.f};
        cur = nxt; cA = nA; cB = nB; ++ui;
        if constexpr (GATHER) {
#pragma unroll
            for (int h = 0; h < 2; ++h)
#pragma unroll
                for (int i = 0; i < 2; ++i) vA[h][i] = PG8_GOFF(ui, h, i);
        }
        if constexpr (ALIGN_EPI) { if (wr == 1) PG8_BAR; }
    }
    PG8_WAIT_V(0);
    if constexpr (!ALIGN_EPI) { if (wr == 0) PG8_BAR; }
    PG8_BAR;
    if constexpr (Epi::AFTER_DRAIN) { E.fused(acc, cur, wr, wc, fr, fq, lds, wid, lane); }
#undef PG8_SA
#undef PG8_SB
#undef PG8_STAGE
#undef PG8_LDA
#undef PG8_LDB
#undef PG8_MMA
#undef PG8_GOFF
#undef PG8_F8CAT
#undef PG8_WAIT_V
#undef PG8_WAIT_L
#undef PG8_BAR
#undef PG8_SCHED
}
}

namespace attn_body {
using bf16=__hip_bfloat16;
using bf16x8=__attribute__((ext_vector_type(8)))short;
using s16x4=__attribute__((ext_vector_type(4)))short;
using f32x16=__attribute__((ext_vector_type(16)))float;
using u32x4=__attribute__((ext_vector_type(4)))unsigned;
constexpr int SEQ=4096,D=64,DMI=512,DMO=1024;
constexpr int NW=8,QBLK=32,QB=QBLK*NW,KVBLK=64,NQB=SEQ/QB;
__device__ __forceinline__ int crow(int r,int hi){return (r&3)+8*(r>>2)+4*hi;}
#define SBAR() __builtin_amdgcn_sched_barrier(0)
__device__ __forceinline__ void cmask(f32x16&p0,f32x16&p1,int jb,int qrel,int hi){
  const float NEG=-INFINITY; int kb=64*jb+4*hi;
  #pragma unroll
  for(int r=0;r<16;++r){int kv=kb+(r&3)+8*(r>>2); if(kv>qrel)p0[r]=NEG; if(kv+32>qrel)p1[r]=NEG;}
}
constexpr int NSLOT=3, SLOTB=8192;
constexpr int LDS_K=0, LDS_V=NSLOT*SLOTB, LDS_WS=2*NSLOT*SLOTB, LDS_OST=LDS_WS+NW*64*4, LDS_BYTES=LDS_OST+NW*4096;
constexpr float C2=0.125f*1.4426950408889634f;
__device__ __forceinline__ void glds16(const void*gsrc,unsigned lds_dst){unsigned keep;
  asm volatile("s_mov_b32 %0, m0\n\ts_mov_b32 m0, %2\n\ts_nop 0\n\tglobal_load_lds_dwordx4 %1, off\n\ts_mov_b32 m0, %0":"=&s"(keep):"v"(gsrc),"s"(lds_dst):"memory");}
__device__ __forceinline__ float max3f(float a,float b,float c){float r;asm("v_max3_f32 %0, %1, %2, %3":"=v"(r):"v"(a),"v"(b),"v"(c));return r;}
__device__ __forceinline__ float max2f(float a,float b){float r;asm("v_max_f32_e32 %0, %1, %2":"=v"(r):"v"(a),"v"(b));return r;}
__device__ __forceinline__ float fadd_s(float a,float b){float r;asm("v_add_f32_e32 %0, %1, %2":"=v"(r):"v"(a),"v"(b));return r;}
__device__ __forceinline__ float fsub_s(float a,float b){float r;asm("v_sub_f32_e32 %0, %1, %2":"=v"(r):"v"(a),"v"(b));return r;}
typedef float f32x2_t __attribute__((ext_vector_type(2))); typedef __bf16 bf16x2_t __attribute__((ext_vector_type(2)));
__device__ __forceinline__ unsigned cvtpk_s(float lo,float hi){f32x2_t v={lo,hi};bf16x2_t b=__builtin_convertvector(v,bf16x2_t);return __builtin_bit_cast(unsigned,b);}
#define WAIT_BAR(N) asm volatile("s_waitcnt vmcnt(" #N ") lgkmcnt(0)\n\ts_barrier":::"memory")

__device__ __forceinline__ void qkt(f32x16&p0,f32x16&p1,const char*Kslot,const bf16x8*qr,const f32x16&negm,int r32,int hi){
  const char*kb=Kslot+hi*1024+r32*16;
  #pragma unroll
  for(int d0=0;d0<4;++d0){
    const bf16x8 b0=*reinterpret_cast<const bf16x8*>(kb+d0*2048);
    const bf16x8 b1=*reinterpret_cast<const bf16x8*>(kb+d0*2048+512);
    if(d0==0){p0=__builtin_amdgcn_mfma_f32_32x32x16_bf16(b0,qr[0],negm,0,0,0);p1=__builtin_amdgcn_mfma_f32_32x32x16_bf16(b1,qr[0],negm,0,0,0);}
    else{p0=__builtin_amdgcn_mfma_f32_32x32x16_bf16(b0,qr[d0],p0,0,0,0);p1=__builtin_amdgcn_mfma_f32_32x32x16_bf16(b1,qr[d0],p1,0,0,0);}}
}
typedef __attribute__((address_space(3))) const char* lds_cptr;
typedef short v4i16_t __attribute__((ext_vector_type(4)));
__device__ __forceinline__ void kload8(bf16x8*kf,lds_cptr kp){
  kf[0]=*(const __attribute__((address_space(3))) bf16x8*)(kp);      kf[1]=*(const __attribute__((address_space(3))) bf16x8*)(kp+512);
  kf[2]=*(const __attribute__((address_space(3))) bf16x8*)(kp+2048); kf[3]=*(const __attribute__((address_space(3))) bf16x8*)(kp+2560);
  kf[4]=*(const __attribute__((address_space(3))) bf16x8*)(kp+4096); kf[5]=*(const __attribute__((address_space(3))) bf16x8*)(kp+4608);
  kf[6]=*(const __attribute__((address_space(3))) bf16x8*)(kp+6144); kf[7]=*(const __attribute__((address_space(3))) bf16x8*)(kp+6656);
}
__device__ __forceinline__ void kload2(bf16x8*kf,lds_cptr kp,int j){ kf[2*j]=*(const __attribute__((address_space(3))) bf16x8*)(kp+j*2048); kf[2*j+1]=*(const __attribute__((address_space(3))) bf16x8*)(kp+j*2048+512); }
__device__ __forceinline__ s16x4 vtr(lds_cptr p){ return __builtin_bit_cast(s16x4,__builtin_amdgcn_ds_read_tr16_b64_v4i16((__attribute__((address_space(3))) v4i16_t*)p)); }
__device__ __forceinline__ float rowmax(const f32x16&p0,const f32x16&p1){
  float a=max3f(p0[0],p0[1],p1[0]),b=max3f(p0[2],p0[3],p1[1]);a=max3f(a,p1[2],p1[3]);
  #pragma unroll
  for(int r=4;r<16;r+=4){a=max3f(a,p0[r],p0[r+1]);b=max3f(b,p0[r+2],p0[r+3]);a=max3f(a,p1[r],p1[r+1]);b=max3f(b,p1[r+2],p1[r+3]);}
  const float m=max2f(a,b);
  auto rr=__builtin_amdgcn_permlane32_swap(__float_as_uint(m),__float_as_uint(m),false,false);
  return max2f(__uint_as_float(rr[0]),__uint_as_float(rr[1]));
}
__device__ __forceinline__ void pv(f32x16*o,int vb,bf16x8 pa0,bf16x8 pa1,bf16x8 pa2,bf16x8 pa3){
  #pragma unroll
  for(int d0=0;d0<2;++d0){s16x4 lo[4],hi[4];
    #pragma unroll
    for(int ks=0;ks<4;++ks){
      asm volatile("ds_read_b64_tr_b16 %0,%1 offset:%c2":"=&v"(lo[ks]):"v"(vb),"i"(d0*4096+ks*1024):"memory");
      asm volatile("ds_read_b64_tr_b16 %0,%1 offset:%c2":"=&v"(hi[ks]):"v"(vb),"i"(d0*4096+ks*1024+512):"memory");}
    asm volatile("s_waitcnt lgkmcnt(0)":::"memory");SBAR();
    #define PK(k) (bf16x8){lo[k][0],lo[k][1],lo[k][2],lo[k][3],hi[k][0],hi[k][1],hi[k][2],hi[k][3]}
    o[d0]=__builtin_amdgcn_mfma_f32_32x32x16_bf16(pa0,PK(0),o[d0],0,0,0);
    o[d0]=__builtin_amdgcn_mfma_f32_32x32x16_bf16(pa1,PK(1),o[d0],0,0,0);
    o[d0]=__builtin_amdgcn_mfma_f32_32x32x16_bf16(pa2,PK(2),o[d0],0,0,0);
    o[d0]=__builtin_amdgcn_mfma_f32_32x32x16_bf16(pa3,PK(3),o[d0],0,0,0);
    #undef PK
  }
}
#define ATTN_STORE16(p,v) (*(u32x4*)(p)=(v))
template<int THRL> __device__ __forceinline__ void attn_unit(int qb,const bf16*Qh,const bf16*__restrict__ Kh,const bf16*__restrict__ Vh,bf16*Oh,char*shm){
  int tid_=threadIdx.x; asm volatile("":"+v"(tid_));
  const int tid=tid_,lane=tid&63,r32=lane&31,hi=lane>>5; const int wid=__builtin_amdgcn_readfirstlane(tid>>6);
  const int q0=qb*QB;
  const bf16*Qw=Qh+(long)(q0+wid*QBLK)*DMI;
  const unsigned lds0=(unsigned)(uintptr_t)shm;
  float*wsf=(float*)(shm+LDS_WS)+wid*64;
  const bf16*ksrc=Kh+(long)lane*DMI+wid*8;
  const bf16*vsrc=Vh+(long)(16*(wid&3)+(lane>>2))*DMI+(wid>>2)*32+(lane&3)*8;
  const unsigned kdst=lds0+LDS_K+wid*1024, vdst=lds0+LDS_V+wid*1024;
  #define DMA_K(t,slot) glds16(ksrc+(long)(t)*KVBLK*DMI,(unsigned)__builtin_amdgcn_readfirstlane(kdst+(slot)))
  #define DMA_V(t,slot) glds16(vsrc+(long)(t)*KVBLK*DMI,(unsigned)__builtin_amdgcn_readfirstlane(vdst+(slot)))
  const int vb0=(int)(lds0+LDS_V)+((lane>>4)&1)*32+(lane&3)*8+(4*hi+((lane&15)>>2))*64;
  const char*Kbase=shm+LDS_K; bf16x8 kf[8];
  const lds_cptr shm3=(lds_cptr)shm; const lds_cptr kp0=shm3+LDS_K+hi*1024+r32*16; const lds_cptr vp0=shm3+LDS_V+((lane>>4)&1)*32+(lane&3)*8+(4*hi+((lane&15)>>2))*64;
  const int NT=(q0+QB)/KVBLK;
  DMA_K(0,0);DMA_V(0,0);DMA_K(1,SLOTB);
  bf16x8 qr[4];
  #pragma unroll
  for(int d0=0;d0<4;++d0)qr[d0]=*reinterpret_cast<const bf16x8*>(&Qw[(long)r32*DMI+d0*16+hi*8]);
  float mhat=0.f,l_reg=0.f;f32x16 o[2];o[0]=f32x16{};o[1]=f32x16{};f32x16 negm=f32x16{};asm volatile("":"+v"(negm));
  const int qrel=wid*QBLK+r32;
  #define CMASK(P0,P1,t) do{int jb_=(t)-(NT-4); if(jb_>=0)cmask(P0,P1,jb_,qrel,hi);}while(0)
  bool resc=false;
  #define START(P0,P1) do{ const float rm=rowmax(P0,P1); resc=false; \
    { const float dl=rm; mhat=fadd_s(mhat,dl); \
      _Pragma("unroll") for(int r=0;r<16;++r){P0[r]=fsub_s(P0[r],dl);P1[r]=fsub_s(P1[r],dl);} \
      _Pragma("unroll") for(int r=0;r<16;++r)negm[r]=-mhat; asm volatile("":"+v"(negm)); } \
    _Pragma("unroll") for(int r=0;r<16;++r)P0[r]=__builtin_amdgcn_exp2f(P0[r]); }while(0)
  #define RESC() do{ if(resc){ asm volatile("s_waitcnt lgkmcnt(0)":::"memory"); \
      _Pragma("unroll") for(int d_=0;d_<2;++d_) _Pragma("unroll") for(int r=0;r<16;++r)o[d_][r]*=wsf[crow(r,hi)]; } }while(0)
  f32x16 pA0,pA1,pB0,pB1;
  int sl_prev=0,sl_cur=0,sl_next=SLOTB;
  #define ROT() do{sl_prev=sl_cur;sl_cur=sl_next;sl_next=(sl_next==(NSLOT-1)*SLOTB)?0:sl_next+SLOTB;}while(0)
  DMA_K(2,2*SLOTB);
  WAIT_BAR(3);
  qkt(pA0,pA1,Kbase,qr,negm,r32,hi);asm volatile("s_nop 15\n\ts_nop 7":"+v"(pA0),"+v"(pA1));CMASK(pA0,pA1,0);
  START(pA0,pA1);
  _Pragma("unroll") for(int r=0;r<16;++r)pA1[r]=__builtin_amdgcn_exp2f(pA1[r]);
  WAIT_BAR(0);
  DMA_K(3,0);DMA_V(1,SLOTB);
  ROT();
  kload8(kf,kp0+sl_cur);
  WAIT_BAR(2);
  s16x4 vlo[8],vhi[8]; u32x4 pw0,pw1,pw2,pw3;
  #define PKW(P,B) cvtpk_s(P[B],P[B+1])
  #define PAF(k) __builtin_bit_cast(bf16x8,pw##k)
  #define VFR(i) (bf16x8){vlo[i][0],vlo[i][1],vlo[i][2],vlo[i][3],vhi[i][0],vhi[i][1],vhi[i][2],vhi[i][3]}
  #define PIN(x) asm volatile("":"+v"(x))
  #define MX3(a,b,c) __builtin_fmaxf(__builtin_fmaxf((a),(b)),(c))
  #define GAPA(MF,A0,A1,A2,A3,W0,W1,PW) do{ MF; sacc+=A0; sacc+=A1; sacc+=A2; sacc+=A3; PIN(sacc); W0; W1; PIN(PW); SBAR(); }while(0)
  #define EX(v) __builtin_amdgcn_exp2f(v)
  #define GAPB(MF,X,B) do{ MF; X[B]=EX(X[B]); X[B+1]=EX(X[B+1]); X[B+2]=EX(X[B+2]); X[B+3]=EX(X[B+3]); PIN(X); SBAR(); }while(0)
  #define VRD(i) do{ vlo[i]=vtr(vp_+(((i)>>2)*4096+((i)&3)*1024)); vhi[i]=vtr(vp_+(((i)>>2)*4096+((i)&3)*1024+512)); }while(0)
  #define KRD(G,j) do{ if(G){ kload2(kf,kp0+sl_next,j); SBAR(); } }while(0)
  #define STEP(C0,C1,P0,P1,t,GK,GV,GL) do{ SBAR(); \
    const lds_cptr vp_=vp0+sl_prev; \
    VRD(0); SBAR(); float sacc=(P0[0]+P0[1]); \
    GAPA(C0=__builtin_amdgcn_mfma_f32_32x32x16_bf16(kf[0],qr[0],negm,0,0,0), P0[2],P0[3],P0[4],P0[5],     pw0[0]=PKW(P0,0), pw0[1]=PKW(P0,2), pw0); \
    VRD(4); SBAR(); GAPA(C1=__builtin_amdgcn_mfma_f32_32x32x16_bf16(kf[1],qr[0],negm,0,0,0), P0[6],P0[7],P0[8],P0[9],     pw0[2]=PKW(P0,4), pw0[3]=PKW(P0,6), pw0); \
    VRD(1); SBAR(); GAPA(C0=__builtin_amdgcn_mfma_f32_32x32x16_bf16(kf[2],qr[1],C0,0,0,0),   P0[10],P0[11],P0[12],P0[13], pw1[0]=PKW(P0,8), pw1[1]=PKW(P0,10), pw1); \
    VRD(5); SBAR(); GAPA(C1=__builtin_amdgcn_mfma_f32_32x32x16_bf16(kf[3],qr[1],C1,0,0,0),   P0[14],P0[15],P1[0],P1[1],   pw1[2]=PKW(P0,12),pw1[3]=PKW(P0,14), pw1); \
    VRD(2); SBAR(); GAPA(C0=__builtin_amdgcn_mfma_f32_32x32x16_bf16(kf[4],qr[2],C0,0,0,0),   P1[2],P1[3],P1[4],P1[5],     pw2[0]=PKW(P1,0), pw2[1]=PKW(P1,2), pw2); \
    VRD(6); SBAR(); GAPA(C1=__builtin_amdgcn_mfma_f32_32x32x16_bf16(kf[5],qr[2],C1,0,0,0),   P1[6],P1[7],P1[8],P1[9],     pw2[2]=PKW(P1,4), pw2[3]=PKW(P1,6), pw2); \
    VRD(3); SBAR(); GAPA(C0=__builtin_amdgcn_mfma_f32_32x32x16_bf16(kf[6],qr[3],C0,0,0,0),   P1[10],P1[11],P1[12],P1[13], pw3[0]=PKW(P1,8), pw3[1]=PKW(P1,10), pw3); \
    VRD(7); SBAR(); GAPA(C1=__builtin_amdgcn_mfma_f32_32x32x16_bf16(kf[7],qr[3],C1,0,0,0),   P1[14],P1[15],0.f,0.f,       pw3[2]=PKW(P1,12),pw3[3]=PKW(P1,14), pw3); \
    l_reg+=sacc; \
    if(GK){DMA_K((t)+3,sl_cur);} if(GV){DMA_V((t)+1,sl_next);} \
    CMASK(C0,C1,t); \
    { float a=MX3(C0[0],C0[1],C1[0]),b=MX3(C0[2],C0[3],C1[1]); a=MX3(a,C1[2],C1[3]); \
      _Pragma("unroll") for(int r=4;r<16;r+=4){a=MX3(a,C0[r],C0[r+1]);b=MX3(b,C0[r+2],C0[r+3]);a=MX3(a,C1[r],C1[r+1]);b=MX3(b,C1[r+2],C1[r+3]);} \
      float rm=__builtin_fmaxf(a,b); { auto rr=__builtin_amdgcn_permlane32_swap(__float_as_uint(rm),__float_as_uint(rm),false,false); rm=__builtin_fmaxf(__uint_as_float(rr[0]),__uint_as_float(rr[1])); } \
      resc=false; \
      if(__builtin_expect(__any(rm>(float)THRL),0)){ const float dl=__builtin_fmaxf(rm,0.f); mhat+=dl; \
        _Pragma("unroll") for(int r=0;r<16;++r){C0[r]-=dl;C1[r]-=dl;} \
        _Pragma("unroll") for(int r=0;r<16;++r)negm[r]=-mhat; asm volatile("":"+v"(negm)); \
        const float f=__builtin_amdgcn_exp2f(-dl); l_reg*=f; if(hi==0)wsf[r32]=f; resc=true; } } \
    SBAR(); \
    GAPB(o[0]=__builtin_amdgcn_mfma_f32_32x32x16_bf16(PAF(0),VFR(0),o[0],0,0,0), C0,0); \
    GAPB(o[1]=__builtin_amdgcn_mfma_f32_32x32x16_bf16(PAF(0),VFR(4),o[1],0,0,0), C0,4); \
    KRD(GL,0); GAPB(o[0]=__builtin_amdgcn_mfma_f32_32x32x16_bf16(PAF(1),VFR(1),o[0],0,0,0), C0,8); \
    KRD(GL,1); GAPB(o[1]=__builtin_amdgcn_mfma_f32_32x32x16_bf16(PAF(1),VFR(5),o[1],0,0,0), C0,12); \
    KRD(GL,2); GAPB(o[0]=__builtin_amdgcn_mfma_f32_32x32x16_bf16(PAF(2),VFR(2),o[0],0,0,0), C1,0); \
    KRD(GL,3); GAPB(o[1]=__builtin_amdgcn_mfma_f32_32x32x16_bf16(PAF(2),VFR(6),o[1],0,0,0), C1,4); \
    GAPB(o[0]=__builtin_amdgcn_mfma_f32_32x32x16_bf16(PAF(3),VFR(3),o[0],0,0,0), C1,8); \
    GAPB(o[1]=__builtin_amdgcn_mfma_f32_32x32x16_bf16(PAF(3),VFR(7),o[1],0,0,0), C1,12); \
    }while(0)
  int t=1;
  #undef CMASK
  #define CMASK(P0,P1,t) do{}while(0)
  for(;t+5<NT;t+=2){
    STEP(pB0,pB1,pA0,pA1,t,true,true,true);     WAIT_BAR(2); RESC(); ROT();
    STEP(pA0,pA1,pB0,pB1,t+1,true,true,true);   WAIT_BAR(2); RESC(); ROT();
  }
  #undef CMASK
  #define CMASK(P0,P1,t) do{int jb_=(t)-(NT-4); if(jb_>=0)cmask(P0,P1,jb_,qrel,hi);}while(0)
  #define ENDW(tt) do{ if((tt)+3<NT){WAIT_BAR(2);} else if((tt)+2<NT){WAIT_BAR(1);} else {WAIT_BAR(0);} }while(0)
  for(;t+1<NT;t+=2){
    STEP(pB0,pB1,pA0,pA1,t,(t+3<NT),(t+1<NT),(t+1<NT));       ENDW(t);   RESC(); ROT();
    STEP(pA0,pA1,pB0,pB1,t+1,(t+4<NT),(t+2<NT),(t+2<NT));     ENDW(t+1); RESC(); ROT();
  }
  STEP(pB0,pB1,pA0,pA1,NT-1,false,false,false); RESC();
  { float sacc=pB0[0]+pB0[1]; _Pragma("unroll") for(int r=2;r<16;++r)sacc+=pB0[r]; _Pragma("unroll") for(int r=0;r<16;++r)sacc+=pB1[r]; l_reg+=sacc;
    pw0=(u32x4){PKW(pB0,0),PKW(pB0,2),PKW(pB0,4),PKW(pB0,6)};pw1=(u32x4){PKW(pB0,8),PKW(pB0,10),PKW(pB0,12),PKW(pB0,14)};pw2=(u32x4){PKW(pB1,0),PKW(pB1,2),PKW(pB1,4),PKW(pB1,6)};pw3=(u32x4){PKW(pB1,8),PKW(pB1,10),PKW(pB1,12),PKW(pB1,14)};
    SBAR(); pv(o,vb0+sl_cur,PAF(0),PAF(1),PAF(2),PAF(3)); }
  #undef PKW
  #undef PAF
  #undef VFR
  #undef PIN
  #undef MX3
  #undef GAPA
  #undef GAPB
  #undef EX
  #undef VRD
  #undef KRD
  #undef STEP
  #undef ENDW
  {auto rr=__builtin_amdgcn_permlane32_swap(__float_as_uint(l_reg),__float_as_uint(l_reg),false,false);l_reg=__uint_as_float(rr[0])+__uint_as_float(rr[1]);}
  if(hi==0)wsf[32+r32]=l_reg;asm volatile("s_waitcnt lgkmcnt(0)":::"memory");
  float rli[16];
  #pragma unroll
  for(int r=0;r<16;++r)rli[r]=__builtin_amdgcn_rcpf(wsf[32+crow(r,hi)]);
  bf16*Ow=Oh+(long)(q0+wid*QBLK)*DMO;
  { bf16*stg=(bf16*)(shm+LDS_OST)+wid*2048;
    #pragma unroll
    for(int r=0;r<16;++r){const int orow=crow(r,hi);
      #pragma unroll
      for(int d0=0;d0<2;++d0)stg[orow*64+d0*32+r32]=__float2bfloat16(o[d0][r]*rli[r]);}
    asm volatile("s_waitcnt lgkmcnt(0)":::"memory");
    #pragma unroll
    for(int i=0;i<4;++i){const int row=i*8+(lane>>3),ch=lane&7; const u32x4 v=*(const u32x4*)(stg+row*64+ch*8); ATTN_STORE16(Ow+(long)row*DMO+ch*8,v);} }
  asm volatile("s_waitcnt lgkmcnt(0)\n\ts_barrier":::"memory");
  #undef DMA_K
  #undef DMA_V
  #undef CMASK
  #undef START
  #undef RESC
  #undef ROT
}
constexpr int LDS2_K=0, LDS2_V=4*SLOTB, LDS2_WS=LDS2_V+NSLOT*2*SLOTB, LDS2_OST=LDS2_WS+NW*64*4, LDS2_BYTES=LDS2_OST+NW*8192;
__device__ __forceinline__ void pv4(f32x16*o,int vb,bf16x8 pa0,bf16x8 pa1,bf16x8 pa2,bf16x8 pa3){
  #pragma unroll
  for(int d0=0;d0<4;++d0){s16x4 lo[4],hi[4];
    #pragma unroll
    for(int ks=0;ks<4;++ks){
      asm volatile("ds_read_b64_tr_b16 %0,%1 offset:%c2":"=&v"(lo[ks]):"v"(vb),"i"(d0*4096+ks*1024):"memory");
      asm volatile("ds_read_b64_tr_b16 %0,%1 offset:%c2":"=&v"(hi[ks]):"v"(vb),"i"(d0*4096+ks*1024+512):"memory");}
    asm volatile("s_waitcnt lgkmcnt(0)":::"memory");SBAR();
    #define PK(k) (bf16x8){lo[k][0],lo[k][1],lo[k][2],lo[k][3],hi[k][0],hi[k][1],hi[k][2],hi[k][3]}
    o[d0]=__builtin_amdgcn_mfma_f32_32x32x16_bf16(pa0,PK(0),o[d0],0,0,0);
    o[d0]=__builtin_amdgcn_mfma_f32_32x32x16_bf16(pa1,PK(1),o[d0],0,0,0);
    o[d0]=__builtin_amdgcn_mfma_f32_32x32x16_bf16(pa2,PK(2),o[d0],0,0,0);
    o[d0]=__builtin_amdgcn_mfma_f32_32x32x16_bf16(pa3,PK(3),o[d0],0,0,0);
    #undef PK
  }
}
template<int THRL> __device__ __forceinline__ void attn_unit2(int qb,const bf16*Qh,const bf16*__restrict__ Kh,const bf16*__restrict__ Vh,bf16*Oh,char*shm,const int wave){
  const int tid=wave*64+lane_id_opaque(),lane=tid&63,r32=lane&31,hi=lane>>5; const int wid=__builtin_amdgcn_readfirstlane(tid>>6);
  const int q0=qb*QB;
  const bf16*Qw=Qh+(long)(q0+wid*QBLK)*DMI;
  const unsigned lds0=(unsigned)(uintptr_t)shm;
  float*wsf=(float*)(shm+LDS2_WS)+wid*64;
  const bf16*ksrc=Kh+(long)lane*DMI+wid*8;
  const bf16*vsrc=Vh+(long)(16*(wid&3)+(lane>>2))*DMI+(wid>>2)*32+(lane&3)*8;
  const unsigned kdst=lds0+LDS2_K+wid*1024, vdst=lds0+LDS2_V+(wid>>2)*4096+(wid&3)*1024;
  #define DMA_K(t,slot) glds16(ksrc+(long)(t)*KVBLK*DMI,(unsigned)__builtin_amdgcn_readfirstlane(kdst+(slot)))
  #define DMA_V(t,slot) do{ glds16(vsrc+(long)(t)*KVBLK*DMI,(unsigned)__builtin_amdgcn_readfirstlane(vdst+2*(slot))); glds16(vsrc+(long)(t)*KVBLK*DMI+64,(unsigned)__builtin_amdgcn_readfirstlane(vdst+2*(slot)+8192)); }while(0)
  const int vb0=(int)(lds0+LDS2_V)+((lane>>4)&1)*32+(lane&3)*8+(4*hi+((lane&15)>>2))*64;
  const char*Kbase=shm+LDS2_K; bf16x8 kf[8];
  const lds_cptr shm3=(lds_cptr)shm; const lds_cptr kp0=shm3+LDS2_K+hi*1024+r32*16; const lds_cptr vp0=shm3+LDS2_V+((lane>>4)&1)*32+(lane&3)*8+(4*hi+((lane&15)>>2))*64;
  const int NT=(q0+QB)/KVBLK;
  DMA_K(0,0);DMA_V(0,0);DMA_K(1,SLOTB);DMA_K(2,2*SLOTB);
  bf16x8 qr[4];
  #pragma unroll
  for(int d0=0;d0<4;++d0)qr[d0]=*reinterpret_cast<const bf16x8*>(&Qw[(long)r32*DMI+d0*16+hi*8]);
  float zf_=0.f; asm volatile("":"+v"(zf_)); f32x16 zz_; _Pragma("unroll") for(int r=0;r<16;++r)zz_[r]=zf_;
  float mhat=0.f,l_reg=0.f;f32x16 o[4];o[0]=zz_;o[1]=zz_;o[2]=zz_;o[3]=zz_;f32x16 negm=zz_;asm volatile("":"+v"(negm));
  const int qrel=wid*QBLK+r32;
  #define CMASK(P0,P1,t) do{int jb_=(t)-(NT-4); if(jb_>=0)cmask(P0,P1,jb_,qrel,hi);}while(0)
  bool resc=false;
  #define START(P0,P1) do{ const float rm=rowmax(P0,P1); resc=false; \
    { const float dl=rm; mhat=fadd_s(mhat,dl); \
      _Pragma("unroll") for(int r=0;r<16;++r){P0[r]=fsub_s(P0[r],dl);P1[r]=fsub_s(P1[r],dl);} \
      _Pragma("unroll") for(int r=0;r<16;++r)negm[r]=-mhat; asm volatile("":"+v"(negm)); } \
    _Pragma("unroll") for(int r=0;r<16;++r)P0[r]=__builtin_amdgcn_exp2f(P0[r]); }while(0)
  #define RESC() do{ if(resc){ asm volatile("s_waitcnt lgkmcnt(0)":::"memory"); \
      _Pragma("unroll") for(int d_=0;d_<4;++d_) _Pragma("unroll") for(int r=0;r<16;++r)o[d_][r]*=wsf[crow(r,hi)]; } }while(0)
  f32x16 pA0,pA1,pB0,pB1;
  int sl_prev=0,sl_cur=0,sl_next=SLOTB;
  int kc=0,kn=SLOTB,kp=3*SLOTB;
  #define ROT() do{sl_prev=sl_cur;sl_cur=sl_next;sl_next=(sl_next==(NSLOT-1)*SLOTB)?0:sl_next+SLOTB; kp=kc;kc=kn;kn=(kn==3*SLOTB)?0:kn+SLOTB;}while(0)
  WAIT_BAR(4);
  qkt(pA0,pA1,Kbase,qr,negm,r32,hi);asm volatile("s_nop 15\n\ts_nop 7":"+v"(pA0),"+v"(pA1));CMASK(pA0,pA1,0);
  START(pA0,pA1);
  _Pragma("unroll") for(int r=0;r<16;++r)pA1[r]=__builtin_amdgcn_exp2f(pA1[r]);
  DMA_K(3,3*SLOTB);DMA_V(1,SLOTB);
  WAIT_BAR(3);
  ROT();
  kload2(kf,kp0+kc,0); kload2(kf,kp0+kc,1);
  s16x4 vlo[16],vhi[16]; u32x4 pw0,pw1,pw2,pw3;
  #define PKW(P,B) cvtpk_s(P[B],P[B+1])
  #define PAF(k) __builtin_bit_cast(bf16x8,pw##k)
  #define VFR(i) (bf16x8){vlo[i][0],vlo[i][1],vlo[i][2],vlo[i][3],vhi[i][0],vhi[i][1],vhi[i][2],vhi[i][3]}
  #define PIN(x) asm volatile("":"+v"(x))
  #define MX3(a,b,c) __builtin_fmaxf(__builtin_fmaxf((a),(b)),(c))
  #define GAPA(MF,A0,A1,A2,A3,W0,W1,PW) do{ MF; sacc+=A0; sacc+=A1; sacc+=A2; sacc+=A3; PIN(sacc); W0; W1; PIN(PW); SBAR(); }while(0)
  #define EX(v) __builtin_amdgcn_exp2f(v)
  #define GAPB(MF,X,B) do{ MF; X[B]=EX(X[B]); X[B+1]=EX(X[B+1]); PIN(X); SBAR(); }while(0)
  #define VRD(i) do{ vlo[i]=vtr(vp_+(((i)>>2)*4096+((i)&3)*1024)); vhi[i]=vtr(vp_+(((i)>>2)*4096+((i)&3)*1024+512)); }while(0)
  #define STEP(C0,C1,P0,P1,t,GK,GV,GL) do{ SBAR(); \
    const lds_cptr vp_=vp0+2*sl_prev; \
    VRD(0); SBAR(); float sacc=(P0[0]+P0[1]); \
    GAPA(C0=__builtin_amdgcn_mfma_f32_32x32x16_bf16(kf[0],qr[0],negm,0,0,0), P0[2],P0[3],P0[4],P0[5],     pw0[0]=PKW(P0,0), pw0[1]=PKW(P0,2), pw0); \
    VRD(4); kload2(kf,kp0+kc,2); SBAR(); GAPA(C1=__builtin_amdgcn_mfma_f32_32x32x16_bf16(kf[1],qr[0],negm,0,0,0), P0[6],P0[7],P0[8],P0[9],     pw0[2]=PKW(P0,4), pw0[3]=PKW(P0,6), pw0); \
    VRD(1); SBAR(); GAPA(C0=__builtin_amdgcn_mfma_f32_32x32x16_bf16(kf[2],qr[1],C0,0,0,0),   P0[10],P0[11],P0[12],P0[13], pw1[0]=PKW(P0,8), pw1[1]=PKW(P0,10), pw1); \
    VRD(5); kload2(kf,kp0+kc,3); SBAR(); GAPA(C1=__builtin_amdgcn_mfma_f32_32x32x16_bf16(kf[3],qr[1],C1,0,0,0),   P0[14],P0[15],P1[0],P1[1],   pw1[2]=PKW(P0,12),pw1[3]=PKW(P0,14), pw1); \
    VRD(2); SBAR(); GAPA(C0=__builtin_amdgcn_mfma_f32_32x32x16_bf16(kf[4],qr[2],C0,0,0,0),   P1[2],P1[3],P1[4],P1[5],     pw2[0]=PKW(P1,0), pw2[1]=PKW(P1,2), pw2); \
    VRD(6); SBAR(); GAPA(C1=__builtin_amdgcn_mfma_f32_32x32x16_bf16(kf[5],qr[2],C1,0,0,0),   P1[6],P1[7],P1[8],P1[9],     pw2[2]=PKW(P1,4), pw2[3]=PKW(P1,6), pw2); \
    VRD(3); SBAR(); GAPA(C0=__builtin_amdgcn_mfma_f32_32x32x16_bf16(kf[6],qr[3],C0,0,0,0),   P1[10],P1[11],P1[12],P1[13], pw3[0]=PKW(P1,8), pw3[1]=PKW(P1,10), pw3); \
    VRD(7); SBAR(); GAPA(C1=__builtin_amdgcn_mfma_f32_32x32x16_bf16(kf[7],qr[3],C1,0,0,0),   P1[14],P1[15],0.f,0.f,       pw3[2]=PKW(P1,12),pw3[3]=PKW(P1,14), pw3); \
    l_reg+=sacc; \
    if(GK){DMA_K((t)+3,kp);} if(GV){DMA_V((t)+1,sl_next);} \
    CMASK(C0,C1,t); \
    { float a=MX3(C0[0],C0[1],C1[0]),b=MX3(C0[2],C0[3],C1[1]); a=MX3(a,C1[2],C1[3]); \
      _Pragma("unroll") for(int r=4;r<16;r+=4){a=MX3(a,C0[r],C0[r+1]);b=MX3(b,C0[r+2],C0[r+3]);a=MX3(a,C1[r],C1[r+1]);b=MX3(b,C1[r+2],C1[r+3]);} \
      float rm=__builtin_fmaxf(a,b); { auto rr=__builtin_amdgcn_permlane32_swap(__float_as_uint(rm),__float_as_uint(rm),false,false); rm=__builtin_fmaxf(__uint_as_float(rr[0]),__uint_as_float(rr[1])); } \
      resc=false; \
      if(__builtin_expect(__any(rm>(float)THRL),0)){ const float dl=__builtin_fmaxf(rm,0.f); mhat+=dl; \
        _Pragma("unroll") for(int r=0;r<16;++r){C0[r]-=dl;C1[r]-=dl;} \
        _Pragma("unroll") for(int r=0;r<16;++r)negm[r]=-mhat; asm volatile("":"+v"(negm)); \
        const float f=__builtin_amdgcn_exp2f(-dl); l_reg*=f; if(hi==0)wsf[r32]=f; resc=true; } } \
    SBAR(); \
    VRD(8);  SBAR(); GAPB(o[0]=__builtin_amdgcn_mfma_f32_32x32x16_bf16(PAF(0),VFR(0),o[0],0,0,0), C0,0); \
    VRD(12); SBAR(); GAPB(o[1]=__builtin_amdgcn_mfma_f32_32x32x16_bf16(PAF(0),VFR(4),o[1],0,0,0), C0,2); \
    VRD(9);  SBAR(); GAPB(o[0]=__builtin_amdgcn_mfma_f32_32x32x16_bf16(PAF(1),VFR(1),o[0],0,0,0), C0,4); \
    VRD(13); SBAR(); GAPB(o[1]=__builtin_amdgcn_mfma_f32_32x32x16_bf16(PAF(1),VFR(5),o[1],0,0,0), C0,6); \
    VRD(10); SBAR(); GAPB(o[0]=__builtin_amdgcn_mfma_f32_32x32x16_bf16(PAF(2),VFR(2),o[0],0,0,0), C0,8); \
    VRD(14); SBAR(); GAPB(o[1]=__builtin_amdgcn_mfma_f32_32x32x16_bf16(PAF(2),VFR(6),o[1],0,0,0), C0,10); \
    VRD(11); SBAR(); GAPB(o[0]=__builtin_amdgcn_mfma_f32_32x32x16_bf16(PAF(3),VFR(3),o[0],0,0,0), C0,12); \
    VRD(15); SBAR(); GAPB(o[1]=__builtin_amdgcn_mfma_f32_32x32x16_bf16(PAF(3),VFR(7),o[1],0,0,0), C0,14); \
    GAPB(o[2]=__builtin_amdgcn_mfma_f32_32x32x16_bf16(PAF(0),VFR(8),o[2],0,0,0),  C1,0); \
    GAPB(o[3]=__builtin_amdgcn_mfma_f32_32x32x16_bf16(PAF(0),VFR(12),o[3],0,0,0), C1,2); \
    GAPB(o[2]=__builtin_amdgcn_mfma_f32_32x32x16_bf16(PAF(1),VFR(9),o[2],0,0,0),  C1,4); \
    GAPB(o[3]=__builtin_amdgcn_mfma_f32_32x32x16_bf16(PAF(1),VFR(13),o[3],0,0,0), C1,6); \
    GAPB(o[2]=__builtin_amdgcn_mfma_f32_32x32x16_bf16(PAF(2),VFR(10),o[2],0,0,0), C1,8); \
    GAPB(o[3]=__builtin_amdgcn_mfma_f32_32x32x16_bf16(PAF(2),VFR(14),o[3],0,0,0), C1,10); \
    GAPB(o[2]=__builtin_amdgcn_mfma_f32_32x32x16_bf16(PAF(3),VFR(11),o[2],0,0,0), C1,12); \
    GAPB(o[3]=__builtin_amdgcn_mfma_f32_32x32x16_bf16(PAF(3),VFR(15),o[3],0,0,0), C1,14); \
    if(GL){ kload2(kf,kp0+kn,0); kload2(kf,kp0+kn,1); SBAR(); } \
    }while(0)
  int t=1;
  #undef CMASK
  #define CMASK(P0,P1,t) do{}while(0)
  for(;t+5<NT;t+=2){
    STEP(pB0,pB1,pA0,pA1,t,true,true,true);     WAIT_BAR(3); RESC(); ROT();
    STEP(pA0,pA1,pB0,pB1,t+1,true,true,true);   WAIT_BAR(3); RESC(); ROT();
  }
  #undef CMASK
  #define CMASK(P0,P1,t) do{int jb_=(t)-(NT-4); if(jb_>=0)cmask(P0,P1,jb_,qrel,hi);}while(0)
  #define ENDW(tt) do{ if((tt)+3<NT){WAIT_BAR(3);} else if((tt)+2<NT){WAIT_BAR(2);} else {WAIT_BAR(0);} }while(0)
  for(;t+1<NT;t+=2){
    STEP(pB0,pB1,pA0,pA1,t,(t+3<NT),(t+1<NT),(t+1<NT));       ENDW(t);   RESC(); ROT();
    STEP(pA0,pA1,pB0,pB1,t+1,(t+4<NT),(t+2<NT),(t+2<NT));     ENDW(t+1); RESC(); ROT();
  }
  STEP(pB0,pB1,pA0,pA1,NT-1,false,false,false); RESC();
  { float sacc=pB0[0]+pB0[1]; _Pragma("unroll") for(int r=2;r<16;++r)sacc+=pB0[r]; _Pragma("unroll") for(int r=0;r<16;++r)sacc+=pB1[r]; l_reg+=sacc;
    pw0=(u32x4){PKW(pB0,0),PKW(pB0,2),PKW(pB0,4),PKW(pB0,6)};pw1=(u32x4){PKW(pB0,8),PKW(pB0,10),PKW(pB0,12),PKW(pB0,14)};pw2=(u32x4){PKW(pB1,0),PKW(pB1,2),PKW(pB1,4),PKW(pB1,6)};pw3=(u32x4){PKW(pB1,8),PKW(pB1,10),PKW(pB1,12),PKW(pB1,14)};
    SBAR(); pv4(o,vb0+2*sl_cur,PAF(0),PAF(1),PAF(2),PAF(3)); }
  #undef PKW
  #undef PAF
  #undef VFR
  #undef PIN
  #undef MX3
  #undef GAPA
  #undef GAPB
  #undef EX
  #undef VRD
  #undef STEP
  #undef ENDW
  {auto rr=__builtin_amdgcn_permlane32_swap(__float_as_uint(l_reg),__float_as_uint(l_reg),false,false);l_reg=__uint_as_float(rr[0])+__uint_as_float(rr[1]);}
  if(hi==0)wsf[32+r32]=l_reg;asm volatile("s_waitcnt lgkmcnt(0)":::"memory");
  float rli[16];
  #pragma unroll
  for(int r=0;r<16;++r)rli[r]=__builtin_amdgcn_rcpf(wsf[32+crow(r,hi)]);
  bf16*Ow=Oh+(long)(q0+wid*QBLK)*DMO;
  { bf16*stg=(bf16*)(shm+LDS2_OST)+wid*4096;
    #pragma unroll
    for(int r=0;r<16;++r){const int orow=crow(r,hi);
      #pragma unroll
      for(int d0=0;d0<4;++d0)stg[orow*128+d0*32+r32]=__float2bfloat16(o[d0][r]*rli[r]);}
    asm volatile("s_waitcnt lgkmcnt(0)":::"memory");
    #pragma unroll
    for(int i=0;i<8;++i){const int row=i*4+(lane>>4),ch=lane&15; const u32x4 v=*(const u32x4*)(stg+row*128+ch*8); ATTN_STORE16(Ow+(long)row*DMO+ch*8,v);} }
  asm volatile("s_waitcnt lgkmcnt(0)\n\ts_barrier":::"memory");
  #undef DMA_K
  #undef DMA_V
  #undef CMASK
  #undef START
  #undef RESC
  #undef ROT
}
constexpr int ATTN_LDS_BYTES=LDS_BYTES;
#undef SBAR
#undef WAIT_BAR
}

constexpr int NWAVES = 8;
constexpr int NTOK = 32768, DM = 1024, SEQ = 4096, NB = 8, NEXP = 32, TOPK = 4;
constexpr int N_PHASES = 10;
constexpr size_t MiB = 1u << 20;
constexpr size_t WS_CTL = 0, CTL_ZERO_BYTES = 32768;
constexpr size_t WS_MODP = 864 * MiB;
constexpr size_t WS_MODF = 3 * MiB;
constexpr size_t WS_LAM16 = 3 * MiB + 512 * 1024;
constexpr size_t WS_WRH = 3 * MiB + 640 * 1024, WS_WRL = 3 * MiB + 704 * 1024;
constexpr size_t WS_WIN = 4 * MiB;
constexpr size_t WS_WOUT = 8 * MiB;
constexpr size_t WS_WGLU = 10 * MiB;
constexpr size_t WS_WM = 11 * MiB;
constexpr size_t WS_TV = 15 * MiB;
constexpr size_t WS_W1T = 22 * MiB;
constexpr size_t WS_W2T = 150 * MiB;
constexpr size_t WS_H = 214 * MiB;
constexpr size_t WS_Q = 278 * MiB, WS_K = 310 * MiB, WS_V = 342 * MiB;
constexpr size_t WS_UA = 374 * MiB;
constexpr size_t WS_Z = 422 * MiB;
constexpr size_t WS_OB = 454 * MiB;
constexpr size_t WS_MIX = 518 * MiB;
constexpr size_t WS_PTOK = 582 * MiB;
constexpr size_t WS_SLOT = 586 * MiB;
constexpr size_t WS_GATE = 587 * MiB;
constexpr size_t WS_A2 = 278 * MiB;
constexpr size_t WS_Y2 = 590 * MiB;
constexpr size_t WS_X1B = 872 * MiB;
constexpr size_t WS_END = 936 * MiB;
constexpr int MAXTILES = 544;
static_assert(WS_A2 + (size_t)MAXTILES * 256 * 1024 * 2 <= WS_PTOK && WS_Y2 + (size_t)MAXTILES * 256 * 1024 * 2 <= WS_MODP, "ws map");
constexpr int CW_TMO = 0, CW_CNT = 1024  , CW_BAR = 4096;
constexpr int CW_DEP0 = 7680  , CW_DEPB = 7744  ;
constexpr int RING_OFF = 0, RING_BYTES = 131072;
constexpr int VEC_OFF = 132096;
constexpr int TILE_E_OFF = 140288;
constexpr int TILE0_OFF = 140928;
constexpr int CNTL_OFF = 141056;
constexpr int MOE_T_OFF = 141184;
constexpr int ROWTAB_OFF = 141312;
constexpr int LDSCTL_OFF = 159744, MISC_OFF = LDSCTL_OFF;
constexpr int LDS_BYTES = 163840;

typedef unsigned short bf16;
typedef unsigned v4u __attribute__((ext_vector_type(4)));
typedef unsigned v2u __attribute__((ext_vector_type(2)));
typedef float f32x4 __attribute__((ext_vector_type(4)));
typedef GAS unsigned gu32;
#define RLX_AGENT __ATOMIC_RELAXED, __HIP_MEMORY_SCOPE_AGENT
#define LDS_WAIT() asm volatile("s_waitcnt lgkmcnt(0)" ::: "memory")
#define VM_WAIT() asm volatile("s_waitcnt vmcnt(0)" ::: "memory")
__device__ __forceinline__ unsigned f2bf(float f) { unsigned u = __builtin_bit_cast(unsigned, f); return (u + 0x7fffu + ((u >> 16) & 1u)) >> 16; }
__device__ __forceinline__ unsigned pk2(float lo, float hi) { return f2bf(lo) | (f2bf(hi) << 16); }

#define XB_TMO      128
#define XB_XCNT(j)  (256  + 64 * (j))
#define XB_XSUB(j)  (1280 + 64 * (j))
#define XB_XGEN(j)  (2304 + 64 * (j))
#define XB_TOP      3328
#define XB_TOPGEN   3392
#define XCD_BAR_WORDS 3456
#define XB_SPIN_CAP (1u << 18)
__device__ __forceinline__ unsigned xb_ld(unsigned* p)              { return __hip_atomic_load(p, __ATOMIC_RELAXED, __HIP_MEMORY_SCOPE_AGENT); }
__device__ __forceinline__ unsigned xb_add(unsigned* p, unsigned v) { return __hip_atomic_fetch_add(p, v, __ATOMIC_RELAXED, __HIP_MEMORY_SCOPE_AGENT); }
__device__ __forceinline__ unsigned xb_xcc_id() { return (unsigned)__builtin_amdgcn_s_getreg((3 << 11) | 20) & 0xFu; }
#define XB_SPIN(cond, bar) do { unsigned _sp = 0; while (cond) { __builtin_amdgcn_s_sleep(1); \
    if ((++_sp & 255u) == 0u) { if (xb_ld(&(bar)[XB_TMO])) break; if (_sp > XB_SPIN_CAP) { atomicAdd(&(bar)[XB_TMO], 1u); break; } } } } while (0)
struct XcdBarrier { unsigned* bar; unsigned x; volatile LAS unsigned* st; };
__device__ __forceinline__ XcdBarrier xcd_barrier_post(unsigned* bar, volatile LAS unsigned* st) {
    XcdBarrier b; b.bar = bar; b.x = xb_xcc_id(); b.st = st;
    if (threadIdx.x == 0) (void)xb_add(&bar[XB_XCNT(b.x)], 1u);
    return b;
}
__device__ __forceinline__ void xcd_barrier_complete(unsigned* bar, unsigned x, unsigned& nloc, unsigned& nx) {
    const unsigned G = gridDim.x * gridDim.y * gridDim.z;
    unsigned sum, cnt, mine, sp = 0u;
    for (;;) {
        sum = 0u; cnt = 0u; mine = 0u;
#pragma unroll
        for (unsigned j = 0; j < 16; ++j) { const unsigned c = xb_ld(&bar[XB_XCNT(j)]); sum += c; cnt += (c > 0u) ? 1u : 0u; mine = (j == x) ? c : mine; }
        if (sum == G) break;
        __builtin_amdgcn_s_sleep(1);
        if ((++sp & 255u) == 0u) { if (xb_ld(&bar[XB_TMO])) break; if (sp > XB_SPIN_CAP) { atomicAdd(&bar[XB_TMO], 1u); break; } }
    }
    nloc = mine > 0u ? mine : 1u; nx = cnt > 0u ? cnt : 1u;
}
__device__ __forceinline__ void xcd_barrier(const XcdBarrier& b, const int wave) {
    asm volatile("s_waitcnt vmcnt(0)" ::: "memory");
    __syncthreads();
    if (wave == 0 && lane_id_opaque() == 0) {
        unsigned* bar = b.bar;
        __builtin_amdgcn_s_waitcnt(0);
        unsigned nloc = b.st[0], nx = b.st[1];
        if (nloc == 0u) { xcd_barrier_complete(bar, b.x, nloc, nx); b.st[0] = nloc; b.st[1] = nx; }
        const unsigned old = xb_add(&bar[XB_XSUB(b.x)], 1u);
        const unsigned gen = old / nloc;
        if (old + 1u == (gen + 1u) * nloc) {
            __builtin_amdgcn_fence(__ATOMIC_RELEASE, "agent");
            asm volatile("s_waitcnt vmcnt(0)" ::: "memory");
            const unsigned og = xb_add(&bar[XB_TOP], 1u);
            const unsigned tg = og / nx;
            if (og + 1u == (tg + 1u) * nx) xb_add(&bar[XB_TOPGEN], 1u);
            else XB_SPIN(xb_ld(&bar[XB_TOPGEN]) == tg, bar);
            __builtin_amdgcn_fence(__ATOMIC_ACQUIRE, "agent");
            xb_add(&bar[XB_XGEN(b.x)], 1u);
            asm volatile("s_waitcnt vmcnt(0)" ::: "memory");
        } else {
            XB_SPIN(xb_ld(&bar[XB_XGEN(b.x)]) == gen, bar);
            __builtin_amdgcn_fence(__ATOMIC_ACQUIRE, "agent");
            asm volatile("s_waitcnt vmcnt(0)" ::: "memory");
        }
    }
    __syncthreads();
}

struct Frame {
    LAS unsigned char* lds;
    gu32* ctl;
    int tid, lane, wave, vcu, G;
    float* out; unsigned char* ws;
};
typedef const float* cfptr_t;
__device__ __forceinline__ const float* inp(int i) { const __attribute__((address_space(4))) cfptr_t* kp = (const __attribute__((address_space(4))) cfptr_t*)__builtin_amdgcn_kernarg_segment_ptr(); asm volatile("" : "+s"(kp)); return kp[i]; }
__device__ __forceinline__ float wave_sum(float v) {
#pragma unroll
    for (int o = 1; o < 64; o <<= 1) v += __shfl_xor(v, o);
    return v;
}
__device__ __forceinline__ float wave_max(float v) {
#pragma unroll
    for (int o = 1; o < 64; o <<= 1) v = fmaxf(v, __shfl_xor(v, o));
    return v;
}
__device__ __forceinline__ int wave_min_i(int v) {
#pragma unroll
    for (int o = 1; o < 64; o <<= 1) { const int w = __shfl_xor(v, o); v = w < v ? w : v; }
    return v;
}

#define DPP_F(v, ctrl) __builtin_bit_cast(float, __builtin_amdgcn_update_dpp(__builtin_bit_cast(int, (v)), __builtin_bit_cast(int, (v)), (ctrl), 0xF, 0xF, false))
#define DPP_I(v, ctrl) __builtin_amdgcn_update_dpp((v), (v), (ctrl), 0xF, 0xF, false)
__device__ __forceinline__ float wave_max_u(float v) {
    v = fmaxf(v, DPP_F(v, 0xB1)); v = fmaxf(v, DPP_F(v, 0x4E)); v = fmaxf(v, DPP_F(v, 0x141)); v = fmaxf(v, DPP_F(v, 0x140));
    const int b = __builtin_bit_cast(int, v);
    return fmaxf(fmaxf(__builtin_bit_cast(float, __builtin_amdgcn_readlane(b, 15)), __builtin_bit_cast(float, __builtin_amdgcn_readlane(b, 31))), fmaxf(__builtin_bit_cast(float, __builtin_amdgcn_readlane(b, 47)), __builtin_bit_cast(float, __builtin_amdgcn_readlane(b, 63))));
}
__device__ __forceinline__ int wave_min_iu(int v) {
    int w;
    w = DPP_I(v, 0xB1); v = w < v ? w : v; w = DPP_I(v, 0x4E); v = w < v ? w : v; w = DPP_I(v, 0x141); v = w < v ? w : v; w = DPP_I(v, 0x140); v = w < v ? w : v;
    const int a = __builtin_amdgcn_readlane(v, 15), b = __builtin_amdgcn_readlane(v, 31), c = __builtin_amdgcn_readlane(v, 47), d = __builtin_amdgcn_readlane(v, 63);
    const int ab = a < b ? a : b, cd = c < d ? c : d; return ab < cd ? ab : cd;
}
__device__ __forceinline__ float wave_sum_u(float v) {
    v += DPP_F(v, 0xB1); v += DPP_F(v, 0x4E); v += DPP_F(v, 0x141); v += DPP_F(v, 0x140);
    const int b = __builtin_bit_cast(int, v);
    return (__builtin_bit_cast(float, __builtin_amdgcn_readlane(b, 15)) + __builtin_bit_cast(float, __builtin_amdgcn_readlane(b, 31))) + (__builtin_bit_cast(float, __builtin_amdgcn_readlane(b, 47)) + __builtin_bit_cast(float, __builtin_amdgcn_readlane(b, 63)));
}
struct TrItem { const float* W; bf16* WT; int ldw, ldt; };
__device__ __forceinline__ void tr_dma(const TrItem& d, LAS float* buf, int lane) {
    const int kr = lane >> 3, q = lane & 7;
#pragma unroll
    for (int i = 0; i < 8; ++i) __builtin_amdgcn_global_load_lds((const unsigned*)(d.W + (size_t)(8 * i + kr) * d.ldw + 4 * ((q - i) & 7)), (LAS unsigned*)(buf + i * 256), 16, 0, 2);
}
__device__ __forceinline__ void tr_out(const TrItem& d, const LAS float* buf, int lane) {
    const int c = lane & 7;
#pragma unroll
    for (int j = 0; j < 4; ++j) { const int n = (lane >> 3) + 8 * j; const LAS float* s = buf + (8 * c) * 32 + 4 * (((n >> 2) + c) & 7) + (n & 3);
        if (d.ldt < 0) { const f32x4 a = (f32x4){s[0 * 32], s[1 * 32], s[2 * 32], s[3 * 32]} * pg8::F8_W, e = (f32x4){s[4 * 32], s[5 * 32], s[6 * 32], s[7 * 32]} * pg8::F8_W;
            __builtin_nontemporal_store(pg8::pack8_fp8(a, e), (pg8::i32x2*)((unsigned char*)d.WT + (size_t)n * (size_t)(-d.ldt) + 8 * c)); }
        else { v4u o; o.x = pg8::cvt_pk_bf16(s[0 * 32], s[1 * 32]); o.y = pg8::cvt_pk_bf16(s[2 * 32], s[3 * 32]); o.z = pg8::cvt_pk_bf16(s[4 * 32], s[5 * 32]); o.w = pg8::cvt_pk_bf16(s[6 * 32], s[7 * 32]);
            *(GAS v4u*)(d.WT + (size_t)n * d.ldt + 8 * c) = o; } }
}
__device__ __forceinline__ void dsincos(double x, double& s, double& c) {
    const double k = rint(x * 0.63661977236758134308);
    double r = fma(-k, 1.57079632673412561417e+00, x); r = fma(-k, 6.07710050650619224932e-11, r);
    const int q = ((int)k) & 3; const double r2 = r * r;
    const double sp = r + r * r2 * (-1.66666666666666324348e-01 + r2 * (8.33333333332248946124e-03 + r2 * (-1.98412698298579493134e-04 + r2 * (2.75573137070700676789e-06 + r2 * (-2.50507602534068634195e-08 + r2 * 1.58969099521155010221e-10)))));
    const double cp = 1.0 - 0.5 * r2 + r2 * r2 * (4.16666666666666019037e-02 + r2 * (-1.38888888888741095749e-03 + r2 * (2.48015872894767294178e-05 + r2 * (-2.75573143513906633035e-07 + r2 * (2.08757232129817482790e-09 + r2 * -1.13596475577881948265e-11)))));
    s = (q == 0) ? sp : (q == 1) ? cp : (q == 2) ? -sp : -cp;
    c = (q == 0) ? cp : (q == 1) ? -sp : (q == 2) ? -cp : sp;
}
__device__ __forceinline__ double dexp(double x) {
    const double k = rint(x * 1.44269504088896340736); const double r = fma(-k, 6.93147180369123816490e-01, x) - k * 1.90821492927058770002e-10;
    double p = 1.0 / 6227020800.0;
    p = p * r + 1.0 / 479001600.0; p = p * r + 1.0 / 39916800.0; p = p * r + 1.0 / 3628800.0; p = p * r + 1.0 / 362880.0; p = p * r + 1.0 / 40320.0; p = p * r + 1.0 / 5040.0;
    p = p * r + 1.0 / 720.0; p = p * r + 1.0 / 120.0; p = p * r + 1.0 / 24.0; p = p * r + 1.0 / 6.0; p = p * r + 0.5; p = p * r + 1.0; p = p * r + 1.0;
    return ldexp(p, (int)k);
}
__device__ __forceinline__ void ssm_tables_item(Frame& F, int g, int r) {
    LAS float* pwr = (LAS float*)(F.lds); LAS float* pwi = pwr + 17 * 64;
    LAS float* ccr = pwi + 17 * 64; LAS float* cci = ccr + 1040;
    LAS float* bbr = cci + 1040; LAS float* bbi = bbr + 1024;
    LAS float* kt = bbi + 1024;
    LAS double* lb1 = (LAS double*)(kt + 4096);
    const float* a_re = inp(11); const float* a_im = inp(12); const float* log_dt = inp(13);
    const float* b_re = inp(14); const float* b_im = inp(15); const float* c_re = inp(16); const float* c_im = inp(17); const float* dsk = inp(18);
    const int tid = F.tid;
    const double dtv = dexp((double)log_dt[g]);
    for (int idx = tid; idx < 17 * 64; idx += 512) { const int t = idx >> 6, p = idx & 63;
        const double re = fmin((double)a_re[g * 64 + p], -1e-4), im = (double)a_im[g * 64 + p];
        const double mag = dexp(re * dtv * (double)t); double s, c; dsincos(im * dtv * (double)t, s, c);
        pwr[idx] = (float)(mag * c); pwi[idx] = (float)(mag * s); if (t == 1) { lb1[2 * p] = mag * c - 1.0; lb1[2 * p + 1] = mag * s; } }
    for (int idx = tid; idx < 1024; idx += 512) { const int c = idx >> 6, p = idx & 63; ccr[c * 65 + p] = c_re[(g * 16 + c) * 64 + p]; cci[c * 65 + p] = c_im[(g * 16 + c) * 64 + p]; }
    __syncthreads();
    for (int idx = tid; idx < 1024; idx += 512) { const int p = idx >> 4, c1 = idx & 15;
        const double re = fmin((double)a_re[g * 64 + p], -1e-4), im = (double)a_im[g * 64 + p];
        const double nr = lb1[2 * p], ni = lb1[2 * p + 1], den = re * re + im * im;
        const double qr = (nr * re + ni * im) / den, qi = (ni * re - nr * im) / den;
        const double br = (double)b_re[(g * 64 + p) * 16 + c1], bi = (double)b_im[(g * 64 + p) * 16 + c1];
        bbr[idx] = (float)(qr * br - qi * bi); bbi[idx] = (float)(qr * bi + qi * br); }
    __syncthreads();
    { const int t = tid >> 5, c = (tid >> 1) & 15, h8 = (tid & 1) * 8; float acc[8];
#pragma unroll
      for (int q = 0; q < 8; ++q) acc[q] = 0.f;
      for (int p = 0; p < 64; ++p) { const float cr = ccr[c * 65 + p], ci = cci[c * 65 + p], pr = pwr[t * 64 + p], pi = pwi[t * 64 + p]; const float mr = cr * pr - ci * pi, mi = cr * pi + ci * pr;
          const f32x4 r0 = *(const LAS f32x4*)(bbr + p * 16 + h8), r1 = *(const LAS f32x4*)(bbr + p * 16 + h8 + 4), i0 = *(const LAS f32x4*)(bbi + p * 16 + h8), i1 = *(const LAS f32x4*)(bbi + p * 16 + h8 + 4);
          acc[0] += mr * r0.x - mi * i0.x; acc[1] += mr * r0.y - mi * i0.y; acc[2] += mr * r0.z - mi * i0.z; acc[3] += mr * r0.w - mi * i0.w;
          acc[4] += mr * r1.x - mi * i1.x; acc[5] += mr * r1.y - mi * i1.y; acc[6] += mr * r1.z - mi * i1.z; acc[7] += mr * r1.w - mi * i1.w; }
#pragma unroll
      for (int q = 0; q < 8; ++q) kt[(t * 16 + c) * 16 + h8 + q] = acc[q]; }
    __syncthreads();
    bf16* TV = (bf16*)(F.ws + WS_TV) + (size_t)g * 256 * 384; bf16* WM = (bf16*)(F.ws + WS_WM) + (size_t)g * 256 * 256;
    for (int idx = tid; idx < 32 * 192; idx += 512) { const int row = 32 * r + idx / 192, col = 2 * (idx % 192), s = row >> 4, c = row & 15; float v[2];
#pragma unroll
        for (int q = 0; q < 2; ++q) { const int cq = col + q;
            if (cq < 256) { const int j = cq >> 4, c1 = cq & 15; v[q] = (j <= s) ? kt[((s - j) * 16 + c) * 16 + c1] : 0.f; if (j == s && c == c1) v[q] += dsk[g * 16 + c]; }
            else { const int p = (cq - 256) & 63; const float cr = ccr[c * 65 + p], ci = cci[c * 65 + p], pr = pwr[(s + 1) * 64 + p], pi = pwi[(s + 1) * 64 + p];
                v[q] = (cq < 320) ? (cr * pr - ci * pi) : -(cr * pi + ci * pr); } }
        *(unsigned*)(TV + (size_t)row * 384 + col) = pk2(v[0], v[1]); }
    for (int idx = tid; idx < 16 * 128; idx += 512) { const int row = 16 * r + (idx >> 7), col = 2 * (idx & 127), p = row & 63, ri = row >> 6, j = col >> 4, c1 = col & 15;
        const float pr = pwr[(15 - j) * 64 + p], pi = pwi[(15 - j) * 64 + p]; float v[2];
#pragma unroll
        for (int q = 0; q < 2; ++q) { const float br = bbr[p * 16 + c1 + q], bi = bbi[p * 16 + c1 + q]; v[q] = ri == 0 ? (pr * br - pi * bi) : (pr * bi + pi * br); }
        *(unsigned*)(WM + (size_t)row * 256 + col) = pk2(v[0], v[1]); *(unsigned*)(WM + (size_t)(128 + row) * 256 + col) = 0u; }
    if (r == 0 && tid < 64) { float* L16 = (float*)(F.ws + WS_LAM16) + (g * 64 + tid) * 2; L16[0] = pwr[16 * 64 + tid]; L16[1] = pwi[16 * 64 + tid]; }
    __syncthreads();
}
constexpr int MOD_NKS = 32;
__device__ __forceinline__ void modp_item(Frame& F, int it) {
    const int ng = it % 6, ks = it / 6, tid = F.tid;
    LAS float* cact = (LAS float*)F.lds;
    LAS f32x4* red = (LAS f32x4*)(cact + 256);
    const float* cin = inp(1); const float* w = inp(2);
    if (tid < 256) { const int b = tid >> 5, kk = tid & 31; const float c = cin[b * 1024 + ks * 32 + kk]; cact[tid] = c / (1.0f + __expf(-c)); }
    __syncthreads();
    const int c4 = tid & 255, kq = tid >> 8, col = ng * 1024 + 4 * c4; f32x4 wv[16], acc[8];
#pragma unroll
    for (int i = 0; i < 16; ++i) wv[i] = *(const GAS f32x4*)(w + (size_t)(ks * 32 + kq * 16 + i) * 6144 + col);
#pragma unroll
    for (int b = 0; b < 8; ++b) { acc[b] = (f32x4){0.f, 0.f, 0.f, 0.f};
#pragma unroll
        for (int i = 0; i < 16; ++i) acc[b] += wv[i] * cact[b * 32 + kq * 16 + i]; }
    if (kq == 1) {
#pragma unroll
        for (int b = 0; b < 8; ++b) red[b * 256 + c4] = acc[b]; }
    __syncthreads();
    if (kq == 0) { float* mp = (float*)(F.ws + WS_MODP);
#pragma unroll
        for (int b = 0; b < 8; ++b) *(GAS f32x4*)(mp + (size_t)(ks * 8 + b) * 6144 + col) = acc[b] + red[b * 256 + c4]; }
    __syncthreads();
}
__device__ __forceinline__ float mod_value(Frame& F, const float* b_ada, int b, int n) {
    const float* mp = (const float*)(F.ws + WS_MODP); float v = b_ada[n];
    float t[MOD_NKS];
#pragma unroll
    for (int ks = 0; ks < MOD_NKS; ++ks) t[ks] = mp[(size_t)(ks * 8 + b) * 6144 + n];
#pragma unroll
    for (int ks = 0; ks < MOD_NKS; ++ks) v += t[ks];
    return v;
}
#ifndef TR_HOSTED
#define TR_HOSTED 32768
#endif
constexpr int TR_I_W1 = 32 * 16 * 64, TR_I_W2 = 32 * 16 * 32, TR_I_IN = 16 * 64, TR_I_OUT = 16 * 32, TR_I_GLU = 8 * 16, TR_NITEMS = TR_I_W1 + TR_I_W2 + TR_I_IN + TR_I_OUT + TR_I_GLU;
__device__ __forceinline__ void tr_run(Frame& F, const int lo, const int hi, const int gw, const int NGW) {
    LAS float* scr = (LAS float*)(F.lds + RING_OFF + F.wave * 16384);
    constexpr int I_W1 = TR_I_W1, I_W2 = TR_I_W2, I_IN = TR_I_IN, I_OUT = TR_I_OUT;
    const int NITEMS = hi;
    const float* w1p = inp(25); const float* w2p = inp(27); const float* winp = inp(5); const float* woutp = inp(21); const float* wglup = inp(19);
    bf16* w1t = (bf16*)(F.ws + WS_W1T); bf16* w2t = (bf16*)(F.ws + WS_W2T); bf16* wint = (bf16*)(F.ws + WS_WIN); bf16* woutt = (bf16*)(F.ws + WS_WOUT); bf16* wglut = (bf16*)(F.ws + WS_WGLU);
#define TR_DESC(d, item) do { int r = (item); \
        if (r < I_W1) { const int e = r >> 10, rr = r & 1023, kb = rr >> 6, nb = rr & 63, n0 = 32 * nb, bj = n0 >> 10, rem = n0 & 1023, pn = rem >> 7, jj = rem & 127; \
            d.W = w1p + (size_t)e * 1024 * 2048 + (size_t)(64 * kb) * 2048 + n0; d.WT = (bf16*)((unsigned char*)w1t + (size_t)e * 2048 * 1024 + (size_t)(pn * 256 + bj * 128 + jj) * 1024 + 64 * kb); d.ldw = 2048; d.ldt = -1024; } \
        else if ((r -= I_W1) < I_W2) { const int e = r >> 9, rr = r & 511, kb = rr >> 5, nb = rr & 31; \
            d.W = w2p + (size_t)e * 1024 * 1024 + (size_t)(64 * kb) * 1024 + 32 * nb; d.WT = (bf16*)((unsigned char*)w2t + (size_t)e * 1024 * 1024 + (size_t)(32 * nb) * 1024 + 64 * kb); d.ldw = 1024; d.ldt = -1024; } \
        else if ((r -= I_W2) < I_IN) { const int kb = r >> 6, nb = r & 63; d.W = winp + (size_t)(64 * kb) * 2048 + 32 * nb; d.WT = wint + (size_t)(32 * nb) * 1024 + 64 * kb; d.ldw = 2048; d.ldt = 1024; } \
        else if ((r -= I_IN) < I_OUT) { const int kb = r >> 5, nb = r & 31; d.W = woutp + (size_t)(64 * kb) * 1024 + 32 * nb; d.WT = (bf16*)((unsigned char*)woutt + (size_t)(32 * nb) * 1024 + 64 * kb); d.ldw = 1024; d.ldt = -1024; } \
        else { r -= I_OUT; const int kb = r >> 4, nb = r & 15; d.W = wglup + (size_t)(64 * kb) * 512 + 32 * nb; d.WT = wglut + (size_t)(32 * nb) * 512 + 64 * kb; d.ldw = 512; d.ldt = 512; } } while (0)
    { TrItem dc, dn; int it = lo + gw, par = 0;
      if (it < NITEMS) { TR_DESC(dc, it); tr_dma(dc, scr, F.lane); }
      while (it < NITEMS) { const int nx = it + NGW;
          if (nx < NITEMS) { TR_DESC(dn, nx); tr_dma(dn, scr + (par ^ 1) * 2048, F.lane); asm volatile("s_waitcnt vmcnt(8)" ::: "memory"); }
          else { asm volatile("s_waitcnt vmcnt(0)" ::: "memory"); }
          tr_out(dc, scr + par * 2048, F.lane);
          LDS_WAIT(); asm volatile("" ::: "memory");
          dc = dn; it = nx; par ^= 1; }
      asm volatile("s_waitcnt vmcnt(0)" ::: "memory"); }
}
__device__ __forceinline__ void trq_load(v4u (&r)[8], const TrItem& d, int lane) {
    const int kr = lane >> 3, q = lane & 7;
#pragma unroll
    for (int i = 0; i < 8; ++i) { const float* p = d.W + (size_t)(8 * i) * d.ldw; const unsigned voff = (unsigned)(kr * d.ldw + 4 * ((q - i) & 7)) * 4u;
        asm volatile("global_load_dwordx4 %0, %1, %2 nt" : "=v"(r[i]) : "v"(voff), "s"(p) : "memory"); }
}
__device__ __forceinline__ void tr_run_deep(Frame& F, const int lo, const int hi, const int gw, const int NGW) {
    LAS float* scr = (LAS float*)(F.lds + RING_OFF + F.wave * 16384);
    constexpr int I_W1 = TR_I_W1, I_W2 = TR_I_W2, I_IN = TR_I_IN, I_OUT = TR_I_OUT;
    const float* w1p = inp(25); const float* w2p = inp(27); const float* winp = inp(5); const float* woutp = inp(21); const float* wglup = inp(19);
    bf16* w1t = (bf16*)(F.ws + WS_W1T); bf16* w2t = (bf16*)(F.ws + WS_W2T); bf16* wint = (bf16*)(F.ws + WS_WIN); bf16* woutt = (bf16*)(F.ws + WS_WOUT); bf16* wglut = (bf16*)(F.ws + WS_WGLU);
    if (lo + gw >= hi) return;
    const int n_it = (hi - lo - gw + NGW - 1) / NGW;
#define TRQ_DESC(d, j) do { const int jc_ = (j) < n_it ? (j) : n_it - 1; TR_DESC(d, lo + gw + jc_ * NGW); } while (0)
#define TRQ_STEP(r, d, j, par) do { \
        asm volatile("s_waitcnt vmcnt(16)" : "+v"(r[0]), "+v"(r[1]), "+v"(r[2]), "+v"(r[3]), "+v"(r[4]), "+v"(r[5]), "+v"(r[6]), "+v"(r[7]) :: "memory"); \
        LAS float* buf_ = scr + (par) * 2048; const bool live_ = (j) < n_it; \
        if (live_) { _Pragma("unroll") for (int i_ = 0; i_ < 8; ++i_) *(LAS v4u*)(buf_ + i_ * 256 + F.lane * 4) = r[i_]; } \
        LDS_WAIT(); TrItem dn_; TRQ_DESC(dn_, (j) + 3); trq_load(r, dn_, F.lane); \
        if (live_) tr_out(d, buf_, F.lane); \
        d = dn_; } while (0)
    v4u r0[8], r1[8], r2[8]; TrItem d0, d1, d2;
    TRQ_DESC(d0, 0); trq_load(r0, d0, F.lane); TRQ_DESC(d1, 1); trq_load(r1, d1, F.lane); TRQ_DESC(d2, 2); trq_load(r2, d2, F.lane);
    for (int j = 0; j < n_it; j += 6) {
        TRQ_STEP(r0, d0, j, 0); TRQ_STEP(r1, d1, j + 1, 1); TRQ_STEP(r2, d2, j + 2, 0);
        TRQ_STEP(r0, d0, j + 3, 1); TRQ_STEP(r1, d1, j + 4, 0); TRQ_STEP(r2, d2, j + 5, 1); }
    asm volatile("s_waitcnt vmcnt(0)" : "+v"(r0[0]), "+v"(r0[1]), "+v"(r0[2]), "+v"(r0[3]), "+v"(r0[4]), "+v"(r0[5]), "+v"(r0[6]), "+v"(r0[7]) :: "memory");
    asm volatile("" : "+v"(r1[0]), "+v"(r1[1]), "+v"(r1[2]), "+v"(r1[3]), "+v"(r1[4]), "+v"(r1[5]), "+v"(r1[6]), "+v"(r1[7]) :: "memory");
    asm volatile("" : "+v"(r2[0]), "+v"(r2[1]), "+v"(r2[2]), "+v"(r2[3]), "+v"(r2[4]), "+v"(r2[5]), "+v"(r2[6]), "+v"(r2[7]) :: "memory");
#undef TRQ_STEP
#undef TRQ_DESC
}
#undef TR_DESC
__device__ __forceinline__ void dep_signal(Frame& F, int word);
__device__ __forceinline__ void p0_prologue(Frame& F, int mode = 0) {
    { const float* wr = inp(23); bf16* wh = (bf16*)(F.ws + WS_WRH); bf16* wl = (bf16*)(F.ws + WS_WRL);
      for (int idx = F.vcu * 512 + F.tid; idx < 32768; idx += F.G * 512) { const int k = idx >> 5, e = idx & 31; const float w = wr[idx]; const unsigned hi = f2bf(w);
          wh[e * 1024 + k] = (bf16)hi; wl[e * 1024 + k] = (bf16)f2bf(w - __builtin_bit_cast(float, hi << 16)); } }
    const bool tab_last = (mode == 0) && !(F.vcu & 1);
    if (mode != 2 && mode != 4 && !tab_last) { for (int it = F.vcu; it < 256; it += F.G) ssm_tables_item(F, it >> 3, it & 7); }
    if (mode != 2 && mode != 3) { for (int it = F.vcu; it < 192; it += F.G) modp_item(F, it); }
    if (mode == 0) dep_signal(F, CW_DEP0);
    if (mode == 1 || mode == 3 || mode == 4) return;
    if (F.G == 256) tr_run(F, TR_HOSTED, TR_NITEMS, F.vcu * NWAVES + F.wave, F.G * NWAVES);
    else tr_run(F, 0, TR_NITEMS, F.vcu * NWAVES + F.wave, F.G * NWAVES);
    if (tab_last) { LDS_WAIT(); __syncthreads(); for (int it = F.vcu; it < 256; it += F.G) ssm_tables_item(F, it >> 3, it & 7); }
}
__device__ __forceinline__ void p1_h1(Frame& F) {
    const int bx = blockIdx.x, rows_per = NTOK / F.G, row_base = bx * rows_per, b = row_base >> 12;
    LAS float* vec = (LAS float*)(F.lds + VEC_OFF);
    const float* b_ada = inp(3); const float* n1g = inp(4); const float* xin = inp(0);
    for (int n = F.tid; n < 2048; n += 512) { float v = mod_value(F, b_ada, b, n); if (n >= 1024) v = (1.0f + v) * n1g[n - 1024]; vec[n] = v; }
    { const int per = (NB * 6144) / F.G; float* mf = (float*)(F.ws + WS_MODF);
      for (int i = F.tid; i < per; i += 512) { const int idx = bx * per + i; mf[idx] = mod_value(F, b_ada, idx / 6144, idx % 6144); } }
    __syncthreads();
    bf16* H = (bf16*)(F.ws + WS_H);
    for (int r = F.wave; r < rows_per; r += NWAVES) { const size_t row = (size_t)(row_base + r);
        const GAS f32x4* xr = (const GAS f32x4*)(xin + row * DM) + F.lane; f32x4 v[4]; float s = 0.f;
#pragma unroll
        for (int j = 0; j < 4; ++j) { v[j] = __builtin_nontemporal_load((const f32x4*)(xr + 64 * j)); s += (v[j].x * v[j].x + v[j].y * v[j].y) + (v[j].z * v[j].z + v[j].w * v[j].w); }
        const float rs = 1.0f / sqrtf(wave_sum_u(s) * (1.f / DM) + 1e-6f);
        GAS v2u* o8 = (GAS v2u*)(H + row * DM) + F.lane;
#pragma unroll
        for (int j = 0; j < 4; ++j) { const int c = 256 * j + 4 * F.lane; const f32x4 sh = *(LAS f32x4*)(vec + c), sc = *(LAS f32x4*)(vec + 1024 + c); const f32x4 h = v[j] * rs * sc + sh;
            v2u w; w.x = pk2(h.x, h.y); w.y = pk2(h.z, h.w); o8[64 * j] = w; } }
}
__device__ __forceinline__ void p4_combine(Frame& F) {
    const float lam = __expf(wave_sum(inp(6)[F.lane] * inp(7)[F.lane])) - __expf(wave_sum(inp(8)[F.lane] * inp(9)[F.lane])) + 0.2f;
    const bf16* OB = (const bf16*)(F.ws + WS_OB); bf16* MIX = (bf16*)(F.ws + WS_MIX);
    const int h = F.lane >> 4, d0 = (F.lane & 15) * 8; const float* sg = inp(10) + d0;
    float gs[8];
#pragma unroll
    for (int j = 0; j < 8; ++j) gs[j] = sg[j] * 0.8f;
    const int gw = F.vcu * NWAVES + F.wave, NGW = F.G * NWAVES;
    for (int tok = gw; tok < NTOK; tok += NGW) {
        const v4u a0 = *(const GAS v4u*)(OB + (size_t)tok * 1024 + (h * 2) * 128 + d0), a1 = *(const GAS v4u*)(OB + (size_t)tok * 1024 + (h * 2 + 1) * 128 + d0);
        float a[8];
        a[0] = pg8::bf_lo(a0.x) - lam * pg8::bf_lo(a1.x); a[1] = pg8::bf_hi(a0.x) - lam * pg8::bf_hi(a1.x); a[2] = pg8::bf_lo(a0.y) - lam * pg8::bf_lo(a1.y); a[3] = pg8::bf_hi(a0.y) - lam * pg8::bf_hi(a1.y);
        a[4] = pg8::bf_lo(a0.z) - lam * pg8::bf_lo(a1.z); a[5] = pg8::bf_hi(a0.z) - lam * pg8::bf_hi(a1.z); a[6] = pg8::bf_lo(a0.w) - lam * pg8::bf_lo(a1.w); a[7] = pg8::bf_hi(a0.w) - lam * pg8::bf_hi(a1.w);
        float ss = 0.f;
#pragma unroll
        for (int j = 0; j < 8; ++j) ss += a[j] * a[j];
        ss += __shfl_xor(ss, 1); ss += __shfl_xor(ss, 2); ss += __shfl_xor(ss, 4); ss += __shfl_xor(ss, 8);
        const float rs = 1.0f / sqrtf(ss * (1.f / 128.f) + 1e-6f);
        v4u o; o.x = pk2(a[0] * rs * gs[0], a[1] * rs * gs[1]); o.y = pk2(a[2] * rs * gs[2], a[3] * rs * gs[3]); o.z = pk2(a[4] * rs * gs[4], a[5] * rs * gs[5]); o.w = pk2(a[6] * rs * gs[6], a[7] * rs * gs[7]);
        *(GAS v4u*)(MIX + (size_t)tok * 1024 + h * 128 + d0) = o;
    }
}
constexpr int WRB = 2064;
constexpr int SEL_OFF = 140288;
static_assert(4 * 16 * WRB <= VEC_OFF, "router weights in LDS");
__device__ __forceinline__ void ins4(float v, int i, float (&tv)[4], int (&ti)[4]) {
#pragma unroll
    for (int k = 0; k < 4; ++k) { const bool better = v > tv[k] || (v == tv[k] && i < ti[k]); const float ov = tv[k]; const int oi = ti[k]; tv[k] = better ? v : ov; ti[k] = better ? i : oi; v = better ? ov : v; i = better ? oi : i; }
}
__device__ __forceinline__ void p6_fill(Frame& F) {
    const int bx = blockIdx.x, rows_per = NTOK / F.G, row_base = bx * rows_per, b = row_base >> 12;
    LAS float* vec = (LAS float*)(F.lds + VEC_OFF);
    LAS unsigned* hist = (LAS unsigned*)(F.lds + SEL_OFF) + 1536;
    const float* n2g = inp(22); const float* mf = (const float*)(F.ws + WS_MODF) + (size_t)b * 6144;
    __syncthreads();
    { const unsigned char* wsrc = F.ws + WS_WRH;
      for (int c = F.tid; c < 8192; c += 512) { const int row = c >> 7, col = c & 127; *(LAS v4u*)(F.lds + RING_OFF + row * WRB + col * 16) = *(const GAS v4u*)(wsrc + (size_t)row * 2048 + col * 16); } }
    for (int n = F.tid; n < 1024; n += 512) { vec[n] = mf[3072 + n]; vec[1024 + n] = (1.0f + mf[4096 + n]) * n2g[n]; }
    if (F.tid < 32) hist[F.tid] = 0u;
    __syncthreads();
}
__device__ __forceinline__ void p6_router(Frame& F, bool dummy = false, bool filled = false) {
    const int bx = blockIdx.x, rows_per = NTOK / F.G, row_base = bx * rows_per;
    LAS float* vec = (LAS float*)(F.lds + VEC_OFF);
    LAS unsigned* sel_e = (LAS unsigned*)(F.lds + SEL_OFF); LAS unsigned* sel_r = sel_e + 512; LAS float* sel_g = (LAS float*)(sel_r + 512); LAS unsigned* hist = (LAS unsigned*)(sel_g + 512); LAS unsigned* base = hist + 32;
    if (!filled) p6_fill(F);
    unsigned char* H = (unsigned char*)(F.ws + WS_H); const bf16* X1 = (const bf16*)(F.ws + WS_X1B);
    int* ptok = (int*)(F.ws + (dummy ? WS_Q : WS_PTOK)); unsigned* slot = (unsigned*)(F.ws + (dummy ? WS_Q + 8 * MiB : WS_SLOT)); float* gate = (float*)(F.ws + (dummy ? WS_Q + 16 * MiB : WS_GATE));
    const int cwc = dummy ? CW_CNT + 2048 : CW_CNT;
    const int t = F.lane & 15, kg = F.lane >> 4;
    for (int r0 = 16 * F.wave; r0 < rows_per; r0 += 16 * NWAVES) { const int tok = row_base + r0 + t;
        const GAS v4u* xp = (const GAS v4u*)(X1 + (size_t)tok * DM + 8 * kg);
        v4u xr[32]; float ss = 0.f;
#pragma unroll
        for (int s = 0; s < 32; ++s) xr[s] = xp[4 * s];
#pragma unroll
        for (int s = 0; s < 32; ++s) { const float x0 = pg8::bf_lo(xr[s].x), x1 = pg8::bf_hi(xr[s].x), x2 = pg8::bf_lo(xr[s].y), x3 = pg8::bf_hi(xr[s].y), x4 = pg8::bf_lo(xr[s].z), x5 = pg8::bf_hi(xr[s].z), x6 = pg8::bf_lo(xr[s].w), x7 = pg8::bf_hi(xr[s].w);
            ss += ((x0 * x0 + x1 * x1) + (x2 * x2 + x3 * x3)) + ((x4 * x4 + x5 * x5) + (x6 * x6 + x7 * x7)); }
        ss += __shfl_xor(ss, 16); ss += __shfl_xor(ss, 32);
        const float rs = 1.0f / sqrtf(ss * (1.f / DM) + 1e-6f);
        f32x4 acc0 = {0.f, 0.f, 0.f, 0.f}, acc1 = {0.f, 0.f, 0.f, 0.f};
        GAS unsigned char* hp = (GAS unsigned char*)(H + (size_t)tok * DM + 8 * kg);
        const LAS unsigned char* wa = F.lds + RING_OFF + t * WRB + 16 * kg;
        const LAS float* vp = vec + 8 * kg;
#pragma unroll
        for (int s = 0; s < 32; ++s) {
            const f32x4 sh0 = *(const LAS f32x4*)(vp), sh1 = *(const LAS f32x4*)(vp + 4), sc0 = *(const LAS f32x4*)(vp + 1024), sc1 = *(const LAS f32x4*)(vp + 1024 + 4);
            v4u xs = xr[s]; asm volatile("" : "+v"(xs));
            const f32x4 xa = {pg8::bf_lo(xs.x), pg8::bf_hi(xs.x), pg8::bf_lo(xs.y), pg8::bf_hi(xs.y)}, xb = {pg8::bf_lo(xs.z), pg8::bf_hi(xs.z), pg8::bf_lo(xs.w), pg8::bf_hi(xs.w)};
            const f32x4 h0 = xa * rs * sc0 + sh0, h1 = xb * rs * sc1 + sh1;
            const pg8::u32x4 bh = pg8::pack8(h0, h1);
            const f32x4 d0 = h0 - (f32x4){pg8::bf_lo(bh.x), pg8::bf_hi(bh.x), pg8::bf_lo(bh.y), pg8::bf_hi(bh.y)}, d1 = h1 - (f32x4){pg8::bf_lo(bh.z), pg8::bf_hi(bh.z), pg8::bf_lo(bh.w), pg8::bf_hi(bh.w)};
            const pg8::u32x4 bl = pg8::pack8(d0, d1);
            *(GAS pg8::i32x2*)(hp + 32 * s) = pg8::pack8_fp8(h0 * pg8::F8_ACT, h1 * pg8::F8_ACT);
            const pg8::bf16x8 Bh = __builtin_bit_cast(pg8::bf16x8, bh), Bl = __builtin_bit_cast(pg8::bf16x8, bl);
            const pg8::bf16x8 Ah0 = *(const LAS pg8::bf16x8*)(wa), Ah1 = *(const LAS pg8::bf16x8*)(wa + 16 * WRB), Al0 = *(const LAS pg8::bf16x8*)(wa + 32 * WRB), Al1 = *(const LAS pg8::bf16x8*)(wa + 48 * WRB);
            acc0 = __builtin_amdgcn_mfma_f32_16x16x32_bf16(Ah0, Bh, acc0, 0, 0, 0); acc1 = __builtin_amdgcn_mfma_f32_16x16x32_bf16(Ah1, Bh, acc1, 0, 0, 0);
            acc0 = __builtin_amdgcn_mfma_f32_16x16x32_bf16(Ah0, Bl, acc0, 0, 0, 0); acc1 = __builtin_amdgcn_mfma_f32_16x16x32_bf16(Ah1, Bl, acc1, 0, 0, 0);
            acc0 = __builtin_amdgcn_mfma_f32_16x16x32_bf16(Al0, Bh, acc0, 0, 0, 0); acc1 = __builtin_amdgcn_mfma_f32_16x16x32_bf16(Al1, Bh, acc1, 0, 0, 0);
            wa += 64; vp += 32;
            asm volatile("" : "+v"(wa), "+v"(vp), "+v"(acc0), "+v"(acc1)); }
        const float* br = inp(24) + 4 * kg;
        float tv[4] = {-INFINITY, -INFINITY, -INFINITY, -INFINITY}; int ti[4] = {99, 99, 99, 99};
#pragma unroll
        for (int r = 0; r < 4; ++r) ins4(acc0[r] + br[r], 4 * kg + r, tv, ti);
#pragma unroll
        for (int r = 0; r < 4; ++r) ins4(acc1[r] + br[16 + r], 16 + 4 * kg + r, tv, ti);
#pragma unroll
        for (int xr_ = 16; xr_ <= 32; xr_ <<= 1) { float ov[4]; int oi[4];
#pragma unroll
            for (int k = 0; k < 4; ++k) { ov[k] = __shfl_xor(tv[k], xr_); oi[k] = __shfl_xor(ti[k], xr_); }
#pragma unroll
            for (int k = 0; k < 4; ++k) ins4(ov[k], oi[k], tv, ti); }
        { const int k = kg;
          const float e1 = __expf(tv[1] - tv[0]), e2 = __expf(tv[2] - tv[0]), e3 = __expf(tv[3] - tv[0]); const float inv = 1.0f / (1.0f + e1 + e2 + e3);
          const int ek = k == 0 ? ti[0] : k == 1 ? ti[1] : k == 2 ? ti[2] : ti[3]; const float gk = (k == 0 ? 1.0f : k == 1 ? e1 : k == 2 ? e2 : e3) * inv;
          const unsigned rank = __hip_atomic_fetch_add(hist + ek, 1u, __ATOMIC_RELAXED, __HIP_MEMORY_SCOPE_WORKGROUP);
          const int q = (r0 + t) * 4 + k; sel_e[q] = (unsigned)ek; sel_r[q] = rank; sel_g[q] = gk; }
    }
    LDS_WAIT(); __syncthreads();
    if (F.tid < 32) base[F.tid] = __hip_atomic_fetch_add((unsigned*)(F.ctl + cwc + 64 * F.tid), hist[F.tid], RLX_AGENT);
    LDS_WAIT(); __syncthreads();
    { const int q = F.tid, tok = row_base + (q >> 2), k = q & 3; const unsigned ek = sel_e[q], pos = base[ek] + sel_r[q];
      ptok[(size_t)ek * NTOK + pos] = tok; slot[(size_t)tok * 4 + k] = (ek << 16) | pos; gate[(size_t)tok * 4 + k] = sel_g[q]; }
}
__device__ __forceinline__ void moe_tables(Frame& F) {
    LAS unsigned char* tile_e = (LAS unsigned char*)(F.lds + TILE_E_OFF); LAS int* tile0 = (LAS int*)(F.lds + TILE0_OFF); LAS int* cntl = (LAS int*)(F.lds + CNTL_OFF); LAS int* Tp = (LAS int*)(F.lds + MOE_T_OFF);
    if (F.tid < 32) { const int c = (int)__hip_atomic_load((unsigned*)(F.ctl + CW_CNT + 64 * F.tid), RLX_AGENT); const int nt = (c + 255) >> 8; int incl = nt;
#pragma unroll
        for (int o = 1; o < 32; o <<= 1) { const int w = __shfl_up(incl, o); if (F.tid >= o) incl += w; }
        const int excl = incl - nt; tile0[F.tid] = excl; cntl[F.tid] = c; if (F.tid == 31) Tp[0] = incl;
        for (int k = 0; k < nt; ++k) tile_e[excl + k] = (unsigned char)F.tid; }
    __syncthreads();
}
struct MoeSched {
    const LAS unsigned char* tile_e; const LAS int* tile0; const LAS unsigned* rowtab; int T, nN, G, c, rev, a_mask, e_mask; size_t tA, tBe, tB;
    __device__ __forceinline__ bool next(int i, pg8::Unit& u) const { const int x = c & 7, y = c >> 3, tpx = 32 / nN, t = (i * 8 + x) * tpx + (y % tpx); if (t >= T) return false; u.pm = rev ? T - 1 - t : t; u.pn = y / tpx; u.e = __builtin_amdgcn_readfirstlane((int)tile_e[u.pm]); return true; }
    __device__ __forceinline__ size_t aoff(const pg8::Unit& u) const { return (size_t)(u.pm & a_mask) * tA; }
    __device__ __forceinline__ size_t boff(const pg8::Unit& u) const { return (size_t)(u.e & e_mask) * tBe + (size_t)u.pn * tB; }
    __device__ __forceinline__ unsigned rowoff(int i, int r) const { return rowtab[i * 256 + r]; }
};
__device__ __forceinline__ void p9_final(Frame& F, bool dummy = false) {
    const int bx = blockIdx.x, rows_per = NTOK / F.G, row_base = bx * rows_per, b = row_base >> 12;
    moe_tables(F);
    const LAS int* tile0 = (const LAS int*)(F.lds + TILE0_OFF);
    const float* g2 = (const float*)(F.ws + WS_MODF) + (size_t)b * 6144 + 5120; const float* fg = inp(29);
    const unsigned char* Y2 = (const unsigned char*)(F.ws + WS_Y2); const unsigned* slot = (const unsigned*)(F.ws + WS_SLOT); const float* gate = (const float*)(F.ws + WS_GATE);
    f32x4 g2v[4], fgv[4];
#pragma unroll
    for (int j = 0; j < 4; ++j) { g2v[j] = *(const f32x4*)(g2 + 256 * j + 4 * F.lane); fgv[j] = *(const f32x4*)(fg + 256 * j + 4 * F.lane); }
    for (int r = F.wave; r < rows_per; r += NWAVES) { const int tok = row_base + r;
        f32x4 acc[4];
#pragma unroll
        for (int j = 0; j < 4; ++j) acc[j] = (f32x4){0.f, 0.f, 0.f, 0.f};
#pragma unroll
        for (int k = 0; k < 4; ++k) { const unsigned sw = slot[(size_t)tok * 4 + k]; const float gk = gate[(size_t)tok * 4 + k]; const size_t p = (size_t)tile0[sw >> 16] * 256 + (sw & 0xffffu);
            const GAS int* yr = (const GAS int*)(Y2 + p * 1024) + F.lane; const float g8 = gk * 0.125f; typedef float f32x2 __attribute__((ext_vector_type(2)));
#pragma unroll
            for (int j = 0; j < 4; ++j) { const int w = yr[64 * j]; const f32x2 lo = __builtin_amdgcn_cvt_pk_f32_fp8(w, false), hi = __builtin_amdgcn_cvt_pk_f32_fp8(w, true);
                acc[j].x += g8 * lo.x; acc[j].y += g8 * lo.y; acc[j].z += g8 * hi.x; acc[j].w += g8 * hi.y; } }
        const GAS v2u* xr = (const GAS v2u*)((const bf16*)(F.ws + WS_X1B) + (size_t)tok * DM) + F.lane;
        GAS f32x4* xw = (GAS f32x4*)((dummy ? (float*)(F.ws + WS_A2) : F.out) + (size_t)tok * DM) + F.lane; f32x4 v[4]; float s = 0.f;
#pragma unroll
        for (int j = 0; j < 4; ++j) { const v2u wx = xr[64 * j]; v[j] = (f32x4){pg8::bf_lo(wx.x), pg8::bf_hi(wx.x), pg8::bf_lo(wx.y), pg8::bf_hi(wx.y)} + g2v[j] * acc[j]; s += (v[j].x * v[j].x + v[j].y * v[j].y) + (v[j].z * v[j].z + v[j].w * v[j].w); }
        const float rs = 1.0f / sqrtf(wave_sum_u(s) * (1.f / DM) + 1e-6f);
#pragma unroll
        for (int j = 0; j < 4; ++j) __builtin_nontemporal_store(v[j] * rs * fgv[j], (f32x4*)(xw + 64 * j));
    }
}

__device__ __forceinline__ void dep_signal(Frame& F, int word) {
    asm volatile("s_waitcnt vmcnt(0)" ::: "memory"); __syncthreads();
    if (F.wave == 0 && lane_id_opaque() == 0) { __builtin_amdgcn_fence(__ATOMIC_RELEASE, "agent"); asm volatile("s_waitcnt vmcnt(0)" ::: "memory"); (void)xb_add((unsigned*)(F.ctl + word), 1u); }
}
__device__ __forceinline__ void dep_wait(Frame& F, int word, unsigned need) {
    if (F.wave == 0 && lane_id_opaque() == 0) { unsigned* p = (unsigned*)(F.ctl + word); unsigned* bar = (unsigned*)(F.ctl + CW_BAR); XB_SPIN(xb_ld(p) < need, bar);
        __builtin_amdgcn_fence(__ATOMIC_ACQUIRE, "agent"); asm volatile("s_waitcnt vmcnt(0)" ::: "memory"); }
    __syncthreads();
}
#ifndef P2_NG
#define P2_NG 176
#endif
__device__ __forceinline__ void phase0(Frame& F, unsigned char* lds, unsigned char* ws) { p0_prologue(F);  }
__device__ __forceinline__ void phase1(Frame& F, unsigned char* lds, unsigned char* ws) { dep_wait(F, CW_DEP0, (unsigned)F.G); p1_h1(F);  }
__device__ __forceinline__ void phase2(Frame& F, unsigned char* lds, unsigned char* ws) {
        pg8::Gemm g{(const bf16*)(ws + WS_H), (const bf16*)(ws + WS_WIN), 1024, 1024, 1024}; const bool hosted = (F.G == 256); const int ng = hosted ? P2_NG : F.G;
        pg8::StaticOrder S; S.init(NTOK, 2048, ng, (int)blockIdx.x, 1024, 1024);
        pg8::EpiQKVU E{(bf16*)(ws + WS_Q), (size_t)(WS_K - WS_Q) / 2, (bf16*)(ws + WS_UA), attn_body::C2};
        if ((int)blockIdx.x < ng) pg8::gemm_phase<pg8::EpiQKVU, pg8::StaticOrder, true, false>(F.lds + RING_OFF, g, S, E, F.wave);
        else tr_run(F, 0, TR_HOSTED, ((int)blockIdx.x - ng) * NWAVES + F.wave, (F.G - ng) * NWAVES);

    }
__device__ __forceinline__ void phase4_glu(Frame& F, unsigned char* ws) {
        pg8::Gemm g{(const bf16*)(ws + WS_Z), (const bf16*)(ws + WS_WGLU), 512, 512, 512}; pg8::StaticOrder S; S.init(NTOK, 512, F.G, (int)blockIdx.x, 512, 512);
        { pg8::Unit u; const bool one = (F.G == 256) && S.next(0, u);
          if (one) dep_wait(F, CW_DEPB + 16 * (u.pm >> 4), 32u);
          else { for (int bb = 0; bb < NB; ++bb) dep_wait(F, CW_DEPB + 16 * bb, 32u); } }
        pg8::EpiGLU E{(const bf16*)(ws + WS_Z), (bf16*)(ws + WS_MIX), inp(20)};
        pg8::gemm_phase<pg8::EpiGLU, pg8::StaticOrder, true, false>(F.lds + RING_OFF, g, S, E, F.wave);
        __syncthreads();
    }
__device__ __forceinline__ void phase3(Frame& F, unsigned char* lds, unsigned char* ws) {
        for (int it = F.vcu; it < 256; it += F.G) { const int g = it >> 3, b = it & 7;
            bf16* UAgb = (bf16*)(ws + WS_UA) + (size_t)((g * 8 + b) * 256) * 384;
            { pg8::Gemm gx{UAgb, (const bf16*)(ws + WS_WM) + (size_t)g * 256 * 256, 256, 384, 256}; pg8::SingleUnit S; pg8::EpiX E;
              pg8::gemm_phase<pg8::EpiX, pg8::SingleUnit, false, false>(F.lds + RING_OFF, gx, S, E, F.wave); }
            LDS_WAIT(); __syncthreads();
            {
                const int p = lane_id_opaque(), c0 = F.wave * 32; const float* L16 = (const float*)(ws + WS_LAM16) + (g * 64 + p) * 2; const float lr = L16[0], li = L16[1];
                LAS float* X = (LAS float*)(F.lds + RING_OFF); LAS float* EW = X + 256 * pg8::XS;
                float hr = 0.f, hi2 = 0.f;
#pragma unroll 8
                for (int k = 0; k < 32; ++k) { LAS float* xc = X + (c0 + k) * pg8::XS + p; const float xr = xc[0], xi = xc[64]; xc[0] = hr; xc[64] = hi2;
                    const float nr = lr * hr - li * hi2 + xr, ni = lr * hi2 + li * hr + xi; hr = nr; hi2 = ni; }
                EW[F.wave * 128 + p] = hr; EW[F.wave * 128 + 64 + p] = hi2;
                float qr = lr, qi = li;
#pragma unroll
                for (int sq = 0; sq < 5; ++sq) { const float t = qr * qr - qi * qi; qi = 2.f * qr * qi; qr = t; }
                LDS_WAIT(); __syncthreads();
                float cr = 0.f, ci = 0.f;
                for (int v = 0; v < F.wave; ++v) { const float er = EW[v * 128 + p], ei = EW[v * 128 + 64 + p]; const float nr = qr * cr - qi * ci + er, ni = qr * ci + qi * cr + ei; cr = nr; ci = ni; }
                bf16* hrow = UAgb + (size_t)c0 * 384 + 256 + p; float pr = 1.f, pi = 0.f;
#pragma unroll 8
                for (int k = 0; k < 32; ++k) { const LAS float* xc = X + (c0 + k) * pg8::XS + p; const float hr2 = xc[0] + (pr * cr - pi * ci), hi3 = xc[64] + (pr * ci + pi * cr);
                    hrow[(size_t)k * 384] = (bf16)f2bf(hr2); hrow[(size_t)k * 384 + 64] = (bf16)f2bf(hi3);
                    const float t = pr * lr - pi * li; pi = pr * li + pi * lr; pr = t; }
                VM_WAIT(); if (F.wave == 0) { __builtin_amdgcn_fence(__ATOMIC_ACQUIRE, "agent"); VM_WAIT(); } }
            LDS_WAIT(); __syncthreads();
            { pg8::Gemm gy{UAgb, (const bf16*)(ws + WS_TV) + (size_t)g * 256 * 384, 384, 384, 384}; pg8::SingleUnit S; pg8::EpiY E{(bf16*)(ws + WS_Z), g, b};
              pg8::gemm_phase<pg8::EpiY, pg8::SingleUnit, false, false>(F.lds + RING_OFF, gy, S, E, F.wave); }
            dep_signal(F, CW_DEPB + 16 * b);
        }
        static_assert(attn_body::LDS2_BYTES <= LDSCTL_OFF, "attention LDS vs control words");
        for (int it = F.vcu; it < 256; it += F.G) { const int bh = it >> 3, sdx = it & 7, b = bh >> 2, h = bh & 3;
            for (int i4 = 0; i4 < 4; ++i4) { const int qb = (i4 >> 1) ? 15 - sdx : sdx;
                { const int m = i4 & 1, hm = h * 2 + m;
                    const attn_body::bf16* q_ = (const attn_body::bf16*)(ws + WS_Q) + (size_t)b * SEQ * 512 + hm * 64; const attn_body::bf16* k_ = (const attn_body::bf16*)(ws + WS_K) + (size_t)b * SEQ * 512 + hm * 64;
                    const attn_body::bf16* v_ = (const attn_body::bf16*)(ws + WS_V) + (size_t)b * SEQ * 512 + h * 128; attn_body::bf16* o_ = (attn_body::bf16*)(ws + WS_OB) + (size_t)b * SEQ * 1024 + hm * 128;
                    asm volatile("" : "+s"(q_), "+s"(k_), "+s"(v_), "+s"(o_));
                    attn_body::attn_unit2<8>(qb, q_, k_, v_, o_, (char*)lds + RING_OFF, F.wave); }
                if (i4 & 1) { VM_WAIT(); __syncthreads();
 const int ln = lane_id_opaque(), t16 = F.wave * 4 + (ln >> 4), d0 = (ln & 15) * 8; const float* sg = inp(10) + d0;
                  const float lam = __expf(wave_sum(inp(6)[ln] * inp(7)[ln])) - __expf(wave_sum(inp(8)[ln] * inp(9)[ln])) + 0.2f;
                  const bf16* OB = (const bf16*)(ws + WS_OB); bf16* MIX = (bf16*)(ws + WS_MIX);
                  for (int p = 0; p < 8; ++p) { const size_t tok = (size_t)b * SEQ + qb * 256 + p * 32 + t16;
                      const v4u a0 = *(const GAS v4u*)(OB + tok * 1024 + (h * 2) * 128 + d0), a1 = *(const GAS v4u*)(OB + tok * 1024 + (h * 2 + 1) * 128 + d0);
                      float a[8];
                      a[0] = pg8::bf_lo(a0.x) - lam * pg8::bf_lo(a1.x); a[1] = pg8::bf_hi(a0.x) - lam * pg8::bf_hi(a1.x); a[2] = pg8::bf_lo(a0.y) - lam * pg8::bf_lo(a1.y); a[3] = pg8::bf_hi(a0.y) - lam * pg8::bf_hi(a1.y);
                      a[4] = pg8::bf_lo(a0.z) - lam * pg8::bf_lo(a1.z); a[5] = pg8::bf_hi(a0.z) - lam * pg8::bf_hi(a1.z); a[6] = pg8::bf_lo(a0.w) - lam * pg8::bf_lo(a1.w); a[7] = pg8::bf_hi(a0.w) - lam * pg8::bf_hi(a1.w);
                      float ss = 0.f;
#pragma unroll
                      for (int j = 0; j < 8; ++j) ss += a[j] * a[j];
                      ss += __shfl_xor(ss, 1); ss += __shfl_xor(ss, 2); ss += __shfl_xor(ss, 4); ss += __shfl_xor(ss, 8);
                      const float rs = 0.8f / sqrtf(ss * (1.f / 128.f) + 1e-6f);
                      const float r4 = rs * 4.0f; const pg8::f32x4 q0 = {a[0] * r4 * sg[0], a[1] * r4 * sg[1], a[2] * r4 * sg[2], a[3] * r4 * sg[3]}, q1 = {a[4] * r4 * sg[4], a[5] * r4 * sg[5], a[6] * r4 * sg[6], a[7] * r4 * sg[7]};
                      *(GAS pg8::i32x2*)((unsigned char*)MIX + tok * 1024 + h * 128 + d0) = pg8::pack8_fp8(q0, q1); } }
            }
        }
        __syncthreads(); phase4_glu(F, ws);
}
__device__ __forceinline__ void phase4(Frame& F, unsigned char* lds, unsigned char* ws) { }
__device__ __forceinline__ void phase5(Frame& F, unsigned char* lds, unsigned char* ws) {
        pg8::Gemm g{(const bf16*)(ws + WS_MIX), (const bf16*)(ws + WS_WOUT), 512, 512, 512}; pg8::StaticOrder S; S.init(NTOK, 1024, F.G, (int)blockIdx.x, 512, 512);
        pg8::EpiOut E{inp(0), (bf16*)(ws + WS_X1B), (const float*)(ws + WS_MODF) + 2048, F.lds + VEC_OFF};
        pg8::gemm_phase<pg8::EpiOut, pg8::StaticOrder, true, false, true>(F.lds + RING_OFF, g, S, E, F.wave);

    }
__device__ __forceinline__ void phase6(Frame& F, unsigned char* lds, unsigned char* ws) { p6_router(F, false, !MK_PER_PHASE);  }
__device__ __forceinline__ void phase7(Frame& F, unsigned char* lds, unsigned char* ws) {
        moe_tables(F);
        MoeSched S; S.tile_e = (const LAS unsigned char*)(F.lds + TILE_E_OFF); S.tile0 = (const LAS int*)(F.lds + TILE0_OFF); S.rowtab = (const LAS unsigned*)(F.lds + ROWTAB_OFF);
        S.T = __builtin_amdgcn_readfirstlane(((const LAS int*)(F.lds + MOE_T_OFF))[0]); S.nN = 8; S.G = F.G; S.c = (int)blockIdx.x; S.rev = 0; S.a_mask = -1; S.e_mask = -1; S.tA = 0; S.tBe = (size_t)2048 * 1024; S.tB = (size_t)256 * 1024;
        { const LAS int* cntl = (const LAS int*)(F.lds + CNTL_OFF); LAS unsigned* rt = (LAS unsigned*)(F.lds + ROWTAB_OFF); const int* ptok = (const int*)(ws + WS_PTOK);
          int tokv[18]; bool live[18];
#pragma unroll
          for (int i = 0; i < 18; ++i) { pg8::Unit u; live[i] = S.next(i, u); tokv[i] = 0;
              if (live[i] && F.tid < 256) { const int e = u.e, pos = (u.pm - S.tile0[e]) * 256 + F.tid; tokv[i] = ptok[(size_t)e * NTOK + (pos < cntl[e] ? pos : 0)]; } }
#pragma unroll
          for (int i = 0; i < 18; ++i) if (live[i] && F.tid < 256) rt[i * 256 + F.tid] = (unsigned)tokv[i] * 1024u; }
        VM_WAIT(); LDS_WAIT(); __syncthreads();
        pg8::Gemm g{(const bf16*)(ws + WS_H), (const bf16*)(ws + WS_W1T), 512, 512, 512};
        pg8::EpiMoe1 E{(unsigned char*)(ws + WS_A2), inp(26)};
        pg8::gemm_phase<pg8::EpiMoe1, MoeSched, true, true, true>(F.lds + RING_OFF, g, S, E, F.wave);

    }
__device__ __forceinline__ void phase8(Frame& F, unsigned char* lds, unsigned char* ws) {
        moe_tables(F);
        MoeSched S; S.tile_e = (const LAS unsigned char*)(F.lds + TILE_E_OFF); S.tile0 = (const LAS int*)(F.lds + TILE0_OFF); S.rowtab = (const LAS unsigned*)(F.lds + ROWTAB_OFF);
        S.T = __builtin_amdgcn_readfirstlane(((const LAS int*)(F.lds + MOE_T_OFF))[0]); S.nN = 4; S.G = F.G; S.c = (int)blockIdx.x; S.rev = 1; S.a_mask = -1; S.e_mask = -1; S.tA = (size_t)256 * 1024; S.tBe = (size_t)1024 * 1024; S.tB = (size_t)256 * 1024;
        pg8::Gemm g{(const bf16*)(ws + WS_A2), (const bf16*)(ws + WS_W2T), 512, 512, 512};
        pg8::EpiMoe2 E{(unsigned char*)(ws + WS_Y2), inp(28), -1};
        pg8::gemm_phase<pg8::EpiMoe2, MoeSched, true, false, true>(F.lds + RING_OFF, g, S, E, F.wave);

    }
__device__ __forceinline__ void phase9(Frame& F, unsigned char* lds, unsigned char* ws) { p9_final(F); }
__device__ __forceinline__ bool relaunder(Frame& F) { F.lane = lane_id_opaque(); F.tid = F.wave * 64 + F.lane; return true; }
struct Args { const float* in[30]; float* out; unsigned char* ws; int ph_lo, ph_hi; };
__global__ void __launch_bounds__(NWAVES * 64, 2) mega_fwd(Args args) {
    extern __shared__ __attribute__((aligned(16))) unsigned char lds[];
    Frame F;
    F.lds = (LAS unsigned char*)lds;
    F.tid = threadIdx.x; F.lane = F.tid & 63; F.wave = __builtin_amdgcn_readfirstlane(F.tid >> 6);
    F.G = gridDim.x; { const int bx = blockIdx.x; F.vcu = (F.G % 8 == 0) ? (bx % 8) * (F.G / 8) + bx / 8 : bx; }
    F.ws = args.ws; F.out = args.out; F.ctl = (gu32*)(args.ws + WS_CTL);
    volatile LAS unsigned* MISC = (volatile LAS unsigned*)(F.lds + MISC_OFF);
    for (int u = F.tid; u < (LDS_BYTES - LDSCTL_OFF) / 4; u += NWAVES * 64) ((LAS unsigned*)(F.lds + LDSCTL_OFF))[u] = 0u;
    __syncthreads();
    XcdBarrier bar; bar.bar = (unsigned*)(F.ctl + CW_BAR); bar.x = 0; bar.st = nullptr;
    if (!MK_PER_PHASE) bar = xcd_barrier_post((unsigned*)(F.ctl + CW_BAR), MISC + 8);
    const int lo = args.ph_lo, hi = args.ph_hi;
#ifndef MK_MASK
#define MK_MASK 0x3ff
#endif
#define IN(k) (((MK_MASK >> (k)) & 1) && lo <= (k) && (k) < hi && relaunder(F))
#define SEAM(k) do { if (IN(k) && IN((k) + 1)) xcd_barrier(bar, F.wave); } while (0)
    unsigned char* ws = args.ws;

    if (IN(0)) { phase0(F, lds, ws); }
#if MK_DUP == 0
    if (IN(0)) { phase0(F, lds, ws); SEAM(0); }
#endif
    if (IN(1)) { phase1(F, lds, ws); SEAM(1); }
#if MK_DUP == 1
    if (IN(1)) { phase1(F, lds, ws); SEAM(1); }
#endif
    if (IN(2)) { phase2(F, lds, ws); SEAM(2); }
#if MK_DUP == 2
    if (IN(2)) { phase2(F, lds, ws); SEAM(2); }
#endif
#if MK_DUP == 18
    if (IN(2)) { for (int rr = 0; rr < 8; ++rr) { phase2(F, lds, ws); xcd_barrier(bar, F.wave); } }
#endif
    if (IN(3)) { phase3(F, lds, ws); }
#if MK_DUP == 3
    if (IN(3)) { phase3(F, lds, ws); SEAM(3); }
#endif
    if (IN(4)) { phase4(F, lds, ws); SEAM(4); }
#if MK_DUP == 4
    if (IN(4)) { phase4(F, lds, ws); SEAM(4); }
#endif
    if (IN(5)) { phase5(F, lds, ws); if (!MK_PER_PHASE && IN(6)) p6_fill(F); SEAM(5); }
#if MK_DUP == 5
    if (IN(5)) { phase5(F, lds, ws); SEAM(5); }
#endif
#if MK_DUP == 6
    if (IN(6)) { p6_router(F, true); xcd_barrier(bar, F.wave); }
#endif
    if (IN(6)) { phase6(F, lds, ws); SEAM(6); }
    if (IN(7)) { phase7(F, lds, ws); SEAM(7); }
#if MK_DUP == 7
    if (IN(7)) { phase7(F, lds, ws); SEAM(7); }
#endif
    if (IN(8)) { phase8(F, lds, ws); SEAM(8); }
#if MK_DUP == 8
    if (IN(8)) { phase8(F, lds, ws); SEAM(8); }
#endif
#if MK_DUP == 9
    if (IN(9)) { p9_final(F, true); xcd_barrier(bar, F.wave); }
#endif
#if MK_DUP == 16 || MK_DUP == 17
    if (IN(8)) {
        moe_tables(F);
        MoeSched S; S.tile_e = (const LAS unsigned char*)(F.lds + TILE_E_OFF); S.tile0 = (const LAS int*)(F.lds + TILE0_OFF); S.rowtab = (const LAS unsigned*)(F.lds + ROWTAB_OFF);
        S.T = __builtin_amdgcn_readfirstlane(((const LAS int*)(F.lds + MOE_T_OFF))[0]); S.nN = 4; S.G = F.G; S.c = (int)blockIdx.x; S.rev = 1; S.e_mask = (MK_DUP == 16) ? 0 : -1; S.a_mask = (MK_DUP == 16) ? 0 : -1; S.tA = (size_t)256 * 1024; S.tBe = (size_t)1024 * 1024; S.tB = (size_t)256 * 1024;
        pg8::Gemm g{(const bf16*)(ws + WS_A2), (const bf16*)(ws + WS_W2T), 512, 512, 512};
        pg8::EpiMoe2 E{(unsigned char*)(ws + WS_W1T), inp(28), 127};
        pg8::gemm_phase<pg8::EpiMoe2, MoeSched, true, false, true>(F.lds + RING_OFF, g, S, E, F.wave);
        xcd_barrier(bar, F.wave);
    }
#endif
    if (IN(9)) { phase9(F, lds, ws); }
#if MK_DUP == 19
    if (IN(9)) { xcd_barrier(bar, F.wave); phase7(F, lds, ws); }
#endif
#if MK_DUP == 20
    if (IN(9)) { xcd_barrier(bar, F.wave); phase8(F, lds, ws); }
#endif
#if MK_DUP == 10
    if (IN(9)) { xcd_barrier(bar, F.wave); phase0(F, lds, ws); }
#endif
#if MK_DUP == 11
    if (IN(9)) { xcd_barrier(bar, F.wave); p0_prologue(F, 1); }
#endif
#if MK_DUP == 13
    if (IN(9)) { xcd_barrier(bar, F.wave); p0_prologue(F, 3); }
#endif
#if MK_DUP == 14
    if (IN(9)) { xcd_barrier(bar, F.wave); p0_prologue(F, 4); }
#endif
#if MK_DUP == 15
    if (IN(9)) { xcd_barrier(bar, F.wave); }
#endif
#if MK_DUP == 12
    if (IN(9)) { xcd_barrier(bar, F.wave); p0_prologue(F, 2); }
#endif
#undef IN
#undef SEAM
}

extern "C" void kernel_launch(void* const* d_in, const int* in_sizes, int n_in, void* d_out, int out_size, void* d_ws, size_t ws_size, hipStream_t stream) {
    static int grid = 0;
    if (grid == 0) {
        if (n_in != 30 || in_sizes[0] != NTOK * DM || out_size != NTOK * DM || ws_size < WS_END) { fprintf(stderr, "kernel_launch: unexpected shapes (n_in %d, in0 %d, out %d, ws %zu); nothing launched\n", n_in, n_in > 0 ? in_sizes[0] : -1, out_size, ws_size); grid = -1; return; }
        int dev = 0, cus = 0;
        if (hipGetDevice(&dev) != hipSuccess || hipDeviceGetAttribute(&cus, hipDeviceAttributeMultiprocessorCount, dev) != hipSuccess) { fprintf(stderr, "kernel_launch: device query failed\n"); grid = -1; return; }
        if (hipFuncSetAttribute((const void*)mega_fwd, hipFuncAttributeMaxDynamicSharedMemorySize, LDS_BYTES) != hipSuccess) { fprintf(stderr, "kernel_launch: hipFuncSetAttribute failed\n"); grid = -1; return; }
        (void)hipGetLastError();
        grid = cus;
        if (grid != 256) { fprintf(stderr, "kernel_launch: built for a 256-CU device, found %d CUs; nothing launched\n", grid); grid = -1; return; }
    }
    if (grid < 0) return;
    if (hipMemsetAsync((char*)d_ws + WS_CTL, 0, CTL_ZERO_BYTES, stream) != hipSuccess) { fprintf(stderr, "kernel_launch: memset failed\n"); return; }
    Args a{};
    for (int i = 0; i < 30; ++i) a.in[i] = (const float*)d_in[i];
    a.out = (float*)d_out; a.ws = (unsigned char*)d_ws;
#if MK_PER_PHASE
    for (int p = 0; p < N_PHASES; ++p) { a.ph_lo = p; a.ph_hi = p + 1; hipLaunchKernelGGL(mega_fwd, dim3(grid), dim3(NWAVES * 64), LDS_BYTES, stream, a); }
#else
    a.ph_lo = 0; a.ph_hi = N_PHASES; hipLaunchKernelGGL(mega_fwd, dim3(grid), dim3(NWAVES * 64), LDS_BYTES, stream, a);
#endif
    const hipError_t le = hipPeekAtLastError();
    if (le != hipSuccess) fprintf(stderr, "kernel_launch: launch failed: %s\n", hipGetErrorName(le));
}
```

```cpp
#include <hip/hip_runtime.h>
#include <hip/hip_bf16.h>
#include <cstdio>
#include <cstdint>
#include <cmath>

#ifndef MK_PER_PHASE
#define MK_PER_PHASE 0
#endif

#ifdef MK_EPI2
#define MK_EPI2V MK_EPI2
#else
#define MK_EPI2V (-1)
#endif
#ifndef MK_DUP
#define MK_DUP (-1)
#endif

#define LAS __attribute__((address_space(3)))
#define GAS __attribute__((address_space(1)))

__device__ __forceinline__ int lane_id_opaque() { int l = (int)__builtin_amdgcn_mbcnt_hi(~0u, __builtin_amdgcn_mbcnt_lo(~0u, 0u)); asm volatile("" : "+v"(l)); return l; }

namespace pg8 {
typedef unsigned short bf16_t;
typedef short bf16x8 __attribute__((ext_vector_type(8)));
typedef float f32x4 __attribute__((ext_vector_type(4)));
typedef unsigned u32x4 __attribute__((ext_vector_type(4)));
typedef float f32x2 __attribute__((ext_vector_type(2)));
typedef int i32x4 __attribute__((ext_vector_type(4)));
typedef int i32x8 __attribute__((ext_vector_type(8)));
typedef int i32x2 __attribute__((ext_vector_type(2)));
constexpr int BM = 256, BK = 64, HALF = 128, HTB = HALF * BK * 2, STAGE_BYTES = 8 * HTB, NXCD = 8, WGM = 8;

__host__ __device__ __forceinline__ int lds_byte(int r, int c) { const int st = (r >> 4) * 2 + (c >> 5), rr = r & 15, cc = c & 31, ob = rr * 64 + cc * 2; return st * 1024 + (ob ^ (((ob >> 9) & 1) << 5)); }
__host__ __device__ __forceinline__ void stage_rc(int b, int& R, int& C) { const int st = b / 1024, sb = b % 1024, swz = sb ^ (((sb >> 9) & 1) << 5); R = (st >> 1) * 16 + swz / 64; C = (st & 1) * 32 + (swz % 64) / 2; }
__host__ __device__ __forceinline__ int perm32(int rho) { const int n = rho >> 4, i = rho & 15; return 8 * (i >> 2) + 4 * n + (i & 3); }

struct Unit { int pm, pn, e; };
struct Gemm { const bf16_t* A; const bf16_t* Bt; int K, lda, ldb; };

struct StaticOrder {
    int nM, nN, nwg, G, c; size_t tA, tB;
    __device__ __forceinline__ void init(int M, int N, int G_, int c_, int lda, int ldb) { nM = M / BM; nN = N / BM; nwg = nM * nN; G = G_; c = c_; tA = (size_t)BM * lda * 2; tB = (size_t)BM * ldb * 2; }
    __device__ __forceinline__ bool next(int i, Unit& u) const {
        const long L = (long)i * G + c; if (L >= nwg) return false;
        int wgid = (int)L; { const int q = nwg / NXCD, r = nwg % NXCD, xcd = wgid % NXCD, off = wgid / NXCD; wgid = (xcd < r ? xcd * (q + 1) : r * (q + 1) + (xcd - r) * q) + off; }
        const int nig = WGM * nN, gid = wgid / nig, fm = gid * WGM, gsz = (nM - fm) < WGM ? (nM - fm) : WGM;
        u.pm = fm + ((wgid % nig) % gsz); u.pn = (wgid % nig) / gsz; u.e = 0; return true;
    }
    __device__ __forceinline__ size_t aoff(const Unit& u) const { return (size_t)u.pm * tA; }
    __device__ __forceinline__ size_t boff(const Unit& u) const { return (size_t)u.pn * tB; }
    __device__ __forceinline__ unsigned rowoff(int, int) const { return 0u; }
};
struct SingleUnit {
    __device__ __forceinline__ bool next(int i, Unit& u) const { if (i > 0) return false; u.pm = 0; u.pn = 0; u.e = 0; return true; }
    __device__ __forceinline__ size_t aoff(const Unit&) const { return 0; }
    __device__ __forceinline__ size_t boff(const Unit&) const { return 0; }
    __device__ __forceinline__ unsigned rowoff(int, int) const { return 0u; }
};

__device__ __forceinline__ unsigned cvt_pk_bf16(float lo, float hi) { unsigned r; asm volatile("v_cvt_pk_bf16_f32 %0, %1, %2" : "=v"(r) : "v"(lo), "v"(hi)); return r; }
__device__ __forceinline__ float sigm(float x) { return __builtin_amdgcn_rcpf(1.0f + __builtin_amdgcn_exp2f(-1.4426950408889634f * x)); }
__device__ __forceinline__ float gelu_tanh(float y) { return y * sigm(1.5957691216057308f * (y + 0.044715f * y * y * y)); }
__device__ __forceinline__ f32x2 gelu_tanh2(f32x2 y) {
    const f32x2 y2 = y * y, u = y * __builtin_elementwise_fma(y2, (f32x2){0.044715f, 0.044715f}, (f32x2){1.f, 1.f}), ea = u * (-1.5957691216057308f * 1.4426950408889634f);
    f32x2 d; d.x = __builtin_amdgcn_exp2f(ea.x); d.y = __builtin_amdgcn_exp2f(ea.y); d = d + 1.0f; f32x2 r; r.x = __builtin_amdgcn_rcpf(d.x); r.y = __builtin_amdgcn_rcpf(d.y); return y * r; }
__device__ __forceinline__ u32x4 pack8(const f32x4& a, const f32x4& b) { u32x4 w; w.x = cvt_pk_bf16(a[0], a[1]); w.y = cvt_pk_bf16(a[2], a[3]); w.z = cvt_pk_bf16(b[0], b[1]); w.w = cvt_pk_bf16(b[2], b[3]); return w; }
__device__ __forceinline__ float clamp_fp8(float v) { return __builtin_amdgcn_fmed3f(v, -448.0f, 448.0f); }
__device__ __forceinline__ i32x2 pack8_fp8(const f32x4& a, const f32x4& c) {
    int w0 = __builtin_amdgcn_cvt_pk_fp8_f32(clamp_fp8(a[0]), clamp_fp8(a[1]), 0, false); w0 = __builtin_amdgcn_cvt_pk_fp8_f32(clamp_fp8(a[2]), clamp_fp8(a[3]), w0, true);
    int w1 = __builtin_amdgcn_cvt_pk_fp8_f32(clamp_fp8(c[0]), clamp_fp8(c[1]), 0, false); w1 = __builtin_amdgcn_cvt_pk_fp8_f32(clamp_fp8(c[2]), clamp_fp8(c[3]), w1, true);
    return (i32x2){w0, w1};
}

struct EpiQKVU {
    static constexpr bool PERM = true, AFTER_DRAIN = false, PROBE2 = (MK_EPI2V == 2);
    bf16_t* QKV; size_t stride; bf16_t* UA; float scale0;
    __device__ __forceinline__ void operator()(const f32x4 (&acc)[2][2][4][2], const Unit& u, int wr, int wc, int fr, int fq) const {
        const int t = u.pn >> 1, colt = (u.pn & 1) * 256 + wc * 32 + 8 * fq, row0 = u.pm * BM + wr * 64 + fr;
        if (t < 3) {
            bf16_t* base = QKV + (size_t)t * stride; const float sc = (t == 0) ? scale0 : 1.f;
#pragma unroll
            for (int ai = 0; ai < 2; ++ai)
#pragma unroll
                for (int m = 0; m < 4; ++m) { bf16_t* rowp = base + (size_t)(row0 + ai * HALF + m * 16) * 512 + colt;
#pragma unroll
                    for (int bj = 0; bj < 2; ++bj) *(u32x4*)(rowp + bj * HALF) = pack8(acc[ai][bj][m][0] * sc, acc[ai][bj][m][1] * sc); }
        } else {
#pragma unroll
            for (int ai = 0; ai < 2; ++ai)
#pragma unroll
                for (int m = 0; m < 4; ++m) { const int r = row0 + ai * HALF + m * 16, b = r >> 12, tt = r & 4095, chunk = tt >> 4, j = tt & 15;
#pragma unroll
                    for (int bj = 0; bj < 2; ++bj) { const int cu = colt + bj * HALF, g = cu >> 4, c0 = cu & 15;
                        *(u32x4*)(UA + ((size_t)((g * 8 + b) * 256 + chunk)) * 384 + j * 16 + c0) = pack8(acc[ai][bj][m][0], acc[ai][bj][m][1]); } }
        }
    }
};
constexpr int XS = 132;
struct EpiX {
    static constexpr bool PERM = false, AFTER_DRAIN = true, PROBE2 = false, HALF_N = true;
    __device__ __forceinline__ void fused(const f32x4 (&acc)[2][2][4][2], const Unit&, int wr, int wc, int fr, int fq, LAS unsigned char* lds, int, int) const {
        LAS float* X = (LAS float*)lds;
#pragma unroll
        for (int ai = 0; ai < 2; ++ai)
#pragma unroll
            for (int m = 0; m < 4; ++m) { const int row = ai * HALF + wr * 64 + m * 16 + fr;
#pragma unroll
                for (int n = 0; n < 2; ++n) *(LAS f32x4*)(X + row * XS + wc * 32 + n * 16 + 4 * fq) = acc[ai][0][m][n]; }
    }
};
struct EpiY {
    static constexpr bool PERM = true, AFTER_DRAIN = false, PROBE2 = false;
    bf16_t* Z; int g, b;
    __device__ __forceinline__ void operator()(const f32x4 (&acc)[2][2][4][2], const Unit&, int wr, int wc, int fr, int fq) const {
#pragma unroll
        for (int ai = 0; ai < 2; ++ai)
#pragma unroll
            for (int m = 0; m < 4; ++m) { const int chunk = ai * HALF + wr * 64 + m * 16 + fr;
#pragma unroll
                for (int bj = 0; bj < 2; ++bj) { const int col0 = bj * HALF + wc * 32 + 8 * fq, s = col0 >> 4, c0 = col0 & 15;
                    f32x4 v0 = acc[ai][bj][m][0], v1 = acc[ai][bj][m][1];
#pragma unroll
                    for (int q = 0; q < 4; q += 2) { const f32x2 a = gelu_tanh2((f32x2){v0[q], v0[q + 1]}), c = gelu_tanh2((f32x2){v1[q], v1[q + 1]}); v0[q] = a.x; v0[q + 1] = a.y; v1[q] = c.x; v1[q + 1] = c.y; }
                    *(u32x4*)(Z + (size_t)(b * 4096 + chunk * 16 + s) * 512 + g * 16 + c0) = pack8(v0, v1); }
                __builtin_amdgcn_sched_barrier(0); }
    }
};
__device__ __forceinline__ float bf_lo(unsigned w) { return __uint_as_float(w << 16); }
__device__ __forceinline__ float bf_hi(unsigned w) { return __uint_as_float(w & 0xffff0000u); }
struct EpiGLU {
    static constexpr bool PERM = true, AFTER_DRAIN = false, PROBE2 = false;
    const bf16_t* Z; bf16_t* MIX; const float* bias;
    __device__ __forceinline__ void operator()(const f32x4 (&acc)[2][2][4][2], const Unit& u, int wr, int wc, int fr, int fq) const {
        const int row0 = u.pm * BM + wr * 64 + fr, col0 = u.pn * BM + wc * 32 + 8 * fq;
        f32x4 bv[2][2];
#pragma unroll
        for (int bj = 0; bj < 2; ++bj)
#pragma unroll
            for (int n = 0; n < 2; ++n) bv[bj][n] = *(const f32x4*)(bias + col0 + bj * HALF + 4 * n);
#pragma unroll
        for (int ai = 0; ai < 2; ++ai)
#pragma unroll
            for (int m = 0; m < 4; ++m) { const size_t row = (size_t)(row0 + ai * HALF + m * 16);
#pragma unroll
                for (int bj = 0; bj < 2; ++bj) { const int col = col0 + bj * HALF; const u32x4 zz = *(const u32x4*)(Z + row * 512 + col);
                    const f32x4 a0 = acc[ai][bj][m][0] + bv[bj][0], a1 = acc[ai][bj][m][1] + bv[bj][1];
                    f32x4 o0, o1;
                    o0[0] = bf_lo(zz.x) * sigm(a0[0]); o0[1] = bf_hi(zz.x) * sigm(a0[1]); o0[2] = bf_lo(zz.y) * sigm(a0[2]); o0[3] = bf_hi(zz.y) * sigm(a0[3]);
                    o1[0] = bf_lo(zz.z) * sigm(a1[0]); o1[1] = bf_hi(zz.z) * sigm(a1[1]); o1[2] = bf_lo(zz.w) * sigm(a1[2]); o1[3] = bf_hi(zz.w) * sigm(a1[3]);
                    *(i32x2*)((unsigned char*)MIX + row * 1024 + 512 + col) = pack8_fp8(o0 * 4.0f, o1 * 4.0f); }
                __builtin_amdgcn_sched_barrier(0); }
    }
};
struct EpiOut {
    static constexpr bool PERM = true, AFTER_DRAIN = false, PROBE2 = (MK_EPI2V == 5);
    const float* X; bf16_t* X1; const float* g1; LAS unsigned char* stg;
    __device__ __forceinline__ void operator()(const f32x4 (&acc)[2][2][4][2], const Unit& u, int wr, int wc, int fr, int fq) const {
        const int col0 = wc * 32 + 8 * fq, b = (u.pm * BM) >> 12, t = (wr * 4 + wc) * 64 + fq * 16 + fr, rs = t >> 4, ch = t & 15;
        f32x4 gv[2][2];
#pragma unroll
        for (int bj = 0; bj < 2; ++bj)
#pragma unroll
            for (int n = 0; n < 2; ++n) gv[bj][n] = *(const f32x4*)(g1 + (size_t)b * 6144 + u.pn * BM + col0 + bj * HALF + 4 * n) * (1.0f / 128.0f);
        LAS unsigned char* wp = stg + (16 * wr + fr) * 528 + col0 * 2; const LAS unsigned char* rp = stg + rs * 528 + ch * 32;
        const size_t off0 = (size_t)(u.pm * BM + 64 * (rs >> 4) + (rs & 15)) * 1024 + u.pn * BM + 16 * ch;
        f32x4 xv[4], xn[4];
#pragma unroll
        for (int q = 0; q < 4; ++q) xv[q] = *(const f32x4*)(X + off0 + 4 * q);
#pragma unroll
        for (int sidx = 0; sidx < 8; ++sidx) { const int ai = sidx >> 2, m = sidx & 3; const size_t off = off0 + (size_t)(ai * HALF + 16 * m) * 1024;
            if (sidx < 7) { const size_t offn = off0 + (size_t)(((sidx + 1) >> 2) * HALF + 16 * ((sidx + 1) & 3)) * 1024;
#pragma unroll
                for (int q = 0; q < 4; ++q) xn[q] = *(const f32x4*)(X + offn + 4 * q); }
#pragma unroll
            for (int bj = 0; bj < 2; ++bj) *(LAS u32x4*)(wp + bj * 256) = pack8(gv[bj][0] * acc[ai][bj][m][0], gv[bj][1] * acc[ai][bj][m][1]);
            asm volatile("s_waitcnt lgkmcnt(0)" ::: "memory"); __builtin_amdgcn_s_barrier(); asm volatile("" ::: "memory");
            const u32x4 m0 = *(const LAS u32x4*)(rp), m1 = *(const LAS u32x4*)(rp + 16);
            f32x4 o0, o1, o2, o3;
            o0 = xv[0] + (f32x4){bf_lo(m0.x), bf_hi(m0.x), bf_lo(m0.y), bf_hi(m0.y)}; o1 = xv[1] + (f32x4){bf_lo(m0.z), bf_hi(m0.z), bf_lo(m0.w), bf_hi(m0.w)};
            o2 = xv[2] + (f32x4){bf_lo(m1.x), bf_hi(m1.x), bf_lo(m1.y), bf_hi(m1.y)}; o3 = xv[3] + (f32x4){bf_lo(m1.z), bf_hi(m1.z), bf_lo(m1.w), bf_hi(m1.w)};
            *(u32x4*)(X1 + off) = pack8(o0, o1); *(u32x4*)(X1 + off + 8) = pack8(o2, o3);
            asm volatile("s_waitcnt lgkmcnt(0)" ::: "memory"); __builtin_amdgcn_s_barrier(); asm volatile("" ::: "memory");
#pragma unroll
            for (int q = 0; q < 4; ++q) xv[q] = xn[q]; }
    }
};
constexpr float F8_ACT = 4.0f, F8_W = 32.0f, F8_UNDO = 1.0f / (4.0f * 32.0f);
struct EpiMoe1 {
    static constexpr bool PERM = true, AFTER_DRAIN = false, PROBE2 = (MK_EPI2V == 7);
    unsigned char* A2; const float* b1;
    __device__ __forceinline__ void operator()(const f32x4 (&acc)[2][2][4][2], const Unit& u, int wr, int wc, int fr, int fq) const {
        asm volatile("" : "+v"(fr), "+v"(fq));
        const int row0 = u.pm * BM + wr * 64 + fr, jc = u.pn * 128 + wc * 32 + 8 * fq;
        f32x4 bg[2], bu[2];
#pragma unroll
        for (int n = 0; n < 2; ++n) { bg[n] = *(const f32x4*)(b1 + (size_t)u.e * 2048 + jc + 4 * n); bu[n] = *(const f32x4*)(b1 + (size_t)u.e * 2048 + 1024 + jc + 4 * n); }
#pragma unroll
        for (int ai = 0; ai < 2; ++ai)
#pragma unroll
            for (int m = 0; m < 4; ++m) { f32x4 o[2];
#pragma unroll
                for (int n = 0; n < 2; ++n) {
#pragma unroll
                    for (int hq = 0; hq < 2; ++hq) { const f32x2 ag = {acc[ai][0][m][n][2 * hq], acc[ai][0][m][n][2 * hq + 1]}, au = {acc[ai][1][m][n][2 * hq], acc[ai][1][m][n][2 * hq + 1]};
                        const f32x2 vbg = {bg[n][2 * hq], bg[n][2 * hq + 1]}, vbu = {bu[n][2 * hq], bu[n][2 * hq + 1]}, k7 = {7.0f, 7.0f}, km7 = {-7.0f, -7.0f}, kund = {F8_UNDO, F8_UNDO};
                        const f32x2 g = __builtin_elementwise_min(__builtin_elementwise_fma(ag, kund, vbg), k7), uu = __builtin_elementwise_min(__builtin_elementwise_max(__builtin_elementwise_fma(au, kund, vbu), km7), k7);
                        const f32x2 ea = g * (-1.702f * 1.4426950408889634f); f32x2 den; den.x = __builtin_amdgcn_exp2f(ea.x); den.y = __builtin_amdgcn_exp2f(ea.y); den = den + 1.0f;
                        f32x2 sg; sg.x = __builtin_amdgcn_rcpf(den.x); sg.y = __builtin_amdgcn_rcpf(den.y);
                        const f32x2 r = __builtin_elementwise_fma(uu, (f32x2){F8_ACT, F8_ACT}, (f32x2){F8_ACT, F8_ACT}) * (g * sg); o[n][2 * hq] = r.x; o[n][2 * hq + 1] = r.y; } }
                *(i32x2*)(A2 + (size_t)(row0 + ai * HALF + m * 16) * 1024 + jc) = pack8_fp8(o[0], o[1]);
                __builtin_amdgcn_sched_barrier(0); }
    }
};
struct EpiMoe2 {
    static constexpr bool PERM = true, AFTER_DRAIN = false, PROBE2 = (MK_EPI2V == 8);
    unsigned char* Y2; const float* b2; int pm_mask;
    __device__ __forceinline__ void operator()(const f32x4 (&acc)[2][2][4][2], const Unit& u, int wr, int wc, int fr, int fq) const {
        asm volatile("" : "+v"(fr), "+v"(fq));
        const int row0 = (u.pm & pm_mask) * BM + wr * 64 + fr, col0 = u.pn * BM + wc * 32 + 8 * fq;
        f32x4 bv[2][2];
#pragma unroll
        for (int bj = 0; bj < 2; ++bj)
#pragma unroll
            for (int n = 0; n < 2; ++n) bv[bj][n] = *(const f32x4*)(b2 + (size_t)u.e * 1024 + col0 + bj * HALF + 4 * n);
#pragma unroll
        for (int ai = 0; ai < 2; ++ai)
#pragma unroll
            for (int m = 0; m < 4; ++m) { unsigned char* rowp = Y2 + (size_t)(row0 + ai * HALF + m * 16) * 1024 + col0;
#pragma unroll
                for (int bj = 0; bj < 2; ++bj) *(i32x2*)(rowp + bj * HALF) = pack8_fp8((acc[ai][bj][m][0] * F8_UNDO + bv[bj][0]) * 8.0f, (acc[ai][bj][m][1] * F8_UNDO + bv[bj][1]) * 8.0f); }
    }
};

template <class E, class = void> struct epi_half_n { static constexpr bool value = false; };
template <class E> struct epi_half_n<E, decltype((void)E::HALF_N)> { static constexpr bool value = E::HALF_N; };
template <class Epi, class Sched, bool ALIGN_EPI, bool GATHER, bool F8 = false>
__device__ __forceinline__ void gemm_phase(LAS unsigned char* lds, const Gemm g, const Sched& S, const Epi& E, const int wave) {
    const int tid = wave * 64 + lane_id_opaque(), wid = __builtin_amdgcn_readfirstlane(tid >> 6), lane = tid & 63,
              wr = wid >> 2, wc = wid & 3, fr = lane & 15, fq = lane >> 4;
    const int nt = g.K / BK; constexpr bool HN = epi_half_n<Epi>::value;
    unsigned voffB[2], vA[2][2];
#pragma unroll
    for (int i = 0; i < 2; ++i) { int R, C; stage_rc(tid * 16 + i * 8192, R, C); const int Rb = Epi::PERM ? ((R & ~31) + perm32(R & 31)) : R;
        voffB[i] = (unsigned)(Rb * g.ldb + C) * 2u;
#pragma unroll
        for (int h = 0; h < 2; ++h) vA[h][i] = (unsigned)((R + h * HALF) * g.lda + C) * 2u; }
    const size_t kstep = (size_t)(BK * 2);
    const size_t hstepB = (size_t)HALF * g.ldb * 2;
    const unsigned ldsw = (unsigned)wid * 1024u;
    const unsigned ldsbase = (unsigned)__builtin_amdgcn_readfirstlane((int)((unsigned)(uintptr_t)lds + ldsw));
    const int aoff = lds_byte(wr * 64 + fr, fq * 8), boff = lds_byte(wc * 32 + fr, fq * 8);
#define PG8_SA(b, h) (((b) * 2 + (h)) * HTB)
#define PG8_SB(b, h) ((4 + (b) * 2 + (h)) * HTB)
#define PG8_STAGE(bufoff, gbase, voff) do { if constexpr (F8) { _Pragma("unroll") for (int _i = 0; _i < 2; ++_i) { unsigned keep_; \
            asm volatile("s_mov_b32 %0, m0\n\ts_mov_b32 m0, %3\n\ts_nop 0\n\tglobal_load_lds_dwordx4 %1, %2\n\ts_mov_b32 m0, %0" : "=&s"(keep_) : "v"((voff)[_i]), "s"((const char*)(gbase)), "s"(ldsbase + (unsigned)((bufoff) + _i * 8192)) : "memory"); } } \
        else { _Pragma("unroll") for (int _i = 0; _i < 2; ++_i) \
        __builtin_amdgcn_global_load_lds((const unsigned*)((const char*)(gbase) + (voff)[_i]), (LAS unsigned*)(lds + (bufoff) + ldsw + _i * 8192), 16, 0, 0); } } while (0)
#define PG8_LDA(dst, b, h) do { if constexpr (F8) { _Pragma("unroll") for (int m = 0; m < 4; ++m) dst##8[m] = PG8_F8CAT(*(const LAS bf16x8*)(lds + PG8_SA(b, h) + aoff + m * 2048), *(const LAS bf16x8*)(lds + PG8_SA(b, h) + aoff + m * 2048 + 1024)); } \
        else { _Pragma("unroll") for (int m = 0; m < 4; ++m) _Pragma("unroll") for (int k = 0; k < 2; ++k) dst[m][k] = *(const LAS bf16x8*)(lds + PG8_SA(b, h) + aoff + m * 2048 + k * 1024); } } while (0)
#define PG8_LDB(dst, b, h) do { if constexpr (F8) { _Pragma("unroll") for (int n = 0; n < 2; ++n) dst##8[n] = PG8_F8CAT(*(const LAS bf16x8*)(lds + PG8_SB(b, h) + boff + n * 2048), *(const LAS bf16x8*)(lds + PG8_SB(b, h) + boff + n * 2048 + 1024)); } \
        else { _Pragma("unroll") for (int n = 0; n < 2; ++n) _Pragma("unroll") for (int k = 0; k < 2; ++k) dst[n][k] = *(const LAS bf16x8*)(lds + PG8_SB(b, h) + boff + n * 2048 + k * 1024); } } while (0)
#define PG8_F8CAT(lo, hi) __builtin_shufflevector(__builtin_bit_cast(i32x4, (lo)), __builtin_bit_cast(i32x4, (hi)), 0, 1, 2, 3, 4, 5, 6, 7)
#define PG8_MMA(ai, bj, At, Bt) do { __builtin_amdgcn_s_setprio(1); \
        if constexpr (F8) { _Pragma("unroll") for (int m = 0; m < 4; ++m) _Pragma("unroll") for (int n = 0; n < 2; ++n) \
            acc[ai][bj][m][n] = __builtin_amdgcn_mfma_scale_f32_16x16x128_f8f6f4(Bt##8[n], At##8[m], acc[ai][bj][m][n], 0, 0, 0, 0x7F7F7F7F, 0, 0x7F7F7F7F); } \
        else { _Pragma("unroll") for (int m = 0; m < 4; ++m) _Pragma("unroll") for (int n = 0; n < 2; ++n) _Pragma("unroll") for (int k = 0; k < 2; ++k) \
            acc[ai][bj][m][n] = __builtin_amdgcn_mfma_f32_16x16x32_bf16(Bt[n][k], At[m][k], acc[ai][bj][m][n], 0, 0, 0); } \
        __builtin_amdgcn_s_setprio(0); } while (0)
#define PG8_WAIT_V(n) asm volatile("s_waitcnt vmcnt(" #n ")" ::: "memory")
#define PG8_WAIT_L(n) asm volatile("s_waitcnt lgkmcnt(" #n ")" ::: "memory")
#define PG8_BAR __builtin_amdgcn_s_barrier()
#define PG8_SCHED __builtin_amdgcn_sched_barrier(0)
#define PG8_GOFF(u_, h, i) ({ const int tq_ = wid * 64 + lane_id_opaque(); int R_, C_; stage_rc(tq_ * 16 + (i) * 8192, R_, C_); S.rowoff((u_), (h) * HALF + R_) + (unsigned)C_ * 2u; })
    Unit cur, nxt; int ui = 0;
    if (!S.next(0, cur)) return;
    if constexpr (GATHER) {
#pragma unroll
        for (int h = 0; h < 2; ++h)
#pragma unroll
            for (int i = 0; i < 2; ++i) vA[h][i] = PG8_GOFF(0, h, i);
    }
    f32x4 acc[2][2][4][2];
#pragma unroll
    for (int a = 0; a < 2; ++a)
#pragma unroll
        for (int b = 0; b < 2; ++b)
#pragma unroll
            for (int m = 0; m < 4; ++m)
#pragma unroll
                for (int n = 0; n < 2; ++n) acc[a][b][m][n] = (f32x4){0.f, 0.f, 0.f, 0.f};
    bf16x8 At[4][2], B0[2][2], B1[2][2]; i32x8 At8[4], B08[2], B18[2];
    const char* cA = (const char*)g.A + S.aoff(cur); const char* cB = (const char*)g.Bt + S.boff(cur);
    PG8_STAGE(PG8_SB(0, 0), cB, voffB); PG8_STAGE(PG8_SB(0, 1), cB + hstepB, voffB); PG8_STAGE(PG8_SA(0, 0), cA, vA[0]); PG8_STAGE(PG8_SA(0, 1), cA, vA[1]);
    if (wr == 1) PG8_BAR;
    PG8_WAIT_V(2); PG8_BAR;
    PG8_STAGE(PG8_SB(1, 0), cB + kstep, voffB); PG8_STAGE(PG8_SA(1, 0), cA + kstep, vA[0]); PG8_STAGE(PG8_SB(1, 1), cB + hstepB + kstep, voffB);
    PG8_WAIT_V(6); PG8_BAR;
    for (;;) {
        const bool has_next = S.next(ui + 1, nxt);
        const char* nA = has_next ? (const char*)g.A + S.aoff(nxt) : cA; const char* nB = has_next ? (const char*)g.Bt + S.boff(nxt) : cB;
#pragma unroll 1
        for (int t = 0; t < nt; t += 2) {
            const bool last = (t == nt - 2);
            const char* a1 = cA + (size_t)(t + 1) * kstep;
            const char* a2 = last ? nA : cA + (size_t)(t + 2) * kstep; const char* b2 = last ? nB : cB + (size_t)(t + 2) * kstep;
            const char* a3 = a2 + kstep; const char* b3 = b2 + kstep;
            unsigned w0[2], w1[2];
            if constexpr (GATHER) { const bool nx_ = last && has_next;
                if (nx_) { w0[0] = PG8_GOFF(ui + 1, 0, 0); w0[1] = PG8_GOFF(ui + 1, 0, 1); w1[0] = PG8_GOFF(ui + 1, 1, 0); w1[1] = PG8_GOFF(ui + 1, 1, 1); }
                else { w0[0] = vA[0][0]; w0[1] = vA[0][1]; w1[0] = vA[1][0]; w1[1] = vA[1][1]; } }
            else { w0[0] = vA[0][0]; w0[1] = vA[0][1]; w1[0] = vA[1][0]; w1[1] = vA[1][1]; }
            PG8_LDB(B0, 0, 0); if constexpr (!HN) PG8_LDB(B1, 0, 1); PG8_SCHED; PG8_LDA(At, 0, 0); PG8_STAGE(PG8_SA(1, 1), a1, vA[1]);
            PG8_WAIT_V(8); PG8_WAIT_L(0); PG8_BAR; PG8_MMA(0, 0, At, B0); if constexpr (!HN) PG8_MMA(0, 1, At, B1); PG8_BAR; PG8_SCHED;
            PG8_LDA(At, 0, 1); PG8_STAGE(PG8_SB(0, 0), b2, voffB); PG8_STAGE(PG8_SB(0, 1), b2 + hstepB, voffB); PG8_STAGE(PG8_SA(0, 0), a2, w0);
            PG8_WAIT_V(8); PG8_WAIT_L(0); PG8_BAR; PG8_MMA(1, 0, At, B0); if constexpr (!HN) PG8_MMA(1, 1, At, B1); PG8_BAR; PG8_SCHED;
            PG8_LDB(B0, 1, 0); if constexpr (!HN) PG8_LDB(B1, 1, 1); PG8_SCHED; PG8_LDA(At, 1, 0); PG8_STAGE(PG8_SA(0, 1), a2, w1);
            PG8_WAIT_V(8); PG8_WAIT_L(0); PG8_BAR; PG8_MMA(0, 0, At, B0); if constexpr (!HN) PG8_MMA(0, 1, At, B1); PG8_BAR; PG8_SCHED;
            PG8_LDA(At, 1, 1); PG8_STAGE(PG8_SB(1, 0), b3, voffB); PG8_STAGE(PG8_SB(1, 1), b3 + hstepB, voffB); PG8_STAGE(PG8_SA(1, 0), a3, w0);
            PG8_WAIT_V(8); PG8_WAIT_L(0); PG8_BAR; PG8_MMA(1, 0, At, B0); if constexpr (!HN) PG8_MMA(1, 1, At, B1); PG8_BAR; PG8_SCHED;
        }
        if constexpr (ALIGN_EPI) { if (wr == 0) PG8_BAR; }
        if constexpr (!Epi::AFTER_DRAIN) { const int te_ = lane_id_opaque(); const int fre = te_ & 15, fqe = (te_ >> 4) & 3;
            E(acc, cur, wr, wc, fre, fqe);
#ifdef MK_EPI2
            if constexpr (Epi::PROBE2) { asm volatile("" ::: "memory"); E(acc, cur, wr, wc, fr, fq); }
#endif
        }
        if (!has_next) break;
#pragma unroll
        for (int a = 0; a < 2; ++a)
#pragma unroll
            for (int b = 0; b < 2; ++b)
#pragma unroll
                for (int m = 0; m < 4; ++m)
#pragma unroll
                    for (int n = 0; n < 2; ++n) acc[a][b][m][n] = (f32x4){0.f, 0.f, 0.f, 0.f};
        cur = nxt; cA = nA; cB = nB; ++ui;
        if constexpr (GATHER) {
#pragma unroll
            for (int h = 0; h < 2; ++h)
#pragma unroll
                for (int i = 0; i < 2; ++i) vA[h][i] = PG8_GOFF(ui, h, i);
        }
        if constexpr (ALIGN_EPI) { if (wr == 1) PG8_BAR; }
    }
    PG8_WAIT_V(0);
    if constexpr (!ALIGN_EPI) { if (wr == 0) PG8_BAR; }
    PG8_BAR;
    if constexpr (Epi::AFTER_DRAIN) { E.fused(acc, cur, wr, wc, fr, fq, lds, wid, lane); }
#undef PG8_SA
#undef PG8_SB
#undef PG8_STAGE
#undef PG8_LDA
#undef PG8_LDB
#undef PG8_MMA
#undef PG8_GOFF
#undef PG8_F8CAT
#undef PG8_WAIT_V
#undef PG8_WAIT_L
#undef PG8_BAR
#undef PG8_SCHED
}
}

namespace attn_body {
using bf16=__hip_bfloat16;
using bf16x8=__attribute__((ext_vector_type(8)))short;
using s16x4=__attribute__((ext_vector_type(4)))short;
using f32x16=__attribute__((ext_vector_type(16)))float;
using u32x4=__attribute__((ext_vector_type(4)))unsigned;
constexpr int SEQ=4096,D=64,DMI=512,DMO=1024;
constexpr int NW=8,QBLK=32,QB=QBLK*NW,KVBLK=64,NQB=SEQ/QB;
__device__ __forceinline__ int crow(int r,int hi){return (r&3)+8*(r>>2)+4*hi;}
#define SBAR() __builtin_amdgcn_sched_barrier(0)
__device__ __forceinline__ void cmask(f32x16&p0,f32x16&p1,int jb,int qrel,int hi){
  const float NEG=-INFINITY; int kb=64*jb+4*hi;
  #pragma unroll
  for(int r=0;r<16;++r){int kv=kb+(r&3)+8*(r>>2); if(kv>qrel)p0[r]=NEG; if(kv+32>qrel)p1[r]=NEG;}
}
constexpr int NSLOT=3, SLOTB=8192;
constexpr int LDS_K=0, LDS_V=NSLOT*SLOTB, LDS_WS=2*NSLOT*SLOTB, LDS_OST=LDS_WS+NW*64*4, LDS_BYTES=LDS_OST+NW*4096;
constexpr float C2=0.125f*1.4426950408889634f;
__device__ __forceinline__ void glds16(const void*gsrc,unsigned lds_dst){unsigned keep;
  asm volatile("s_mov_b32 %0, m0\n\ts_mov_b32 m0, %2\n\ts_nop 0\n\tglobal_load_lds_dwordx4 %1, off\n\ts_mov_b32 m0, %0":"=&s"(keep):"v"(gsrc),"s"(lds_dst):"memory");}
__device__ __forceinline__ float max3f(float a,float b,float c){float r;asm("v_max3_f32 %0, %1, %2, %3":"=v"(r):"v"(a),"v"(b),"v"(c));return r;}
__device__ __forceinline__ float max2f(float a,float b){float r;asm("v_max_f32_e32 %0, %1, %2":"=v"(r):"v"(a),"v"(b));return r;}
__device__ __forceinline__ float fadd_s(float a,float b){float r;asm("v_add_f32_e32 %0, %1, %2":"=v"(r):"v"(a),"v"(b));return r;}
__device__ __forceinline__ float fsub_s(float a,float b){float r;asm("v_sub_f32_e32 %0, %1, %2":"=v"(r):"v"(a),"v"(b));return r;}
typedef float f32x2_t __attribute__((ext_vector_type(2))); typedef __bf16 bf16x2_t __attribute__((ext_vector_type(2)));
__device__ __forceinline__ unsigned cvtpk_s(float lo,float hi){f32x2_t v={lo,hi};bf16x2_t b=__builtin_convertvector(v,bf16x2_t);return __builtin_bit_cast(unsigned,b);}
#define WAIT_BAR(N) asm volatile("s_waitcnt vmcnt(" #N ") lgkmcnt(0)\n\ts_barrier":::"memory")

__device__ __forceinline__ void qkt(f32x16&p0,f32x16&p1,const char*Kslot,const bf16x8*qr,const f32x16&negm,int r32,int hi){
  const char*kb=Kslot+hi*1024+r32*16;
  #pragma unroll
  for(int d0=0;d0<4;++d0){
    const bf16x8 b0=*reinterpret_cast<const bf16x8*>(kb+d0*2048);
    const bf16x8 b1=*reinterpret_cast<const bf16x8*>(kb+d0*2048+512);
    if(d0==0){p0=__builtin_amdgcn_mfma_f32_32x32x16_bf16(b0,qr[0],negm,0,0,0);p1=__builtin_amdgcn_mfma_f32_32x32x16_bf16(b1,qr[0],negm,0,0,0);}
    else{p0=__builtin_amdgcn_mfma_f32_32x32x16_bf16(b0,qr[d0],p0,0,0,0);p1=__builtin_amdgcn_mfma_f32_32x32x16_bf16(b1,qr[d0],p1,0,0,0);}}
}
typedef __attribute__((address_space(3))) const char* lds_cptr;
typedef short v4i16_t __attribute__((ext_vector_type(4)));
__device__ __forceinline__ void kload8(bf16x8*kf,lds_cptr kp){
  kf[0]=*(const __attribute__((address_space(3))) bf16x8*)(kp);      kf[1]=*(const __attribute__((address_space(3))) bf16x8*)(kp+512);
  kf[2]=*(const __attribute__((address_space(3))) bf16x8*)(kp+2048); kf[3]=*(const __attribute__((address_space(3))) bf16x8*)(kp+2560);
  kf[4]=*(const __attribute__((address_space(3))) bf16x8*)(kp+4096); kf[5]=*(const __attribute__((address_space(3))) bf16x8*)(kp+4608);
  kf[6]=*(const __attribute__((address_space(3))) bf16x8*)(kp+6144); kf[7]=*(const __attribute__((address_space(3))) bf16x8*)(kp+6656);
}
__device__ __forceinline__ void kload2(bf16x8*kf,lds_cptr kp,int j){ kf[2*j]=*(const __attribute__((address_space(3))) bf16x8*)(kp+j*2048); kf[2*j+1]=*(const __attribute__((address_space(3))) bf16x8*)(kp+j*2048+512); }
__device__ __forceinline__ s16x4 vtr(lds_cptr p){ return __builtin_bit_cast(s16x4,__builtin_amdgcn_ds_read_tr16_b64_v4i16((__attribute__((address_space(3))) v4i16_t*)p)); }
__device__ __forceinline__ float rowmax(const f32x16&p0,const f32x16&p1){
  float a=max3f(p0[0],p0[1],p1[0]),b=max3f(p0[2],p0[3],p1[1]);a=max3f(a,p1[2],p1[3]);
  #pragma unroll
  for(int r=4;r<16;r+=4){a=max3f(a,p0[r],p0[r+1]);b=max3f(b,p0[r+2],p0[r+3]);a=max3f(a,p1[r],p1[r+1]);b=max3f(b,p1[r+2],p1[r+3]);}
  const float m=max2f(a,b);
  auto rr=__builtin_amdgcn_permlane32_swap(__float_as_uint(m),__float_as_uint(m),false,false);
  return max2f(__uint_as_float(rr[0]),__uint_as_float(rr[1]));
}
__device__ __forceinline__ void pv(f32x16*o,int vb,bf16x8 pa0,bf16x8 pa1,bf16x8 pa2,bf16x8 pa3){
  #pragma unroll
  for(int d0=0;d0<2;++d0){s16x4 lo[4],hi[4];
    #pragma unroll
    for(int ks=0;ks<4;++ks){
      asm volatile("ds_read_b64_tr_b16 %0,%1 offset:%c2":"=&v"(lo[ks]):"v"(vb),"i"(d0*4096+ks*1024):"memory");
      asm volatile("ds_read_b64_tr_b16 %0,%1 offset:%c2":"=&v"(hi[ks]):"v"(vb),"i"(d0*4096+ks*1024+512):"memory");}
    asm volatile("s_waitcnt lgkmcnt(0)":::"memory");SBAR();
    #define PK(k) (bf16x8){lo[k][0],lo[k][1],lo[k][2],lo[k][3],hi[k][0],hi[k][1],hi[k][2],hi[k][3]}
    o[d0]=__builtin_amdgcn_mfma_f32_32x32x16_bf16(pa0,PK(0),o[d0],0,0,0);
    o[d0]=__builtin_amdgcn_mfma_f32_32x32x16_bf16(pa1,PK(1),o[d0],0,0,0);
    o[d0]=__builtin_amdgcn_mfma_f32_32x32x16_bf16(pa2,PK(2),o[d0],0,0,0);
    o[d0]=__builtin_amdgcn_mfma_f32_32x32x16_bf16(pa3,PK(3),o[d0],0,0,0);
    #undef PK
  }
}
#define ATTN_STORE16(p,v) (*(u32x4*)(p)=(v))
template<int THRL> __device__ __forceinline__ void attn_unit(int qb,const bf16*Qh,const bf16*__restrict__ Kh,const bf16*__restrict__ Vh,bf16*Oh,char*shm){
  int tid_=threadIdx.x; asm volatile("":"+v"(tid_));
  const int tid=tid_,lane=tid&63,r32=lane&31,hi=lane>>5; const int wid=__builtin_amdgcn_readfirstlane(tid>>6);
  const int q0=qb*QB;
  const bf16*Qw=Qh+(long)(q0+wid*QBLK)*DMI;
  const unsigned lds0=(unsigned)(uintptr_t)shm;
  float*wsf=(float*)(shm+LDS_WS)+wid*64;
  const bf16*ksrc=Kh+(long)lane*DMI+wid*8;
  const bf16*vsrc=Vh+(long)(16*(wid&3)+(lane>>2))*DMI+(wid>>2)*32+(lane&3)*8;
  const unsigned kdst=lds0+LDS_K+wid*1024, vdst=lds0+LDS_V+wid*1024;
  #define DMA_K(t,slot) glds16(ksrc+(long)(t)*KVBLK*DMI,(unsigned)__builtin_amdgcn_readfirstlane(kdst+(slot)))
  #define DMA_V(t,slot) glds16(vsrc+(long)(t)*KVBLK*DMI,(unsigned)__builtin_amdgcn_readfirstlane(vdst+(slot)))
  const int vb0=(int)(lds0+LDS_V)+((lane>>4)&1)*32+(lane&3)*8+(4*hi+((lane&15)>>2))*64;
  const char*Kbase=shm+LDS_K; bf16x8 kf[8];
  const lds_cptr shm3=(lds_cptr)shm; const lds_cptr kp0=shm3+LDS_K+hi*1024+r32*16; const lds_cptr vp0=shm3+LDS_V+((lane>>4)&1)*32+(lane&3)*8+(4*hi+((lane&15)>>2))*64;
  const int NT=(q0+QB)/KVBLK;
  DMA_K(0,0);DMA_V(0,0);DMA_K(1,SLOTB);
  bf16x8 qr[4];
  #pragma unroll
  for(int d0=0;d0<4;++d0)qr[d0]=*reinterpret_cast<const bf16x8*>(&Qw[(long)r32*DMI+d0*16+hi*8]);
  float mhat=0.f,l_reg=0.f;f32x16 o[2];o[0]=f32x16{};o[1]=f32x16{};f32x16 negm=f32x16{};asm volatile("":"+v"(negm));
  const int qrel=wid*QBLK+r32;
  #define CMASK(P0,P1,t) do{int jb_=(t)-(NT-4); if(jb_>=0)cmask(P0,P1,jb_,qrel,hi);}while(0)
  bool resc=false;
  #define START(P0,P1) do{ const float rm=rowmax(P0,P1); resc=false; \
    { const float dl=rm; mhat=fadd_s(mhat,dl); \
      _Pragma("unroll") for(int r=0;r<16;++r){P0[r]=fsub_s(P0[r],dl);P1[r]=fsub_s(P1[r],dl);} \
      _Pragma("unroll") for(int r=0;r<16;++r)negm[r]=-mhat; asm volatile("":"+v"(negm)); } \
    _Pragma("unroll") for(int r=0;r<16;++r)P0[r]=__builtin_amdgcn_exp2f(P0[r]); }while(0)
  #define RESC() do{ if(resc){ asm volatile("s_waitcnt lgkmcnt(0)":::"memory"); \
      _Pragma("unroll") for(int d_=0;d_<2;++d_) _Pragma("unroll") for(int r=0;r<16;++r)o[d_][r]*=wsf[crow(r,hi)]; } }while(0)
  f32x16 pA0,pA1,pB0,pB1;
  int sl_prev=0,sl_cur=0,sl_next=SLOTB;
  #define ROT() do{sl_prev=sl_cur;sl_cur=sl_next;sl_next=(sl_next==(NSLOT-1)*SLOTB)?0:sl_next+SLOTB;}while(0)
  DMA_K(2,2*SLOTB);
  WAIT_BAR(3);
  qkt(pA0,pA1,Kbase,qr,negm,r32,hi);asm volatile("s_nop 15\n\ts_nop 7":"+v"(pA0),"+v"(pA1));CMASK(pA0,pA1,0);
  START(pA0,pA1);
  _Pragma("unroll") for(int r=0;r<16;++r)pA1[r]=__builtin_amdgcn_exp2f(pA1[r]);
  WAIT_BAR(0);
  DMA_K(3,0);DMA_V(1,SLOTB);
  ROT();
  kload8(kf,kp0+sl_cur);
  WAIT_BAR(2);
  s16x4 vlo[8],vhi[8]; u32x4 pw0,pw1,pw2,pw3;
  #define PKW(P,B) cvtpk_s(P[B],P[B+1])
  #define PAF(k) __builtin_bit_cast(bf16x8,pw##k)
  #define VFR(i) (bf16x8){vlo[i][0],vlo[i][1],vlo[i][2],vlo[i][3],vhi[i][0],vhi[i][1],vhi[i][2],vhi[i][3]}
  #define PIN(x) asm volatile("":"+v"(x))
  #define MX3(a,b,c) __builtin_fmaxf(__builtin_fmaxf((a),(b)),(c))
  #define GAPA(MF,A0,A1,A2,A3,W0,W1,PW) do{ MF; sacc+=A0; sacc+=A1; sacc+=A2; sacc+=A3; PIN(sacc); W0; W1; PIN(PW); SBAR(); }while(0)
  #define EX(v) __builtin_amdgcn_exp2f(v)
  #define GAPB(MF,X,B) do{ MF; X[B]=EX(X[B]); X[B+1]=EX(X[B+1]); X[B+2]=EX(X[B+2]); X[B+3]=EX(X[B+3]); PIN(X); SBAR(); }while(0)
  #define VRD(i) do{ vlo[i]=vtr(vp_+(((i)>>2)*4096+((i)&3)*1024)); vhi[i]=vtr(vp_+(((i)>>2)*4096+((i)&3)*1024+512)); }while(0)
  #define KRD(G,j) do{ if(G){ kload2(kf,kp0+sl_next,j); SBAR(); } }while(0)
  #define STEP(C0,C1,P0,P1,t,GK,GV,GL) do{ SBAR(); \
    const lds_cptr vp_=vp0+sl_prev; \
    VRD(0); SBAR(); float sacc=(P0[0]+P0[1]); \
    GAPA(C0=__builtin_amdgcn_mfma_f32_32x32x16_bf16(kf[0],qr[0],negm,0,0,0), P0[2],P0[3],P0[4],P0[5],     pw0[0]=PKW(P0,0), pw0[1]=PKW(P0,2), pw0); \
    VRD(4); SBAR(); GAPA(C1=__builtin_amdgcn_mfma_f32_32x32x16_bf16(kf[1],qr[0],negm,0,0,0), P0[6],P0[7],P0[8],P0[9],     pw0[2]=PKW(P0,4), pw0[3]=PKW(P0,6), pw0); \
    VRD(1); SBAR(); GAPA(C0=__builtin_amdgcn_mfma_f32_32x32x16_bf16(kf[2],qr[1],C0,0,0,0),   P0[10],P0[11],P0[12],P0[13], pw1[0]=PKW(P0,8), pw1[1]=PKW(P0,10), pw1); \
    VRD(5); SBAR(); GAPA(C1=__builtin_amdgcn_mfma_f32_32x32x16_bf16(kf[3],qr[1],C1,0,0,0),   P0[14],P0[15],P1[0],P1[1],   pw1[2]=PKW(P0,12),pw1[3]=PKW(P0,14), pw1); \
    VRD(2); SBAR(); GAPA(C0=__builtin_amdgcn_mfma_f32_32x32x16_bf16(kf[4],qr[2],C0,0,0,0),   P1[2],P1[3],P1[4],P1[5],     pw2[0]=PKW(P1,0), pw2[1]=PKW(P1,2), pw2); \
    VRD(6); SBAR(); GAPA(C1=__builtin_amdgcn_mfma_f32_32x32x16_bf16(kf[5],qr[2],C1,0,0,0),   P1[6],P1[7],P1[8],P1[9],     pw2[2]=PKW(P1,4), pw2[3]=PKW(P1,6), pw2); \
    VRD(3); SBAR(); GAPA(C0=__builtin_amdgcn_mfma_f32_32x32x16_bf16(kf[6],qr[3],C0,0,0,0),   P1[10],P1[11],P1[12],P1[13], pw3[0]=PKW(P1,8), pw3[1]=PKW(P1,10), pw3); \
    VRD(7); SBAR(); GAPA(C1=__builtin_amdgcn_mfma_f32_32x32x16_bf16(kf[7],qr[3],C1,0,0,0),   P1[14],P1[15],0.f,0.f,       pw3[2]=PKW(P1,12),pw3[3]=PKW(P1,14), pw3); \
    l_reg+=sacc; \
    if(GK){DMA_K((t)+3,sl_cur);} if(GV){DMA_V((t)+1,sl_next);} \
    CMASK(C0,C1,t); \
    { float a=MX3(C0[0],C0[1],C1[0]),b=MX3(C0[2],C0[3],C1[1]); a=MX3(a,C1[2],C1[3]); \
      _Pragma("unroll") for(int r=4;r<16;r+=4){a=MX3(a,C0[r],C0[r+1]);b=MX3(b,C0[r+2],C0[r+3]);a=MX3(a,C1[r],C1[r+1]);b=MX3(b,C1[r+2],C1[r+3]);} \
      float rm=__builtin_fmaxf(a,b); { auto rr=__builtin_amdgcn_permlane32_swap(__float_as_uint(rm),__float_as_uint(rm),false,false); rm=__builtin_fmaxf(__uint_as_float(rr[0]),__uint_as_float(rr[1])); } \
      resc=false; \
      if(__builtin_expect(__any(rm>(float)THRL),0)){ const float dl=__builtin_fmaxf(rm,0.f); mhat+=dl; \
        _Pragma("unroll") for(int r=0;r<16;++r){C0[r]-=dl;C1[r]-=dl;} \
        _Pragma("unroll") for(int r=0;r<16;++r)negm[r]=-mhat; asm volatile("":"+v"(negm)); \
        const float f=__builtin_amdgcn_exp2f(-dl); l_reg*=f; if(hi==0)wsf[r32]=f; resc=true; } } \
    SBAR(); \
    GAPB(o[0]=__builtin_amdgcn_mfma_f32_32x32x16_bf16(PAF(0),VFR(0),o[0],0,0,0), C0,0); \
    GAPB(o[1]=__builtin_amdgcn_mfma_f32_32x32x16_bf16(PAF(0),VFR(4),o[1],0,0,0), C0,4); \
    KRD(GL,0); GAPB(o[0]=__builtin_amdgcn_mfma_f32_32x32x16_bf16(PAF(1),VFR(1),o[0],0,0,0), C0,8); \
    KRD(GL,1); GAPB(o[1]=__builtin_amdgcn_mfma_f32_32x32x16_bf16(PAF(1),VFR(5),o[1],0,0,0), C0,12); \
    KRD(GL,2); GAPB(o[0]=__builtin_amdgcn_mfma_f32_32x32x16_bf16(PAF(2),VFR(2),o[0],0,0,0), C1,0); \
    KRD(GL,3); GAPB(o[1]=__builtin_amdgcn_mfma_f32_32x32x16_bf16(PAF(2),VFR(6),o[1],0,0,0), C1,4); \
    GAPB(o[0]=__builtin_amdgcn_mfma_f32_32x32x16_bf16(PAF(3),VFR(3),o[0],0,0,0), C1,8); \
    GAPB(o[1]=__builtin_amdgcn_mfma_f32_32x32x16_bf16(PAF(3),VFR(7),o[1],0,0,0), C1,12); \
    }while(0)
  int t=1;
  #undef CMASK
  #define CMASK(P0,P1,t) do{}while(0)
  for(;t+5<NT;t+=2){
    STEP(pB0,pB1,pA0,pA1,t,true,true,true);     WAIT_BAR(2); RESC(); ROT();
    STEP(pA0,pA1,pB0,pB1,t+1,true,true,true);   WAIT_BAR(2); RESC(); ROT();
  }
  #undef CMASK
  #define CMASK(P0,P1,t) do{int jb_=(t)-(NT-4); if(jb_>=0)cmask(P0,P1,jb_,qrel,hi);}while(0)
  #define ENDW(tt) do{ if((tt)+3<NT){WAIT_BAR(2);} else if((tt)+2<NT){WAIT_BAR(1);} else {WAIT_BAR(0);} }while(0)
  for(;t+1<NT;t+=2){
    STEP(pB0,pB1,pA0,pA1,t,(t+3<NT),(t+1<NT),(t+1<NT));       ENDW(t);   RESC(); ROT();
    STEP(pA0,pA1,pB0,pB1,t+1,(t+4<NT),(t+2<NT),(t+2<NT));     ENDW(t+1); RESC(); ROT();
  }
  STEP(pB0,pB1,pA0,pA1,NT-1,false,false,false); RESC();
  { float sacc=pB0[0]+pB0[1]; _Pragma("unroll") for(int r=2;r<16;++r)sacc+=pB0[r]; _Pragma("unroll") for(int r=0;r<16;++r)sacc+=pB1[r]; l_reg+=sacc;
    pw0=(u32x4){PKW(pB0,0),PKW(pB0,2),PKW(pB0,4),PKW(pB0,6)};pw1=(u32x4){PKW(pB0,8),PKW(pB0,10),PKW(pB0,12),PKW(pB0,14)};pw2=(u32x4){PKW(pB1,0),PKW(pB1,2),PKW(pB1,4),PKW(pB1,6)};pw3=(u32x4){PKW(pB1,8),PKW(pB1,10),PKW(pB1,12),PKW(pB1,14)};
    SBAR(); pv(o,vb0+sl_cur,PAF(0),PAF(1),PAF(2),PAF(3)); }
  #undef PKW
  #undef PAF
  #undef VFR
  #undef PIN
  #undef MX3
  #undef GAPA
  #undef GAPB
  #undef EX
  #undef VRD
  #undef KRD
  #undef STEP
  #undef ENDW
  {auto rr=__builtin_amdgcn_permlane32_swap(__float_as_uint(l_reg),__float_as_uint(l_reg),false,false);l_reg=__uint_as_float(rr[0])+__uint_as_float(rr[1]);}
  if(hi==0)wsf[32+r32]=l_reg;asm volatile("s_waitcnt lgkmcnt(0)":::"memory");
  float rli[16];
  #pragma unroll
  for(int r=0;r<16;++r)rli[r]=__builtin_amdgcn_rcpf(wsf[32+crow(r,hi)]);
  bf16*Ow=Oh+(long)(q0+wid*QBLK)*DMO;
  { bf16*stg=(bf16*)(shm+LDS_OST)+wid*2048;
    #pragma unroll
    for(int r=0;r<16;++r){const int orow=crow(r,hi);
      #pragma unroll
      for(int d0=0;d0<2;++d0)stg[orow*64+d0*32+r32]=__float2bfloat16(o[d0][r]*rli[r]);}
    asm volatile("s_waitcnt lgkmcnt(0)":::"memory");
    #pragma unroll
    for(int i=0;i<4;++i){const int row=i*8+(lane>>3),ch=lane&7; const u32x4 v=*(const u32x4*)(stg+row*64+ch*8); ATTN_STORE16(Ow+(long)row*DMO+ch*8,v);} }
  asm volatile("s_waitcnt lgkmcnt(0)\n\ts_barrier":::"memory");
  #undef DMA_K
  #undef DMA_V
  #undef CMASK
  #undef START
  #undef RESC
  #undef ROT
}
constexpr int LDS2_K=0, LDS2_V=4*SLOTB, LDS2_WS=LDS2_V+NSLOT*2*SLOTB, LDS2_OST=LDS2_WS+NW*64*4, LDS2_BYTES=LDS2_OST+NW*8192;
__device__ __forceinline__ void pv4(f32x16*o,int vb,bf16x8 pa0,bf16x8 pa1,bf16x8 pa2,bf16x8 pa3){
  #pragma unroll
  for(int d0=0;d0<4;++d0){s16x4 lo[4],hi[4];
    #pragma unroll
    for(int ks=0;ks<4;++ks){
      asm volatile("ds_read_b64_tr_b16 %0,%1 offset:%c2":"=&v"(lo[ks]):"v"(vb),"i"(d0*4096+ks*1024):"memory");
      asm volatile("ds_read_b64_tr_b16 %0,%1 offset:%c2":"=&v"(hi[ks]):"v"(vb),"i"(d0*4096+ks*1024+512):"memory");}
    asm volatile("s_waitcnt lgkmcnt(0)":::"memory");SBAR();
    #define PK(k) (bf16x8){lo[k][0],lo[k][1],lo[k][2],lo[k][3],hi[k][0],hi[k][1],hi[k][2],hi[k][3]}
    o[d0]=__builtin_amdgcn_mfma_f32_32x32x16_bf16(pa0,PK(0),o[d0],0,0,0);
    o[d0]=__builtin_amdgcn_mfma_f32_32x32x16_bf16(pa1,PK(1),o[d0],0,0,0);
    o[d0]=__builtin_amdgcn_mfma_f32_32x32x16_bf16(pa2,PK(2),o[d0],0,0,0);
    o[d0]=__builtin_amdgcn_mfma_f32_32x32x16_bf16(pa3,PK(3),o[d0],0,0,0);
    #undef PK
  }
}
template<int THRL> __device__ __forceinline__ void attn_unit2(int qb,const bf16*Qh,const bf16*__restrict__ Kh,const bf16*__restrict__ Vh,bf16*Oh,char*shm,const int wave){
  const int tid=wave*64+lane_id_opaque(),lane=tid&63,r32=lane&31,hi=lane>>5; const int wid=__builtin_amdgcn_readfirstlane(tid>>6);
  const int q0=qb*QB;
  const bf16*Qw=Qh+(long)(q0+wid*QBLK)*DMI;
  const unsigned lds0=(unsigned)(uintptr_t)shm;
  float*wsf=(float*)(shm+LDS2_WS)+wid*64;
  const bf16*ksrc=Kh+(long)lane*DMI+wid*8;
  const bf16*vsrc=Vh+(long)(16*(wid&3)+(lane>>2))*DMI+(wid>>2)*32+(lane&3)*8;
  const unsigned kdst=lds0+LDS2_K+wid*1024, vdst=lds0+LDS2_V+(wid>>2)*4096+(wid&3)*1024;
  #define DMA_K(t,slot) glds16(ksrc+(long)(t)*KVBLK*DMI,(unsigned)__builtin_amdgcn_readfirstlane(kdst+(slot)))
  #define DMA_V(t,slot) do{ glds16(vsrc+(long)(t)*KVBLK*DMI,(unsigned)__builtin_amdgcn_readfirstlane(vdst+2*(slot))); glds16(vsrc+(long)(t)*KVBLK*DMI+64,(unsigned)__builtin_amdgcn_readfirstlane(vdst+2*(slot)+8192)); }while(0)
  const int vb0=(int)(lds0+LDS2_V)+((lane>>4)&1)*32+(lane&3)*8+(4*hi+((lane&15)>>2))*64;
  const char*Kbase=shm+LDS2_K; bf16x8 kf[8];
  const lds_cptr shm3=(lds_cptr)shm; const lds_cptr kp0=shm3+LDS2_K+hi*1024+r32*16; const lds_cptr vp0=shm3+LDS2_V+((lane>>4)&1)*32+(lane&3)*8+(4*hi+((lane&15)>>2))*64;
  const int NT=(q0+QB)/KVBLK;
  DMA_K(0,0);DMA_V(0,0);DMA_K(1,SLOTB);DMA_K(2,2*SLOTB);
  bf16x8 qr[4];
  #pragma unroll
  for(int d0=0;d0<4;++d0)qr[d0]=*reinterpret_cast<const bf16x8*>(&Qw[(long)r32*DMI+d0*16+hi*8]);
  float zf_=0.f; asm volatile("":"+v"(zf_)); f32x16 zz_; _Pragma("unroll") for(int r=0;r<16;++r)zz_[r]=zf_;
  float mhat=0.f,l_reg=0.f;f32x16 o[4];o[0]=zz_;o[1]=zz_;o[2]=zz_;o[3]=zz_;f32x16 negm=zz_;asm volatile("":"+v"(negm));
  const int qrel=wid*QBLK+r32;
  #define CMASK(P0,P1,t) do{int jb_=(t)-(NT-4); if(jb_>=0)cmask(P0,P1,jb_,qrel,hi);}while(0)
  bool resc=false;
  #define START(P0,P1) do{ const float rm=rowmax(P0,P1); resc=false; \
    { const float dl=rm; mhat=fadd_s(mhat,dl); \
      _Pragma("unroll") for(int r=0;r<16;++r){P0[r]=fsub_s(P0[r],dl);P1[r]=fsub_s(P1[r],dl);} \
      _Pragma("unroll") for(int r=0;r<16;++r)negm[r]=-mhat; asm volatile("":"+v"(negm)); } \
    _Pragma("unroll") for(int r=0;r<16;++r)P0[r]=__builtin_amdgcn_exp2f(P0[r]); }while(0)
  #define RESC() do{ if(resc){ asm volatile("s_waitcnt lgkmcnt(0)":::"memory"); \
      _Pragma("unroll") for(int d_=0;d_<4;++d_) _Pragma("unroll") for(int r=0;r<16;++r)o[d_][r]*=wsf[crow(r,hi)]; } }while(0)
  f32x16 pA0,pA1,pB0,pB1;
  int sl_prev=0,sl_cur=0,sl_next=SLOTB;
  int kc=0,kn=SLOTB,kp=3*SLOTB;
  #define ROT() do{sl_prev=sl_cur;sl_cur=sl_next;sl_next=(sl_next==(NSLOT-1)*SLOTB)?0:sl_next+SLOTB; kp=kc;kc=kn;kn=(kn==3*SLOTB)?0:kn+SLOTB;}while(0)
  WAIT_BAR(4);
  qkt(pA0,pA1,Kbase,qr,negm,r32,hi);asm volatile("s_nop 15\n\ts_nop 7":"+v"(pA0),"+v"(pA1));CMASK(pA0,pA1,0);
  START(pA0,pA1);
  _Pragma("unroll") for(int r=0;r<16;++r)pA1[r]=__builtin_amdgcn_exp2f(pA1[r]);
  DMA_K(3,3*SLOTB);DMA_V(1,SLOTB);
  WAIT_BAR(3);
  ROT();
  kload2(kf,kp0+kc,0); kload2(kf,kp0+kc,1);
  s16x4 vlo[16],vhi[16]; u32x4 pw0,pw1,pw2,pw3;
  #define PKW(P,B) cvtpk_s(P[B],P[B+1])
  #define PAF(k) __builtin_bit_cast(bf16x8,pw##k)
  #define VFR(i) (bf16x8){vlo[i][0],vlo[i][1],vlo[i][2],vlo[i][3],vhi[i][0],vhi[i][1],vhi[i][2],vhi[i][3]}
  #define PIN(x) asm volatile("":"+v"(x))
  #define MX3(a,b,c) __builtin_fmaxf(__builtin_fmaxf((a),(b)),(c))
  #define GAPA(MF,A0,A1,A2,A3,W0,W1,PW) do{ MF; sacc+=A0; sacc+=A1; sacc+=A2; sacc+=A3; PIN(sacc); W0; W1; PIN(PW); SBAR(); }while(0)
  #define EX(v) __builtin_amdgcn_exp2f(v)
  #define GAPB(MF,X,B) do{ MF; X[B]=EX(X[B]); X[B+1]=EX(X[B+1]); PIN(X); SBAR(); }while(0)
  #define VRD(i) do{ vlo[i]=vtr(vp_+(((i)>>2)*4096+((i)&3)*1024)); vhi[i]=vtr(vp_+(((i)>>2)*4096+((i)&3)*1024+512)); }while(0)
  #define STEP(C0,C1,P0,P1,t,GK,GV,GL) do{ SBAR(); \
    const lds_cptr vp_=vp0+2*sl_prev; \
    VRD(0); SBAR(); float sacc=(P0[0]+P0[1]); \
    GAPA(C0=__builtin_amdgcn_mfma_f32_32x32x16_bf16(kf[0],qr[0],negm,0,0,0), P0[2],P0[3],P0[4],P0[5],     pw0[0]=PKW(P0,0), pw0[1]=PKW(P0,2), pw0); \
    VRD(4); kload2(kf,kp0+kc,2); SBAR(); GAPA(C1=__builtin_amdgcn_mfma_f32_32x32x16_bf16(kf[1],qr[0],negm,0,0,0), P0[6],P0[7],P0[8],P0[9],     pw0[2]=PKW(P0,4), pw0[3]=PKW(P0,6), pw0); \
    VRD(1); SBAR(); GAPA(C0=__builtin_amdgcn_mfma_f32_32x32x16_bf16(kf[2],qr[1],C0,0,0,0),   P0[10],P0[11],P0[12],P0[13], pw1[0]=PKW(P0,8), pw1[1]=PKW(P0,10), pw1); \
    VRD(5); kload2(kf,kp0+kc,3); SBAR(); GAPA(C1=__builtin_amdgcn_mfma_f32_32x32x16_bf16(kf[3],qr[1],C1,0,0,0),   P0[14],P0[15],P1[0],P1[1],   pw1[2]=PKW(P0,12),pw1[3]=PKW(P0,14), pw1); \
    VRD(2); SBAR(); GAPA(C0=__builtin_amdgcn_mfma_f32_32x32x16_bf16(kf[4],qr[2],C0,0,0,0),   P1[2],P1[3],P1[4],P1[5],     pw2[0]=PKW(P1,0), pw2[1]=PKW(P1,2), pw2); \
    VRD(6); SBAR(); GAPA(C1=__builtin_amdgcn_mfma_f32_32x32x16_bf16(kf[5],qr[2],C1,0,0,0),   P1[6],P1[7],P1[8],P1[9],     pw2[2]=PKW(P1,4), pw2[3]=PKW(P1,6), pw2); \
    VRD(3); SBAR(); GAPA(C0=__builtin_amdgcn_mfma_f32_32x32x16_bf16(kf[6],qr[3],C0,0,0,0),   P1[10],P1[11],P1[12],P1[13], pw3[0]=PKW(P1,8), pw3[1]=PKW(P1,10), pw3); \
    VRD(7); SBAR(); GAPA(C1=__builtin_amdgcn_mfma_f32_32x32x16_bf16(kf[7],qr[3],C1,0,0,0),   P1[14],P1[15],0.f,0.f,       pw3[2]=PKW(P1,12),pw3[3]=PKW(P1,14), pw3); \
    l_reg+=sacc; \
    if(GK){DMA_K((t)+3,kp);} if(GV){DMA_V((t)+1,sl_next);} \
    CMASK(C0,C1,t); \
    { float a=MX3(C0[0],C0[1],C1[0]),b=MX3(C0[2],C0[3],C1[1]); a=MX3(a,C1[2],C1[3]); \
      _Pragma("unroll") for(int r=4;r<16;r+=4){a=MX3(a,C0[r],C0[r+1]);b=MX3(b,C0[r+2],C0[r+3]);a=MX3(a,C1[r],C1[r+1]);b=MX3(b,C1[r+2],C1[r+3]);} \
      float rm=__builtin_fmaxf(a,b); { auto rr=__builtin_amdgcn_permlane32_swap(__float_as_uint(rm),__float_as_uint(rm),false,false); rm=__builtin_fmaxf(__uint_as_float(rr[0]),__uint_as_float(rr[1])); } \
      resc=false; \
      if(__builtin_expect(__any(rm>(float)THRL),0)){ const float dl=__builtin_fmaxf(rm,0.f); mhat+=dl; \
        _Pragma("unroll") for(int r=0;r<16;++r){C0[r]-=dl;C1[r]-=dl;} \
        _Pragma("unroll") for(int r=0;r<16;++r)negm[r]=-mhat; asm volatile("":"+v"(negm)); \
        const float f=__builtin_amdgcn_exp2f(-dl); l_reg*=f; if(hi==0)wsf[r32]=f; resc=true; } } \
    SBAR(); \
    VRD(8);  SBAR(); GAPB(o[0]=__builtin_amdgcn_mfma_f32_32x32x16_bf16(PAF(0),VFR(0),o[0],0,0,0), C0,0); \
    VRD(12); SBAR(); GAPB(o[1]=__builtin_amdgcn_mfma_f32_32x32x16_bf16(PAF(0),VFR(4),o[1],0,0,0), C0,2); \
    VRD(9);  SBAR(); GAPB(o[0]=__builtin_amdgcn_mfma_f32_32x32x16_bf16(PAF(1),VFR(1),o[0],0,0,0), C0,4); \
    VRD(13); SBAR(); GAPB(o[1]=__builtin_amdgcn_mfma_f32_32x32x16_bf16(PAF(1),VFR(5),o[1],0,0,0), C0,6); \
    VRD(10); SBAR(); GAPB(o[0]=__builtin_amdgcn_mfma_f32_32x32x16_bf16(PAF(2),VFR(2),o[0],0,0,0), C0,8); \
    VRD(14); SBAR(); GAPB(o[1]=__builtin_amdgcn_mfma_f32_32x32x16_bf16(PAF(2),VFR(6),o[1],0,0,0), C0,10); \
    VRD(11); SBAR(); GAPB(o[0]=__builtin_amdgcn_mfma_f32_32x32x16_bf16(PAF(3),VFR(3),o[0],0,0,0), C0,12); \
    VRD(15); SBAR(); GAPB(o[1]=__builtin_amdgcn_mfma_f32_32x32x16_bf16(PAF(3),VFR(7),o[1],0,0,0), C0,14); \
    GAPB(o[2]=__builtin_amdgcn_mfma_f32_32x32x16_bf16(PAF(0),VFR(8),o[2],0,0,0),  C1,0); \
    GAPB(o[3]=__builtin_amdgcn_mfma_f32_32x32x16_bf16(PAF(0),VFR(12),o[3],0,0,0), C1,2); \
    GAPB(o[2]=__builtin_amdgcn_mfma_f32_32x32x16_bf16(PAF(1),VFR(9),o[2],0,0,0),  C1,4); \
    GAPB(o[3]=__builtin_amdgcn_mfma_f32_32x32x16_bf16(PAF(1),VFR(13),o[3],0,0,0), C1,6); \
    GAPB(o[2]=__builtin_amdgcn_mfma_f32_32x32x16_bf16(PAF(2),VFR(10),o[2],0,0,0), C1,8); \
    GAPB(o[3]=__builtin_amdgcn_mfma_f32_32x32x16_bf16(PAF(2),VFR(14),o[3],0,0,0), C1,10); \
    GAPB(o[2]=__builtin_amdgcn_mfma_f32_32x32x16_bf16(PAF(3),VFR(11),o[2],0,0,0), C1,12); \
    GAPB(o[3]=__builtin_amdgcn_mfma_f32_32x32x16_bf16(PAF(3),VFR(15),o[3],0,0,0), C1,14); \
    if(GL){ kload2(kf,kp0+kn,0); kload2(kf,kp0+kn,1); SBAR(); } \
    }while(0)
  int t=1;
  #undef CMASK
  #define CMASK(P0,P1,t) do{}while(0)
  for(;t+5<NT;t+=2){
    STEP(pB0,pB1,pA0,pA1,t,true,true,true);     WAIT_BAR(3); RESC(); ROT();
    STEP(pA0,pA1,pB0,pB1,t+1,true,true,true);   WAIT_BAR(3); RESC(); ROT();
  }
  #undef CMASK
  #define CMASK(P0,P1,t) do{int jb_=(t)-(NT-4); if(jb_>=0)cmask(P0,P1,jb_,qrel,hi);}while(0)
  #define ENDW(tt) do{ if((tt)+3<NT){WAIT_BAR(3);} else if((tt)+2<NT){WAIT_BAR(2);} else {WAIT_BAR(0);} }while(0)
  for(;t+1<NT;t+=2){
    STEP(pB0,pB1,pA0,pA1,t,(t+3<NT),(t+1<NT),(t+1<NT));       ENDW(t);   RESC(); ROT();
    STEP(pA0,pA1,pB0,pB1,t+1,(t+4<NT),(t+2<NT),(t+2<NT));     ENDW(t+1); RESC(); ROT();
  }
  STEP(pB0,pB1,pA0,pA1,NT-1,false,false,false); RESC();
  { float sacc=pB0[0]+pB0[1]; _Pragma("unroll") for(int r=2;r<16;++r)sacc+=pB0[r]; _Pragma("unroll") for(int r=0;r<16;++r)sacc+=pB1[r]; l_reg+=sacc;
    pw0=(u32x4){PKW(pB0,0),PKW(pB0,2),PKW(pB0,4),PKW(pB0,6)};pw1=(u32x4){PKW(pB0,8),PKW(pB0,10),PKW(pB0,12),PKW(pB0,14)};pw2=(u32x4){PKW(pB1,0),PKW(pB1,2),PKW(pB1,4),PKW(pB1,6)};pw3=(u32x4){PKW(pB1,8),PKW(pB1,10),PKW(pB1,12),PKW(pB1,14)};
    SBAR(); pv4(o,vb0+2*sl_cur,PAF(0),PAF(1),PAF(2),PAF(3)); }
  #undef PKW
  #undef PAF
  #undef VFR
  #undef PIN
  #undef MX3
  #undef GAPA
  #undef GAPB
  #undef EX
  #undef VRD
  #undef STEP
  #undef ENDW
  {auto rr=__builtin_amdgcn_permlane32_swap(__float_as_uint(l_reg),__float_as_uint(l_reg),false,false);l_reg=__uint_as_float(rr[0])+__uint_as_float(rr[1]);}
  if(hi==0)wsf[32+r32]=l_reg;asm volatile("s_waitcnt lgkmcnt(0)":::"memory");
  float rli[16];
  #pragma unroll
  for(int r=0;r<16;++r)rli[r]=__builtin_amdgcn_rcpf(wsf[32+crow(r,hi)]);
  bf16*Ow=Oh+(long)(q0+wid*QBLK)*DMO;
  { bf16*stg=(bf16*)(shm+LDS2_OST)+wid*4096;
    #pragma unroll
    for(int r=0;r<16;++r){const int orow=crow(r,hi);
      #pragma unroll
      for(int d0=0;d0<4;++d0)stg[orow*128+d0*32+r32]=__float2bfloat16(o[d0][r]*rli[r]);}
    asm volatile("s_waitcnt lgkmcnt(0)":::"memory");
    #pragma unroll
    for(int i=0;i<8;++i){const int row=i*4+(lane>>4),ch=lane&15; const u32x4 v=*(const u32x4*)(stg+row*128+ch*8); ATTN_STORE16(Ow+(long)row*DMO+ch*8,v);} }
  asm volatile("s_waitcnt lgkmcnt(0)\n\ts_barrier":::"memory");
  #undef DMA_K
  #undef DMA_V
  #undef CMASK
  #undef START
  #undef RESC
  #undef ROT
}
constexpr int ATTN_LDS_BYTES=LDS_BYTES;
#undef SBAR
#undef WAIT_BAR
}

constexpr int NWAVES = 8;
constexpr int NTOK = 32768, DM = 1024, SEQ = 4096, NB = 8, NEXP = 32, TOPK = 4;
constexpr int N_PHASES = 10;
constexpr size_t MiB = 1u << 20;
constexpr size_t WS_CTL = 0, CTL_ZERO_BYTES = 32768;
constexpr size_t WS_MODP = 864 * MiB;
constexpr size_t WS_MODF = 3 * MiB;
constexpr size_t WS_LAM16 = 3 * MiB + 512 * 1024;
constexpr size_t WS_WRH = 3 * MiB + 640 * 1024, WS_WRL = 3 * MiB + 704 * 1024;
constexpr size_t WS_WIN = 4 * MiB;
constexpr size_t WS_WOUT = 8 * MiB;
constexpr size_t WS_WGLU = 10 * MiB;
constexpr size_t WS_WM = 11 * MiB;
constexpr size_t WS_TV = 15 * MiB;
constexpr size_t WS_W1T = 22 * MiB;
constexpr size_t WS_W2T = 150 * MiB;
constexpr size_t WS_H = 214 * MiB;
constexpr size_t WS_Q = 278 * MiB, WS_K = 310 * MiB, WS_V = 342 * MiB;
constexpr size_t WS_UA = 374 * MiB;
constexpr size_t WS_Z = 422 * MiB;
constexpr size_t WS_OB = 454 * MiB;
constexpr size_t WS_MIX = 518 * MiB;
constexpr size_t WS_PTOK = 582 * MiB;
constexpr size_t WS_SLOT = 586 * MiB;
constexpr size_t WS_GATE = 587 * MiB;
constexpr size_t WS_A2 = 278 * MiB;
constexpr size_t WS_Y2 = 590 * MiB;
constexpr size_t WS_X1B = 872 * MiB;
constexpr size_t WS_END = 936 * MiB;
constexpr int MAXTILES = 544;
static_assert(WS_A2 + (size_t)MAXTILES * 256 * 1024 * 2 <= WS_PTOK && WS_Y2 + (size_t)MAXTILES * 256 * 1024 * 2 <= WS_MODP, "ws map");
constexpr int CW_TMO = 0, CW_CNT = 1024  , CW_BAR = 4096;
constexpr int CW_DEP0 = 7680  , CW_DEPB = 7744  ;
constexpr int RING_OFF = 0, RING_BYTES = 131072;
constexpr int VEC_OFF = 132096;
constexpr int TILE_E_OFF = 140288;
constexpr int TILE0_OFF = 140928;
constexpr int CNTL_OFF = 141056;
constexpr int MOE_T_OFF = 141184;
constexpr int ROWTAB_OFF = 141312;
constexpr int LDSCTL_OFF = 159744, MISC_OFF = LDSCTL_OFF;
constexpr int LDS_BYTES = 163840;

typedef unsigned short bf16;
typedef unsigned v4u __attribute__((ext_vector_type(4)));
typedef unsigned v2u __attribute__((ext_vector_type(2)));
typedef float f32x4 __attribute__((ext_vector_type(4)));
typedef GAS unsigned gu32;
#define RLX_AGENT __ATOMIC_RELAXED, __HIP_MEMORY_SCOPE_AGENT
#define LDS_WAIT() asm volatile("s_waitcnt lgkmcnt(0)" ::: "memory")
#define VM_WAIT() asm volatile("s_waitcnt vmcnt(0)" ::: "memory")
__device__ __forceinline__ unsigned f2bf(float f) { unsigned u = __builtin_bit_cast(unsigned, f); return (u + 0x7fffu + ((u >> 16) & 1u)) >> 16; }
__device__ __forceinline__ unsigned pk2(float lo, float hi) { return f2bf(lo) | (f2bf(hi) << 16); }

#define XB_TMO      128
#define XB_XCNT(j)  (256  + 64 * (j))
#define XB_XSUB(j)  (1280 + 64 * (j))
#define XB_XGEN(j)  (2304 + 64 * (j))
#define XB_TOP      3328
#define XB_TOPGEN   3392
#define XCD_BAR_WORDS 3456
#define XB_SPIN_CAP (1u << 18)
__device__ __forceinline__ unsigned xb_ld(unsigned* p)              { return __hip_atomic_load(p, __ATOMIC_RELAXED, __HIP_MEMORY_SCOPE_AGENT); }
__device__ __forceinline__ unsigned xb_add(unsigned* p, unsigned v) { return __hip_atomic_fetch_add(p, v, __ATOMIC_RELAXED, __HIP_MEMORY_SCOPE_AGENT); }
__device__ __forceinline__ unsigned xb_xcc_id() { return (unsigned)__builtin_amdgcn_s_getreg((3 << 11) | 20) & 0xFu; }
#define XB_SPIN(cond, bar) do { unsigned _sp = 0; while (cond) { __builtin_amdgcn_s_sleep(1); \
    if ((++_sp & 255u) == 0u) { if (xb_ld(&(bar)[XB_TMO])) break; if (_sp > XB_SPIN_CAP) { atomicAdd(&(bar)[XB_TMO], 1u); break; } } } } while (0)
struct XcdBarrier { unsigned* bar; unsigned x; volatile LAS unsigned* st; };
__device__ __forceinline__ XcdBarrier xcd_barrier_post(unsigned* bar, volatile LAS unsigned* st) {
    XcdBarrier b; b.bar = bar; b.x = xb_xcc_id(); b.st = st;
    if (threadIdx.x == 0) (void)xb_add(&bar[XB_XCNT(b.x)], 1u);
    return b;
}
__device__ __forceinline__ void xcd_barrier_complete(unsigned* bar, unsigned x, unsigned& nloc, unsigned& nx) {
    const unsigned G = gridDim.x * gridDim.y * gridDim.z;
    unsigned sum, cnt, mine, sp = 0u;
    for (;;) {
        sum = 0u; cnt = 0u; mine = 0u;
#pragma unroll
        for (unsigned j = 0; j < 16; ++j) { const unsigned c = xb_ld(&bar[XB_XCNT(j)]); sum += c; cnt += (c > 0u) ? 1u : 0u; mine = (j == x) ? c : mine; }
        if (sum == G) break;
        __builtin_amdgcn_s_sleep(1);
        if ((++sp & 255u) == 0u) { if (xb_ld(&bar[XB_TMO])) break; if (sp > XB_SPIN_CAP) { atomicAdd(&bar[XB_TMO], 1u); break; } }
    }
    nloc = mine > 0u ? mine : 1u; nx = cnt > 0u ? cnt : 1u;
}
__device__ __forceinline__ void xcd_barrier(const XcdBarrier& b, const int wave) {
    asm volatile("s_waitcnt vmcnt(0)" ::: "memory");
    __syncthreads();
    if (wave == 0 && lane_id_opaque() == 0) {
        unsigned* bar = b.bar;
        __builtin_amdgcn_s_waitcnt(0);
        unsigned nloc = b.st[0], nx = b.st[1];
        if (nloc == 0u) { xcd_barrier_complete(bar, b.x, nloc, nx); b.st[0] = nloc; b.st[1] = nx; }
        const unsigned old = xb_add(&bar[XB_XSUB(b.x)], 1u);
        const unsigned gen = old / nloc;
        if (old + 1u == (gen + 1u) * nloc) {
            __builtin_amdgcn_fence(__ATOMIC_RELEASE, "agent");
            asm volatile("s_waitcnt vmcnt(0)" ::: "memory");
            const unsigned og = xb_add(&bar[XB_TOP], 1u);
            const unsigned tg = og / nx;
            if (og + 1u == (tg + 1u) * nx) xb_add(&bar[XB_TOPGEN], 1u);
            else XB_SPIN(xb_ld(&bar[XB_TOPGEN]) == tg, bar);
            __builtin_amdgcn_fence(__ATOMIC_ACQUIRE, "agent");
            xb_add(&bar[XB_XGEN(b.x)], 1u);
            asm volatile("s_waitcnt vmcnt(0)" ::: "memory");
        } else {
            XB_SPIN(xb_ld(&bar[XB_XGEN(b.x)]) == gen, bar);
            __builtin_amdgcn_fence(__ATOMIC_ACQUIRE, "agent");
            asm volatile("s_waitcnt vmcnt(0)" ::: "memory");
        }
    }
    __syncthreads();
}

struct Frame {
    LAS unsigned char* lds;
    gu32* ctl;
    int tid, lane, wave, vcu, G;
    float* out; unsigned char* ws;
};
typedef const float* cfptr_t;
__device__ __forceinline__ const float* inp(int i) { const __attribute__((address_space(4))) cfptr_t* kp = (const __attribute__((address_space(4))) cfptr_t*)__builtin_amdgcn_kernarg_segment_ptr(); asm volatile("" : "+s"(kp)); return kp[i]; }
__device__ __forceinline__ float wave_sum(float v) {
#pragma unroll
    for (int o = 1; o < 64; o <<= 1) v += __shfl_xor(v, o);
    return v;
}
__device__ __forceinline__ float wave_max(float v) {
#pragma unroll
    for (int o = 1; o < 64; o <<= 1) v = fmaxf(v, __shfl_xor(v, o));
    return v;
}
__device__ __forceinline__ int wave_min_i(int v) {
#pragma unroll
    for (int o = 1; o < 64; o <<= 1) { const int w = __shfl_xor(v, o); v = w < v ? w : v; }
    return v;
}

#define DPP_F(v, ctrl) __builtin_bit_cast(float, __builtin_amdgcn_update_dpp(__builtin_bit_cast(int, (v)), __builtin_bit_cast(int, (v)), (ctrl), 0xF, 0xF, false))
#define DPP_I(v, ctrl) __builtin_amdgcn_update_dpp((v), (v), (ctrl), 0xF, 0xF, false)
__device__ __forceinline__ float wave_max_u(float v) {
    v = fmaxf(v, DPP_F(v, 0xB1)); v = fmaxf(v, DPP_F(v, 0x4E)); v = fmaxf(v, DPP_F(v, 0x141)); v = fmaxf(v, DPP_F(v, 0x140));
    const int b = __builtin_bit_cast(int, v);
    return fmaxf(fmaxf(__builtin_bit_cast(float, __builtin_amdgcn_readlane(b, 15)), __builtin_bit_cast(float, __builtin_amdgcn_readlane(b, 31))), fmaxf(__builtin_bit_cast(float, __builtin_amdgcn_readlane(b, 47)), __builtin_bit_cast(float, __builtin_amdgcn_readlane(b, 63))));
}
__device__ __forceinline__ int wave_min_iu(int v) {
    int w;
    w = DPP_I(v, 0xB1); v = w < v ? w : v; w = DPP_I(v, 0x4E); v = w < v ? w : v; w = DPP_I(v, 0x141); v = w < v ? w : v; w = DPP_I(v, 0x140); v = w < v ? w : v;
    const int a = __builtin_amdgcn_readlane(v, 15), b = __builtin_amdgcn_readlane(v, 31), c = __builtin_amdgcn_readlane(v, 47), d = __builtin_amdgcn_readlane(v, 63);
    const int ab = a < b ? a : b, cd = c < d ? c : d; return ab < cd ? ab : cd;
}
__device__ __forceinline__ float wave_sum_u(float v) {
    v += DPP_F(v, 0xB1); v += DPP_F(v, 0x4E); v += DPP_F(v, 0x141); v += DPP_F(v, 0x140);
    const int b = __builtin_bit_cast(int, v);
    return (__builtin_bit_cast(float, __builtin_amdgcn_readlane(b, 15)) + __builtin_bit_cast(float, __builtin_amdgcn_readlane(b, 31))) + (__builtin_bit_cast(float, __builtin_amdgcn_readlane(b, 47)) + __builtin_bit_cast(float, __builtin_amdgcn_readlane(b, 63)));
}
struct TrItem { const float* W; bf16* WT; int ldw, ldt; };
__device__ __forceinline__ void tr_dma(const TrItem& d, LAS float* buf, int lane) {
    const int kr = lane >> 3, q = lane & 7;
#pragma unroll
    for (int i = 0; i < 8; ++i) __builtin_amdgcn_global_load_lds((const unsigned*)(d.W + (size_t)(8 * i + kr) * d.ldw + 4 * ((q - i) & 7)), (LAS unsigned*)(buf + i * 256), 16, 0, 2);
}
__device__ __forceinline__ void tr_out(const TrItem& d, const LAS float* buf, int lane) {
    const int c = lane & 7;
#pragma unroll
    for (int j = 0; j < 4; ++j) { const int n = (lane >> 3) + 8 * j; const LAS float* s = buf + (8 * c) * 32 + 4 * (((n >> 2) + c) & 7) + (n & 3);
        if (d.ldt < 0) { const f32x4 a = (f32x4){s[0 * 32], s[1 * 32], s[2 * 32], s[3 * 32]} * pg8::F8_W, e = (f32x4){s[4 * 32], s[5 * 32], s[6 * 32], s[7 * 32]} * pg8::F8_W;
            __builtin_nontemporal_store(pg8::pack8_fp8(a, e), (pg8::i32x2*)((unsigned char*)d.WT + (size_t)n * (size_t)(-d.ldt) + 8 * c)); }
        else { v4u o; o.x = pg8::cvt_pk_bf16(s[0 * 32], s[1 * 32]); o.y = pg8::cvt_pk_bf16(s[2 * 32], s[3 * 32]); o.z = pg8::cvt_pk_bf16(s[4 * 32], s[5 * 32]); o.w = pg8::cvt_pk_bf16(s[6 * 32], s[7 * 32]);
            *(GAS v4u*)(d.WT + (size_t)n * d.ldt + 8 * c) = o; } }
}
__device__ __forceinline__ void dsincos(double x, double& s, double& c) {
    const double k = rint(x * 0.63661977236758134308);
    double r = fma(-k, 1.57079632673412561417e+00, x); r = fma(-k, 6.07710050650619224932e-11, r);
    const int q = ((int)k) & 3; const double r2 = r * r;
    const double sp = r + r * r2 * (-1.66666666666666324348e-01 + r2 * (8.33333333332248946124e-03 + r2 * (-1.98412698298579493134e-04 + r2 * (2.75573137070700676789e-06 + r2 * (-2.50507602534068634195e-08 + r2 * 1.58969099521155010221e-10)))));
    const double cp = 1.0 - 0.5 * r2 + r2 * r2 * (4.16666666666666019037e-02 + r2 * (-1.38888888888741095749e-03 + r2 * (2.48015872894767294178e-05 + r2 * (-2.75573143513906633035e-07 + r2 * (2.08757232129817482790e-09 + r2 * -1.13596475577881948265e-11)))));
    s = (q == 0) ? sp : (q == 1) ? cp : (q == 2) ? -sp : -cp;
    c = (q == 0) ? cp : (q == 1) ? -sp : (q == 2) ? -cp : sp;
}
__device__ __forceinline__ double dexp(double x) {
    const double k = rint(x * 1.44269504088896340736); const double r = fma(-k, 6.93147180369123816490e-01, x) - k * 1.90821492927058770002e-10;
    double p = 1.0 / 6227020800.0;
    p = p * r + 1.0 / 479001600.0; p = p * r + 1.0 / 39916800.0; p = p * r + 1.0 / 3628800.0; p = p * r + 1.0 / 362880.0; p = p * r + 1.0 / 40320.0; p = p * r + 1.0 / 5040.0;
    p = p * r + 1.0 / 720.0; p = p * r + 1.0 / 120.0; p = p * r + 1.0 / 24.0; p = p * r + 1.0 / 6.0; p = p * r + 0.5; p = p * r + 1.0; p = p * r + 1.0;
    return ldexp(p, (int)k);
}
__device__ __forceinline__ void ssm_tables_item(Frame& F, int g, int r) {
    LAS float* pwr = (LAS float*)(F.lds); LAS float* pwi = pwr + 17 * 64;
    LAS float* ccr = pwi + 17 * 64; LAS float* cci = ccr + 1040;
    LAS float* bbr = cci + 1040; LAS float* bbi = bbr + 1024;
    LAS float* kt = bbi + 1024;
    LAS double* lb1 = (LAS double*)(kt + 4096);
    const float* a_re = inp(11); const float* a_im = inp(12); const float* log_dt = inp(13);
    const float* b_re = inp(14); const float* b_im = inp(15); const float* c_re = inp(16); const float* c_im = inp(17); const float* dsk = inp(18);
    const int tid = F.tid;
    const double dtv = dexp((double)log_dt[g]);
    for (int idx = tid; idx < 17 * 64; idx += 512) { const int t = idx >> 6, p = idx & 63;
        const double re = fmin((double)a_re[g * 64 + p], -1e-4), im = (double)a_im[g * 64 + p];
        const double mag = dexp(re * dtv * (double)t); double s, c; dsincos(im * dtv * (double)t, s, c);
        pwr[idx] = (float)(mag * c); pwi[idx] = (float)(mag * s); if (t == 1) { lb1[2 * p] = mag * c - 1.0; lb1[2 * p + 1] = mag * s; } }
    for (int idx = tid; idx < 1024; idx += 512) { const int c = idx >> 6, p = idx & 63; ccr[c * 65 + p] = c_re[(g * 16 + c) * 64 + p]; cci[c * 65 + p] = c_im[(g * 16 + c) * 64 + p]; }
    __syncthreads();
    for (int idx = tid; idx < 1024; idx += 512) { const int p = idx >> 4, c1 = idx & 15;
        const double re = fmin((double)a_re[g * 64 + p], -1e-4), im = (double)a_im[g * 64 + p];
        const double nr = lb1[2 * p], ni = lb1[2 * p + 1], den = re * re + im * im;
        const double qr = (nr * re + ni * im) / den, qi = (ni * re - nr * im) / den;
        const double br = (double)b_re[(g * 64 + p) * 16 + c1], bi = (double)b_im[(g * 64 + p) * 16 + c1];
        bbr[idx] = (float)(qr * br - qi * bi); bbi[idx] = (float)(qr * bi + qi * br); }
    __syncthreads();
    { const int t = tid >> 5, c = (tid >> 1) & 15, h8 = (tid & 1) * 8; float acc[8];
#pragma unroll
      for (int q = 0; q < 8; ++q) acc[q] = 0.f;
      for (int p = 0; p < 64; ++p) { const float cr = ccr[c * 65 + p], ci = cci[c * 65 + p], pr = pwr[t * 64 + p], pi = pwi[t * 64 + p]; const float mr = cr * pr - ci * pi, mi = cr * pi + ci * pr;
          const f32x4 r0 = *(const LAS f32x4*)(bbr + p * 16 + h8), r1 = *(const LAS f32x4*)(bbr + p * 16 + h8 + 4), i0 = *(const LAS f32x4*)(bbi + p * 16 + h8), i1 = *(const LAS f32x4*)(bbi + p * 16 + h8 + 4);
          acc[0] += mr * r0.x - mi * i0.x; acc[1] += mr * r0.y - mi * i0.y; acc[2] += mr * r0.z - mi * i0.z; acc[3] += mr * r0.w - mi * i0.w;
          acc[4] += mr * r1.x - mi * i1.x; acc[5] += mr * r1.y - mi * i1.y; acc[6] += mr * r1.z - mi * i1.z; acc[7] += mr * r1.w - mi * i1.w; }
#pragma unroll
      for (int q = 0; q < 8; ++q) kt[(t * 16 + c) * 16 + h8 + q] = acc[q]; }
    __syncthreads();
    bf16* TV = (bf16*)(F.ws + WS_TV) + (size_t)g * 256 * 384; bf16* WM = (bf16*)(F.ws + WS_WM) + (size_t)g * 256 * 256;
    for (int idx = tid; idx < 32 * 192; idx += 512) { const int row = 32 * r + idx / 192, col = 2 * (idx % 192), s = row >> 4, c = row & 15; float v[2];
#pragma unroll
        for (int q = 0; q < 2; ++q) { const int cq = col + q;
            if (cq < 256) { const int j = cq >> 4, c1 = cq & 15; v[q] = (j <= s) ? kt[((s - j) * 16 + c) * 16 + c1] : 0.f; if (j == s && c == c1) v[q] += dsk[g * 16 + c]; }
            else { const int p = (cq - 256) & 63; const float cr = ccr[c * 65 + p], ci = cci[c * 65 + p], pr = pwr[(s + 1) * 64 + p], pi = pwi[(s + 1) * 64 + p];
                v[q] = (cq < 320) ? (cr * pr - ci * pi) : -(cr * pi + ci * pr); } }
        *(unsigned*)(TV + (size_t)row * 384 + col) = pk2(v[0], v[1]); }
    for (int idx = tid; idx < 16 * 128; idx += 512) { const int row = 16 * r + (idx >> 7), col = 2 * (idx & 127), p = row & 63, ri = row >> 6, j = col >> 4, c1 = col & 15;
        const float pr = pwr[(15 - j) * 64 + p], pi = pwi[(15 - j) * 64 + p]; float v[2];
#pragma unroll
        for (int q = 0; q < 2; ++q) { const float br = bbr[p * 16 + c1 + q], bi = bbi[p * 16 + c1 + q]; v[q] = ri == 0 ? (pr * br - pi * bi) : (pr * bi + pi * br); }
        *(unsigned*)(WM + (size_t)row * 256 + col) = pk2(v[0], v[1]); *(unsigned*)(WM + (size_t)(128 + row) * 256 + col) = 0u; }
    if (r == 0 && tid < 64) { float* L16 = (float*)(F.ws + WS_LAM16) + (g * 64 + tid) * 2; L16[0] = pwr[16 * 64 + tid]; L16[1] = pwi[16 * 64 + tid]; }
    __syncthreads();
}
constexpr int MOD_NKS = 32;
__device__ __forceinline__ void modp_item(Frame& F, int it) {
    const int ng = it % 6, ks = it / 6, tid = F.tid;
    LAS float* cact = (LAS float*)F.lds;
    LAS f32x4* red = (LAS f32x4*)(cact + 256);
    const float* cin = inp(1); const float* w = inp(2);
    if (tid < 256) { const int b = tid >> 5, kk = tid & 31; const float c = cin[b * 1024 + ks * 32 + kk]; cact[tid] = c / (1.0f + __expf(-c)); }
    __syncthreads();
    const int c4 = tid & 255, kq = tid >> 8, col = ng * 1024 + 4 * c4; f32x4 wv[16], acc[8];
#pragma unroll
    for (int i = 0; i < 16; ++i) wv[i] = *(const GAS f32x4*)(w + (size_t)(ks * 32 + kq * 16 + i) * 6144 + col);
#pragma unroll
    for (int b = 0; b < 8; ++b) { acc[b] = (f32x4){0.f, 0.f, 0.f, 0.f};
#pragma unroll
        for (int i = 0; i < 16; ++i) acc[b] += wv[i] * cact[b * 32 + kq * 16 + i]; }
    if (kq == 1) {
#pragma unroll
        for (int b = 0; b < 8; ++b) red[b * 256 + c4] = acc[b]; }
    __syncthreads();
    if (kq == 0) { float* mp = (float*)(F.ws + WS_MODP);
#pragma unroll
        for (int b = 0; b < 8; ++b) *(GAS f32x4*)(mp + (size_t)(ks * 8 + b) * 6144 + col) = acc[b] + red[b * 256 + c4]; }
    __syncthreads();
}
__device__ __forceinline__ float mod_value(Frame& F, const float* b_ada, int b, int n) {
    const float* mp = (const float*)(F.ws + WS_MODP); float v = b_ada[n];
    float t[MOD_NKS];
#pragma unroll
    for (int ks = 0; ks < MOD_NKS; ++ks) t[ks] = mp[(size_t)(ks * 8 + b) * 6144 + n];
#pragma unroll
    for (int ks = 0; ks < MOD_NKS; ++ks) v += t[ks];
    return v;
}
#ifndef TR_HOSTED
#define TR_HOSTED 32768
#endif
constexpr int TR_I_W1 = 32 * 16 * 64, TR_I_W2 = 32 * 16 * 32, TR_I_IN = 16 * 64, TR_I_OUT = 16 * 32, TR_I_GLU = 8 * 16, TR_NITEMS = TR_I_W1 + TR_I_W2 + TR_I_IN + TR_I_OUT + TR_I_GLU;
__device__ __forceinline__ void tr_run(Frame& F, const int lo, const int hi, const int gw, const int NGW) {
    LAS float* scr = (LAS float*)(F.lds + RING_OFF + F.wave * 16384);
    constexpr int I_W1 = TR_I_W1, I_W2 = TR_I_W2, I_IN = TR_I_IN, I_OUT = TR_I_OUT;
    const int NITEMS = hi;
    const float* w1p = inp(25); const float* w2p = inp(27); const float* winp = inp(5); const float* woutp = inp(21); const float* wglup = inp(19);
    bf16* w1t = (bf16*)(F.ws + WS_W1T); bf16* w2t = (bf16*)(F.ws + WS_W2T); bf16* wint = (bf16*)(F.ws + WS_WIN); bf16* woutt = (bf16*)(F.ws + WS_WOUT); bf16* wglut = (bf16*)(F.ws + WS_WGLU);
#define TR_DESC(d, item) do { int r = (item); \
        if (r < I_W1) { const int e = r >> 10, rr = r & 1023, kb = rr >> 6, nb = rr & 63, n0 = 32 * nb, bj = n0 >> 10, rem = n0 & 1023, pn = rem >> 7, jj = rem & 127; \
            d.W = w1p + (size_t)e * 1024 * 2048 + (size_t)(64 * kb) * 2048 + n0; d.WT = (bf16*)((unsigned char*)w1t + (size_t)e * 2048 * 1024 + (size_t)(pn * 256 + bj * 128 + jj) * 1024 + 64 * kb); d.ldw = 2048; d.ldt = -1024; } \
        else if ((r -= I_W1) < I_W2) { const int e = r >> 9, rr = r & 511, kb = rr >> 5, nb = rr & 31; \
            d.W = w2p + (size_t)e * 1024 * 1024 + (size_t)(64 * kb) * 1024 + 32 * nb; d.WT = (bf16*)((unsigned char*)w2t + (size_t)e * 1024 * 1024 + (size_t)(32 * nb) * 1024 + 64 * kb); d.ldw = 1024; d.ldt = -1024; } \
        else if ((r -= I_W2) < I_IN) { const int kb = r >> 6, nb = r & 63; d.W = winp + (size_t)(64 * kb) * 2048 + 32 * nb; d.WT = wint + (size_t)(32 * nb) * 1024 + 64 * kb; d.ldw = 2048; d.ldt = 1024; } \
        else if ((r -= I_IN) < I_OUT) { const int kb = r >> 5, nb = r & 31; d.W = woutp + (size_t)(64 * kb) * 1024 + 32 * nb; d.WT = (bf16*)((unsigned char*)woutt + (size_t)(32 * nb) * 1024 + 64 * kb); d.ldw = 1024; d.ldt = -1024; } \
        else { r -= I_OUT; const int kb = r >> 4, nb = r & 15; d.W = wglup + (size_t)(64 * kb) * 512 + 32 * nb; d.WT = wglut + (size_t)(32 * nb) * 512 + 64 * kb; d.ldw = 512; d.ldt = 512; } } while (0)
    { TrItem dc, dn; int it = lo + gw, par = 0;
      if (it < NITEMS) { TR_DESC(dc, it); tr_dma(dc, scr, F.lane); }
      while (it < NITEMS) { const int nx = it + NGW;
          if (nx < NITEMS) { TR_DESC(dn, nx); tr_dma(dn, scr + (par ^ 1) * 2048, F.lane); asm volatile("s_waitcnt vmcnt(8)" ::: "memory"); }
          else { asm volatile("s_waitcnt vmcnt(0)" ::: "memory"); }
          tr_out(dc, scr + par * 2048, F.lane);
          LDS_WAIT(); asm volatile("" ::: "memory");
          dc = dn; it = nx; par ^= 1; }
      asm volatile("s_waitcnt vmcnt(0)" ::: "memory"); }
}
__device__ __forceinline__ void trq_load(v4u (&r)[8], const TrItem& d, int lane) {
    const int kr = lane >> 3, q = lane & 7;
#pragma unroll
    for (int i = 0; i < 8; ++i) { const float* p = d.W + (size_t)(8 * i) * d.ldw; const unsigned voff = (unsigned)(kr * d.ldw + 4 * ((q - i) & 7)) * 4u;
        asm volatile("global_load_dwordx4 %0, %1, %2 nt" : "=v"(r[i]) : "v"(voff), "s"(p) : "memory"); }
}
__device__ __forceinline__ void tr_run_deep(Frame& F, const int lo, const int hi, const int gw, const int NGW) {
    LAS float* scr = (LAS float*)(F.lds + RING_OFF + F.wave * 16384);
    constexpr int I_W1 = TR_I_W1, I_W2 = TR_I_W2, I_IN = TR_I_IN, I_OUT = TR_I_OUT;
    const float* w1p = inp(25); const float* w2p = inp(27); const float* winp = inp(5); const float* woutp = inp(21); const float* wglup = inp(19);
    bf16* w1t = (bf16*)(F.ws + WS_W1T); bf16* w2t = (bf16*)(F.ws + WS_W2T); bf16* wint = (bf16*)(F.ws + WS_WIN); bf16* woutt = (bf16*)(F.ws + WS_WOUT); bf16* wglut = (bf16*)(F.ws + WS_WGLU);
    if (lo + gw >= hi) return;
    const int n_it = (hi - lo - gw + NGW - 1) / NGW;
#define TRQ_DESC(d, j) do { const int jc_ = (j) < n_it ? (j) : n_it - 1; TR_DESC(d, lo + gw + jc_ * NGW); } while (0)
#define TRQ_STEP(r, d, j, par) do { \
        asm volatile("s_waitcnt vmcnt(16)" : "+v"(r[0]), "+v"(r[1]), "+v"(r[2]), "+v"(r[3]), "+v"(r[4]), "+v"(r[5]), "+v"(r[6]), "+v"(r[7]) :: "memory"); \
        LAS float* buf_ = scr + (par) * 2048; const bool live_ = (j) < n_it; \
        if (live_) { _Pragma("unroll") for (int i_ = 0; i_ < 8; ++i_) *(LAS v4u*)(buf_ + i_ * 256 + F.lane * 4) = r[i_]; } \
        LDS_WAIT(); TrItem dn_; TRQ_DESC(dn_, (j) + 3); trq_load(r, dn_, F.lane); \
        if (live_) tr_out(d, buf_, F.lane); \
        d = dn_; } while (0)
    v4u r0[8], r1[8], r2[8]; TrItem d0, d1, d2;
    TRQ_DESC(d0, 0); trq_load(r0, d0, F.lane); TRQ_DESC(d1, 1); trq_load(r1, d1, F.lane); TRQ_DESC(d2, 2); trq_load(r2, d2, F.lane);
    for (int j = 0; j < n_it; j += 6) {
        TRQ_STEP(r0, d0, j, 0); TRQ_STEP(r1, d1, j + 1, 1); TRQ_STEP(r2, d2, j + 2, 0);
        TRQ_STEP(r0, d0, j + 3, 1); TRQ_STEP(r1, d1, j + 4, 0); TRQ_STEP(r2, d2, j + 5, 1); }
    asm volatile("s_waitcnt vmcnt(0)" : "+v"(r0[0]), "+v"(r0[1]), "+v"(r0[2]), "+v"(r0[3]), "+v"(r0[4]), "+v"(r0[5]), "+v"(r0[6]), "+v"(r0[7]) :: "memory");
    asm volatile("" : "+v"(r1[0]), "+v"(r1[1]), "+v"(r1[2]), "+v"(r1[3]), "+v"(r1[4]), "+v"(r1[5]), "+v"(r1[6]), "+v"(r1[7]) :: "memory");
    asm volatile("" : "+v"(r2[0]), "+v"(r2[1]), "+v"(r2[2]), "+v"(r2[3]), "+v"(r2[4]), "+v"(r2[5]), "+v"(r2[6]), "+v"(r2[7]) :: "memory");
#undef TRQ_STEP
#undef TRQ_DESC
}
#undef TR_DESC
__device__ __forceinline__ void dep_signal(Frame& F, int word);
__device__ __forceinline__ void p0_prologue(Frame& F, int mode = 0) {
    { const float* wr = inp(23); bf16* wh = (bf16*)(F.ws + WS_WRH); bf16* wl = (bf16*)(F.ws + WS_WRL);
      for (int idx = F.vcu * 512 + F.tid; idx < 32768; idx += F.G * 512) { const int k = idx >> 5, e = idx & 31; const float w = wr[idx]; const unsigned hi = f2bf(w);
          wh[e * 1024 + k] = (bf16)hi; wl[e * 1024 + k] = (bf16)f2bf(w - __builtin_bit_cast(float, hi << 16)); } }
    const bool tab_last = (mode == 0) && !(F.vcu & 1);
    if (mode != 2 && mode != 4 && !tab_last) { for (int it = F.vcu; it < 256; it += F.G) ssm_tables_item(F, it >> 3, it & 7); }
    if (mode != 2 && mode != 3) { for (int it = F.vcu; it < 192; it += F.G) modp_item(F, it); }
    if (mode == 0) dep_signal(F, CW_DEP0);
    if (mode == 1 || mode == 3 || mode == 4) return;
    if (F.G == 256) tr_run(F, TR_HOSTED, TR_NITEMS, F.vcu * NWAVES + F.wave, F.G * NWAVES);
    else tr_run(F, 0, TR_NITEMS, F.vcu * NWAVES + F.wave, F.G * NWAVES);
    if (tab_last) { LDS_WAIT(); __syncthreads(); for (int it = F.vcu; it < 256; it += F.G) ssm_tables_item(F, it >> 3, it & 7); }
}
__device__ __forceinline__ void p1_h1(Frame& F) {
    const int bx = blockIdx.x, rows_per = NTOK / F.G, row_base = bx * rows_per, b = row_base >> 12;
    LAS float* vec = (LAS float*)(F.lds + VEC_OFF);
    const float* b_ada = inp(3); const float* n1g = inp(4); const float* xin = inp(0);
    for (int n = F.tid; n < 2048; n += 512) { float v = mod_value(F, b_ada, b, n); if (n >= 1024) v = (1.0f + v) * n1g[n - 1024]; vec[n] = v; }
    { const int per = (NB * 6144) / F.G; float* mf = (float*)(F.ws + WS_MODF);
      for (int i = F.tid; i < per; i += 512) { const int idx = bx * per + i; mf[idx] = mod_value(F, b_ada, idx / 6144, idx % 6144); } }
    __syncthreads();
    bf16* H = (bf16*)(F.ws + WS_H);
    for (int r = F.wave; r < rows_per; r += NWAVES) { const size_t row = (size_t)(row_base + r);
        const GAS f32x4* xr = (const GAS f32x4*)(xin + row * DM) + F.lane; f32x4 v[4]; float s = 0.f;
#pragma unroll
        for (int j = 0; j < 4; ++j) { v[j] = __builtin_nontemporal_load((const f32x4*)(xr + 64 * j)); s += (v[j].x * v[j].x + v[j].y * v[j].y) + (v[j].z * v[j].z + v[j].w * v[j].w); }
        const float rs = 1.0f / sqrtf(wave_sum_u(s) * (1.f / DM) + 1e-6f);
        GAS v2u* o8 = (GAS v2u*)(H + row * DM) + F.lane;
#pragma unroll
        for (int j = 0; j < 4; ++j) { const int c = 256 * j + 4 * F.lane; const f32x4 sh = *(LAS f32x4*)(vec + c), sc = *(LAS f32x4*)(vec + 1024 + c); const f32x4 h = v[j] * rs * sc + sh;
            v2u w; w.x = pk2(h.x, h.y); w.y = pk2(h.z, h.w); o8[64 * j] = w; } }
}
__device__ __forceinline__ void p4_combine(Frame& F) {
    const float lam = __expf(wave_sum(inp(6)[F.lane] * inp(7)[F.lane])) - __expf(wave_sum(inp(8)[F.lane] * inp(9)[F.lane])) + 0.2f;
    const bf16* OB = (const bf16*)(F.ws + WS_OB); bf16* MIX = (bf16*)(F.ws + WS_MIX);
    const int h = F.lane >> 4, d0 = (F.lane & 15) * 8; const float* sg = inp(10) + d0;
    float gs[8];
#pragma unroll
    for (int j = 0; j < 8; ++j) gs[j] = sg[j] * 0.8f;
    const int gw = F.vcu * NWAVES + F.wave, NGW = F.G * NWAVES;
    for (int tok = gw; tok < NTOK; tok += NGW) {
        const v4u a0 = *(const GAS v4u*)(OB + (size_t)tok * 1024 + (h * 2) * 128 + d0), a1 = *(const GAS v4u*)(OB + (size_t)tok * 1024 + (h * 2 + 1) * 128 + d0);
        float a[8];
        a[0] = pg8::bf_lo(a0.x) - lam * pg8::bf_lo(a1.x); a[1] = pg8::bf_hi(a0.x) - lam * pg8::bf_hi(a1.x); a[2] = pg8::bf_lo(a0.y) - lam * pg8::bf_lo(a1.y); a[3] = pg8::bf_hi(a0.y) - lam * pg8::bf_hi(a1.y);
        a[4] = pg8::bf_lo(a0.z) - lam * pg8::bf_lo(a1.z); a[5] = pg8::bf_hi(a0.z) - lam * pg8::bf_hi(a1.z); a[6] = pg8::bf_lo(a0.w) - lam * pg8::bf_lo(a1.w); a[7] = pg8::bf_hi(a0.w) - lam * pg8::bf_hi(a1.w);
        float ss = 0.f;
#pragma unroll
        for (int j = 0; j < 8; ++j) ss += a[j] * a[j];
        ss += __shfl_xor(ss, 1); ss += __shfl_xor(ss, 2); ss += __shfl_xor(ss, 4); ss += __shfl_xor(ss, 8);
        const float rs = 1.0f / sqrtf(ss * (1.f / 128.f) + 1e-6f);
        v4u o; o.x = pk2(a[0] * rs * gs[0], a[1] * rs * gs[1]); o.y = pk2(a[2] * rs * gs[2], a[3] * rs * gs[3]); o.z = pk2(a[4] * rs * gs[4], a[5] * rs * gs[5]); o.w = pk2(a[6] * rs * gs[6], a[7] * rs * gs[7]);
        *(GAS v4u*)(MIX + (size_t)tok * 1024 + h * 128 + d0) = o;
    }
}
constexpr int WRB = 2064;
constexpr int SEL_OFF = 140288;
static_assert(4 * 16 * WRB <= VEC_OFF, "router weights in LDS");
__device__ __forceinline__ void ins4(float v, int i, float (&tv)[4], int (&ti)[4]) {
#pragma unroll
    for (int k = 0; k < 4; ++k) { const bool better = v > tv[k] || (v == tv[k] && i < ti[k]); const float ov = tv[k]; const int oi = ti[k]; tv[k] = better ? v : ov; ti[k] = better ? i : oi; v = better ? ov : v; i = better ? oi : i; }
}
__device__ __forceinline__ void p6_fill(Frame& F) {
    const int bx = blockIdx.x, rows_per = NTOK / F.G, row_base = bx * rows_per, b = row_base >> 12;
    LAS float* vec = (LAS float*)(F.lds + VEC_OFF);
    LAS unsigned* hist = (LAS unsigned*)(F.lds + SEL_OFF) + 1536;
    const float* n2g = inp(22); const float* mf = (const float*)(F.ws + WS_MODF) + (size_t)b * 6144;
    __syncthreads();
    { const unsigned char* wsrc = F.ws + WS_WRH;
      for (int c = F.tid; c < 8192; c += 512) { const int row = c >> 7, col = c & 127; *(LAS v4u*)(F.lds + RING_OFF + row * WRB + col * 16) = *(const GAS v4u*)(wsrc + (size_t)row * 2048 + col * 16); } }
    for (int n = F.tid; n < 1024; n += 512) { vec[n] = mf[3072 + n]; vec[1024 + n] = (1.0f + mf[4096 + n]) * n2g[n]; }
    if (F.tid < 32) hist[F.tid] = 0u;
    __syncthreads();
}
__device__ __forceinline__ void p6_router(Frame& F, bool dummy = false, bool filled = false) {
    const int bx = blockIdx.x, rows_per = NTOK / F.G, row_base = bx * rows_per;
    LAS float* vec = (LAS float*)(F.lds + VEC_OFF);
    LAS unsigned* sel_e = (LAS unsigned*)(F.lds + SEL_OFF); LAS unsigned* sel_r = sel_e + 512; LAS float* sel_g = (LAS float*)(sel_r + 512); LAS unsigned* hist = (LAS unsigned*)(sel_g + 512); LAS unsigned* base = hist + 32;
    if (!filled) p6_fill(F);
    unsigned char* H = (unsigned char*)(F.ws + WS_H); const bf16* X1 = (const bf16*)(F.ws + WS_X1B);
    int* ptok = (int*)(F.ws + (dummy ? WS_Q : WS_PTOK)); unsigned* slot = (unsigned*)(F.ws + (dummy ? WS_Q + 8 * MiB : WS_SLOT)); float* gate = (float*)(F.ws + (dummy ? WS_Q + 16 * MiB : WS_GATE));
    const int cwc = dummy ? CW_CNT + 2048 : CW_CNT;
    const int t = F.lane & 15, kg = F.lane >> 4;
    for (int r0 = 16 * F.wave; r0 < rows_per; r0 += 16 * NWAVES) { const int tok = row_base + r0 + t;
        const GAS v4u* xp = (const GAS v4u*)(X1 + (size_t)tok * DM + 8 * kg);
        v4u xr[32]; float ss = 0.f;
#pragma unroll
        for (int s = 0; s < 32; ++s) xr[s] = xp[4 * s];
#pragma unroll
        for (int s = 0; s < 32; ++s) { const float x0 = pg8::bf_lo(xr[s].x), x1 = pg8::bf_hi(xr[s].x), x2 = pg8::bf_lo(xr[s].y), x3 = pg8::bf_hi(xr[s].y), x4 = pg8::bf_lo(xr[s].z), x5 = pg8::bf_hi(xr[s].z), x6 = pg8::bf_lo(xr[s].w), x7 = pg8::bf_hi(xr[s].w);
            ss += ((x0 * x0 + x1 * x1) + (x2 * x2 + x3 * x3)) + ((x4 * x4 + x5 * x5) + (x6 * x6 + x7 * x7)); }
        ss += __shfl_xor(ss, 16); ss += __shfl_xor(ss, 32);
        const float rs = 1.0f / sqrtf(ss * (1.f / DM) + 1e-6f);
        f32x4 acc0 = {0.f, 0.f, 0.f, 0.f}, acc1 = {0.f, 0.f, 0.f, 0.f};
        GAS unsigned char* hp = (GAS unsigned char*)(H + (size_t)tok * DM + 8 * kg);
        const LAS unsigned char* wa = F.lds + RING_OFF + t * WRB + 16 * kg;
        const LAS float* vp = vec + 8 * kg;
#pragma unroll
        for (int s = 0; s < 32; ++s) {
            const f32x4 sh0 = *(const LAS f32x4*)(vp), sh1 = *(const LAS f32x4*)(vp + 4), sc0 = *(const LAS f32x4*)(vp + 1024), sc1 = *(const LAS f32x4*)(vp + 1024 + 4);
            v4u xs = xr[s]; asm volatile("" : "+v"(xs));
            const f32x4 xa = {pg8::bf_lo(xs.x), pg8::bf_hi(xs.x), pg8::bf_lo(xs.y), pg8::bf_hi(xs.y)}, xb = {pg8::bf_lo(xs.z), pg8::bf_hi(xs.z), pg8::bf_lo(xs.w), pg8::bf_hi(xs.w)};
            const f32x4 h0 = xa * rs * sc0 + sh0, h1 = xb * rs * sc1 + sh1;
            const pg8::u32x4 bh = pg8::pack8(h0, h1);
            const f32x4 d0 = h0 - (f32x4){pg8::bf_lo(bh.x), pg8::bf_hi(bh.x), pg8::bf_lo(bh.y), pg8::bf_hi(bh.y)}, d1 = h1 - (f32x4){pg8::bf_lo(bh.z), pg8::bf_hi(bh.z), pg8::bf_lo(bh.w), pg8::bf_hi(bh.w)};
            const pg8::u32x4 bl = pg8::pack8(d0, d1);
            *(GAS pg8::i32x2*)(hp + 32 * s) = pg8::pack8_fp8(h0 * pg8::F8_ACT, h1 * pg8::F8_ACT);
            const pg8::bf16x8 Bh = __builtin_bit_cast(pg8::bf16x8, bh), Bl = __builtin_bit_cast(pg8::bf16x8, bl);
            const pg8::bf16x8 Ah0 = *(const LAS pg8::bf16x8*)(wa), Ah1 = *(const LAS pg8::bf16x8*)(wa + 16 * WRB), Al0 = *(const LAS pg8::bf16x8*)(wa + 32 * WRB), Al1 = *(const LAS pg8::bf16x8*)(wa + 48 * WRB);
            acc0 = __builtin_amdgcn_mfma_f32_16x16x32_bf16(Ah0, Bh, acc0, 0, 0, 0); acc1 = __builtin_amdgcn_mfma_f32_16x16x32_bf16(Ah1, Bh, acc1, 0, 0, 0);
            acc0 = __builtin_amdgcn_mfma_f32_16x16x32_bf16(Ah0, Bl, acc0, 0, 0, 0); acc1 = __builtin_amdgcn_mfma_f32_16x16x32_bf16(Ah1, Bl, acc1, 0, 0, 0);
            acc0 = __builtin_amdgcn_mfma_f32_16x16x32_bf16(Al0, Bh, acc0, 0, 0, 0); acc1 = __builtin_amdgcn_mfma_f32_16x16x32_bf16(Al1, Bh, acc1, 0, 0, 0);
            wa += 64; vp += 32;
            asm volatile("" : "+v"(wa), "+v"(vp), "+v"(acc0), "+v"(acc1)); }
        const float* br = inp(24) + 4 * kg;
        float tv[4] = {-INFINITY, -INFINITY, -INFINITY, -INFINITY}; int ti[4] = {99, 99, 99, 99};
#pragma unroll
        for (int r = 0; r < 4; ++r) ins4(acc0[r] + br[r], 4 * kg + r, tv, ti);
#pragma unroll
        for (int r = 0; r < 4; ++r) ins4(acc1[r] + br[16 + r], 16 + 4 * kg + r, tv, ti);
#pragma unroll
        for (int xr_ = 16; xr_ <= 32; xr_ <<= 1) { float ov[4]; int oi[4];
#pragma unroll
            for (int k = 0; k < 4; ++k) { ov[k] = __shfl_xor(tv[k], xr_); oi[k] = __shfl_xor(ti[k], xr_); }
#pragma unroll
            for (int k = 0; k < 4; ++k) ins4(ov[k], oi[k], tv, ti); }
        { const int k = kg;
          const float e1 = __expf(tv[1] - tv[0]), e2 = __expf(tv[2] - tv[0]), e3 = __expf(tv[3] - tv[0]); const float inv = 1.0f / (1.0f + e1 + e2 + e3);
          const int ek = k == 0 ? ti[0] : k == 1 ? ti[1] : k == 2 ? ti[2] : ti[3]; const float gk = (k == 0 ? 1.0f : k == 1 ? e1 : k == 2 ? e2 : e3) * inv;
          const unsigned rank = __hip_atomic_fetch_add(hist + ek, 1u, __ATOMIC_RELAXED, __HIP_MEMORY_SCOPE_WORKGROUP);
          const int q = (r0 + t) * 4 + k; sel_e[q] = (unsigned)ek; sel_r[q] = rank; sel_g[q] = gk; }
    }
    LDS_WAIT(); __syncthreads();
    if (F.tid < 32) base[F.tid] = __hip_atomic_fetch_add((unsigned*)(F.ctl + cwc + 64 * F.tid), hist[F.tid], RLX_AGENT);
    LDS_WAIT(); __syncthreads();
    { const int q = F.tid, tok = row_base + (q >> 2), k = q & 3; const unsigned ek = sel_e[q], pos = base[ek] + sel_r[q];
      ptok[(size_t)ek * NTOK + pos] = tok; slot[(size_t)tok * 4 + k] = (ek << 16) | pos; gate[(size_t)tok * 4 + k] = sel_g[q]; }
}
__device__ __forceinline__ void moe_tables(Frame& F) {
    LAS unsigned char* tile_e = (LAS unsigned char*)(F.lds + TILE_E_OFF); LAS int* tile0 = (LAS int*)(F.lds + TILE0_OFF); LAS int* cntl = (LAS int*)(F.lds + CNTL_OFF); LAS int* Tp = (LAS int*)(F.lds + MOE_T_OFF);
    if (F.tid < 32) { const int c = (int)__hip_atomic_load((unsigned*)(F.ctl + CW_CNT + 64 * F.tid), RLX_AGENT); const int nt = (c + 255) >> 8; int incl = nt;
#pragma unroll
        for (int o = 1; o < 32; o <<= 1) { const int w = __shfl_up(incl, o); if (F.tid >= o) incl += w; }
        const int excl = incl - nt; tile0[F.tid] = excl; cntl[F.tid] = c; if (F.tid == 31) Tp[0] = incl;
        for (int k = 0; k < nt; ++k) tile_e[excl + k] = (unsigned char)F.tid; }
    __syncthreads();
}
struct MoeSched {
    const LAS unsigned char* tile_e; const LAS int* tile0; const LAS unsigned* rowtab; int T, nN, G, c, rev, a_mask, e_mask; size_t tA, tBe, tB;
    __device__ __forceinline__ bool next(int i, pg8::Unit& u) const { const int x = c & 7, y = c >> 3, tpx = 32 / nN, t = (i * 8 + x) * tpx + (y % tpx); if (t >= T) return false; u.pm = rev ? T - 1 - t : t; u.pn = y / tpx; u.e = __builtin_amdgcn_readfirstlane((int)tile_e[u.pm]); return true; }
    __device__ __forceinline__ size_t aoff(const pg8::Unit& u) const { return (size_t)(u.pm & a_mask) * tA; }
    __device__ __forceinline__ size_t boff(const pg8::Unit& u) const { return (size_t)(u.e & e_mask) * tBe + (size_t)u.pn * tB; }
    __device__ __forceinline__ unsigned rowoff(int i, int r) const { return rowtab[i * 256 + r]; }
};
__device__ __forceinline__ void p9_final(Frame& F, bool dummy = false) {
    const int bx = blockIdx.x, rows_per = NTOK / F.G, row_base = bx * rows_per, b = row_base >> 12;
    if (MK_PER_PHASE || dummy) moe_tables(F);
    const LAS int* tile0 = (const LAS int*)(F.lds + TILE0_OFF);
    const float* g2 = (const float*)(F.ws + WS_MODF) + (size_t)b * 6144 + 5120; const float* fg = inp(29);
    const unsigned char* Y2 = (const unsigned char*)(F.ws + WS_Y2); const unsigned* slot = (const unsigned*)(F.ws + WS_SLOT); const float* gate = (const float*)(F.ws + WS_GATE);
    f32x4 g2v[4], fgv[4];
#pragma unroll
    for (int j = 0; j < 4; ++j) { g2v[j] = *(const f32x4*)(g2 + 256 * j + 4 * F.lane); fgv[j] = *(const f32x4*)(fg + 256 * j + 4 * F.lane); }
    for (int r = F.wave; r < rows_per; r += NWAVES) { const int tok = row_base + r;
        f32x4 acc[4];
#pragma unroll
        for (int j = 0; j < 4; ++j) acc[j] = (f32x4){0.f, 0.f, 0.f, 0.f};
#pragma unroll
        for (int k = 0; k < 4; ++k) { const unsigned sw = slot[(size_t)tok * 4 + k]; const float gk = gate[(size_t)tok * 4 + k]; const size_t p = (size_t)tile0[sw >> 16] * 256 + (sw & 0xffffu);
            const GAS int* yr = (const GAS int*)(Y2 + p * 1024) + F.lane; const float g8 = gk * 0.125f; typedef float f32x2 __attribute__((ext_vector_type(2)));
#pragma unroll
            for (int j = 0; j < 4; ++j) { const int w = yr[64 * j]; const f32x2 lo = __builtin_amdgcn_cvt_pk_f32_fp8(w, false), hi = __builtin_amdgcn_cvt_pk_f32_fp8(w, true);
                acc[j].x += g8 * lo.x; acc[j].y += g8 * lo.y; acc[j].z += g8 * hi.x; acc[j].w += g8 * hi.y; } }
        const GAS v2u* xr = (const GAS v2u*)((const bf16*)(F.ws + WS_X1B) + (size_t)tok * DM) + F.lane;
        GAS f32x4* xw = (GAS f32x4*)((dummy ? (float*)(F.ws + WS_A2) : F.out) + (size_t)tok * DM) + F.lane; f32x4 v[4]; float s = 0.f;
#pragma unroll
        for (int j = 0; j < 4; ++j) { const v2u wx = xr[64 * j]; v[j] = (f32x4){pg8::bf_lo(wx.x), pg8::bf_hi(wx.x), pg8::bf_lo(wx.y), pg8::bf_hi(wx.y)} + g2v[j] * acc[j]; s += (v[j].x * v[j].x + v[j].y * v[j].y) + (v[j].z * v[j].z + v[j].w * v[j].w); }
        const float rs = 1.0f / sqrtf(wave_sum_u(s) * (1.f / DM) + 1e-6f);
#pragma unroll
        for (int j = 0; j < 4; ++j) __builtin_nontemporal_store(v[j] * rs * fgv[j], (f32x4*)(xw + 64 * j));
    }
}

__device__ __forceinline__ void dep_signal(Frame& F, int word) {
    asm volatile("s_waitcnt vmcnt(0)" ::: "memory"); __syncthreads();
    if (F.wave == 0 && lane_id_opaque() == 0) { __builtin_amdgcn_fence(__ATOMIC_RELEASE, "agent"); asm volatile("s_waitcnt vmcnt(0)" ::: "memory"); (void)xb_add((unsigned*)(F.ctl + word), 1u); }
}
__device__ __forceinline__ void dep_wait(Frame& F, int word, unsigned need) {
    if (F.wave == 0 && lane_id_opaque() == 0) { unsigned* p = (unsigned*)(F.ctl + word); unsigned* bar = (unsigned*)(F.ctl + CW_BAR); XB_SPIN(xb_ld(p) < need, bar);
        __builtin_amdgcn_fence(__ATOMIC_ACQUIRE, "agent"); asm volatile("s_waitcnt vmcnt(0)" ::: "memory"); }
    __syncthreads();
}
#ifndef P2_NG
#define P2_NG 176
#endif
__device__ __forceinline__ void phase0(Frame& F, unsigned char* lds, unsigned char* ws) { p0_prologue(F);  }
__device__ __forceinline__ void phase1(Frame& F, unsigned char* lds, unsigned char* ws) { dep_wait(F, CW_DEP0, (unsigned)F.G); p1_h1(F);  }
__device__ __forceinline__ void phase2(Frame& F, unsigned char* lds, unsigned char* ws) {
        pg8::Gemm g{(const bf16*)(ws + WS_H), (const bf16*)(ws + WS_WIN), 1024, 1024, 1024}; const bool hosted = (F.G == 256); const int ng = hosted ? P2_NG : F.G;
        pg8::StaticOrder S; S.init(NTOK, 2048, ng, (int)blockIdx.x, 1024, 1024);
        pg8::EpiQKVU E{(bf16*)(ws + WS_Q), (size_t)(WS_K - WS_Q) / 2, (bf16*)(ws + WS_UA), attn_body::C2};
        if ((int)blockIdx.x < ng) pg8::gemm_phase<pg8::EpiQKVU, pg8::StaticOrder, true, false>(F.lds + RING_OFF, g, S, E, F.wave);
        else tr_run(F, 0, TR_HOSTED, ((int)blockIdx.x - ng) * NWAVES + F.wave, (F.G - ng) * NWAVES);

    }
__device__ __forceinline__ void phase4_glu(Frame& F, unsigned char* ws) {
        pg8::Gemm g{(const bf16*)(ws + WS_Z), (const bf16*)(ws + WS_WGLU), 512, 512, 512}; pg8::StaticOrder S; S.init(NTOK, 512, F.G, (int)blockIdx.x, 512, 512);
        { pg8::Unit u; const bool one = (F.G == 256) && S.next(0, u);
          if (one) dep_wait(F, CW_DEPB + 16 * (u.pm >> 4), 32u);
          else { for (int bb = 0; bb < NB; ++bb) dep_wait(F, CW_DEPB + 16 * bb, 32u); } }
        pg8::EpiGLU E{(const bf16*)(ws + WS_Z), (bf16*)(ws + WS_MIX), inp(20)};
        pg8::gemm_phase<pg8::EpiGLU, pg8::StaticOrder, true, false>(F.lds + RING_OFF, g, S, E, F.wave);
        __syncthreads();
    }
__device__ __forceinline__ void phase3(Frame& F, unsigned char* lds, unsigned char* ws) {
        for (int it = F.vcu; it < 256; it += F.G) { const int g = it >> 3, b = it & 7;
            bf16* UAgb = (bf16*)(ws + WS_UA) + (size_t)((g * 8 + b) * 256) * 384;
            { pg8::Gemm gx{UAgb, (const bf16*)(ws + WS_WM) + (size_t)g * 256 * 256, 256, 384, 256}; pg8::SingleUnit S; pg8::EpiX E;
              pg8::gemm_phase<pg8::EpiX, pg8::SingleUnit, false, false>(F.lds + RING_OFF, gx, S, E, F.wave); }
            LDS_WAIT(); __syncthreads();
            {
                const int p = lane_id_opaque(), c0 = F.wave * 32; const float* L16 = (const float*)(ws + WS_LAM16) + (g * 64 + p) * 2; const float lr = L16[0], li = L16[1];
                LAS float* X = (LAS float*)(F.lds + RING_OFF); LAS float* EW = X + 256 * pg8::XS;
                float hr = 0.f, hi2 = 0.f;
#pragma unroll 8
                for (int k = 0; k < 32; ++k) { LAS float* xc = X + (c0 + k) * pg8::XS + p; const float xr = xc[0], xi = xc[64]; xc[0] = hr; xc[64] = hi2;
                    const float nr = lr * hr - li * hi2 + xr, ni = lr * hi2 + li * hr + xi; hr = nr; hi2 = ni; }
                EW[F.wave * 128 + p] = hr; EW[F.wave * 128 + 64 + p] = hi2;
                float qr = lr, qi = li;
#pragma unroll
                for (int sq = 0; sq < 5; ++sq) { const float t = qr * qr - qi * qi; qi = 2.f * qr * qi; qr = t; }
                LDS_WAIT(); __syncthreads();
                float cr = 0.f, ci = 0.f;
                for (int v = 0; v < F.wave; ++v) { const float er = EW[v * 128 + p], ei = EW[v * 128 + 64 + p]; const float nr = qr * cr - qi * ci + er, ni = qr * ci + qi * cr + ei; cr = nr; ci = ni; }
                bf16* hrow = UAgb + (size_t)c0 * 384 + 256 + p; float pr = 1.f, pi = 0.f;
#pragma unroll 8
                for (int k = 0; k < 32; ++k) { const LAS float* xc = X + (c0 + k) * pg8::XS + p; const float hr2 = xc[0] + (pr * cr - pi * ci), hi3 = xc[64] + (pr * ci + pi * cr);
                    hrow[(size_t)k * 384] = (bf16)f2bf(hr2); hrow[(size_t)k * 384 + 64] = (bf16)f2bf(hi3);
                    const float t = pr * lr - pi * li; pi = pr * li + pi * lr; pr = t; }
                VM_WAIT(); if (F.wave == 0) { __builtin_amdgcn_fence(__ATOMIC_ACQUIRE, "agent"); VM_WAIT(); } }
            LDS_WAIT(); __syncthreads();
            { pg8::Gemm gy{UAgb, (const bf16*)(ws + WS_TV) + (size_t)g * 256 * 384, 384, 384, 384}; pg8::SingleUnit S; pg8::EpiY E{(bf16*)(ws + WS_Z), g, b};
              pg8::gemm_phase<pg8::EpiY, pg8::SingleUnit, false, false>(F.lds + RING_OFF, gy, S, E, F.wave); }
            dep_signal(F, CW_DEPB + 16 * b);
        }
        static_assert(attn_body::LDS2_BYTES <= LDSCTL_OFF, "attention LDS vs control words");
        for (int it = F.vcu; it < 256; it += F.G) { const int bh = it >> 3, sdx = it & 7, b = bh >> 2, h = bh & 3;
            for (int i4 = 0; i4 < 4; ++i4) { const int qb = (i4 >> 1) ? 15 - sdx : sdx;
                { const int m = i4 & 1, hm = h * 2 + m;
                    const attn_body::bf16* q_ = (const attn_body::bf16*)(ws + WS_Q) + (size_t)b * SEQ * 512 + hm * 64; const attn_body::bf16* k_ = (const attn_body::bf16*)(ws + WS_K) + (size_t)b * SEQ * 512 + hm * 64;
                    const attn_body::bf16* v_ = (const attn_body::bf16*)(ws + WS_V) + (size_t)b * SEQ * 512 + h * 128; attn_body::bf16* o_ = (attn_body::bf16*)(ws + WS_OB) + (size_t)b * SEQ * 1024 + hm * 128;
                    asm volatile("" : "+s"(q_), "+s"(k_), "+s"(v_), "+s"(o_));
                    attn_body::attn_unit2<8>(qb, q_, k_, v_, o_, (char*)lds + RING_OFF, F.wave); }
                if (i4 & 1) { VM_WAIT(); __syncthreads();
 const int ln = lane_id_opaque(), t16 = F.wave * 4 + (ln >> 4), d0 = (ln & 15) * 8; const float* sg = inp(10) + d0;
                  const float lam = __expf(wave_sum(inp(6)[ln] * inp(7)[ln])) - __expf(wave_sum(inp(8)[ln] * inp(9)[ln])) + 0.2f;
                  const bf16* OB = (const bf16*)(ws + WS_OB); bf16* MIX = (bf16*)(ws + WS_MIX);
                  for (int p = 0; p < 8; ++p) { const size_t tok = (size_t)b * SEQ + qb * 256 + p * 32 + t16;
                      const v4u a0 = *(const GAS v4u*)(OB + tok * 1024 + (h * 2) * 128 + d0), a1 = *(const GAS v4u*)(OB + tok * 1024 + (h * 2 + 1) * 128 + d0);
                      float a[8];
                      a[0] = pg8::bf_lo(a0.x) - lam * pg8::bf_lo(a1.x); a[1] = pg8::bf_hi(a0.x) - lam * pg8::bf_hi(a1.x); a[2] = pg8::bf_lo(a0.y) - lam * pg8::bf_lo(a1.y); a[3] = pg8::bf_hi(a0.y) - lam * pg8::bf_hi(a1.y);
                      a[4] = pg8::bf_lo(a0.z) - lam * pg8::bf_lo(a1.z); a[5] = pg8::bf_hi(a0.z) - lam * pg8::bf_hi(a1.z); a[6] = pg8::bf_lo(a0.w) - lam * pg8::bf_lo(a1.w); a[7] = pg8::bf_hi(a0.w) - lam * pg8::bf_hi(a1.w);
                      float ss = 0.f;
#pragma unroll
                      for (int j = 0; j < 8; ++j) ss += a[j] * a[j];
                      ss += __shfl_xor(ss, 1); ss += __shfl_xor(ss, 2); ss += __shfl_xor(ss, 4); ss += __shfl_xor(ss, 8);
                      const float rs = 0.8f / sqrtf(ss * (1.f / 128.f) + 1e-6f);
                      const float r4 = rs * 4.0f; const pg8::f32x4 q0 = {a[0] * r4 * sg[0], a[1] * r4 * sg[1], a[2] * r4 * sg[2], a[3] * r4 * sg[3]}, q1 = {a[4] * r4 * sg[4], a[5] * r4 * sg[5], a[6] * r4 * sg[6], a[7] * r4 * sg[7]};
                      *(GAS pg8::i32x2*)((unsigned char*)MIX + tok * 1024 + h * 128 + d0) = pg8::pack8_fp8(q0, q1); } }
            }
        }
        __syncthreads(); phase4_glu(F, ws);
}
__device__ __forceinline__ void phase4(Frame& F, unsigned char* lds, unsigned char* ws) { }
__device__ __forceinline__ void phase5(Frame& F, unsigned char* lds, unsigned char* ws) {
        pg8::Gemm g{(const bf16*)(ws + WS_MIX), (const bf16*)(ws + WS_WOUT), 512, 512, 512}; pg8::StaticOrder S; S.init(NTOK, 1024, F.G, (int)blockIdx.x, 512, 512);
        pg8::EpiOut E{inp(0), (bf16*)(ws + WS_X1B), (const float*)(ws + WS_MODF) + 2048, F.lds + VEC_OFF};
        pg8::gemm_phase<pg8::EpiOut, pg8::StaticOrder, true, false, true>(F.lds + RING_OFF, g, S, E, F.wave);

    }
__device__ __forceinline__ void phase6(Frame& F, unsigned char* lds, unsigned char* ws) { p6_router(F, false, !MK_PER_PHASE);  }
__device__ __forceinline__ void phase7(Frame& F, unsigned char* lds, unsigned char* ws) {
        moe_tables(F);
        MoeSched S; S.tile_e = (const LAS unsigned char*)(F.lds + TILE_E_OFF); S.tile0 = (const LAS int*)(F.lds + TILE0_OFF); S.rowtab = (const LAS unsigned*)(F.lds + ROWTAB_OFF);
        S.T = __builtin_amdgcn_readfirstlane(((const LAS int*)(F.lds + MOE_T_OFF))[0]); S.nN = 8; S.G = F.G; S.c = (int)blockIdx.x; S.rev = 0; S.a_mask = -1; S.e_mask = -1; S.tA = 0; S.tBe = (size_t)2048 * 1024; S.tB = (size_t)256 * 1024;
        { const LAS int* cntl = (const LAS int*)(F.lds + CNTL_OFF); LAS unsigned* rt = (LAS unsigned*)(F.lds + ROWTAB_OFF); const int* ptok = (const int*)(ws + WS_PTOK);
          int tokv[18]; bool live[18];
#pragma unroll
          for (int i = 0; i < 18; ++i) { pg8::Unit u; live[i] = S.next(i, u); tokv[i] = 0;
              if (live[i] && F.tid < 256) { const int e = u.e, pos = (u.pm - S.tile0[e]) * 256 + F.tid; tokv[i] = ptok[(size_t)e * NTOK + (pos < cntl[e] ? pos : 0)]; } }
#pragma unroll
          for (int i = 0; i < 18; ++i) if (live[i] && F.tid < 256) rt[i * 256 + F.tid] = (unsigned)tokv[i] * 1024u; }
        VM_WAIT(); LDS_WAIT(); __syncthreads();
        pg8::Gemm g{(const bf16*)(ws + WS_H), (const bf16*)(ws + WS_W1T), 512, 512, 512};
        pg8::EpiMoe1 E{(unsigned char*)(ws + WS_A2), inp(26)};
        pg8::gemm_phase<pg8::EpiMoe1, MoeSched, true, true, true>(F.lds + RING_OFF, g, S, E, F.wave);

    }
__device__ __forceinline__ void phase8(Frame& F, unsigned char* lds, unsigned char* ws) {
        if (MK_PER_PHASE) moe_tables(F);
        MoeSched S; S.tile_e = (const LAS unsigned char*)(F.lds + TILE_E_OFF); S.tile0 = (const LAS int*)(F.lds + TILE0_OFF); S.rowtab = (const LAS unsigned*)(F.lds + ROWTAB_OFF);
        S.T = __builtin_amdgcn_readfirstlane(((const LAS int*)(F.lds + MOE_T_OFF))[0]); S.nN = 4; S.G = F.G; S.c = (int)blockIdx.x; S.rev = 1; S.a_mask = -1; S.e_mask = -1; S.tA = (size_t)256 * 1024; S.tBe = (size_t)1024 * 1024; S.tB = (size_t)256 * 1024;
        pg8::Gemm g{(const bf16*)(ws + WS_A2), (const bf16*)(ws + WS_W2T), 512, 512, 512};
        pg8::EpiMoe2 E{(unsigned char*)(ws + WS_Y2), inp(28), -1};
        pg8::gemm_phase<pg8::EpiMoe2, MoeSched, true, false, true>(F.lds + RING_OFF, g, S, E, F.wave);

    }
__device__ __forceinline__ void phase9(Frame& F, unsigned char* lds, unsigned char* ws) { p9_final(F); }
__device__ __forceinline__ bool relaunder(Frame& F) { F.lane = lane_id_opaque(); F.tid = F.wave * 64 + F.lane; return true; }
struct Args { const float* in[30]; float* out; unsigned char* ws; int ph_lo, ph_hi; };
__global__ void __launch_bounds__(NWAVES * 64, 2) mega_fwd(Args args) {
    extern __shared__ __attribute__((aligned(16))) unsigned char lds[];
    Frame F;
    F.lds = (LAS unsigned char*)lds;
    F.tid = threadIdx.x; F.lane = F.tid & 63; F.wave = __builtin_amdgcn_readfirstlane(F.tid >> 6);
    F.G = gridDim.x; { const int bx = blockIdx.x; F.vcu = (F.G % 8 == 0) ? (bx % 8) * (F.G / 8) + bx / 8 : bx; }
    F.ws = args.ws; F.out = args.out; F.ctl = (gu32*)(args.ws + WS_CTL);
    volatile LAS unsigned* MISC = (volatile LAS unsigned*)(F.lds + MISC_OFF);
    for (int u = F.tid; u < (LDS_BYTES - LDSCTL_OFF) / 4; u += NWAVES * 64) ((LAS unsigned*)(F.lds + LDSCTL_OFF))[u] = 0u;
    __syncthreads();
    XcdBarrier bar; bar.bar = (unsigned*)(F.ctl + CW_BAR); bar.x = 0; bar.st = nullptr;
    if (!MK_PER_PHASE) bar = xcd_barrier_post((unsigned*)(F.ctl + CW_BAR), MISC + 8);
    const int lo = args.ph_lo, hi = args.ph_hi;
#ifndef MK_MASK
#define MK_MASK 0x3ff
#endif
#define IN(k) (((MK_MASK >> (k)) & 1) && lo <= (k) && (k) < hi && relaunder(F))
#define SEAM(k) do { if (IN(k) && IN((k) + 1)) xcd_barrier(bar, F.wave); } while (0)
    unsigned char* ws = args.ws;

    if (IN(0)) { phase0(F, lds, ws); }
#if MK_DUP == 0
    if (IN(0)) { phase0(F, lds, ws); SEAM(0); }
#endif
    if (IN(1)) { phase1(F, lds, ws); SEAM(1); }
#if MK_DUP == 1
    if (IN(1)) { phase1(F, lds, ws); SEAM(1); }
#endif
    if (IN(2)) { phase2(F, lds, ws); SEAM(2); }
#if MK_DUP == 2
    if (IN(2)) { phase2(F, lds, ws); SEAM(2); }
#endif
#if MK_DUP == 18
    if (IN(2)) { for (int rr = 0; rr < 8; ++rr) { phase2(F, lds, ws); xcd_barrier(bar, F.wave); } }
#endif
    if (IN(3)) { phase3(F, lds, ws); }
#if MK_DUP == 3
    if (IN(3)) { phase3(F, lds, ws); SEAM(3); }
#endif
    if (IN(4)) { phase4(F, lds, ws); SEAM(4); }
#if MK_DUP == 4
    if (IN(4)) { phase4(F, lds, ws); SEAM(4); }
#endif
    if (IN(5)) { phase5(F, lds, ws); if (!MK_PER_PHASE && IN(6)) p6_fill(F); SEAM(5); }
#if MK_DUP == 5
    if (IN(5)) { phase5(F, lds, ws); SEAM(5); }
#endif
#if MK_DUP == 6
    if (IN(6)) { p6_router(F, true); xcd_barrier(bar, F.wave); }
#endif
    if (IN(6)) { phase6(F, lds, ws); SEAM(6); }
    if (IN(7)) { phase7(F, lds, ws); SEAM(7); }
#if MK_DUP == 7
    if (IN(7)) { phase7(F, lds, ws); SEAM(7); }
#endif
    if (IN(8)) { phase8(F, lds, ws); SEAM(8); }
#if MK_DUP == 8
    if (IN(8)) { phase8(F, lds, ws); SEAM(8); }
#endif
#if MK_DUP == 9
    if (IN(9)) { p9_final(F, true); xcd_barrier(bar, F.wave); }
#endif
#if MK_DUP == 16 || MK_DUP == 17
    if (IN(8)) {
        moe_tables(F);
        MoeSched S; S.tile_e = (const LAS unsigned char*)(F.lds + TILE_E_OFF); S.tile0 = (const LAS int*)(F.lds + TILE0_OFF); S.rowtab = (const LAS unsigned*)(F.lds + ROWTAB_OFF);
        S.T = __builtin_amdgcn_readfirstlane(((const LAS int*)(F.lds + MOE_T_OFF))[0]); S.nN = 4; S.G = F.G; S.c = (int)blockIdx.x; S.rev = 1; S.e_mask = (MK_DUP == 16) ? 0 : -1; S.a_mask = (MK_DUP == 16) ? 0 : -1; S.tA = (size_t)256 * 1024; S.tBe = (size_t)1024 * 1024; S.tB = (size_t)256 * 1024;
        pg8::Gemm g{(const bf16*)(ws + WS_A2), (const bf16*)(ws + WS_W2T), 512, 512, 512};
        pg8::EpiMoe2 E{(unsigned char*)(ws + WS_W1T), inp(28), 127};
        pg8::gemm_phase<pg8::EpiMoe2, MoeSched, true, false, true>(F.lds + RING_OFF, g, S, E, F.wave);
        xcd_barrier(bar, F.wave);
    }
#endif
    if (IN(9)) { phase9(F, lds, ws); }
#if MK_DUP == 19
    if (IN(9)) { xcd_barrier(bar, F.wave); phase7(F, lds, ws); }
#endif
#if MK_DUP == 20
    if (IN(9)) { xcd_barrier(bar, F.wave); phase8(F, lds, ws); }
#endif
#if MK_DUP == 10
    if (IN(9)) { xcd_barrier(bar, F.wave); phase0(F, lds, ws); }
#endif
#if MK_DUP == 11
    if (IN(9)) { xcd_barrier(bar, F.wave); p0_prologue(F, 1); }
#endif
#if MK_DUP == 13
    if (IN(9)) { xcd_barrier(bar, F.wave); p0_prologue(F, 3); }
#endif
#if MK_DUP == 14
    if (IN(9)) { xcd_barrier(bar, F.wave); p0_prologue(F, 4); }
#endif
#if MK_DUP == 15
    if (IN(9)) { xcd_barrier(bar, F.wave); }
#endif
#if MK_DUP == 12
    if (IN(9)) { xcd_barrier(bar, F.wave); p0_prologue(F, 2); }
#endif
#undef IN
#undef SEAM
}

extern "C" void kernel_launch(void* const* d_in, const int* in_sizes, int n_in, void* d_out, int out_size, void* d_ws, size_t ws_size, hipStream_t stream) {
    static int grid = 0;
    if (grid == 0) {
        if (n_in != 30 || in_sizes[0] != NTOK * DM || out_size != NTOK * DM || ws_size < WS_END) { fprintf(stderr, "kernel_launch: unexpected shapes (n_in %d, in0 %d, out %d, ws %zu); nothing launched\n", n_in, n_in > 0 ? in_sizes[0] : -1, out_size, ws_size); grid = -1; return; }
        int dev = 0, cus = 0;
        if (hipGetDevice(&dev) != hipSuccess || hipDeviceGetAttribute(&cus, hipDeviceAttributeMultiprocessorCount, dev) != hipSuccess) { fprintf(stderr, "kernel_launch: device query failed\n"); grid = -1; return; }
        if (hipFuncSetAttribute((const void*)mega_fwd, hipFuncAttributeMaxDynamicSharedMemorySize, LDS_BYTES) != hipSuccess) { fprintf(stderr, "kernel_launch: hipFuncSetAttribute failed\n"); grid = -1; return; }
        (void)hipGetLastError();
        grid = cus;
        if (grid != 256) { fprintf(stderr, "kernel_launch: built for a 256-CU device, found %d CUs; nothing launched\n", grid); grid = -1; return; }
    }
    if (grid < 0) return;
    if (hipMemsetAsync((char*)d_ws + WS_CTL, 0, CTL_ZERO_BYTES, stream) != hipSuccess) { fprintf(stderr, "kernel_launch: memset failed\n"); return; }
    Args a{};
    for (int i = 0; i < 30; ++i) a.in[i] = (const float*)d_in[i];
    a.out = (float*)d_out; a.ws = (unsigned char*)d_ws;
#if MK_PER_PHASE
    for (int p = 0; p < N_PHASES; ++p) { a.ph_lo = p; a.ph_hi = p + 1; hipLaunchKernelGGL(mega_fwd, dim3(grid), dim3(NWAVES * 64), LDS_BYTES, stream, a); }
#else
    a.ph_lo = 0; a.ph_hi = N_PHASES; hipLaunchKernelGGL(mega_fwd, dim3(grid), dim3(NWAVES * 64), LDS_BYTES, stream, a);
#endif
    const hipError_t le = hipPeekAtLastError();
    if (le != hipSuccess) fprintf(stderr, "kernel_launch: launch failed: %s\n", hipGetErrorName(le));
}
```

```cpp
#include <hip/hip_runtime.h>
#include <hip/hip_bf16.h>
#include <cstdio>
#include <cstdint>
#include <cmath>

#ifndef MK_PER_PHASE
#define MK_PER_PHASE 0
#endif

#ifdef MK_EPI2
#define MK_EPI2V MK_EPI2
#else
#define MK_EPI2V (-1)
#endif
#ifndef MK_DUP
#define MK_DUP (-1)
#endif

#define LAS __attribute__((address_space(3)))
#define GAS __attribute__((address_space(1)))

__device__ __forceinline__ int lane_id_opaque() { int l = (int)__builtin_amdgcn_mbcnt_hi(~0u, __builtin_amdgcn_mbcnt_lo(~0u, 0u)); asm volatile("" : "+v"(l)); return l; }

namespace pg8 {
typedef unsigned short bf16_t;
typedef short bf16x8 __attribute__((ext_vector_type(8)));
typedef float f32x4 __attribute__((ext_vector_type(4)));
typedef unsigned u32x4 __attribute__((ext_vector_type(4)));
typedef float f32x2 __attribute__((ext_vector_type(2)));
typedef int i32x4 __attribute__((ext_vector_type(4)));
typedef int i32x8 __attribute__((ext_vector_type(8)));
typedef int i32x2 __attribute__((ext_vector_type(2)));
constexpr int BM = 256, BK = 64, HALF = 128, HTB = HALF * BK * 2, STAGE_BYTES = 8 * HTB, NXCD = 8, WGM = 8;

__host__ __device__ __forceinline__ int lds_byte(int r, int c) { const int st = (r >> 4) * 2 + (c >> 5), rr = r & 15, cc = c & 31, ob = rr * 64 + cc * 2; return st * 1024 + (ob ^ (((ob >> 9) & 1) << 5)); }
__host__ __device__ __forceinline__ void stage_rc(int b, int& R, int& C) { const int st = b / 1024, sb = b % 1024, swz = sb ^ (((sb >> 9) & 1) << 5); R = (st >> 1) * 16 + swz / 64; C = (st & 1) * 32 + (swz % 64) / 2; }
__host__ __device__ __forceinline__ int perm32(int rho) { const int n = rho >> 4, i = rho & 15; return 8 * (i >> 2) + 4 * n + (i & 3); }

struct Unit { int pm, pn, e; };
struct Gemm { const bf16_t* A; const bf16_t* Bt; int K, lda, ldb; };

struct StaticOrder {
    int nM, nN, nwg, G, c; size_t tA, tB;
    __device__ __forceinline__ void init(int M, int N, int G_, int c_, int lda, int ldb) { nM = M / BM; nN = N / BM; nwg = nM * nN; G = G_; c = c_; tA = (size_t)BM * lda * 2; tB = (size_t)BM * ldb * 2; }
    __device__ __forceinline__ bool next(int i, Unit& u) const {
        const long L = (long)i * G + c; if (L >= nwg) return false;
        int wgid = (int)L; { const int q = nwg / NXCD, r = nwg % NXCD, xcd = wgid % NXCD, off = wgid / NXCD; wgid = (xcd < r ? xcd * (q + 1) : r * (q + 1) + (xcd - r) * q) + off; }
        const int nig = WGM * nN, gid = wgid / nig, fm = gid * WGM, gsz = (nM - fm) < WGM ? (nM - fm) : WGM;
        u.pm = fm + ((wgid % nig) % gsz); u.pn = (wgid % nig) / gsz; u.e = 0; return true;
    }
    __device__ __forceinline__ size_t aoff(const Unit& u) const { return (size_t)u.pm * tA; }
    __device__ __forceinline__ size_t boff(const Unit& u) const { return (size_t)u.pn * tB; }
    __device__ __forceinline__ unsigned rowoff(int, int) const { return 0u; }
};
struct SingleUnit {
    __device__ __forceinline__ bool next(int i, Unit& u) const { if (i > 0) return false; u.pm = 0; u.pn = 0; u.e = 0; return true; }
    __device__ __forceinline__ size_t aoff(const Unit&) const { return 0; }
    __device__ __forceinline__ size_t boff(const Unit&) const { return 0; }
    __device__ __forceinline__ unsigned rowoff(int, int) const { return 0u; }
};

__device__ __forceinline__ unsigned cvt_pk_bf16(float lo, float hi) { unsigned r; asm volatile("v_cvt_pk_bf16_f32 %0, %1, %2" : "=v"(r) : "v"(lo), "v"(hi)); return r; }
__device__ __forceinline__ float sigm(float x) { return __builtin_amdgcn_rcpf(1.0f + __builtin_amdgcn_exp2f(-1.4426950408889634f * x)); }
__device__ __forceinline__ float gelu_tanh(float y) { return y * sigm(1.5957691216057308f * (y + 0.044715f * y * y * y)); }
__device__ __forceinline__ f32x2 gelu_tanh2(f32x2 y) {
    const f32x2 y2 = y * y, u = y * __builtin_elementwise_fma(y2, (f32x2){0.044715f, 0.044715f}, (f32x2){1.f, 1.f}), ea = u * (-1.5957691216057308f * 1.4426950408889634f);
    f32x2 d; d.x = __builtin_amdgcn_exp2f(ea.x); d.y = __builtin_amdgcn_exp2f(ea.y); d = d + 1.0f; f32x2 r; r.x = __builtin_amdgcn_rcpf(d.x); r.y = __builtin_amdgcn_rcpf(d.y); return y * r; }
__device__ __forceinline__ u32x4 pack8(const f32x4& a, const f32x4& b) { u32x4 w; w.x = cvt_pk_bf16(a[0], a[1]); w.y = cvt_pk_bf16(a[2], a[3]); w.z = cvt_pk_bf16(b[0], b[1]); w.w = cvt_pk_bf16(b[2], b[3]); return w; }
__device__ __forceinline__ float clamp_fp8(float v) { return __builtin_amdgcn_fmed3f(v, -448.0f, 448.0f); }
__device__ __forceinline__ i32x2 pack8_fp8(const f32x4& a, const f32x4& c) {
    int w0 = __builtin_amdgcn_cvt_pk_fp8_f32(clamp_fp8(a[0]), clamp_fp8(a[1]), 0, false); w0 = __builtin_amdgcn_cvt_pk_fp8_f32(clamp_fp8(a[2]), clamp_fp8(a[3]), w0, true);
    int w1 = __builtin_amdgcn_cvt_pk_fp8_f32(clamp_fp8(c[0]), clamp_fp8(c[1]), 0, false); w1 = __builtin_amdgcn_cvt_pk_fp8_f32(clamp_fp8(c[2]), clamp_fp8(c[3]), w1, true);
    return (i32x2){w0, w1};
}

struct EpiQKVU {
    static constexpr bool PERM = true, AFTER_DRAIN = false, PROBE2 = (MK_EPI2V == 2);
    bf16_t* QKV; size_t stride; bf16_t* UA; float scale0;
    __device__ __forceinline__ void operator()(const f32x4 (&acc)[2][2][4][2], const Unit& u, int wr, int wc, int fr, int fq) const {
        const int t = u.pn >> 1, colt = (u.pn & 1) * 256 + wc * 32 + 8 * fq, row0 = u.pm * BM + wr * 64 + fr;
        if (t < 3) {
            bf16_t* base = QKV + (size_t)t * stride; const float sc = (t == 0) ? scale0 : 1.f;
#pragma unroll
            for (int ai = 0; ai < 2; ++ai)
#pragma unroll
                for (int m = 0; m < 4; ++m) { bf16_t* rowp = base + (size_t)(row0 + ai * HALF + m * 16) * 512 + colt;
#pragma unroll
                    for (int bj = 0; bj < 2; ++bj) *(u32x4*)(rowp + bj * HALF) = pack8(acc[ai][bj][m][0] * sc, acc[ai][bj][m][1] * sc); }
        } else {
#pragma unroll
            for (int ai = 0; ai < 2; ++ai)
#pragma unroll
                for (int m = 0; m < 4; ++m) { const int r = row0 + ai * HALF + m * 16, b = r >> 12, tt = r & 4095, chunk = tt >> 4, j = tt & 15;
#pragma unroll
                    for (int bj = 0; bj < 2; ++bj) { const int cu = colt + bj * HALF, g = cu >> 4, c0 = cu & 15;
                        *(u32x4*)(UA + ((size_t)((g * 8 + b) * 256 + chunk)) * 384 + j * 16 + c0) = pack8(acc[ai][bj][m][0], acc[ai][bj][m][1]); } }
        }
    }
};
constexpr int XS = 132;
struct EpiX {
    static constexpr bool PERM = false, AFTER_DRAIN = true, PROBE2 = false, HALF_N = true;
    __device__ __forceinline__ void fused(const f32x4 (&acc)[2][2][4][2], const Unit&, int wr, int wc, int fr, int fq, LAS unsigned char* lds, int, int) const {
        LAS float* X = (LAS float*)lds;
#pragma unroll
        for (int ai = 0; ai < 2; ++ai)
#pragma unroll
            for (int m = 0; m < 4; ++m) { const int row = ai * HALF + wr * 64 + m * 16 + fr;
#pragma unroll
                for (int n = 0; n < 2; ++n) *(LAS f32x4*)(X + row * XS + wc * 32 + n * 16 + 4 * fq) = acc[ai][0][m][n]; }
    }
};
struct EpiY {
    static constexpr bool PERM = true, AFTER_DRAIN = false, PROBE2 = false;
    bf16_t* Z; int g, b;
    __device__ __forceinline__ void operator()(const f32x4 (&acc)[2][2][4][2], const Unit&, int wr, int wc, int fr, int fq) const {
#pragma unroll
        for (int ai = 0; ai < 2; ++ai)
#pragma unroll
            for (int m = 0; m < 4; ++m) { const int chunk = ai * HALF + wr * 64 + m * 16 + fr;
#pragma unroll
                for (int bj = 0; bj < 2; ++bj) { const int col0 = bj * HALF + wc * 32 + 8 * fq, s = col0 >> 4, c0 = col0 & 15;
                    f32x4 v0 = acc[ai][bj][m][0], v1 = acc[ai][bj][m][1];
#pragma unroll
                    for (int q = 0; q < 4; q += 2) { const f32x2 a = gelu_tanh2((f32x2){v0[q], v0[q + 1]}), c = gelu_tanh2((f32x2){v1[q], v1[q + 1]}); v0[q] = a.x; v0[q + 1] = a.y; v1[q] = c.x; v1[q + 1] = c.y; }
                    *(u32x4*)(Z + (size_t)(b * 4096 + chunk * 16 + s) * 512 + g * 16 + c0) = pack8(v0, v1); }
                __builtin_amdgcn_sched_barrier(0); }
    }
};
__device__ __forceinline__ float bf_lo(unsigned w) { return __uint_as_float(w << 16); }
__device__ __forceinline__ float bf_hi(unsigned w) { return __uint_as_float(w & 0xffff0000u); }
struct EpiGLU {
    static constexpr bool PERM = true, AFTER_DRAIN = false, PROBE2 = false;
    const bf16_t* Z; bf16_t* MIX; const float* bias;
    __device__ __forceinline__ void operator()(const f32x4 (&acc)[2][2][4][2], const Unit& u, int wr, int wc, int fr, int fq) const {
        const int row0 = u.pm * BM + wr * 64 + fr, col0 = u.pn * BM + wc * 32 + 8 * fq;
        f32x4 bv[2][2];
#pragma unroll
        for (int bj = 0; bj < 2; ++bj)
#pragma unroll
            for (int n = 0; n < 2; ++n) bv[bj][n] = *(const f32x4*)(bias + col0 + bj * HALF + 4 * n);
#pragma unroll
        for (int ai = 0; ai < 2; ++ai)
#pragma unroll
            for (int m = 0; m < 4; ++m) { const size_t row = (size_t)(row0 + ai * HALF + m * 16);
#pragma unroll
                for (int bj = 0; bj < 2; ++bj) { const int col = col0 + bj * HALF; const u32x4 zz = *(const u32x4*)(Z + row * 512 + col);
                    const f32x4 a0 = acc[ai][bj][m][0] + bv[bj][0], a1 = acc[ai][bj][m][1] + bv[bj][1];
                    f32x4 o0, o1;
                    o0[0] = bf_lo(zz.x) * sigm(a0[0]); o0[1] = bf_hi(zz.x) * sigm(a0[1]); o0[2] = bf_lo(zz.y) * sigm(a0[2]); o0[3] = bf_hi(zz.y) * sigm(a0[3]);
                    o1[0] = bf_lo(zz.z) * sigm(a1[0]); o1[1] = bf_hi(zz.z) * sigm(a1[1]); o1[2] = bf_lo(zz.w) * sigm(a1[2]); o1[3] = bf_hi(zz.w) * sigm(a1[3]);
                    *(i32x2*)((unsigned char*)MIX + row * 1024 + 512 + col) = pack8_fp8(o0 * 4.0f, o1 * 4.0f); }
                __builtin_amdgcn_sched_barrier(0); }
    }
};
struct EpiOut {
    static constexpr bool PERM = true, AFTER_DRAIN = false, PROBE2 = (MK_EPI2V == 5);
    const float* X; bf16_t* X1; const float* g1; LAS unsigned char* stg;
    __device__ __forceinline__ void operator()(const f32x4 (&acc)[2][2][4][2], const Unit& u, int wr, int wc, int fr, int fq) const {
        const int col0 = wc * 32 + 8 * fq, b = (u.pm * BM) >> 12, t = (wr * 4 + wc) * 64 + fq * 16 + fr, rs = t >> 4, ch = t & 15;
        f32x4 gv[2][2];
#pragma unroll
        for (int bj = 0; bj < 2; ++bj)
#pragma unroll
            for (int n = 0; n < 2; ++n) gv[bj][n] = *(const f32x4*)(g1 + (size_t)b * 6144 + u.pn * BM + col0 + bj * HALF + 4 * n) * (1.0f / 128.0f);
        LAS unsigned char* wp = stg + (16 * wr + fr) * 528 + col0 * 2; const LAS unsigned char* rp = stg + rs * 528 + ch * 32;
        const size_t off0 = (size_t)(u.pm * BM + 64 * (rs >> 4) + (rs & 15)) * 1024 + u.pn * BM + 16 * ch;
        f32x4 xv[4], xn[4];
#pragma unroll
        for (int q = 0; q < 4; ++q) xv[q] = *(const f32x4*)(X + off0 + 4 * q);
#pragma unroll
        for (int sidx = 0; sidx < 8; ++sidx) { const int ai = sidx >> 2, m = sidx & 3; const size_t off = off0 + (size_t)(ai * HALF + 16 * m) * 1024;
            if (sidx < 7) { const size_t offn = off0 + (size_t)(((sidx + 1) >> 2) * HALF + 16 * ((sidx + 1) & 3)) * 1024;
#pragma unroll
                for (int q = 0; q < 4; ++q) xn[q] = *(const f32x4*)(X + offn + 4 * q); }
#pragma unroll
            for (int bj = 0; bj < 2; ++bj) *(LAS u32x4*)(wp + bj * 256) = pack8(gv[bj][0] * acc[ai][bj][m][0], gv[bj][1] * acc[ai][bj][m][1]);
            asm volatile("s_waitcnt lgkmcnt(0)" ::: "memory"); __builtin_amdgcn_s_barrier(); asm volatile("" ::: "memory");
            const u32x4 m0 = *(const LAS u32x4*)(rp), m1 = *(const LAS u32x4*)(rp + 16);
            f32x4 o0, o1, o2, o3;
            o0 = xv[0] + (f32x4){bf_lo(m0.x), bf_hi(m0.x), bf_lo(m0.y), bf_hi(m0.y)}; o1 = xv[1] + (f32x4){bf_lo(m0.z), bf_hi(m0.z), bf_lo(m0.w), bf_hi(m0.w)};
            o2 = xv[2] + (f32x4){bf_lo(m1.x), bf_hi(m1.x), bf_lo(m1.y), bf_hi(m1.y)}; o3 = xv[3] + (f32x4){bf_lo(m1.z), bf_hi(m1.z), bf_lo(m1.w), bf_hi(m1.w)};
            *(u32x4*)(X1 + off) = pack8(o0, o1); *(u32x4*)(X1 + off + 8) = pack8(o2, o3);
            asm volatile("s_waitcnt lgkmcnt(0)" ::: "memory"); __builtin_amdgcn_s_barrier(); asm volatile("" ::: "memory");
#pragma unroll
            for (int q = 0; q < 4; ++q) xv[q] = xn[q]; }
    }
};
constexpr float F8_ACT = 4.0f, F8_W = 32.0f, F8_UNDO = 1.0f / (4.0f * 32.0f);
struct EpiMoe1 {
    static constexpr bool PERM = true, AFTER_DRAIN = false, PROBE2 = (MK_EPI2V == 7), BIAS_LDS = true;
    unsigned char* A2; const float* b1; LAS unsigned char* bl; mutable int par = 0;
    __device__ __forceinline__ const float* bias_src(const Unit& u, int wc, int lane16, unsigned& voff) const { voff = (unsigned)(((lane16 >> 3) * 1024 + u.pn * 128 + wc * 32 + (lane16 & 7) * 4) * 4); return b1 + (size_t)u.e * 2048; }
    __device__ __forceinline__ void operator()(const f32x4 (&acc)[2][2][4][2], const Unit& u, int wr, int wc, int fr, int fq) const {
        asm volatile("" : "+v"(fr), "+v"(fq));
        const int row0 = u.pm * BM + wr * 64 + fr, jc = u.pn * 128 + wc * 32 + 8 * fq;
        f32x4 bg[2], bu[2];
#pragma unroll
        for (int n = 0; n < 2; ++n) { const LAS unsigned char* bp = bl + par * 2048 + (wr * 4 + wc) * 256 + fq * 32 + n * 16; bg[n] = *(const LAS f32x4*)(bp); bu[n] = *(const LAS f32x4*)(bp + 128); }
#pragma unroll
        for (int ai = 0; ai < 2; ++ai)
#pragma unroll
            for (int m = 0; m < 4; ++m) { f32x4 o[2];
#pragma unroll
                for (int n = 0; n < 2; ++n) {
#pragma unroll
                    for (int hq = 0; hq < 2; ++hq) { const f32x2 ag = {acc[ai][0][m][n][2 * hq], acc[ai][0][m][n][2 * hq + 1]}, au = {acc[ai][1][m][n][2 * hq], acc[ai][1][m][n][2 * hq + 1]};
                        const f32x2 vbg = {bg[n][2 * hq], bg[n][2 * hq + 1]}, vbu = {bu[n][2 * hq], bu[n][2 * hq + 1]}, k7 = {7.0f, 7.0f}, km7 = {-7.0f, -7.0f}, kund = {F8_UNDO, F8_UNDO};
                        const f32x2 g = __builtin_elementwise_min(__builtin_elementwise_fma(ag, kund, vbg), k7), uu = __builtin_elementwise_min(__builtin_elementwise_max(__builtin_elementwise_fma(au, kund, vbu), km7), k7);
                        const f32x2 ea = g * (-1.702f * 1.4426950408889634f); f32x2 den; den.x = __builtin_amdgcn_exp2f(ea.x); den.y = __builtin_amdgcn_exp2f(ea.y); den = den + 1.0f;
                        f32x2 sg; sg.x = __builtin_amdgcn_rcpf(den.x); sg.y = __builtin_amdgcn_rcpf(den.y);
                        const f32x2 r = __builtin_elementwise_fma(uu, (f32x2){F8_ACT, F8_ACT}, (f32x2){F8_ACT, F8_ACT}) * (g * sg); o[n][2 * hq] = r.x; o[n][2 * hq + 1] = r.y; } }
                *(i32x2*)(A2 + (size_t)(row0 + ai * HALF + m * 16) * 1024 + jc) = pack8_fp8(o[0], o[1]);
                __builtin_amdgcn_sched_barrier(0); }
    }
};
struct EpiMoe2 {
    static constexpr bool PERM = true, AFTER_DRAIN = false, PROBE2 = (MK_EPI2V == 8), BIAS_LDS = true;
    unsigned char* Y2; const float* b2; int pm_mask; LAS unsigned char* bl; mutable int par = 0;
    __device__ __forceinline__ const float* bias_src(const Unit& u, int wc, int lane16, unsigned& voff) const { voff = (unsigned)((u.pn * BM + (lane16 >> 3) * HALF + wc * 32 + (lane16 & 7) * 4) * 4); return b2 + (size_t)u.e * 1024; }
    __device__ __forceinline__ void operator()(const f32x4 (&acc)[2][2][4][2], const Unit& u, int wr, int wc, int fr, int fq) const {
        asm volatile("" : "+v"(fr), "+v"(fq));
        const int row0 = (u.pm & pm_mask) * BM + wr * 64 + fr, col0 = u.pn * BM + wc * 32 + 8 * fq;
        f32x4 bv[2][2];
#pragma unroll
        for (int bj = 0; bj < 2; ++bj)
#pragma unroll
            for (int n = 0; n < 2; ++n) bv[bj][n] = *(const LAS f32x4*)(bl + par * 2048 + (wr * 4 + wc) * 256 + bj * 128 + fq * 32 + n * 16);
#pragma unroll
        for (int ai = 0; ai < 2; ++ai)
#pragma unroll
            for (int m = 0; m < 4; ++m) { unsigned char* rowp = Y2 + (size_t)(row0 + ai * HALF + m * 16) * 1024 + col0;
#pragma unroll
                for (int bj = 0; bj < 2; ++bj) *(i32x2*)(rowp + bj * HALF) = pack8_fp8((acc[ai][bj][m][0] * F8_UNDO + bv[bj][0]) * 8.0f, (acc[ai][bj][m][1] * F8_UNDO + bv[bj][1]) * 8.0f); }
    }
};

template <class E, class = void> struct epi_bias_lds { static constexpr bool value = false; };
template <class E> struct epi_bias_lds<E, decltype((void)E::BIAS_LDS)> { static constexpr bool value = E::BIAS_LDS; };
template <class E, class = void> struct epi_half_n { static constexpr bool value = false; };
template <class E> struct epi_half_n<E, decltype((void)E::HALF_N)> { static constexpr bool value = E::HALF_N; };
template <class Epi, class Sched, bool ALIGN_EPI, bool GATHER, bool F8 = false>
__device__ __forceinline__ void gemm_phase(LAS unsigned char* lds, const Gemm g, const Sched& S, const Epi& E, const int wave) {
    const int tid = wave * 64 + lane_id_opaque(), wid = __builtin_amdgcn_readfirstlane(tid >> 6), lane = tid & 63,
              wr = wid >> 2, wc = wid & 3, fr = lane & 15, fq = lane >> 4;
    const int nt = g.K / BK; constexpr bool HN = epi_half_n<Epi>::value; constexpr bool BL = epi_bias_lds<Epi>::value;
    unsigned voffB[2], vA[2][2];
#pragma unroll
    for (int i = 0; i < 2; ++i) { int R, C; stage_rc(tid * 16 + i * 8192, R, C); const int Rb = Epi::PERM ? ((R & ~31) + perm32(R & 31)) : R;
        voffB[i] = (unsigned)(Rb * g.ldb + C) * 2u;
#pragma unroll
        for (int h = 0; h < 2; ++h) vA[h][i] = (unsigned)((R + h * HALF) * g.lda + C) * 2u; }
    const size_t kstep = (size_t)(BK * 2);
    const size_t hstepB = (size_t)HALF * g.ldb * 2;
    const unsigned ldsw = (unsigned)wid * 1024u;
    const unsigned ldsbase = (unsigned)__builtin_amdgcn_readfirstlane((int)((unsigned)(uintptr_t)lds + ldsw));
    const int aoff = lds_byte(wr * 64 + fr, fq * 8), boff = lds_byte(wc * 32 + fr, fq * 8);
#define PG8_SA(b, h) (((b) * 2 + (h)) * HTB)
#define PG8_SB(b, h) ((4 + (b) * 2 + (h)) * HTB)
#define PG8_STAGE(bufoff, gbase, voff) do { if constexpr (F8) { _Pragma("unroll") for (int _i = 0; _i < 2; ++_i) { unsigned keep_; \
            asm volatile("s_mov_b32 %0, m0\n\ts_mov_b32 m0, %3\n\ts_nop 0\n\tglobal_load_lds_dwordx4 %1, %2\n\ts_mov_b32 m0, %0" : "=&s"(keep_) : "v"((voff)[_i]), "s"((const char*)(gbase)), "s"(ldsbase + (unsigned)((bufoff) + _i * 8192)) : "memory"); } } \
        else { _Pragma("unroll") for (int _i = 0; _i < 2; ++_i) \
        __builtin_amdgcn_global_load_lds((const unsigned*)((const char*)(gbase) + (voff)[_i]), (LAS unsigned*)(lds + (bufoff) + ldsw + _i * 8192), 16, 0, 0); } } while (0)
#define PG8_LDA(dst, b, h) do { if constexpr (F8) { _Pragma("unroll") for (int m = 0; m < 4; ++m) dst##8[m] = PG8_F8CAT(*(const LAS bf16x8*)(lds + PG8_SA(b, h) + aoff + m * 2048), *(const LAS bf16x8*)(lds + PG8_SA(b, h) + aoff + m * 2048 + 1024)); } \
        else { _Pragma("unroll") for (int m = 0; m < 4; ++m) _Pragma("unroll") for (int k = 0; k < 2; ++k) dst[m][k] = *(const LAS bf16x8*)(lds + PG8_SA(b, h) + aoff + m * 2048 + k * 1024); } } while (0)
#define PG8_LDB(dst, b, h) do { if constexpr (F8) { _Pragma("unroll") for (int n = 0; n < 2; ++n) dst##8[n] = PG8_F8CAT(*(const LAS bf16x8*)(lds + PG8_SB(b, h) + boff + n * 2048), *(const LAS bf16x8*)(lds + PG8_SB(b, h) + boff + n * 2048 + 1024)); } \
        else { _Pragma("unroll") for (int n = 0; n < 2; ++n) _Pragma("unroll") for (int k = 0; k < 2; ++k) dst[n][k] = *(const LAS bf16x8*)(lds + PG8_SB(b, h) + boff + n * 2048 + k * 1024); } } while (0)
#define PG8_F8CAT(lo, hi) __builtin_shufflevector(__builtin_bit_cast(i32x4, (lo)), __builtin_bit_cast(i32x4, (hi)), 0, 1, 2, 3, 4, 5, 6, 7)
#define PG8_MMA(ai, bj, At, Bt) do { __builtin_amdgcn_s_setprio(1); \
        if constexpr (F8) { _Pragma("unroll") for (int m = 0; m < 4; ++m) _Pragma("unroll") for (int n = 0; n < 2; ++n) \
            acc[ai][bj][m][n] = __builtin_amdgcn_mfma_scale_f32_16x16x128_f8f6f4(Bt##8[n], At##8[m], acc[ai][bj][m][n], 0, 0, 0, 0x7F7F7F7F, 0, 0x7F7F7F7F); } \
        else { _Pragma("unroll") for (int m = 0; m < 4; ++m) _Pragma("unroll") for (int n = 0; n < 2; ++n) _Pragma("unroll") for (int k = 0; k < 2; ++k) \
            acc[ai][bj][m][n] = __builtin_amdgcn_mfma_f32_16x16x32_bf16(Bt[n][k], At[m][k], acc[ai][bj][m][n], 0, 0, 0); } \
        __builtin_amdgcn_s_setprio(0); } while (0)
#define PG8_WAIT_V(n) asm volatile("s_waitcnt vmcnt(" #n ")" ::: "memory")
#define PG8_WAIT_L(n) asm volatile("s_waitcnt lgkmcnt(" #n ")" ::: "memory")
#define PG8_BAR __builtin_amdgcn_s_barrier()
#define PG8_SCHED __builtin_amdgcn_sched_barrier(0)
#define PG8_GOFF(u_, h, i) ({ const int tq_ = wid * 64 + lane_id_opaque(); int R_, C_; stage_rc(tq_ * 16 + (i) * 8192, R_, C_); S.rowoff((u_), (h) * HALF + R_) + (unsigned)C_ * 2u; })
    Unit cur, nxt; int ui = 0;
    if (!S.next(0, cur)) return;
#define PG8_BIAS_DMA(u_, par_) do { const int tl_ = lane_id_opaque(); unsigned bvo_; const float* bsrc0_ = E.bias_src((u_), wc, tl_ & 15, bvo_); \
        const uintptr_t bq_ = (uintptr_t)bsrc0_; const char* bsrc_ = (const char*)(((uintptr_t)(unsigned)__builtin_amdgcn_readfirstlane((int)(unsigned)(bq_ >> 32)) << 32) | (uintptr_t)(unsigned)__builtin_amdgcn_readfirstlane((int)(unsigned)bq_)); \
        const unsigned bdst_ = (unsigned)__builtin_amdgcn_readfirstlane((int)((unsigned)(uintptr_t)E.bl + (unsigned)(par_) * 2048u + (unsigned)wid * 256u)); \
        if (tl_ < 16) { unsigned keep_; \
            asm volatile("s_mov_b32 %0, m0\n\ts_mov_b32 m0, %3\n\ts_nop 0\n\tglobal_load_lds_dwordx4 %1, %2\n\ts_mov_b32 m0, %0" : "=&s"(keep_) : "v"(bvo_), "s"(bsrc_), "s"(bdst_) : "memory"); } } while (0)
    if constexpr (BL) PG8_BIAS_DMA(cur, 0);
    if constexpr (GATHER) {
#pragma unroll
        for (int h = 0; h < 2; ++h)
#pragma unroll
            for (int i = 0; i < 2; ++i) vA[h][i] = PG8_GOFF(0, h, i);
    }
    f32x4 acc[2][2][4][2];
#pragma unroll
    for (int a = 0; a < 2; ++a)
#pragma unroll
        for (int b = 0; b < 2; ++b)
#pragma unroll
            for (int m = 0; m < 4; ++m)
#pragma unroll
                for (int n = 0; n < 2; ++n) acc[a][b][m][n] = (f32x4){0.f, 0.f, 0.f, 0.f};
    bf16x8 At[4][2], B0[2][2], B1[2][2]; i32x8 At8[4], B08[2], B18[2];
    const char* cA = (const char*)g.A + S.aoff(cur); const char* cB = (const char*)g.Bt + S.boff(cur);
    PG8_STAGE(PG8_SB(0, 0), cB, voffB); PG8_STAGE(PG8_SB(0, 1), cB + hstepB, voffB); PG8_STAGE(PG8_SA(0, 0), cA, vA[0]); PG8_STAGE(PG8_SA(0, 1), cA, vA[1]);
    if (wr == 1) PG8_BAR;
    PG8_WAIT_V(2); PG8_BAR;
    PG8_STAGE(PG8_SB(1, 0), cB + kstep, voffB); PG8_STAGE(PG8_SA(1, 0), cA + kstep, vA[0]); PG8_STAGE(PG8_SB(1, 1), cB + hstepB + kstep, voffB);
    PG8_WAIT_V(6); PG8_BAR;
    for (;;) {
        const bool has_next = S.next(ui + 1, nxt);
        const char* nA = has_next ? (const char*)g.A + S.aoff(nxt) : cA; const char* nB = has_next ? (const char*)g.Bt + S.boff(nxt) : cB;
#pragma unroll 1
        for (int t = 0; t < nt; t += 2) {
            const bool last = (t == nt - 2);
            const char* a1 = cA + (size_t)(t + 1) * kstep;
            const char* a2 = last ? nA : cA + (size_t)(t + 2) * kstep; const char* b2 = last ? nB : cB + (size_t)(t + 2) * kstep;
            const char* a3 = a2 + kstep; const char* b3 = b2 + kstep;
            unsigned w0[2], w1[2];
            if constexpr (GATHER) { const bool nx_ = last && has_next;
                if (nx_) { w0[0] = PG8_GOFF(ui + 1, 0, 0); w0[1] = PG8_GOFF(ui + 1, 0, 1); w1[0] = PG8_GOFF(ui + 1, 1, 0); w1[1] = PG8_GOFF(ui + 1, 1, 1); }
                else { w0[0] = vA[0][0]; w0[1] = vA[0][1]; w1[0] = vA[1][0]; w1[1] = vA[1][1]; } }
            else { w0[0] = vA[0][0]; w0[1] = vA[0][1]; w1[0] = vA[1][0]; w1[1] = vA[1][1]; }
            PG8_LDB(B0, 0, 0); if constexpr (!HN) PG8_LDB(B1, 0, 1); PG8_SCHED; PG8_LDA(At, 0, 0); PG8_STAGE(PG8_SA(1, 1), a1, vA[1]);
            PG8_WAIT_V(8); PG8_WAIT_L(0); PG8_BAR; PG8_MMA(0, 0, At, B0); if constexpr (!HN) PG8_MMA(0, 1, At, B1); PG8_BAR; PG8_SCHED;
            PG8_LDA(At, 0, 1); PG8_STAGE(PG8_SB(0, 0), b2, voffB); PG8_STAGE(PG8_SB(0, 1), b2 + hstepB, voffB); PG8_STAGE(PG8_SA(0, 0), a2, w0);
            PG8_WAIT_V(8); PG8_WAIT_L(0); PG8_BAR; PG8_MMA(1, 0, At, B0); if constexpr (!HN) PG8_MMA(1, 1, At, B1); PG8_BAR; PG8_SCHED;
            PG8_LDB(B0, 1, 0); if constexpr (!HN) PG8_LDB(B1, 1, 1); PG8_SCHED; PG8_LDA(At, 1, 0); PG8_STAGE(PG8_SA(0, 1), a2, w1);
            PG8_WAIT_V(8); PG8_WAIT_L(0); PG8_BAR; PG8_MMA(0, 0, At, B0); if constexpr (!HN) PG8_MMA(0, 1, At, B1); PG8_BAR; PG8_SCHED;
            PG8_LDA(At, 1, 1); PG8_STAGE(PG8_SB(1, 0), b3, voffB); PG8_STAGE(PG8_SB(1, 1), b3 + hstepB, voffB); PG8_STAGE(PG8_SA(1, 0), a3, w0);
            PG8_WAIT_V(8); PG8_WAIT_L(0); PG8_BAR; PG8_MMA(1, 0, At, B0); if constexpr (!HN) PG8_MMA(1, 1, At, B1); PG8_BAR; PG8_SCHED;
        }
        if constexpr (ALIGN_EPI) { if (wr == 0) PG8_BAR; }
        if constexpr (BL) { if (has_next) PG8_BIAS_DMA(nxt, (ui + 1) & 1); }
        if constexpr (!Epi::AFTER_DRAIN) { const int te_ = lane_id_opaque(); const int fre = te_ & 15, fqe = (te_ >> 4) & 3;
            if constexpr (BL) E.par = ui & 1;
            E(acc, cur, wr, wc, fre, fqe);
#ifdef MK_EPI2
            if constexpr (Epi::PROBE2) { asm volatile("" ::: "memory"); E(acc, cur, wr, wc, fr, fq); }
#endif
        }
        if (!has_next) break;
#pragma unroll
        for (int a = 0; a < 2; ++a)
#pragma unroll
            for (int b = 0; b < 2; ++b)
#pragma unroll
                for (int m = 0; m < 4; ++m)
#pragma unroll
                    for (int n = 0; n < 2; ++n) acc[a][b][m][n] = (f32x4){0.f, 0.f, 0.f, 0.f};
        cur = nxt; cA = nA; cB = nB; ++ui;
        if constexpr (GATHER) {
#pragma unroll
            for (int h = 0; h < 2; ++h)
#pragma unroll
                for (int i = 0; i < 2; ++i) vA[h][i] = PG8_GOFF(ui, h, i);
        }
        if constexpr (ALIGN_EPI) { if (wr == 1) PG8_BAR; }
    }
    PG8_WAIT_V(0);
    if constexpr (!ALIGN_EPI) { if (wr == 0) PG8_BAR; }
    PG8_BAR;
    if constexpr (Epi::AFTER_DRAIN) { E.fused(acc, cur, wr, wc, fr, fq, lds, wid, lane); }
#undef PG8_BIAS_DMA
#undef PG8_SA
#undef PG8_SB
#undef PG8_STAGE
#undef PG8_LDA
#undef PG8_LDB
#undef PG8_MMA
#undef PG8_GOFF
#undef PG8_F8CAT
#undef PG8_WAIT_V
#undef PG8_WAIT_L
#undef PG8_BAR
#undef PG8_SCHED
}
}

namespace attn_body {
using bf16=__hip_bfloat16;
using bf16x8=__attribute__((ext_vector_type(8)))short;
using s16x4=__attribute__((ext_vector_type(4)))short;
using f32x16=__attribute__((ext_vector_type(16)))float;
using u32x4=__attribute__((ext_vector_type(4)))unsigned;
constexpr int SEQ=4096,D=64,DMI=512,DMO=1024;
constexpr int NW=8,QBLK=32,QB=QBLK*NW,KVBLK=64,NQB=SEQ/QB;
__device__ __forceinline__ int crow(int r,int hi){return (r&3)+8*(r>>2)+4*hi;}
#define SBAR() __builtin_amdgcn_sched_barrier(0)
__device__ __forceinline__ void cmask(f32x16&p0,f32x16&p1,int jb,int qrel,int hi){
  const float NEG=-INFINITY; int kb=64*jb+4*hi;
  #pragma unroll
  for(int r=0;r<16;++r){int kv=kb+(r&3)+8*(r>>2); if(kv>qrel)p0[r]=NEG; if(kv+32>qrel)p1[r]=NEG;}
}
constexpr int NSLOT=3, SLOTB=8192;
constexpr int LDS_K=0, LDS_V=NSLOT*SLOTB, LDS_WS=2*NSLOT*SLOTB, LDS_OST=LDS_WS+NW*64*4, LDS_BYTES=LDS_OST+NW*4096;
constexpr float C2=0.125f*1.4426950408889634f;
__device__ __forceinline__ void glds16(const void*gsrc,unsigned lds_dst){unsigned keep;
  asm volatile("s_mov_b32 %0, m0\n\ts_mov_b32 m0, %2\n\ts_nop 0\n\tglobal_load_lds_dwordx4 %1, off\n\ts_mov_b32 m0, %0":"=&s"(keep):"v"(gsrc),"s"(lds_dst):"memory");}
__device__ __forceinline__ float max3f(float a,float b,float c){float r;asm("v_max3_f32 %0, %1, %2, %3":"=v"(r):"v"(a),"v"(b),"v"(c));return r;}
__device__ __forceinline__ float max2f(float a,float b){float r;asm("v_max_f32_e32 %0, %1, %2":"=v"(r):"v"(a),"v"(b));return r;}
__device__ __forceinline__ float fadd_s(float a,float b){float r;asm("v_add_f32_e32 %0, %1, %2":"=v"(r):"v"(a),"v"(b));return r;}
__device__ __forceinline__ float fsub_s(float a,float b){float r;asm("v_sub_f32_e32 %0, %1, %2":"=v"(r):"v"(a),"v"(b));return r;}
typedef float f32x2_t __attribute__((ext_vector_type(2))); typedef __bf16 bf16x2_t __attribute__((ext_vector_type(2)));
__device__ __forceinline__ unsigned cvtpk_s(float lo,float hi){f32x2_t v={lo,hi};bf16x2_t b=__builtin_convertvector(v,bf16x2_t);return __builtin_bit_cast(unsigned,b);}
#define WAIT_BAR(N) asm volatile("s_waitcnt vmcnt(" #N ") lgkmcnt(0)\n\ts_barrier":::"memory")

__device__ __forceinline__ void qkt(f32x16&p0,f32x16&p1,const char*Kslot,const bf16x8*qr,const f32x16&negm,int r32,int hi){
  const char*kb=Kslot+hi*1024+r32*16;
  #pragma unroll
  for(int d0=0;d0<4;++d0){
    const bf16x8 b0=*reinterpret_cast<const bf16x8*>(kb+d0*2048);
    const bf16x8 b1=*reinterpret_cast<const bf16x8*>(kb+d0*2048+512);
    if(d0==0){p0=__builtin_amdgcn_mfma_f32_32x32x16_bf16(b0,qr[0],negm,0,0,0);p1=__builtin_amdgcn_mfma_f32_32x32x16_bf16(b1,qr[0],negm,0,0,0);}
    else{p0=__builtin_amdgcn_mfma_f32_32x32x16_bf16(b0,qr[d0],p0,0,0,0);p1=__builtin_amdgcn_mfma_f32_32x32x16_bf16(b1,qr[d0],p1,0,0,0);}}
}
typedef __attribute__((address_space(3))) const char* lds_cptr;
typedef short v4i16_t __attribute__((ext_vector_type(4)));
__device__ __forceinline__ void kload8(bf16x8*kf,lds_cptr kp){
  kf[0]=*(const __attribute__((address_space(3))) bf16x8*)(kp);      kf[1]=*(const __attribute__((address_space(3))) bf16x8*)(kp+512);
  kf[2]=*(const __attribute__((address_space(3))) bf16x8*)(kp+2048); kf[3]=*(const __attribute__((address_space(3))) bf16x8*)(kp+2560);
  kf[4]=*(const __attribute__((address_space(3))) bf16x8*)(kp+4096); kf[5]=*(const __attribute__((address_space(3))) bf16x8*)(kp+4608);
  kf[6]=*(const __attribute__((address_space(3))) bf16x8*)(kp+6144); kf[7]=*(const __attribute__((address_space(3))) bf16x8*)(kp+6656);
}
__device__ __forceinline__ void kload2(bf16x8*kf,lds_cptr kp,int j){ kf[2*j]=*(const __attribute__((address_space(3))) bf16x8*)(kp+j*2048); kf[2*j+1]=*(const __attribute__((address_space(3))) bf16x8*)(kp+j*2048+512); }
__device__ __forceinline__ s16x4 vtr(lds_cptr p){ return __builtin_bit_cast(s16x4,__builtin_amdgcn_ds_read_tr16_b64_v4i16((__attribute__((address_space(3))) v4i16_t*)p)); }
__device__ __forceinline__ float rowmax(const f32x16&p0,const f32x16&p1){
  float a=max3f(p0[0],p0[1],p1[0]),b=max3f(p0[2],p0[3],p1[1]);a=max3f(a,p1[2],p1[3]);
  #pragma unroll
  for(int r=4;r<16;r+=4){a=max3f(a,p0[r],p0[r+1]);b=max3f(b,p0[r+2],p0[r+3]);a=max3f(a,p1[r],p1[r+1]);b=max3f(b,p1[r+2],p1[r+3]);}
  const float m=max2f(a,b);
  auto rr=__builtin_amdgcn_permlane32_swap(__float_as_uint(m),__float_as_uint(m),false,false);
  return max2f(__uint_as_float(rr[0]),__uint_as_float(rr[1]));
}
__device__ __forceinline__ void pv(f32x16*o,int vb,bf16x8 pa0,bf16x8 pa1,bf16x8 pa2,bf16x8 pa3){
  #pragma unroll
  for(int d0=0;d0<2;++d0){s16x4 lo[4],hi[4];
    #pragma unroll
    for(int ks=0;ks<4;++ks){
      asm volatile("ds_read_b64_tr_b16 %0,%1 offset:%c2":"=&v"(lo[ks]):"v"(vb),"i"(d0*4096+ks*1024):"memory");
      asm volatile("ds_read_b64_tr_b16 %0,%1 offset:%c2":"=&v"(hi[ks]):"v"(vb),"i"(d0*4096+ks*1024+512):"memory");}
    asm volatile("s_waitcnt lgkmcnt(0)":::"memory");SBAR();
    #define PK(k) (bf16x8){lo[k][0],lo[k][1],lo[k][2],lo[k][3],hi[k][0],hi[k][1],hi[k][2],hi[k][3]}
    o[d0]=__builtin_amdgcn_mfma_f32_32x32x16_bf16(pa0,PK(0),o[d0],0,0,0);
    o[d0]=__builtin_amdgcn_mfma_f32_32x32x16_bf16(pa1,PK(1),o[d0],0,0,0);
    o[d0]=__builtin_amdgcn_mfma_f32_32x32x16_bf16(pa2,PK(2),o[d0],0,0,0);
    o[d0]=__builtin_amdgcn_mfma_f32_32x32x16_bf16(pa3,PK(3),o[d0],0,0,0);
    #undef PK
  }
}
#define ATTN_STORE16(p,v) (*(u32x4*)(p)=(v))
template<int THRL> __device__ __forceinline__ void attn_unit(int qb,const bf16*Qh,const bf16*__restrict__ Kh,const bf16*__restrict__ Vh,bf16*Oh,char*shm){
  int tid_=threadIdx.x; asm volatile("":"+v"(tid_));
  const int tid=tid_,lane=tid&63,r32=lane&31,hi=lane>>5; const int wid=__builtin_amdgcn_readfirstlane(tid>>6);
  const int q0=qb*QB;
  const bf16*Qw=Qh+(long)(q0+wid*QBLK)*DMI;
  const unsigned lds0=(unsigned)(uintptr_t)shm;
  float*wsf=(float*)(shm+LDS_WS)+wid*64;
  const bf16*ksrc=Kh+(long)lane*DMI+wid*8;
  const bf16*vsrc=Vh+(long)(16*(wid&3)+(lane>>2))*DMI+(wid>>2)*32+(lane&3)*8;
  const unsigned kdst=lds0+LDS_K+wid*1024, vdst=lds0+LDS_V+wid*1024;
  #define DMA_K(t,slot) glds16(ksrc+(long)(t)*KVBLK*DMI,(unsigned)__builtin_amdgcn_readfirstlane(kdst+(slot)))
  #define DMA_V(t,slot) glds16(vsrc+(long)(t)*KVBLK*DMI,(unsigned)__builtin_amdgcn_readfirstlane(vdst+(slot)))
  const int vb0=(int)(lds0+LDS_V)+((lane>>4)&1)*32+(lane&3)*8+(4*hi+((lane&15)>>2))*64;
  const char*Kbase=shm+LDS_K; bf16x8 kf[8];
  const lds_cptr shm3=(lds_cptr)shm; const lds_cptr kp0=shm3+LDS_K+hi*1024+r32*16; const lds_cptr vp0=shm3+LDS_V+((lane>>4)&1)*32+(lane&3)*8+(4*hi+((lane&15)>>2))*64;
  const int NT=(q0+QB)/KVBLK;
  DMA_K(0,0);DMA_V(0,0);DMA_K(1,SLOTB);
  bf16x8 qr[4];
  #pragma unroll
  for(int d0=0;d0<4;++d0)qr[d0]=*reinterpret_cast<const bf16x8*>(&Qw[(long)r32*DMI+d0*16+hi*8]);
  float mhat=0.f,l_reg=0.f;f32x16 o[2];o[0]=f32x16{};o[1]=f32x16{};f32x16 negm=f32x16{};asm volatile("":"+v"(negm));
  const int qrel=wid*QBLK+r32;
  #define CMASK(P0,P1,t) do{int jb_=(t)-(NT-4); if(jb_>=0)cmask(P0,P1,jb_,qrel,hi);}while(0)
  bool resc=false;
  #define START(P0,P1) do{ const float rm=rowmax(P0,P1); resc=false; \
    { const float dl=rm; mhat=fadd_s(mhat,dl); \
      _Pragma("unroll") for(int r=0;r<16;++r){P0[r]=fsub_s(P0[r],dl);P1[r]=fsub_s(P1[r],dl);} \
      _Pragma("unroll") for(int r=0;r<16;++r)negm[r]=-mhat; asm volatile("":"+v"(negm)); } \
    _Pragma("unroll") for(int r=0;r<16;++r)P0[r]=__builtin_amdgcn_exp2f(P0[r]); }while(0)
  #define RESC() do{ if(resc){ asm volatile("s_waitcnt lgkmcnt(0)":::"memory"); \
      _Pragma("unroll") for(int d_=0;d_<2;++d_) _Pragma("unroll") for(int r=0;r<16;++r)o[d_][r]*=wsf[crow(r,hi)]; } }while(0)
  f32x16 pA0,pA1,pB0,pB1;
  int sl_prev=0,sl_cur=0,sl_next=SLOTB;
  #define ROT() do{sl_prev=sl_cur;sl_cur=sl_next;sl_next=(sl_next==(NSLOT-1)*SLOTB)?0:sl_next+SLOTB;}while(0)
  DMA_K(2,2*SLOTB);
  WAIT_BAR(3);
  qkt(pA0,pA1,Kbase,qr,negm,r32,hi);asm volatile("s_nop 15\n\ts_nop 7":"+v"(pA0),"+v"(pA1));CMASK(pA0,pA1,0);
  START(pA0,pA1);
  _Pragma("unroll") for(int r=0;r<16;++r)pA1[r]=__builtin_amdgcn_exp2f(pA1[r]);
  WAIT_BAR(0);
  DMA_K(3,0);DMA_V(1,SLOTB);
  ROT();
  kload8(kf,kp0+sl_cur);
  WAIT_BAR(2);
  s16x4 vlo[8],vhi[8]; u32x4 pw0,pw1,pw2,pw3;
  #define PKW(P,B) cvtpk_s(P[B],P[B+1])
  #define PAF(k) __builtin_bit_cast(bf16x8,pw##k)
  #define VFR(i) (bf16x8){vlo[i][0],vlo[i][1],vlo[i][2],vlo[i][3],vhi[i][0],vhi[i][1],vhi[i][2],vhi[i][3]}
  #define PIN(x) asm volatile("":"+v"(x))
  #define MX3(a,b,c) __builtin_fmaxf(__builtin_fmaxf((a),(b)),(c))
  #define GAPA(MF,A0,A1,A2,A3,W0,W1,PW) do{ MF; sacc+=A0; sacc+=A1; sacc+=A2; sacc+=A3; PIN(sacc); W0; W1; PIN(PW); SBAR(); }while(0)
  #define EX(v) __builtin_amdgcn_exp2f(v)
  #define GAPB(MF,X,B) do{ MF; X[B]=EX(X[B]); X[B+1]=EX(X[B+1]); X[B+2]=EX(X[B+2]); X[B+3]=EX(X[B+3]); PIN(X); SBAR(); }while(0)
  #define VRD(i) do{ vlo[i]=vtr(vp_+(((i)>>2)*4096+((i)&3)*1024)); vhi[i]=vtr(vp_+(((i)>>2)*4096+((i)&3)*1024+512)); }while(0)
  #define KRD(G,j) do{ if(G){ kload2(kf,kp0+sl_next,j); SBAR(); } }while(0)
  #define STEP(C0,C1,P0,P1,t,GK,GV,GL) do{ SBAR(); \
    const lds_cptr vp_=vp0+sl_prev; \
    VRD(0); SBAR(); float sacc=(P0[0]+P0[1]); \
    GAPA(C0=__builtin_amdgcn_mfma_f32_32x32x16_bf16(kf[0],qr[0],negm,0,0,0), P0[2],P0[3],P0[4],P0[5],     pw0[0]=PKW(P0,0), pw0[1]=PKW(P0,2), pw0); \
    VRD(4); SBAR(); GAPA(C1=__builtin_amdgcn_mfma_f32_32x32x16_bf16(kf[1],qr[0],negm,0,0,0), P0[6],P0[7],P0[8],P0[9],     pw0[2]=PKW(P0,4), pw0[3]=PKW(P0,6), pw0); \
    VRD(1); SBAR(); GAPA(C0=__builtin_amdgcn_mfma_f32_32x32x16_bf16(kf[2],qr[1],C0,0,0,0),   P0[10],P0[11],P0[12],P0[13], pw1[0]=PKW(P0,8), pw1[1]=PKW(P0,10), pw1); \
    VRD(5); SBAR(); GAPA(C1=__builtin_amdgcn_mfma_f32_32x32x16_bf16(kf[3],qr[1],C1,0,0,0),   P0[14],P0[15],P1[0],P1[1],   pw1[2]=PKW(P0,12),pw1[3]=PKW(P0,14), pw1); \
    VRD(2); SBAR(); GAPA(C0=__builtin_amdgcn_mfma_f32_32x32x16_bf16(kf[4],qr[2],C0,0,0,0),   P1[2],P1[3],P1[4],P1[5],     pw2[0]=PKW(P1,0), pw2[1]=PKW(P1,2), pw2); \
    VRD(6); SBAR(); GAPA(C1=__builtin_amdgcn_mfma_f32_32x32x16_bf16(kf[5],qr[2],C1,0,0,0),   P1[6],P1[7],P1[8],P1[9],     pw2[2]=PKW(P1,4), pw2[3]=PKW(P1,6), pw2); \
    VRD(3); SBAR(); GAPA(C0=__builtin_amdgcn_mfma_f32_32x32x16_bf16(kf[6],qr[3],C0,0,0,0),   P1[10],P1[11],P1[12],P1[13], pw3[0]=PKW(P1,8), pw3[1]=PKW(P1,10), pw3); \
    VRD(7); SBAR(); GAPA(C1=__builtin_amdgcn_mfma_f32_32x32x16_bf16(kf[7],qr[3],C1,0,0,0),   P1[14],P1[15],0.f,0.f,       pw3[2]=PKW(P1,12),pw3[3]=PKW(P1,14), pw3); \
    l_reg+=sacc; \
    if(GK){DMA_K((t)+3,sl_cur);} if(GV){DMA_V((t)+1,sl_next);} \
    CMASK(C0,C1,t); \
    { float a=MX3(C0[0],C0[1],C1[0]),b=MX3(C0[2],C0[3],C1[1]); a=MX3(a,C1[2],C1[3]); \
      _Pragma("unroll") for(int r=4;r<16;r+=4){a=MX3(a,C0[r],C0[r+1]);b=MX3(b,C0[r+2],C0[r+3]);a=MX3(a,C1[r],C1[r+1]);b=MX3(b,C1[r+2],C1[r+3]);} \
      float rm=__builtin_fmaxf(a,b); { auto rr=__builtin_amdgcn_permlane32_swap(__float_as_uint(rm),__float_as_uint(rm),false,false); rm=__builtin_fmaxf(__uint_as_float(rr[0]),__uint_as_float(rr[1])); } \
      resc=false; \
      if(__builtin_expect(__any(rm>(float)THRL),0)){ const float dl=__builtin_fmaxf(rm,0.f); mhat+=dl; \
        _Pragma("unroll") for(int r=0;r<16;++r){C0[r]-=dl;C1[r]-=dl;} \
        _Pragma("unroll") for(int r=0;r<16;++r)negm[r]=-mhat; asm volatile("":"+v"(negm)); \
        const float f=__builtin_amdgcn_exp2f(-dl); l_reg*=f; if(hi==0)wsf[r32]=f; resc=true; } } \
    SBAR(); \
    GAPB(o[0]=__builtin_amdgcn_mfma_f32_32x32x16_bf16(PAF(0),VFR(0),o[0],0,0,0), C0,0); \
    GAPB(o[1]=__builtin_amdgcn_mfma_f32_32x32x16_bf16(PAF(0),VFR(4),o[1],0,0,0), C0,4); \
    KRD(GL,0); GAPB(o[0]=__builtin_amdgcn_mfma_f32_32x32x16_bf16(PAF(1),VFR(1),o[0],0,0,0), C0,8); \
    KRD(GL,1); GAPB(o[1]=__builtin_amdgcn_mfma_f32_32x32x16_bf16(PAF(1),VFR(5),o[1],0,0,0), C0,12); \
    KRD(GL,2); GAPB(o[0]=__builtin_amdgcn_mfma_f32_32x32x16_bf16(PAF(2),VFR(2),o[0],0,0,0), C1,0); \
    KRD(GL,3); GAPB(o[1]=__builtin_amdgcn_mfma_f32_32x32x16_bf16(PAF(2),VFR(6),o[1],0,0,0), C1,4); \
    GAPB(o[0]=__builtin_amdgcn_mfma_f32_32x32x16_bf16(PAF(3),VFR(3),o[0],0,0,0), C1,8); \
    GAPB(o[1]=__builtin_amdgcn_mfma_f32_32x32x16_bf16(PAF(3),VFR(7),o[1],0,0,0), C1,12); \
    }while(0)
  int t=1;
  #undef CMASK
  #define CMASK(P0,P1,t) do{}while(0)
  for(;t+5<NT;t+=2){
    STEP(pB0,pB1,pA0,pA1,t,true,true,true);     WAIT_BAR(2); RESC(); ROT();
    STEP(pA0,pA1,pB0,pB1,t+1,true,true,true);   WAIT_BAR(2); RESC(); ROT();
  }
  #undef CMASK
  #define CMASK(P0,P1,t) do{int jb_=(t)-(NT-4); if(jb_>=0)cmask(P0,P1,jb_,qrel,hi);}while(0)
  #define ENDW(tt) do{ if((tt)+3<NT){WAIT_BAR(2);} else if((tt)+2<NT){WAIT_BAR(1);} else {WAIT_BAR(0);} }while(0)
  for(;t+1<NT;t+=2){
    STEP(pB0,pB1,pA0,pA1,t,(t+3<NT),(t+1<NT),(t+1<NT));       ENDW(t);   RESC(); ROT();
    STEP(pA0,pA1,pB0,pB1,t+1,(t+4<NT),(t+2<NT),(t+2<NT));     ENDW(t+1); RESC(); ROT();
  }
  STEP(pB0,pB1,pA0,pA1,NT-1,false,false,false); RESC();
  { float sacc=pB0[0]+pB0[1]; _Pragma("unroll") for(int r=2;r<16;++r)sacc+=pB0[r]; _Pragma("unroll") for(int r=0;r<16;++r)sacc+=pB1[r]; l_reg+=sacc;
    pw0=(u32x4){PKW(pB0,0),PKW(pB0,2),PKW(pB0,4),PKW(pB0,6)};pw1=(u32x4){PKW(pB0,8),PKW(pB0,10),PKW(pB0,12),PKW(pB0,14)};pw2=(u32x4){PKW(pB1,0),PKW(pB1,2),PKW(pB1,4),PKW(pB1,6)};pw3=(u32x4){PKW(pB1,8),PKW(pB1,10),PKW(pB1,12),PKW(pB1,14)};
    SBAR(); pv(o,vb0+sl_cur,PAF(0),PAF(1),PAF(2),PAF(3)); }
  #undef PKW
  #undef PAF
  #undef VFR
  #undef PIN
  #undef MX3
  #undef GAPA
  #undef GAPB
  #undef EX
  #undef VRD
  #undef KRD
  #undef STEP
  #undef ENDW
  {auto rr=__builtin_amdgcn_permlane32_swap(__float_as_uint(l_reg),__float_as_uint(l_reg),false,false);l_reg=__uint_as_float(rr[0])+__uint_as_float(rr[1]);}
  if(hi==0)wsf[32+r32]=l_reg;asm volatile("s_waitcnt lgkmcnt(0)":::"memory");
  float rli[16];
  #pragma unroll
  for(int r=0;r<16;++r)rli[r]=__builtin_amdgcn_rcpf(wsf[32+crow(r,hi)]);
  bf16*Ow=Oh+(long)(q0+wid*QBLK)*DMO;
  { bf16*stg=(bf16*)(shm+LDS_OST)+wid*2048;
    #pragma unroll
    for(int r=0;r<16;++r){const int orow=crow(r,hi);
      #pragma unroll
      for(int d0=0;d0<2;++d0)stg[orow*64+d0*32+r32]=__float2bfloat16(o[d0][r]*rli[r]);}
    asm volatile("s_waitcnt lgkmcnt(0)":::"memory");
    #pragma unroll
    for(int i=0;i<4;++i){const int row=i*8+(lane>>3),ch=lane&7; const u32x4 v=*(const u32x4*)(stg+row*64+ch*8); ATTN_STORE16(Ow+(long)row*DMO+ch*8,v);} }
  asm volatile("s_waitcnt lgkmcnt(0)\n\ts_barrier":::"memory");
  #undef DMA_K
  #undef DMA_V
  #undef CMASK
  #undef START
  #undef RESC
  #undef ROT
}
constexpr int LDS2_K=0, LDS2_V=4*SLOTB, LDS2_WS=LDS2_V+NSLOT*2*SLOTB, LDS2_OST=LDS2_WS+NW*64*4, LDS2_BYTES=LDS2_OST+NW*8192;
__device__ __forceinline__ void pv4(f32x16*o,int vb,bf16x8 pa0,bf16x8 pa1,bf16x8 pa2,bf16x8 pa3){
  #pragma unroll
  for(int d0=0;d0<4;++d0){s16x4 lo[4],hi[4];
    #pragma unroll
    for(int ks=0;ks<4;++ks){
      asm volatile("ds_read_b64_tr_b16 %0,%1 offset:%c2":"=&v"(lo[ks]):"v"(vb),"i"(d0*4096+ks*1024):"memory");
      asm volatile("ds_read_b64_tr_b16 %0,%1 offset:%c2":"=&v"(hi[ks]):"v"(vb),"i"(d0*4096+ks*1024+512):"memory");}
    asm volatile("s_waitcnt lgkmcnt(0)":::"memory");SBAR();
    #define PK(k) (bf16x8){lo[k][0],lo[k][1],lo[k][2],lo[k][3],hi[k][0],hi[k][1],hi[k][2],hi[k][3]}
    o[d0]=__builtin_amdgcn_mfma_f32_32x32x16_bf16(pa0,PK(0),o[d0],0,0,0);
    o[d0]=__builtin_amdgcn_mfma_f32_32x32x16_bf16(pa1,PK(1),o[d0],0,0,0);
    o[d0]=__builtin_amdgcn_mfma_f32_32x32x16_bf16(pa2,PK(2),o[d0],0,0,0);
    o[d0]=__builtin_amdgcn_mfma_f32_32x32x16_bf16(pa3,PK(3),o[d0],0,0,0);
    #undef PK
  }
}
template<int THRL> __device__ __forceinline__ void attn_unit2(int qb,const bf16*Qh,const bf16*__restrict__ Kh,const bf16*__restrict__ Vh,bf16*Oh,char*shm,const int wave){
  const int tid=wave*64+lane_id_opaque(),lane=tid&63,r32=lane&31,hi=lane>>5; const int wid=__builtin_amdgcn_readfirstlane(tid>>6);
  const int q0=qb*QB;
  const bf16*Qw=Qh+(long)(q0+wid*QBLK)*DMI;
  const unsigned lds0=(unsigned)(uintptr_t)shm;
  float*wsf=(float*)(shm+LDS2_WS)+wid*64;
  const bf16*ksrc=Kh+(long)lane*DMI+wid*8;
  const bf16*vsrc=Vh+(long)(16*(wid&3)+(lane>>2))*DMI+(wid>>2)*32+(lane&3)*8;
  const unsigned kdst=lds0+LDS2_K+wid*1024, vdst=lds0+LDS2_V+(wid>>2)*4096+(wid&3)*1024;
  #define DMA_K(t,slot) glds16(ksrc+(long)(t)*KVBLK*DMI,(unsigned)__builtin_amdgcn_readfirstlane(kdst+(slot)))
  #define DMA_V(t,slot) do{ glds16(vsrc+(long)(t)*KVBLK*DMI,(unsigned)__builtin_amdgcn_readfirstlane(vdst+2*(slot))); glds16(vsrc+(long)(t)*KVBLK*DMI+64,(unsigned)__builtin_amdgcn_readfirstlane(vdst+2*(slot)+8192)); }while(0)
  const int vb0=(int)(lds0+LDS2_V)+((lane>>4)&1)*32+(lane&3)*8+(4*hi+((lane&15)>>2))*64;
  const char*Kbase=shm+LDS2_K; bf16x8 kf[8];
  const lds_cptr shm3=(lds_cptr)shm; const lds_cptr kp0=shm3+LDS2_K+hi*1024+r32*16; const lds_cptr vp0=shm3+LDS2_V+((lane>>4)&1)*32+(lane&3)*8+(4*hi+((lane&15)>>2))*64;
  const int NT=(q0+QB)/KVBLK;
  DMA_K(0,0);DMA_V(0,0);DMA_K(1,SLOTB);DMA_K(2,2*SLOTB);
  bf16x8 qr[4];
  #pragma unroll
  for(int d0=0;d0<4;++d0)qr[d0]=*reinterpret_cast<const bf16x8*>(&Qw[(long)r32*DMI+d0*16+hi*8]);
  float zf_=0.f; asm volatile("":"+v"(zf_)); f32x16 zz_; _Pragma("unroll") for(int r=0;r<16;++r)zz_[r]=zf_;
  float mhat=0.f,l_reg=0.f;f32x16 o[4];o[0]=zz_;o[1]=zz_;o[2]=zz_;o[3]=zz_;f32x16 negm=zz_;asm volatile("":"+v"(negm));
  const int qrel=wid*QBLK+r32;
  #define CMASK(P0,P1,t) do{int jb_=(t)-(NT-4); if(jb_>=0)cmask(P0,P1,jb_,qrel,hi);}while(0)
  bool resc=false;
  #define START(P0,P1) do{ const float rm=rowmax(P0,P1); resc=false; \
    { const float dl=rm; mhat=fadd_s(mhat,dl); \
      _Pragma("unroll") for(int r=0;r<16;++r){P0[r]=fsub_s(P0[r],dl);P1[r]=fsub_s(P1[r],dl);} \
      _Pragma("unroll") for(int r=0;r<16;++r)negm[r]=-mhat; asm volatile("":"+v"(negm)); } \
    _Pragma("unroll") for(int r=0;r<16;++r)P0[r]=__builtin_amdgcn_exp2f(P0[r]); }while(0)
  #define RESC() do{ if(resc){ asm volatile("s_waitcnt lgkmcnt(0)":::"memory"); \
      _Pragma("unroll") for(int d_=0;d_<4;++d_) _Pragma("unroll") for(int r=0;r<16;++r)o[d_][r]*=wsf[crow(r,hi)]; } }while(0)
  f32x16 pA0,pA1,pB0,pB1;
  int sl_prev=0,sl_cur=0,sl_next=SLOTB;
  int kc=0,kn=SLOTB,kp=3*SLOTB;
  #define ROT() do{sl_prev=sl_cur;sl_cur=sl_next;sl_next=(sl_next==(NSLOT-1)*SLOTB)?0:sl_next+SLOTB; kp=kc;kc=kn;kn=(kn==3*SLOTB)?0:kn+SLOTB;}while(0)
  WAIT_BAR(4);
  qkt(pA0,pA1,Kbase,qr,negm,r32,hi);asm volatile("s_nop 15\n\ts_nop 7":"+v"(pA0),"+v"(pA1));CMASK(pA0,pA1,0);
  START(pA0,pA1);
  _Pragma("unroll") for(int r=0;r<16;++r)pA1[r]=__builtin_amdgcn_exp2f(pA1[r]);
  DMA_K(3,3*SLOTB);DMA_V(1,SLOTB);
  WAIT_BAR(3);
  ROT();
  kload2(kf,kp0+kc,0); kload2(kf,kp0+kc,1);
  s16x4 vlo[16],vhi[16]; u32x4 pw0,pw1,pw2,pw3;
  #define PKW(P,B) cvtpk_s(P[B],P[B+1])
  #define PAF(k) __builtin_bit_cast(bf16x8,pw##k)
  #define VFR(i) (bf16x8){vlo[i][0],vlo[i][1],vlo[i][2],vlo[i][3],vhi[i][0],vhi[i][1],vhi[i][2],vhi[i][3]}
  #define PIN(x) asm volatile("":"+v"(x))
  #define MX3(a,b,c) __builtin_fmaxf(__builtin_fmaxf((a),(b)),(c))
  #define GAPA(MF,A0,A1,A2,A3,W0,W1,PW) do{ MF; sacc+=A0; sacc+=A1; sacc+=A2; sacc+=A3; PIN(sacc); W0; W1; PIN(PW); SBAR(); }while(0)
  #define EX(v) __builtin_amdgcn_exp2f(v)
  #define GAPB(MF,X,B) do{ MF; X[B]=EX(X[B]); X[B+1]=EX(X[B+1]); PIN(X); SBAR(); }while(0)
  #define VRD(i) do{ vlo[i]=vtr(vp_+(((i)>>2)*4096+((i)&3)*1024)); vhi[i]=vtr(vp_+(((i)>>2)*4096+((i)&3)*1024+512)); }while(0)
  #define STEP(C0,C1,P0,P1,t,GK,GV,GL) do{ SBAR(); \
    const lds_cptr vp_=vp0+2*sl_prev; \
    VRD(0); SBAR(); float sacc=(P0[0]+P0[1]); \
    GAPA(C0=__builtin_amdgcn_mfma_f32_32x32x16_bf16(kf[0],qr[0],negm,0,0,0), P0[2],P0[3],P0[4],P0[5],     pw0[0]=PKW(P0,0), pw0[1]=PKW(P0,2), pw0); \
    VRD(4); kload2(kf,kp0+kc,2); SBAR(); GAPA(C1=__builtin_amdgcn_mfma_f32_32x32x16_bf16(kf[1],qr[0],negm,0,0,0), P0[6],P0[7],P0[8],P0[9],     pw0[2]=PKW(P0,4), pw0[3]=PKW(P0,6), pw0); \
    VRD(1); SBAR(); GAPA(C0=__builtin_amdgcn_mfma_f32_32x32x16_bf16(kf[2],qr[1],C0,0,0,0),   P0[10],P0[11],P0[12],P0[13], pw1[0]=PKW(P0,8), pw1[1]=PKW(P0,10), pw1); \
    VRD(5); kload2(kf,kp0+kc,3); SBAR(); GAPA(C1=__builtin_amdgcn_mfma_f32_32x32x16_bf16(kf[3],qr[1],C1,0,0,0),   P0[14],P0[15],P1[0],P1[1],   pw1[2]=PKW(P0,12),pw1[3]=PKW(P0,14), pw1); \
    VRD(2); SBAR(); GAPA(C0=__builtin_amdgcn_mfma_f32_32x32x16_bf16(kf[4],qr[2],C0,0,0,0),   P1[2],P1[3],P1[4],P1[5],     pw2[0]=PKW(P1,0), pw2[1]=PKW(P1,2), pw2); \
    VRD(6); SBAR(); GAPA(C1=__builtin_amdgcn_mfma_f32_32x32x16_bf16(kf[5],qr[2],C1,0,0,0),   P1[6],P1[7],P1[8],P1[9],     pw2[2]=PKW(P1,4), pw2[3]=PKW(P1,6), pw2); \
    VRD(3); SBAR(); GAPA(C0=__builtin_amdgcn_mfma_f32_32x32x16_bf16(kf[6],qr[3],C0,0,0,0),   P1[10],P1[11],P1[12],P1[13], pw3[0]=PKW(P1,8), pw3[1]=PKW(P1,10), pw3); \
    VRD(7); SBAR(); GAPA(C1=__builtin_amdgcn_mfma_f32_32x32x16_bf16(kf[7],qr[3],C1,0,0,0),   P1[14],P1[15],0.f,0.f,       pw3[2]=PKW(P1,12),pw3[3]=PKW(P1,14), pw3); \
    l_reg+=sacc; \
    if(GK){DMA_K((t)+3,kp);} if(GV){DMA_V((t)+1,sl_next);} \
    CMASK(C0,C1,t); \
    { float a=MX3(C0[0],C0[1],C1[0]),b=MX3(C0[2],C0[3],C1[1]); a=MX3(a,C1[2],C1[3]); \
      _Pragma("unroll") for(int r=4;r<16;r+=4){a=MX3(a,C0[r],C0[r+1]);b=MX3(b,C0[r+2],C0[r+3]);a=MX3(a,C1[r],C1[r+1]);b=MX3(b,C1[r+2],C1[r+3]);} \
      float rm=__builtin_fmaxf(a,b); { auto rr=__builtin_amdgcn_permlane32_swap(__float_as_uint(rm),__float_as_uint(rm),false,false); rm=__builtin_fmaxf(__uint_as_float(rr[0]),__uint_as_float(rr[1])); } \
      resc=false; \
      if(__builtin_expect(__any(rm>(float)THRL),0)){ const float dl=__builtin_fmaxf(rm,0.f); mhat+=dl; \
        _Pragma("unroll") for(int r=0;r<16;++r){C0[r]-=dl;C1[r]-=dl;} \
        _Pragma("unroll") for(int r=0;r<16;++r)negm[r]=-mhat; asm volatile("":"+v"(negm)); \
        const float f=__builtin_amdgcn_exp2f(-dl); l_reg*=f; if(hi==0)wsf[r32]=f; resc=true; } } \
    SBAR(); \
    VRD(8);  SBAR(); GAPB(o[0]=__builtin_amdgcn_mfma_f32_32x32x16_bf16(PAF(0),VFR(0),o[0],0,0,0), C0,0); \
    VRD(12); SBAR(); GAPB(o[1]=__builtin_amdgcn_mfma_f32_32x32x16_bf16(PAF(0),VFR(4),o[1],0,0,0), C0,2); \
    VRD(9);  SBAR(); GAPB(o[0]=__builtin_amdgcn_mfma_f32_32x32x16_bf16(PAF(1),VFR(1),o[0],0,0,0), C0,4); \
    VRD(13); SBAR(); GAPB(o[1]=__builtin_amdgcn_mfma_f32_32x32x16_bf16(PAF(1),VFR(5),o[1],0,0,0), C0,6); \
    VRD(10); SBAR(); GAPB(o[0]=__builtin_amdgcn_mfma_f32_32x32x16_bf16(PAF(2),VFR(2),o[0],0,0,0), C0,8); \
    VRD(14); SBAR(); GAPB(o[1]=__builtin_amdgcn_mfma_f32_32x32x16_bf16(PAF(2),VFR(6),o[1],0,0,0), C0,10); \
    VRD(11); SBAR(); GAPB(o[0]=__builtin_amdgcn_mfma_f32_32x32x16_bf16(PAF(3),VFR(3),o[0],0,0,0), C0,12); \
    VRD(15); SBAR(); GAPB(o[1]=__builtin_amdgcn_mfma_f32_32x32x16_bf16(PAF(3),VFR(7),o[1],0,0,0), C0,14); \
    GAPB(o[2]=__builtin_amdgcn_mfma_f32_32x32x16_bf16(PAF(0),VFR(8),o[2],0,0,0),  C1,0); \
    GAPB(o[3]=__builtin_amdgcn_mfma_f32_32x32x16_bf16(PAF(0),VFR(12),o[3],0,0,0), C1,2); \
    GAPB(o[2]=__builtin_amdgcn_mfma_f32_32x32x16_bf16(PAF(1),VFR(9),o[2],0,0,0),  C1,4); \
    GAPB(o[3]=__builtin_amdgcn_mfma_f32_32x32x16_bf16(PAF(1),VFR(13),o[3],0,0,0), C1,6); \
    GAPB(o[2]=__builtin_amdgcn_mfma_f32_32x32x16_bf16(PAF(2),VFR(10),o[2],0,0,0), C1,8); \
    GAPB(o[3]=__builtin_amdgcn_mfma_f32_32x32x16_bf16(PAF(2),VFR(14),o[3],0,0,0), C1,10); \
    GAPB(o[2]=__builtin_amdgcn_mfma_f32_32x32x16_bf16(PAF(3),VFR(11),o[2],0,0,0), C1,12); \
    GAPB(o[3]=__builtin_amdgcn_mfma_f32_32x32x16_bf16(PAF(3),VFR(15),o[3],0,0,0), C1,14); \
    if(GL){ kload2(kf,kp0+kn,0); kload2(kf,kp0+kn,1); SBAR(); } \
    }while(0)
  int t=1;
  #undef CMASK
  #define CMASK(P0,P1,t) do{}while(0)
  for(;t+5<NT;t+=2){
    STEP(pB0,pB1,pA0,pA1,t,true,true,true);     WAIT_BAR(3); RESC(); ROT();
    STEP(pA0,pA1,pB0,pB1,t+1,true,true,true);   WAIT_BAR(3); RESC(); ROT();
  }
  #undef CMASK
  #define CMASK(P0,P1,t) do{int jb_=(t)-(NT-4); if(jb_>=0)cmask(P0,P1,jb_,qrel,hi);}while(0)
  #define ENDW(tt) do{ if((tt)+3<NT){WAIT_BAR(3);} else if((tt)+2<NT){WAIT_BAR(2);} else {WAIT_BAR(0);} }while(0)
  for(;t+1<NT;t+=2){
    STEP(pB0,pB1,pA0,pA1,t,(t+3<NT),(t+1<NT),(t+1<NT));       ENDW(t);   RESC(); ROT();
    STEP(pA0,pA1,pB0,pB1,t+1,(t+4<NT),(t+2<NT),(t+2<NT));     ENDW(t+1); RESC(); ROT();
  }
  STEP(pB0,pB1,pA0,pA1,NT-1,false,false,false); RESC();
  { float sacc=pB0[0]+pB0[1]; _Pragma("unroll") for(int r=2;r<16;++r)sacc+=pB0[r]; _Pragma("unroll") for(int r=0;r<16;++r)sacc+=pB1[r]; l_reg+=sacc;
    pw0=(u32x4){PKW(pB0,0),PKW(pB0,2),PKW(pB0,4),PKW(pB0,6)};pw1=(u32x4){PKW(pB0,8),PKW(pB0,10),PKW(pB0,12),PKW(pB0,14)};pw2=(u32x4){PKW(pB1,0),PKW(pB1,2),PKW(pB1,4),PKW(pB1,6)};pw3=(u32x4){PKW(pB1,8),PKW(pB1,10),PKW(pB1,12),PKW(pB1,14)};
    SBAR(); pv4(o,vb0+2*sl_cur,PAF(0),PAF(1),PAF(2),PAF(3)); }
  #undef PKW
  #undef PAF
  #undef VFR
  #undef PIN
  #undef MX3
  #undef GAPA
  #undef GAPB
  #undef EX
  #undef VRD
  #undef STEP
  #undef ENDW
  {auto rr=__builtin_amdgcn_permlane32_swap(__float_as_uint(l_reg),__float_as_uint(l_reg),false,false);l_reg=__uint_as_float(rr[0])+__uint_as_float(rr[1]);}
  if(hi==0)wsf[32+r32]=l_reg;asm volatile("s_waitcnt lgkmcnt(0)":::"memory");
  float rli[16];
  #pragma unroll
  for(int r=0;r<16;++r)rli[r]=__builtin_amdgcn_rcpf(wsf[32+crow(r,hi)]);
  bf16*Ow=Oh+(long)(q0+wid*QBLK)*DMO;
  { bf16*stg=(bf16*)(shm+LDS2_OST)+wid*4096;
    #pragma unroll
    for(int r=0;r<16;++r){const int orow=crow(r,hi);
      #pragma unroll
      for(int d0=0;d0<4;++d0)stg[orow*128+d0*32+r32]=__float2bfloat16(o[d0][r]*rli[r]);}
    asm volatile("s_waitcnt lgkmcnt(0)":::"memory");
    #pragma unroll
    for(int i=0;i<8;++i){const int row=i*4+(lane>>4),ch=lane&15; const u32x4 v=*(const u32x4*)(stg+row*128+ch*8); ATTN_STORE16(Ow+(long)row*DMO+ch*8,v);} }
  asm volatile("s_waitcnt lgkmcnt(0)\n\ts_barrier":::"memory");
  #undef DMA_K
  #undef DMA_V
  #undef CMASK
  #undef START
  #undef RESC
  #undef ROT
}
constexpr int ATTN_LDS_BYTES=LDS_BYTES;
#undef SBAR
#undef WAIT_BAR
}

constexpr int NWAVES = 8;
constexpr int NTOK = 32768, DM = 1024, SEQ = 4096, NB = 8, NEXP = 32, TOPK = 4;
constexpr int N_PHASES = 10;
constexpr size_t MiB = 1u << 20;
constexpr size_t WS_CTL = 0, CTL_ZERO_BYTES = 32768;
constexpr size_t WS_MODP = 864 * MiB;
constexpr size_t WS_MODF = 3 * MiB;
constexpr size_t WS_LAM16 = 3 * MiB + 512 * 1024;
constexpr size_t WS_WRH = 3 * MiB + 640 * 1024, WS_WRL = 3 * MiB + 704 * 1024;
constexpr size_t WS_WIN = 4 * MiB;
constexpr size_t WS_WOUT = 8 * MiB;
constexpr size_t WS_WGLU = 10 * MiB;
constexpr size_t WS_WM = 11 * MiB;
constexpr size_t WS_TV = 15 * MiB;
constexpr size_t WS_W1T = 22 * MiB;
constexpr size_t WS_W2T = 150 * MiB;
constexpr size_t WS_H = 214 * MiB;
constexpr size_t WS_Q = 278 * MiB, WS_K = 310 * MiB, WS_V = 342 * MiB;
constexpr size_t WS_UA = 374 * MiB;
constexpr size_t WS_Z = 422 * MiB;
constexpr size_t WS_OB = 454 * MiB;
constexpr size_t WS_MIX = 518 * MiB;
constexpr size_t WS_PTOK = 582 * MiB;
constexpr size_t WS_SLOT = 586 * MiB;
constexpr size_t WS_GATE = 587 * MiB;
constexpr size_t WS_A2 = 278 * MiB;
constexpr size_t WS_Y2 = 590 * MiB;
constexpr size_t WS_X1B = 872 * MiB;
constexpr size_t WS_END = 936 * MiB;
constexpr int MAXTILES = 544;
static_assert(WS_A2 + (size_t)MAXTILES * 256 * 1024 * 2 <= WS_PTOK && WS_Y2 + (size_t)MAXTILES * 256 * 1024 * 2 <= WS_MODP, "ws map");
constexpr int CW_TMO = 0, CW_CNT = 1024  , CW_BAR = 4096;
constexpr int CW_DEP0 = 7680  , CW_DEPB = 7744  ;
constexpr int RING_OFF = 0, RING_BYTES = 131072;
constexpr int VEC_OFF = 132096;
constexpr int BIASL_OFF = 132096;
constexpr int TILE_E_OFF = 140288;
constexpr int TILE0_OFF = 140928;
constexpr int CNTL_OFF = 141056;
constexpr int MOE_T_OFF = 141184;
constexpr int ROWTAB_OFF = 141312;
constexpr int LDSCTL_OFF = 159744, MISC_OFF = LDSCTL_OFF;
constexpr int LDS_BYTES = 163840;

typedef unsigned short bf16;
typedef unsigned v4u __attribute__((ext_vector_type(4)));
typedef unsigned v2u __attribute__((ext_vector_type(2)));
typedef float f32x4 __attribute__((ext_vector_type(4)));
typedef GAS unsigned gu32;
#define RLX_AGENT __ATOMIC_RELAXED, __HIP_MEMORY_SCOPE_AGENT
#define LDS_WAIT() asm volatile("s_waitcnt lgkmcnt(0)" ::: "memory")
#define VM_WAIT() asm volatile("s_waitcnt vmcnt(0)" ::: "memory")
__device__ __forceinline__ unsigned f2bf(float f) { unsigned u = __builtin_bit_cast(unsigned, f); return (u + 0x7fffu + ((u >> 16) & 1u)) >> 16; }
__device__ __forceinline__ unsigned pk2(float lo, float hi) { return f2bf(lo) | (f2bf(hi) << 16); }

#define XB_TMO      128
#define XB_XCNT(j)  (256  + 64 * (j))
#define XB_XSUB(j)  (1280 + 64 * (j))
#define XB_XGEN(j)  (2304 + 64 * (j))
#define XB_TOP      3328
#define XB_TOPGEN   3392
#define XCD_BAR_WORDS 3456
#define XB_SPIN_CAP (1u << 18)
__device__ __forceinline__ unsigned xb_ld(unsigned* p)              { return __hip_atomic_load(p, __ATOMIC_RELAXED, __HIP_MEMORY_SCOPE_AGENT); }
__device__ __forceinline__ unsigned xb_add(unsigned* p, unsigned v) { return __hip_atomic_fetch_add(p, v, __ATOMIC_RELAXED, __HIP_MEMORY_SCOPE_AGENT); }
__device__ __forceinline__ unsigned xb_xcc_id() { return (unsigned)__builtin_amdgcn_s_getreg((3 << 11) | 20) & 0xFu; }
#define XB_SPIN(cond, bar) do { unsigned _sp = 0; while (cond) { __builtin_amdgcn_s_sleep(1); \
    if ((++_sp & 255u) == 0u) { if (xb_ld(&(bar)[XB_TMO])) break; if (_sp > XB_SPIN_CAP) { atomicAdd(&(bar)[XB_TMO], 1u); break; } } } } while (0)
struct XcdBarrier { unsigned* bar; unsigned x; volatile LAS unsigned* st; };
__device__ __forceinline__ XcdBarrier xcd_barrier_post(unsigned* bar, volatile LAS unsigned* st) {
    XcdBarrier b; b.bar = bar; b.x = xb_xcc_id(); b.st = st;
    if (threadIdx.x == 0) (void)xb_add(&bar[XB_XCNT(b.x)], 1u);
    return b;
}
__device__ __forceinline__ void xcd_barrier_complete(unsigned* bar, unsigned x, unsigned& nloc, unsigned& nx) {
    const unsigned G = gridDim.x * gridDim.y * gridDim.z;
    unsigned sum, cnt, mine, sp = 0u;
    for (;;) {
        sum = 0u; cnt = 0u; mine = 0u;
#pragma unroll
        for (unsigned j = 0; j < 16; ++j) { const unsigned c = xb_ld(&bar[XB_XCNT(j)]); sum += c; cnt += (c > 0u) ? 1u : 0u; mine = (j == x) ? c : mine; }
        if (sum == G) break;
        __builtin_amdgcn_s_sleep(1);
        if ((++sp & 255u) == 0u) { if (xb_ld(&bar[XB_TMO])) break; if (sp > XB_SPIN_CAP) { atomicAdd(&bar[XB_TMO], 1u); break; } }
    }
    nloc = mine > 0u ? mine : 1u; nx = cnt > 0u ? cnt : 1u;
}
__device__ __forceinline__ void xcd_barrier(const XcdBarrier& b, const int wave) {
    asm volatile("s_waitcnt vmcnt(0)" ::: "memory");
    __syncthreads();
    if (wave == 0 && lane_id_opaque() == 0) {
        unsigned* bar = b.bar;
        __builtin_amdgcn_s_waitcnt(0);
        unsigned nloc = b.st[0], nx = b.st[1];
        if (nloc == 0u) { xcd_barrier_complete(bar, b.x, nloc, nx); b.st[0] = nloc; b.st[1] = nx; }
        const unsigned old = xb_add(&bar[XB_XSUB(b.x)], 1u);
        const unsigned gen = old / nloc;
        if (old + 1u == (gen + 1u) * nloc) {
            __builtin_amdgcn_fence(__ATOMIC_RELEASE, "agent");
            asm volatile("s_waitcnt vmcnt(0)" ::: "memory");
            const unsigned og = xb_add(&bar[XB_TOP], 1u);
            const unsigned tg = og / nx;
            if (og + 1u == (tg + 1u) * nx) xb_add(&bar[XB_TOPGEN], 1u);
            else XB_SPIN(xb_ld(&bar[XB_TOPGEN]) == tg, bar);
            __builtin_amdgcn_fence(__ATOMIC_ACQUIRE, "agent");
            xb_add(&bar[XB_XGEN(b.x)], 1u);
            asm volatile("s_waitcnt vmcnt(0)" ::: "memory");
        } else {
            XB_SPIN(xb_ld(&bar[XB_XGEN(b.x)]) == gen, bar);
            __builtin_amdgcn_fence(__ATOMIC_ACQUIRE, "agent");
            asm volatile("s_waitcnt vmcnt(0)" ::: "memory");
        }
    }
    __syncthreads();
}

struct Frame {
    LAS unsigned char* lds;
    gu32* ctl;
    int tid, lane, wave, vcu, G;
    float* out; unsigned char* ws;
};
typedef const float* cfptr_t;
__device__ __forceinline__ const float* inp(int i) { const __attribute__((address_space(4))) cfptr_t* kp = (const __attribute__((address_space(4))) cfptr_t*)__builtin_amdgcn_kernarg_segment_ptr(); asm volatile("" : "+s"(kp)); return kp[i]; }
__device__ __forceinline__ float wave_sum(float v) {
#pragma unroll
    for (int o = 1; o < 64; o <<= 1) v += __shfl_xor(v, o);
    return v;
}
__device__ __forceinline__ float wave_max(float v) {
#pragma unroll
    for (int o = 1; o < 64; o <<= 1) v = fmaxf(v, __shfl_xor(v, o));
    return v;
}
__device__ __forceinline__ int wave_min_i(int v) {
#pragma unroll
    for (int o = 1; o < 64; o <<= 1) { const int w = __shfl_xor(v, o); v = w < v ? w : v; }
    return v;
}

#define DPP_F(v, ctrl) __builtin_bit_cast(float, __builtin_amdgcn_update_dpp(__builtin_bit_cast(int, (v)), __builtin_bit_cast(int, (v)), (ctrl), 0xF, 0xF, false))
#define DPP_I(v, ctrl) __builtin_amdgcn_update_dpp((v), (v), (ctrl), 0xF, 0xF, false)
__device__ __forceinline__ float wave_max_u(float v) {
    v = fmaxf(v, DPP_F(v, 0xB1)); v = fmaxf(v, DPP_F(v, 0x4E)); v = fmaxf(v, DPP_F(v, 0x141)); v = fmaxf(v, DPP_F(v, 0x140));
    const int b = __builtin_bit_cast(int, v);
    return fmaxf(fmaxf(__builtin_bit_cast(float, __builtin_amdgcn_readlane(b, 15)), __builtin_bit_cast(float, __builtin_amdgcn_readlane(b, 31))), fmaxf(__builtin_bit_cast(float, __builtin_amdgcn_readlane(b, 47)), __builtin_bit_cast(float, __builtin_amdgcn_readlane(b, 63))));
}
__device__ __forceinline__ int wave_min_iu(int v) {
    int w;
    w = DPP_I(v, 0xB1); v = w < v ? w : v; w = DPP_I(v, 0x4E); v = w < v ? w : v; w = DPP_I(v, 0x141); v = w < v ? w : v; w = DPP_I(v, 0x140); v = w < v ? w : v;
    const int a = __builtin_amdgcn_readlane(v, 15), b = __builtin_amdgcn_readlane(v, 31), c = __builtin_amdgcn_readlane(v, 47), d = __builtin_amdgcn_readlane(v, 63);
    const int ab = a < b ? a : b, cd = c < d ? c : d; return ab < cd ? ab : cd;
}
__device__ __forceinline__ float wave_sum_u(float v) {
    v += DPP_F(v, 0xB1); v += DPP_F(v, 0x4E); v += DPP_F(v, 0x141); v += DPP_F(v, 0x140);
    const int b = __builtin_bit_cast(int, v);
    return (__builtin_bit_cast(float, __builtin_amdgcn_readlane(b, 15)) + __builtin_bit_cast(float, __builtin_amdgcn_readlane(b, 31))) + (__builtin_bit_cast(float, __builtin_amdgcn_readlane(b, 47)) + __builtin_bit_cast(float, __builtin_amdgcn_readlane(b, 63)));
}
struct TrItem { const float* W; bf16* WT; int ldw, ldt; };
__device__ __forceinline__ void tr_dma(const TrItem& d, LAS float* buf, int lane) {
    const int kr = lane >> 3, q = lane & 7;
#pragma unroll
    for (int i = 0; i < 8; ++i) __builtin_amdgcn_global_load_lds((const unsigned*)(d.W + (size_t)(8 * i + kr) * d.ldw + 4 * ((q - i) & 7)), (LAS unsigned*)(buf + i * 256), 16, 0, 2);
}
__device__ __forceinline__ void tr_out(const TrItem& d, const LAS float* buf, int lane) {
    const int c = lane & 7;
#pragma unroll
    for (int j = 0; j < 4; ++j) { const int n = (lane >> 3) + 8 * j; const LAS float* s = buf + (8 * c) * 32 + 4 * (((n >> 2) + c) & 7) + (n & 3);
        if (d.ldt < 0) { const f32x4 a = (f32x4){s[0 * 32], s[1 * 32], s[2 * 32], s[3 * 32]} * pg8::F8_W, e = (f32x4){s[4 * 32], s[5 * 32], s[6 * 32], s[7 * 32]} * pg8::F8_W;
            __builtin_nontemporal_store(pg8::pack8_fp8(a, e), (pg8::i32x2*)((unsigned char*)d.WT + (size_t)n * (size_t)(-d.ldt) + 8 * c)); }
        else { v4u o; o.x = pg8::cvt_pk_bf16(s[0 * 32], s[1 * 32]); o.y = pg8::cvt_pk_bf16(s[2 * 32], s[3 * 32]); o.z = pg8::cvt_pk_bf16(s[4 * 32], s[5 * 32]); o.w = pg8::cvt_pk_bf16(s[6 * 32], s[7 * 32]);
            *(GAS v4u*)(d.WT + (size_t)n * d.ldt + 8 * c) = o; } }
}
__device__ __forceinline__ void dsincos(double x, double& s, double& c) {
    const double k = rint(x * 0.63661977236758134308);
    double r = fma(-k, 1.57079632673412561417e+00, x); r = fma(-k, 6.07710050650619224932e-11, r);
    const int q = ((int)k) & 3; const double r2 = r * r;
    const double sp = r + r * r2 * (-1.66666666666666324348e-01 + r2 * (8.33333333332248946124e-03 + r2 * (-1.98412698298579493134e-04 + r2 * (2.75573137070700676789e-06 + r2 * (-2.50507602534068634195e-08 + r2 * 1.58969099521155010221e-10)))));
    const double cp = 1.0 - 0.5 * r2 + r2 * r2 * (4.16666666666666019037e-02 + r2 * (-1.38888888888741095749e-03 + r2 * (2.48015872894767294178e-05 + r2 * (-2.75573143513906633035e-07 + r2 * (2.08757232129817482790e-09 + r2 * -1.13596475577881948265e-11)))));
    s = (q == 0) ? sp : (q == 1) ? cp : (q == 2) ? -sp : -cp;
    c = (q == 0) ? cp : (q == 1) ? -sp : (q == 2) ? -cp : sp;
}
__device__ __forceinline__ double dexp(double x) {
    const double k = rint(x * 1.44269504088896340736); const double r = fma(-k, 6.93147180369123816490e-01, x) - k * 1.90821492927058770002e-10;
    double p = 1.0 / 6227020800.0;
    p = p * r + 1.0 / 479001600.0; p = p * r + 1.0 / 39916800.0; p = p * r + 1.0 / 3628800.0; p = p * r + 1.0 / 362880.0; p = p * r + 1.0 / 40320.0; p = p * r + 1.0 / 5040.0;
    p = p * r + 1.0 / 720.0; p = p * r + 1.0 / 120.0; p = p * r + 1.0 / 24.0; p = p * r + 1.0 / 6.0; p = p * r + 0.5; p = p * r + 1.0; p = p * r + 1.0;
    return ldexp(p, (int)k);
}
__device__ __forceinline__ void ssm_tables_item(Frame& F, int g, int r) {
    LAS float* pwr = (LAS float*)(F.lds); LAS float* pwi = pwr + 17 * 64;
    LAS float* ccr = pwi + 17 * 64; LAS float* cci = ccr + 1040;
    LAS float* bbr = cci + 1040; LAS float* bbi = bbr + 1024;
    LAS float* kt = bbi + 1024;
    LAS double* lb1 = (LAS double*)(kt + 4096);
    const float* a_re = inp(11); const float* a_im = inp(12); const float* log_dt = inp(13);
    const float* b_re = inp(14); const float* b_im = inp(15); const float* c_re = inp(16); const float* c_im = inp(17); const float* dsk = inp(18);
    const int tid = F.tid;
    const double dtv = dexp((double)log_dt[g]);
    for (int idx = tid; idx < 17 * 64; idx += 512) { const int t = idx >> 6, p = idx & 63;
        const double re = fmin((double)a_re[g * 64 + p], -1e-4), im = (double)a_im[g * 64 + p];
        const double mag = dexp(re * dtv * (double)t); double s, c; dsincos(im * dtv * (double)t, s, c);
        pwr[idx] = (float)(mag * c); pwi[idx] = (float)(mag * s); if (t == 1) { lb1[2 * p] = mag * c - 1.0; lb1[2 * p + 1] = mag * s; } }
    for (int idx = tid; idx < 1024; idx += 512) { const int c = idx >> 6, p = idx & 63; ccr[c * 65 + p] = c_re[(g * 16 + c) * 64 + p]; cci[c * 65 + p] = c_im[(g * 16 + c) * 64 + p]; }
    __syncthreads();
    for (int idx = tid; idx < 1024; idx += 512) { const int p = idx >> 4, c1 = idx & 15;
        const double re = fmin((double)a_re[g * 64 + p], -1e-4), im = (double)a_im[g * 64 + p];
        const double nr = lb1[2 * p], ni = lb1[2 * p + 1], den = re * re + im * im;
        const double qr = (nr * re + ni * im) / den, qi = (ni * re - nr * im) / den;
        const double br = (double)b_re[(g * 64 + p) * 16 + c1], bi = (double)b_im[(g * 64 + p) * 16 + c1];
        bbr[idx] = (float)(qr * br - qi * bi); bbi[idx] = (float)(qr * bi + qi * br); }
    __syncthreads();
    { const int t = tid >> 5, c = (tid >> 1) & 15, h8 = (tid & 1) * 8; float acc[8];
#pragma unroll
      for (int q = 0; q < 8; ++q) acc[q] = 0.f;
      for (int p = 0; p < 64; ++p) { const float cr = ccr[c * 65 + p], ci = cci[c * 65 + p], pr = pwr[t * 64 + p], pi = pwi[t * 64 + p]; const float mr = cr * pr - ci * pi, mi = cr * pi + ci * pr;
          const f32x4 r0 = *(const LAS f32x4*)(bbr + p * 16 + h8), r1 = *(const LAS f32x4*)(bbr + p * 16 + h8 + 4), i0 = *(const LAS f32x4*)(bbi + p * 16 + h8), i1 = *(const LAS f32x4*)(bbi + p * 16 + h8 + 4);
          acc[0] += mr * r0.x - mi * i0.x; acc[1] += mr * r0.y - mi * i0.y; acc[2] += mr * r0.z - mi * i0.z; acc[3] += mr * r0.w - mi * i0.w;
          acc[4] += mr * r1.x - mi * i1.x; acc[5] += mr * r1.y - mi * i1.y; acc[6] += mr * r1.z - mi * i1.z; acc[7] += mr * r1.w - mi * i1.w; }
#pragma unroll
      for (int q = 0; q < 8; ++q) kt[(t * 16 + c) * 16 + h8 + q] = acc[q]; }
    __syncthreads();
    bf16* TV = (bf16*)(F.ws + WS_TV) + (size_t)g * 256 * 384; bf16* WM = (bf16*)(F.ws + WS_WM) + (size_t)g * 256 * 256;
    for (int idx = tid; idx < 32 * 192; idx += 512) { const int row = 32 * r + idx / 192, col = 2 * (idx % 192), s = row >> 4, c = row & 15; float v[2];
#pragma unroll
        for (int q = 0; q < 2; ++q) { const int cq = col + q;
            if (cq < 256) { const int j = cq >> 4, c1 = cq & 15; v[q] = (j <= s) ? kt[((s - j) * 16 + c) * 16 + c1] : 0.f; if (j == s && c == c1) v[q] += dsk[g * 16 + c]; }
            else { const int p = (cq - 256) & 63; const float cr = ccr[c * 65 + p], ci = cci[c * 65 + p], pr = pwr[(s + 1) * 64 + p], pi = pwi[(s + 1) * 64 + p];
                v[q] = (cq < 320) ? (cr * pr - ci * pi) : -(cr * pi + ci * pr); } }
        *(unsigned*)(TV + (size_t)row * 384 + col) = pk2(v[0], v[1]); }
    for (int idx = tid; idx < 16 * 128; idx += 512) { const int row = 16 * r + (idx >> 7), col = 2 * (idx & 127), p = row & 63, ri = row >> 6, j = col >> 4, c1 = col & 15;
        const float pr = pwr[(15 - j) * 64 + p], pi = pwi[(15 - j) * 64 + p]; float v[2];
#pragma unroll
        for (int q = 0; q < 2; ++q) { const float br = bbr[p * 16 + c1 + q], bi = bbi[p * 16 + c1 + q]; v[q] = ri == 0 ? (pr * br - pi * bi) : (pr * bi + pi * br); }
        *(unsigned*)(WM + (size_t)row * 256 + col) = pk2(v[0], v[1]); *(unsigned*)(WM + (size_t)(128 + row) * 256 + col) = 0u; }
    if (r == 0 && tid < 64) { float* L16 = (float*)(F.ws + WS_LAM16) + (g * 64 + tid) * 2; L16[0] = pwr[16 * 64 + tid]; L16[1] = pwi[16 * 64 + tid]; }
    __syncthreads();
}
constexpr int MOD_NKS = 32;
__device__ __forceinline__ void modp_item(Frame& F, int it) {
    const int ng = it % 6, ks = it / 6, tid = F.tid;
    LAS float* cact = (LAS float*)F.lds;
    LAS f32x4* red = (LAS f32x4*)(cact + 256);
    const float* cin = inp(1); const float* w = inp(2);
    if (tid < 256) { const int b = tid >> 5, kk = tid & 31; const float c = cin[b * 1024 + ks * 32 + kk]; cact[tid] = c / (1.0f + __expf(-c)); }
    __syncthreads();
    const int c4 = tid & 255, kq = tid >> 8, col = ng * 1024 + 4 * c4; f32x4 wv[16], acc[8];
#pragma unroll
    for (int i = 0; i < 16; ++i) wv[i] = *(const GAS f32x4*)(w + (size_t)(ks * 32 + kq * 16 + i) * 6144 + col);
#pragma unroll
    for (int b = 0; b < 8; ++b) { acc[b] = (f32x4){0.f, 0.f, 0.f, 0.f};
#pragma unroll
        for (int i = 0; i < 16; ++i) acc[b] += wv[i] * cact[b * 32 + kq * 16 + i]; }
    if (kq == 1) {
#pragma unroll
        for (int b = 0; b < 8; ++b) red[b * 256 + c4] = acc[b]; }
    __syncthreads();
    if (kq == 0) { float* mp = (float*)(F.ws + WS_MODP);
#pragma unroll
        for (int b = 0; b < 8; ++b) *(GAS f32x4*)(mp + (size_t)(ks * 8 + b) * 6144 + col) = acc[b] + red[b * 256 + c4]; }
    __syncthreads();
}
__device__ __forceinline__ float mod_value(Frame& F, const float* b_ada, int b, int n) {
    const float* mp = (const float*)(F.ws + WS_MODP); float v = b_ada[n];
    float t[MOD_NKS];
#pragma unroll
    for (int ks = 0; ks < MOD_NKS; ++ks) t[ks] = mp[(size_t)(ks * 8 + b) * 6144 + n];
#pragma unroll
    for (int ks = 0; ks < MOD_NKS; ++ks) v += t[ks];
    return v;
}
#ifndef TR_HOSTED
#define TR_HOSTED 32768
#endif
constexpr int TR_I_W1 = 32 * 16 * 64, TR_I_W2 = 32 * 16 * 32, TR_I_IN = 16 * 64, TR_I_OUT = 16 * 32, TR_I_GLU = 8 * 16, TR_NITEMS = TR_I_W1 + TR_I_W2 + TR_I_IN + TR_I_OUT + TR_I_GLU;
__device__ __forceinline__ void tr_run(Frame& F, const int lo, const int hi, const int gw, const int NGW) {
    LAS float* scr = (LAS float*)(F.lds + RING_OFF + F.wave * 16384);
    constexpr int I_W1 = TR_I_W1, I_W2 = TR_I_W2, I_IN = TR_I_IN, I_OUT = TR_I_OUT;
    const int NITEMS = hi;
    const float* w1p = inp(25); const float* w2p = inp(27); const float* winp = inp(5); const float* woutp = inp(21); const float* wglup = inp(19);
    bf16* w1t = (bf16*)(F.ws + WS_W1T); bf16* w2t = (bf16*)(F.ws + WS_W2T); bf16* wint = (bf16*)(F.ws + WS_WIN); bf16* woutt = (bf16*)(F.ws + WS_WOUT); bf16* wglut = (bf16*)(F.ws + WS_WGLU);
#define TR_DESC(d, item) do { int r = (item); \
        if (r < I_W1) { const int e = r >> 10, rr = r & 1023, kb = rr >> 6, nb = rr & 63, n0 = 32 * nb, bj = n0 >> 10, rem = n0 & 1023, pn = rem >> 7, jj = rem & 127; \
            d.W = w1p + (size_t)e * 1024 * 2048 + (size_t)(64 * kb) * 2048 + n0; d.WT = (bf16*)((unsigned char*)w1t + (size_t)e * 2048 * 1024 + (size_t)(pn * 256 + bj * 128 + jj) * 1024 + 64 * kb); d.ldw = 2048; d.ldt = -1024; } \
        else if ((r -= I_W1) < I_W2) { const int e = r >> 9, rr = r & 511, kb = rr >> 5, nb = rr & 31; \
            d.W = w2p + (size_t)e * 1024 * 1024 + (size_t)(64 * kb) * 1024 + 32 * nb; d.WT = (bf16*)((unsigned char*)w2t + (size_t)e * 1024 * 1024 + (size_t)(32 * nb) * 1024 + 64 * kb); d.ldw = 1024; d.ldt = -1024; } \
        else if ((r -= I_W2) < I_IN) { const int kb = r >> 6, nb = r & 63; d.W = winp + (size_t)(64 * kb) * 2048 + 32 * nb; d.WT = wint + (size_t)(32 * nb) * 1024 + 64 * kb; d.ldw = 2048; d.ldt = 1024; } \
        else if ((r -= I_IN) < I_OUT) { const int kb = r >> 5, nb = r & 31; d.W = woutp + (size_t)(64 * kb) * 1024 + 32 * nb; d.WT = (bf16*)((unsigned char*)woutt + (size_t)(32 * nb) * 1024 + 64 * kb); d.ldw = 1024; d.ldt = -1024; } \
        else { r -= I_OUT; const int kb = r >> 4, nb = r & 15; d.W = wglup + (size_t)(64 * kb) * 512 + 32 * nb; d.WT = wglut + (size_t)(32 * nb) * 512 + 64 * kb; d.ldw = 512; d.ldt = 512; } } while (0)
    { TrItem dc, dn; int it = lo + gw, par = 0;
      if (it < NITEMS) { TR_DESC(dc, it); tr_dma(dc, scr, F.lane); }
      while (it < NITEMS) { const int nx = it + NGW;
          if (nx < NITEMS) { TR_DESC(dn, nx); tr_dma(dn, scr + (par ^ 1) * 2048, F.lane); asm volatile("s_waitcnt vmcnt(8)" ::: "memory"); }
          else { asm volatile("s_waitcnt vmcnt(0)" ::: "memory"); }
          tr_out(dc, scr + par * 2048, F.lane);
          LDS_WAIT(); asm volatile("" ::: "memory");
          dc = dn; it = nx; par ^= 1; }
      asm volatile("s_waitcnt vmcnt(0)" ::: "memory"); }
}
__device__ __forceinline__ void trq_load(v4u (&r)[8], const TrItem& d, int lane) {
    const int kr = lane >> 3, q = lane & 7;
#pragma unroll
    for (int i = 0; i < 8; ++i) { const float* p = d.W + (size_t)(8 * i) * d.ldw; const unsigned voff = (unsigned)(kr * d.ldw + 4 * ((q - i) & 7)) * 4u;
        asm volatile("global_load_dwordx4 %0, %1, %2 nt" : "=v"(r[i]) : "v"(voff), "s"(p) : "memory"); }
}
__device__ __forceinline__ void tr_run_deep(Frame& F, const int lo, const int hi, const int gw, const int NGW) {
    LAS float* scr = (LAS float*)(F.lds + RING_OFF + F.wave * 16384);
    constexpr int I_W1 = TR_I_W1, I_W2 = TR_I_W2, I_IN = TR_I_IN, I_OUT = TR_I_OUT;
    const float* w1p = inp(25); const float* w2p = inp(27); const float* winp = inp(5); const float* woutp = inp(21); const float* wglup = inp(19);
    bf16* w1t = (bf16*)(F.ws + WS_W1T); bf16* w2t = (bf16*)(F.ws + WS_W2T); bf16* wint = (bf16*)(F.ws + WS_WIN); bf16* woutt = (bf16*)(F.ws + WS_WOUT); bf16* wglut = (bf16*)(F.ws + WS_WGLU);
    if (lo + gw >= hi) return;
    const int n_it = (hi - lo - gw + NGW - 1) / NGW;
#define TRQ_DESC(d, j) do { const int jc_ = (j) < n_it ? (j) : n_it - 1; TR_DESC(d, lo + gw + jc_ * NGW); } while (0)
#define TRQ_STEP(r, d, j, par) do { \
        asm volatile("s_waitcnt vmcnt(16)" : "+v"(r[0]), "+v"(r[1]), "+v"(r[2]), "+v"(r[3]), "+v"(r[4]), "+v"(r[5]), "+v"(r[6]), "+v"(r[7]) :: "memory"); \
        LAS float* buf_ = scr + (par) * 2048; const bool live_ = (j) < n_it; \
        if (live_) { _Pragma("unroll") for (int i_ = 0; i_ < 8; ++i_) *(LAS v4u*)(buf_ + i_ * 256 + F.lane * 4) = r[i_]; } \
        LDS_WAIT(); TrItem dn_; TRQ_DESC(dn_, (j) + 3); trq_load(r, dn_, F.lane); \
        if (live_) tr_out(d, buf_, F.lane); \
        d = dn_; } while (0)
    v4u r0[8], r1[8], r2[8]; TrItem d0, d1, d2;
    TRQ_DESC(d0, 0); trq_load(r0, d0, F.lane); TRQ_DESC(d1, 1); trq_load(r1, d1, F.lane); TRQ_DESC(d2, 2); trq_load(r2, d2, F.lane);
    for (int j = 0; j < n_it; j += 6) {
        TRQ_STEP(r0, d0, j, 0); TRQ_STEP(r1, d1, j + 1, 1); TRQ_STEP(r2, d2, j + 2, 0);
        TRQ_STEP(r0, d0, j + 3, 1); TRQ_STEP(r1, d1, j + 4, 0); TRQ_STEP(r2, d2, j + 5, 1); }
    asm volatile("s_waitcnt vmcnt(0)" : "+v"(r0[0]), "+v"(r0[1]), "+v"(r0[2]), "+v"(r0[3]), "+v"(r0[4]), "+v"(r0[5]), "+v"(r0[6]), "+v"(r0[7]) :: "memory");
    asm volatile("" : "+v"(r1[0]), "+v"(r1[1]), "+v"(r1[2]), "+v"(r1[3]), "+v"(r1[4]), "+v"(r1[5]), "+v"(r1[6]), "+v"(r1[7]) :: "memory");
    asm volatile("" : "+v"(r2[0]), "+v"(r2[1]), "+v"(r2[2]), "+v"(r2[3]), "+v"(r2[4]), "+v"(r2[5]), "+v"(r2[6]), "+v"(r2[7]) :: "memory");
#undef TRQ_STEP
#undef TRQ_DESC
}
#undef TR_DESC
__device__ __forceinline__ void dep_signal(Frame& F, int word);
__device__ __forceinline__ void p0_prologue(Frame& F, int mode = 0) {
    { const float* wr = inp(23); bf16* wh = (bf16*)(F.ws + WS_WRH); bf16* wl = (bf16*)(F.ws + WS_WRL);
      for (int idx = F.vcu * 512 + F.tid; idx < 32768; idx += F.G * 512) { const int k = idx >> 5, e = idx & 31; const float w = wr[idx]; const unsigned hi = f2bf(w);
          wh[e * 1024 + k] = (bf16)hi; wl[e * 1024 + k] = (bf16)f2bf(w - __builtin_bit_cast(float, hi << 16)); } }
    const bool tab_last = (mode == 0) && !(F.vcu & 1);
    if (mode != 2 && mode != 4 && !tab_last) { for (int it = F.vcu; it < 256; it += F.G) ssm_tables_item(F, it >> 3, it & 7); }
    if (mode != 2 && mode != 3) { for (int it = F.vcu; it < 192; it += F.G) modp_item(F, it); }
    if (mode == 0) dep_signal(F, CW_DEP0);
    if (mode == 1 || mode == 3 || mode == 4) return;
    if (F.G == 256) tr_run(F, TR_HOSTED, TR_NITEMS, F.vcu * NWAVES + F.wave, F.G * NWAVES);
    else tr_run(F, 0, TR_NITEMS, F.vcu * NWAVES + F.wave, F.G * NWAVES);
    if (tab_last) { LDS_WAIT(); __syncthreads(); for (int it = F.vcu; it < 256; it += F.G) ssm_tables_item(F, it >> 3, it & 7); }
}
__device__ __forceinline__ void p1_h1(Frame& F) {
    const int bx = blockIdx.x, rows_per = NTOK / F.G, row_base = bx * rows_per, b = row_base >> 12;
    LAS float* vec = (LAS float*)(F.lds + VEC_OFF);
    const float* b_ada = inp(3); const float* n1g = inp(4); const float* xin = inp(0);
    for (int n = F.tid; n < 2048; n += 512) { float v = mod_value(F, b_ada, b, n); if (n >= 1024) v = (1.0f + v) * n1g[n - 1024]; vec[n] = v; }
    { const int per = (NB * 6144) / F.G; float* mf = (float*)(F.ws + WS_MODF);
      for (int i = F.tid; i < per; i += 512) { const int idx = bx * per + i; mf[idx] = mod_value(F, b_ada, idx / 6144, idx % 6144); } }
    __syncthreads();
    bf16* H = (bf16*)(F.ws + WS_H);
    for (int r = F.wave; r < rows_per; r += NWAVES) { const size_t row = (size_t)(row_base + r);
        const GAS f32x4* xr = (const GAS f32x4*)(xin + row * DM) + F.lane; f32x4 v[4]; float s = 0.f;
#pragma unroll
        for (int j = 0; j < 4; ++j) { v[j] = __builtin_nontemporal_load((const f32x4*)(xr + 64 * j)); s += (v[j].x * v[j].x + v[j].y * v[j].y) + (v[j].z * v[j].z + v[j].w * v[j].w); }
        const float rs = 1.0f / sqrtf(wave_sum_u(s) * (1.f / DM) + 1e-6f);
        GAS v2u* o8 = (GAS v2u*)(H + row * DM) + F.lane;
#pragma unroll
        for (int j = 0; j < 4; ++j) { const int c = 256 * j + 4 * F.lane; const f32x4 sh = *(LAS f32x4*)(vec + c), sc = *(LAS f32x4*)(vec + 1024 + c); const f32x4 h = v[j] * rs * sc + sh;
            v2u w; w.x = pk2(h.x, h.y); w.y = pk2(h.z, h.w); o8[64 * j] = w; } }
}
__device__ __forceinline__ void p4_combine(Frame& F) {
    const float lam = __expf(wave_sum(inp(6)[F.lane] * inp(7)[F.lane])) - __expf(wave_sum(inp(8)[F.lane] * inp(9)[F.lane])) + 0.2f;
    const bf16* OB = (const bf16*)(F.ws + WS_OB); bf16* MIX = (bf16*)(F.ws + WS_MIX);
    const int h = F.lane >> 4, d0 = (F.lane & 15) * 8; const float* sg = inp(10) + d0;
    float gs[8];
#pragma unroll
    for (int j = 0; j < 8; ++j) gs[j] = sg[j] * 0.8f;
    const int gw = F.vcu * NWAVES + F.wave, NGW = F.G * NWAVES;
    for (int tok = gw; tok < NTOK; tok += NGW) {
        const v4u a0 = *(const GAS v4u*)(OB + (size_t)tok * 1024 + (h * 2) * 128 + d0), a1 = *(const GAS v4u*)(OB + (size_t)tok * 1024 + (h * 2 + 1) * 128 + d0);
        float a[8];
        a[0] = pg8::bf_lo(a0.x) - lam * pg8::bf_lo(a1.x); a[1] = pg8::bf_hi(a0.x) - lam * pg8::bf_hi(a1.x); a[2] = pg8::bf_lo(a0.y) - lam * pg8::bf_lo(a1.y); a[3] = pg8::bf_hi(a0.y) - lam * pg8::bf_hi(a1.y);
        a[4] = pg8::bf_lo(a0.z) - lam * pg8::bf_lo(a1.z); a[5] = pg8::bf_hi(a0.z) - lam * pg8::bf_hi(a1.z); a[6] = pg8::bf_lo(a0.w) - lam * pg8::bf_lo(a1.w); a[7] = pg8::bf_hi(a0.w) - lam * pg8::bf_hi(a1.w);
        float ss = 0.f;
#pragma unroll
        for (int j = 0; j < 8; ++j) ss += a[j] * a[j];
        ss += __shfl_xor(ss, 1); ss += __shfl_xor(ss, 2); ss += __shfl_xor(ss, 4); ss += __shfl_xor(ss, 8);
        const float rs = 1.0f / sqrtf(ss * (1.f / 128.f) + 1e-6f);
        v4u o; o.x = pk2(a[0] * rs * gs[0], a[1] * rs * gs[1]); o.y = pk2(a[2] * rs * gs[2], a[3] * rs * gs[3]); o.z = pk2(a[4] * rs * gs[4], a[5] * rs * gs[5]); o.w = pk2(a[6] * rs * gs[6], a[7] * rs * gs[7]);
        *(GAS v4u*)(MIX + (size_t)tok * 1024 + h * 128 + d0) = o;
    }
}
constexpr int WRB = 2064;
constexpr int SEL_OFF = 140288;
static_assert(4 * 16 * WRB <= VEC_OFF, "router weights in LDS");
__device__ __forceinline__ void ins4(float v, int i, float (&tv)[4], int (&ti)[4]) {
#pragma unroll
    for (int k = 0; k < 4; ++k) { const bool better = v > tv[k] || (v == tv[k] && i < ti[k]); const float ov = tv[k]; const int oi = ti[k]; tv[k] = better ? v : ov; ti[k] = better ? i : oi; v = better ? ov : v; i = better ? oi : i; }
}
__device__ __forceinline__ void p6_fill(Frame& F) {
    const int bx = blockIdx.x, rows_per = NTOK / F.G, row_base = bx * rows_per, b = row_base >> 12;
    LAS float* vec = (LAS float*)(F.lds + VEC_OFF);
    LAS unsigned* hist = (LAS unsigned*)(F.lds + SEL_OFF) + 1536;
    const float* n2g = inp(22); const float* mf = (const float*)(F.ws + WS_MODF) + (size_t)b * 6144;
    __syncthreads();
    { const unsigned char* wsrc = F.ws + WS_WRH;
      for (int c = F.tid; c < 8192; c += 512) { const int row = c >> 7, col = c & 127; *(LAS v4u*)(F.lds + RING_OFF + row * WRB + col * 16) = *(const GAS v4u*)(wsrc + (size_t)row * 2048 + col * 16); } }
    for (int n = F.tid; n < 1024; n += 512) { vec[n] = mf[3072 + n]; vec[1024 + n] = (1.0f + mf[4096 + n]) * n2g[n]; }
    if (F.tid < 32) hist[F.tid] = 0u;
    __syncthreads();
}
__device__ __forceinline__ void p6_router(Frame& F, bool dummy = false, bool filled = false) {
    const int bx = blockIdx.x, rows_per = NTOK / F.G, row_base = bx * rows_per;
    LAS float* vec = (LAS float*)(F.lds + VEC_OFF);
    LAS unsigned* sel_e = (LAS unsigned*)(F.lds + SEL_OFF); LAS unsigned* sel_r = sel_e + 512; LAS float* sel_g = (LAS float*)(sel_r + 512); LAS unsigned* hist = (LAS unsigned*)(sel_g + 512); LAS unsigned* base = hist + 32;
    if (!filled) p6_fill(F);
    unsigned char* H = (unsigned char*)(F.ws + WS_H); const bf16* X1 = (const bf16*)(F.ws + WS_X1B);
    int* ptok = (int*)(F.ws + (dummy ? WS_Q : WS_PTOK)); unsigned* slot = (unsigned*)(F.ws + (dummy ? WS_Q + 8 * MiB : WS_SLOT)); float* gate = (float*)(F.ws + (dummy ? WS_Q + 16 * MiB : WS_GATE));
    const int cwc = dummy ? CW_CNT + 2048 : CW_CNT;
    const int t = F.lane & 15, kg = F.lane >> 4;
    for (int r0 = 16 * F.wave; r0 < rows_per; r0 += 16 * NWAVES) { const int tok = row_base + r0 + t;
        const GAS v4u* xp = (const GAS v4u*)(X1 + (size_t)tok * DM + 8 * kg);
        v4u xr[32]; float ss = 0.f;
#pragma unroll
        for (int s = 0; s < 32; ++s) xr[s] = xp[4 * s];
#pragma unroll
        for (int s = 0; s < 32; ++s) { const float x0 = pg8::bf_lo(xr[s].x), x1 = pg8::bf_hi(xr[s].x), x2 = pg8::bf_lo(xr[s].y), x3 = pg8::bf_hi(xr[s].y), x4 = pg8::bf_lo(xr[s].z), x5 = pg8::bf_hi(xr[s].z), x6 = pg8::bf_lo(xr[s].w), x7 = pg8::bf_hi(xr[s].w);
            ss += ((x0 * x0 + x1 * x1) + (x2 * x2 + x3 * x3)) + ((x4 * x4 + x5 * x5) + (x6 * x6 + x7 * x7)); }
        ss += __shfl_xor(ss, 16); ss += __shfl_xor(ss, 32);
        const float rs = 1.0f / sqrtf(ss * (1.f / DM) + 1e-6f);
        f32x4 acc0 = {0.f, 0.f, 0.f, 0.f}, acc1 = {0.f, 0.f, 0.f, 0.f};
        GAS unsigned char* hp = (GAS unsigned char*)(H + (size_t)tok * DM + 8 * kg);
        const LAS unsigned char* wa = F.lds + RING_OFF + t * WRB + 16 * kg;
        const LAS float* vp = vec + 8 * kg;
#pragma unroll
        for (int s = 0; s < 32; ++s) {
            const f32x4 sh0 = *(const LAS f32x4*)(vp), sh1 = *(const LAS f32x4*)(vp + 4), sc0 = *(const LAS f32x4*)(vp + 1024), sc1 = *(const LAS f32x4*)(vp + 1024 + 4);
            v4u xs = xr[s]; asm volatile("" : "+v"(xs));
            const f32x4 xa = {pg8::bf_lo(xs.x), pg8::bf_hi(xs.x), pg8::bf_lo(xs.y), pg8::bf_hi(xs.y)}, xb = {pg8::bf_lo(xs.z), pg8::bf_hi(xs.z), pg8::bf_lo(xs.w), pg8::bf_hi(xs.w)};
            const f32x4 h0 = xa * rs * sc0 + sh0, h1 = xb * rs * sc1 + sh1;
            const pg8::u32x4 bh = pg8::pack8(h0, h1);
            const f32x4 d0 = h0 - (f32x4){pg8::bf_lo(bh.x), pg8::bf_hi(bh.x), pg8::bf_lo(bh.y), pg8::bf_hi(bh.y)}, d1 = h1 - (f32x4){pg8::bf_lo(bh.z), pg8::bf_hi(bh.z), pg8::bf_lo(bh.w), pg8::bf_hi(bh.w)};
            const pg8::u32x4 bl = pg8::pack8(d0, d1);
            *(GAS pg8::i32x2*)(hp + 32 * s) = pg8::pack8_fp8(h0 * pg8::F8_ACT, h1 * pg8::F8_ACT);
            const pg8::bf16x8 Bh = __builtin_bit_cast(pg8::bf16x8, bh), Bl = __builtin_bit_cast(pg8::bf16x8, bl);
            const pg8::bf16x8 Ah0 = *(const LAS pg8::bf16x8*)(wa), Ah1 = *(const LAS pg8::bf16x8*)(wa + 16 * WRB), Al0 = *(const LAS pg8::bf16x8*)(wa + 32 * WRB), Al1 = *(const LAS pg8::bf16x8*)(wa + 48 * WRB);
            acc0 = __builtin_amdgcn_mfma_f32_16x16x32_bf16(Ah0, Bh, acc0, 0, 0, 0); acc1 = __builtin_amdgcn_mfma_f32_16x16x32_bf16(Ah1, Bh, acc1, 0, 0, 0);
            acc0 = __builtin_amdgcn_mfma_f32_16x16x32_bf16(Ah0, Bl, acc0, 0, 0, 0); acc1 = __builtin_amdgcn_mfma_f32_16x16x32_bf16(Ah1, Bl, acc1, 0, 0, 0);
            acc0 = __builtin_amdgcn_mfma_f32_16x16x32_bf16(Al0, Bh, acc0, 0, 0, 0); acc1 = __builtin_amdgcn_mfma_f32_16x16x32_bf16(Al1, Bh, acc1, 0, 0, 0);
            wa += 64; vp += 32;
            asm volatile("" : "+v"(wa), "+v"(vp), "+v"(acc0), "+v"(acc1)); }
        const float* br = inp(24) + 4 * kg;
        float tv[4] = {-INFINITY, -INFINITY, -INFINITY, -INFINITY}; int ti[4] = {99, 99, 99, 99};
#pragma unroll
        for (int r = 0; r < 4; ++r) ins4(acc0[r] + br[r], 4 * kg + r, tv, ti);
#pragma unroll
        for (int r = 0; r < 4; ++r) ins4(acc1[r] + br[16 + r], 16 + 4 * kg + r, tv, ti);
#pragma unroll
        for (int xr_ = 16; xr_ <= 32; xr_ <<= 1) { float ov[4]; int oi[4];
#pragma unroll
            for (int k = 0; k < 4; ++k) { ov[k] = __shfl_xor(tv[k], xr_); oi[k] = __shfl_xor(ti[k], xr_); }
#pragma unroll
            for (int k = 0; k < 4; ++k) ins4(ov[k], oi[k], tv, ti); }
        { const int k = kg;
          const float e1 = __expf(tv[1] - tv[0]), e2 = __expf(tv[2] - tv[0]), e3 = __expf(tv[3] - tv[0]); const float inv = 1.0f / (1.0f + e1 + e2 + e3);
          const int ek = k == 0 ? ti[0] : k == 1 ? ti[1] : k == 2 ? ti[2] : ti[3]; const float gk = (k == 0 ? 1.0f : k == 1 ? e1 : k == 2 ? e2 : e3) * inv;
          const unsigned rank = __hip_atomic_fetch_add(hist + ek, 1u, __ATOMIC_RELAXED, __HIP_MEMORY_SCOPE_WORKGROUP);
          const int q = (r0 + t) * 4 + k; sel_e[q] = (unsigned)ek; sel_r[q] = rank; sel_g[q] = gk; }
    }
    LDS_WAIT(); __syncthreads();
    if (F.tid < 32) base[F.tid] = __hip_atomic_fetch_add((unsigned*)(F.ctl + cwc + 64 * F.tid), hist[F.tid], RLX_AGENT);
    LDS_WAIT(); __syncthreads();
    { const int q = F.tid, tok = row_base + (q >> 2), k = q & 3; const unsigned ek = sel_e[q], pos = base[ek] + sel_r[q];
      ptok[(size_t)ek * NTOK + pos] = tok; slot[(size_t)tok * 4 + k] = (ek << 16) | pos; gate[(size_t)tok * 4 + k] = sel_g[q]; }
}
__device__ __forceinline__ void moe_tables(Frame& F) {
    LAS unsigned char* tile_e = (LAS unsigned char*)(F.lds + TILE_E_OFF); LAS int* tile0 = (LAS int*)(F.lds + TILE0_OFF); LAS int* cntl = (LAS int*)(F.lds + CNTL_OFF); LAS int* Tp = (LAS int*)(F.lds + MOE_T_OFF);
    if (F.tid < 32) { const int c = (int)__hip_atomic_load((unsigned*)(F.ctl + CW_CNT + 64 * F.tid), RLX_AGENT); const int nt = (c + 255) >> 8; int incl = nt;
#pragma unroll
        for (int o = 1; o < 32; o <<= 1) { const int w = __shfl_up(incl, o); if (F.tid >= o) incl += w; }
        const int excl = incl - nt; tile0[F.tid] = excl; cntl[F.tid] = c; if (F.tid == 31) Tp[0] = incl;
        for (int k = 0; k < nt; ++k) tile_e[excl + k] = (unsigned char)F.tid; }
    __syncthreads();
}
struct MoeSched {
    const LAS unsigned char* tile_e; const LAS int* tile0; const LAS unsigned* rowtab; int T, nN, G, c, rev, a_mask, e_mask; size_t tA, tBe, tB;
    __device__ __forceinline__ bool next(int i, pg8::Unit& u) const { const int x = c & 7, y = c >> 3, tpx = 32 / nN, t = (i * 8 + x) * tpx + (y % tpx); if (t >= T) return false; u.pm = rev ? T - 1 - t : t; u.pn = y / tpx; u.e = __builtin_amdgcn_readfirstlane((int)tile_e[u.pm]); return true; }
    __device__ __forceinline__ size_t aoff(const pg8::Unit& u) const { return (size_t)(u.pm & a_mask) * tA; }
    __device__ __forceinline__ size_t boff(const pg8::Unit& u) const { return (size_t)(u.e & e_mask) * tBe + (size_t)u.pn * tB; }
    __device__ __forceinline__ unsigned rowoff(int i, int r) const { return rowtab[i * 256 + r]; }
};
__device__ __forceinline__ void p9_final(Frame& F, bool dummy = false) {
    const int bx = blockIdx.x, rows_per = NTOK / F.G, row_base = bx * rows_per, b = row_base >> 12;
    if (MK_PER_PHASE || dummy) moe_tables(F);
    const LAS int* tile0 = (const LAS int*)(F.lds + TILE0_OFF);
    const float* g2 = (const float*)(F.ws + WS_MODF) + (size_t)b * 6144 + 5120; const float* fg = inp(29);
    const unsigned char* Y2 = (const unsigned char*)(F.ws + WS_Y2); const unsigned* slot = (const unsigned*)(F.ws + WS_SLOT); const float* gate = (const float*)(F.ws + WS_GATE);
    f32x4 g2v[4], fgv[4];
#pragma unroll
    for (int j = 0; j < 4; ++j) { g2v[j] = *(const f32x4*)(g2 + 256 * j + 4 * F.lane); fgv[j] = *(const f32x4*)(fg + 256 * j + 4 * F.lane); }
    for (int r = F.wave; r < rows_per; r += NWAVES) { const int tok = row_base + r;
        f32x4 acc[4];
#pragma unroll
        for (int j = 0; j < 4; ++j) acc[j] = (f32x4){0.f, 0.f, 0.f, 0.f};
#pragma unroll
        for (int k = 0; k < 4; ++k) { const unsigned sw = slot[(size_t)tok * 4 + k]; const float gk = gate[(size_t)tok * 4 + k]; const size_t p = (size_t)tile0[sw >> 16] * 256 + (sw & 0xffffu);
            const GAS int* yr = (const GAS int*)(Y2 + p * 1024) + F.lane; const float g8 = gk * 0.125f; typedef float f32x2 __attribute__((ext_vector_type(2)));
#pragma unroll
            for (int j = 0; j < 4; ++j) { const int w = yr[64 * j]; const f32x2 lo = __builtin_amdgcn_cvt_pk_f32_fp8(w, false), hi = __builtin_amdgcn_cvt_pk_f32_fp8(w, true);
                acc[j].x += g8 * lo.x; acc[j].y += g8 * lo.y; acc[j].z += g8 * hi.x; acc[j].w += g8 * hi.y; } }
        const GAS v2u* xr = (const GAS v2u*)((const bf16*)(F.ws + WS_X1B) + (size_t)tok * DM) + F.lane;
        GAS f32x4* xw = (GAS f32x4*)((dummy ? (float*)(F.ws + WS_A2) : F.out) + (size_t)tok * DM) + F.lane; f32x4 v[4]; float s = 0.f;
#pragma unroll
        for (int j = 0; j < 4; ++j) { const v2u wx = xr[64 * j]; v[j] = (f32x4){pg8::bf_lo(wx.x), pg8::bf_hi(wx.x), pg8::bf_lo(wx.y), pg8::bf_hi(wx.y)} + g2v[j] * acc[j]; s += (v[j].x * v[j].x + v[j].y * v[j].y) + (v[j].z * v[j].z + v[j].w * v[j].w); }
        const float rs = 1.0f / sqrtf(wave_sum_u(s) * (1.f / DM) + 1e-6f);
#pragma unroll
        for (int j = 0; j < 4; ++j) __builtin_nontemporal_store(v[j] * rs * fgv[j], (f32x4*)(xw + 64 * j));
    }
}

__device__ __forceinline__ void dep_signal(Frame& F, int word) {
    asm volatile("s_waitcnt vmcnt(0)" ::: "memory"); __syncthreads();
    if (F.wave == 0 && lane_id_opaque() == 0) { __builtin_amdgcn_fence(__ATOMIC_RELEASE, "agent"); asm volatile("s_waitcnt vmcnt(0)" ::: "memory"); (void)xb_add((unsigned*)(F.ctl + word), 1u); }
}
__device__ __forceinline__ void dep_wait(Frame& F, int word, unsigned need) {
    if (F.wave == 0 && lane_id_opaque() == 0) { unsigned* p = (unsigned*)(F.ctl + word); unsigned* bar = (unsigned*)(F.ctl + CW_BAR); XB_SPIN(xb_ld(p) < need, bar);
        __builtin_amdgcn_fence(__ATOMIC_ACQUIRE, "agent"); asm volatile("s_waitcnt vmcnt(0)" ::: "memory"); }
    __syncthreads();
}
#ifndef P2_NG
#define P2_NG 176
#endif
__device__ __forceinline__ void phase0(Frame& F, unsigned char* lds, unsigned char* ws) { p0_prologue(F);  }
__device__ __forceinline__ void phase1(Frame& F, unsigned char* lds, unsigned char* ws) { dep_wait(F, CW_DEP0, (unsigned)F.G); p1_h1(F);  }
__device__ __forceinline__ void phase2(Frame& F, unsigned char* lds, unsigned char* ws) {
        pg8::Gemm g{(const bf16*)(ws + WS_H), (const bf16*)(ws + WS_WIN), 1024, 1024, 1024}; const bool hosted = (F.G == 256); const int ng = hosted ? P2_NG : F.G;
        pg8::StaticOrder S; S.init(NTOK, 2048, ng, (int)blockIdx.x, 1024, 1024);
        pg8::EpiQKVU E{(bf16*)(ws + WS_Q), (size_t)(WS_K - WS_Q) / 2, (bf16*)(ws + WS_UA), attn_body::C2};
        if ((int)blockIdx.x < ng) pg8::gemm_phase<pg8::EpiQKVU, pg8::StaticOrder, true, false>(F.lds + RING_OFF, g, S, E, F.wave);
        else tr_run(F, 0, TR_HOSTED, ((int)blockIdx.x - ng) * NWAVES + F.wave, (F.G - ng) * NWAVES);

    }
__device__ __forceinline__ void phase4_glu(Frame& F, unsigned char* ws) {
        pg8::Gemm g{(const bf16*)(ws + WS_Z), (const bf16*)(ws + WS_WGLU), 512, 512, 512}; pg8::StaticOrder S; S.init(NTOK, 512, F.G, (int)blockIdx.x, 512, 512);
        { pg8::Unit u; const bool one = (F.G == 256) && S.next(0, u);
          if (one) dep_wait(F, CW_DEPB + 16 * (u.pm >> 4), 32u);
          else { for (int bb = 0; bb < NB; ++bb) dep_wait(F, CW_DEPB + 16 * bb, 32u); } }
        pg8::EpiGLU E{(const bf16*)(ws + WS_Z), (bf16*)(ws + WS_MIX), inp(20)};
        pg8::gemm_phase<pg8::EpiGLU, pg8::StaticOrder, true, false>(F.lds + RING_OFF, g, S, E, F.wave);
        __syncthreads();
    }
__device__ __forceinline__ void phase3(Frame& F, unsigned char* lds, unsigned char* ws) {
        for (int it = F.vcu; it < 256; it += F.G) { const int g = it >> 3, b = it & 7;
            bf16* UAgb = (bf16*)(ws + WS_UA) + (size_t)((g * 8 + b) * 256) * 384;
            { pg8::Gemm gx{UAgb, (const bf16*)(ws + WS_WM) + (size_t)g * 256 * 256, 256, 384, 256}; pg8::SingleUnit S; pg8::EpiX E;
              pg8::gemm_phase<pg8::EpiX, pg8::SingleUnit, false, false>(F.lds + RING_OFF, gx, S, E, F.wave); }
            LDS_WAIT(); __syncthreads();
            {
                const int p = lane_id_opaque(), c0 = F.wave * 32; const float* L16 = (const float*)(ws + WS_LAM16) + (g * 64 + p) * 2; const float lr = L16[0], li = L16[1];
                LAS float* X = (LAS float*)(F.lds + RING_OFF); LAS float* EW = X + 256 * pg8::XS;
                float hr = 0.f, hi2 = 0.f;
#pragma unroll 8
                for (int k = 0; k < 32; ++k) { LAS float* xc = X + (c0 + k) * pg8::XS + p; const float xr = xc[0], xi = xc[64]; xc[0] = hr; xc[64] = hi2;
                    const float nr = lr * hr - li * hi2 + xr, ni = lr * hi2 + li * hr + xi; hr = nr; hi2 = ni; }
                EW[F.wave * 128 + p] = hr; EW[F.wave * 128 + 64 + p] = hi2;
                float qr = lr, qi = li;
#pragma unroll
                for (int sq = 0; sq < 5; ++sq) { const float t = qr * qr - qi * qi; qi = 2.f * qr * qi; qr = t; }
                LDS_WAIT(); __syncthreads();
                float cr = 0.f, ci = 0.f;
                for (int v = 0; v < F.wave; ++v) { const float er = EW[v * 128 + p], ei = EW[v * 128 + 64 + p]; const float nr = qr * cr - qi * ci + er, ni = qr * ci + qi * cr + ei; cr = nr; ci = ni; }
                bf16* hrow = UAgb + (size_t)c0 * 384 + 256 + p; float pr = 1.f, pi = 0.f;
#pragma unroll 8
                for (int k = 0; k < 32; ++k) { const LAS float* xc = X + (c0 + k) * pg8::XS + p; const float hr2 = xc[0] + (pr * cr - pi * ci), hi3 = xc[64] + (pr * ci + pi * cr);
                    hrow[(size_t)k * 384] = (bf16)f2bf(hr2); hrow[(size_t)k * 384 + 64] = (bf16)f2bf(hi3);
                    const float t = pr * lr - pi * li; pi = pr * li + pi * lr; pr = t; }
                VM_WAIT(); if (F.wave == 0) { __builtin_amdgcn_fence(__ATOMIC_ACQUIRE, "agent"); VM_WAIT(); } }
            LDS_WAIT(); __syncthreads();
            { pg8::Gemm gy{UAgb, (const bf16*)(ws + WS_TV) + (size_t)g * 256 * 384, 384, 384, 384}; pg8::SingleUnit S; pg8::EpiY E{(bf16*)(ws + WS_Z), g, b};
              pg8::gemm_phase<pg8::EpiY, pg8::SingleUnit, false, false>(F.lds + RING_OFF, gy, S, E, F.wave); }
            dep_signal(F, CW_DEPB + 16 * b);
        }
        static_assert(attn_body::LDS2_BYTES <= LDSCTL_OFF, "attention LDS vs control words");
        for (int it = F.vcu; it < 256; it += F.G) { const int bh = it >> 3, sdx = it & 7, b = bh >> 2, h = bh & 3;
            for (int i4 = 0; i4 < 4; ++i4) { const int qb = (i4 >> 1) ? 15 - sdx : sdx;
                { const int m = i4 & 1, hm = h * 2 + m;
                    const attn_body::bf16* q_ = (const attn_body::bf16*)(ws + WS_Q) + (size_t)b * SEQ * 512 + hm * 64; const attn_body::bf16* k_ = (const attn_body::bf16*)(ws + WS_K) + (size_t)b * SEQ * 512 + hm * 64;
                    const attn_body::bf16* v_ = (const attn_body::bf16*)(ws + WS_V) + (size_t)b * SEQ * 512 + h * 128; attn_body::bf16* o_ = (attn_body::bf16*)(ws + WS_OB) + (size_t)b * SEQ * 1024 + hm * 128;
                    asm volatile("" : "+s"(q_), "+s"(k_), "+s"(v_), "+s"(o_));
                    attn_body::attn_unit2<8>(qb, q_, k_, v_, o_, (char*)lds + RING_OFF, F.wave); }
                if (i4 & 1) { VM_WAIT(); __syncthreads();
 const int ln = lane_id_opaque(), t16 = F.wave * 4 + (ln >> 4), d0 = (ln & 15) * 8; const float* sg = inp(10) + d0;
                  const float lam = __expf(wave_sum(inp(6)[ln] * inp(7)[ln])) - __expf(wave_sum(inp(8)[ln] * inp(9)[ln])) + 0.2f;
                  const bf16* OB = (const bf16*)(ws + WS_OB); bf16* MIX = (bf16*)(ws + WS_MIX);
                  for (int p = 0; p < 8; ++p) { const size_t tok = (size_t)b * SEQ + qb * 256 + p * 32 + t16;
                      const v4u a0 = *(const GAS v4u*)(OB + tok * 1024 + (h * 2) * 128 + d0), a1 = *(const GAS v4u*)(OB + tok * 1024 + (h * 2 + 1) * 128 + d0);
                      float a[8];
                      a[0] = pg8::bf_lo(a0.x) - lam * pg8::bf_lo(a1.x); a[1] = pg8::bf_hi(a0.x) - lam * pg8::bf_hi(a1.x); a[2] = pg8::bf_lo(a0.y) - lam * pg8::bf_lo(a1.y); a[3] = pg8::bf_hi(a0.y) - lam * pg8::bf_hi(a1.y);
                      a[4] = pg8::bf_lo(a0.z) - lam * pg8::bf_lo(a1.z); a[5] = pg8::bf_hi(a0.z) - lam * pg8::bf_hi(a1.z); a[6] = pg8::bf_lo(a0.w) - lam * pg8::bf_lo(a1.w); a[7] = pg8::bf_hi(a0.w) - lam * pg8::bf_hi(a1.w);
                      float ss = 0.f;
#pragma unroll
                      for (int j = 0; j < 8; ++j) ss += a[j] * a[j];
                      ss += __shfl_xor(ss, 1); ss += __shfl_xor(ss, 2); ss += __shfl_xor(ss, 4); ss += __shfl_xor(ss, 8);
                      const float rs = 0.8f / sqrtf(ss * (1.f / 128.f) + 1e-6f);
                      const float r4 = rs * 4.0f; const pg8::f32x4 q0 = {a[0] * r4 * sg[0], a[1] * r4 * sg[1], a[2] * r4 * sg[2], a[3] * r4 * sg[3]}, q1 = {a[4] * r4 * sg[4], a[5] * r4 * sg[5], a[6] * r4 * sg[6], a[7] * r4 * sg[7]};
                      *(GAS pg8::i32x2*)((unsigned char*)MIX + tok * 1024 + h * 128 + d0) = pg8::pack8_fp8(q0, q1); } }
            }
        }
        __syncthreads(); phase4_glu(F, ws);
}
__device__ __forceinline__ void phase4(Frame& F, unsigned char* lds, unsigned char* ws) { }
__device__ __forceinline__ void phase5(Frame& F, unsigned char* lds, unsigned char* ws) {
        pg8::Gemm g{(const bf16*)(ws + WS_MIX), (const bf16*)(ws + WS_WOUT), 512, 512, 512}; pg8::StaticOrder S; S.init(NTOK, 1024, F.G, (int)blockIdx.x, 512, 512);
        pg8::EpiOut E{inp(0), (bf16*)(ws + WS_X1B), (const float*)(ws + WS_MODF) + 2048, F.lds + VEC_OFF};
        pg8::gemm_phase<pg8::EpiOut, pg8::StaticOrder, true, false, true>(F.lds + RING_OFF, g, S, E, F.wave);

    }
__device__ __forceinline__ void phase6(Frame& F, unsigned char* lds, unsigned char* ws) { p6_router(F, false, !MK_PER_PHASE);  }
__device__ __forceinline__ void phase7(Frame& F, unsigned char* lds, unsigned char* ws) {
        moe_tables(F);
        MoeSched S; S.tile_e = (const LAS unsigned char*)(F.lds + TILE_E_OFF); S.tile0 = (const LAS int*)(F.lds + TILE0_OFF); S.rowtab = (const LAS unsigned*)(F.lds + ROWTAB_OFF);
        S.T = __builtin_amdgcn_readfirstlane(((const LAS int*)(F.lds + MOE_T_OFF))[0]); S.nN = 8; S.G = F.G; S.c = (int)blockIdx.x; S.rev = 0; S.a_mask = -1; S.e_mask = -1; S.tA = 0; S.tBe = (size_t)2048 * 1024; S.tB = (size_t)256 * 1024;
        { const LAS int* cntl = (const LAS int*)(F.lds + CNTL_OFF); LAS unsigned* rt = (LAS unsigned*)(F.lds + ROWTAB_OFF); const int* ptok = (const int*)(ws + WS_PTOK);
          int tokv[18]; bool live[18];
#pragma unroll
          for (int i = 0; i < 18; ++i) { pg8::Unit u; live[i] = S.next(i, u); tokv[i] = 0;
              if (live[i] && F.tid < 256) { const int e = u.e, pos = (u.pm - S.tile0[e]) * 256 + F.tid; tokv[i] = ptok[(size_t)e * NTOK + (pos < cntl[e] ? pos : 0)]; } }
#pragma unroll
          for (int i = 0; i < 18; ++i) if (live[i] && F.tid < 256) rt[i * 256 + F.tid] = (unsigned)tokv[i] * 1024u; }
        VM_WAIT(); LDS_WAIT(); __syncthreads();
        pg8::Gemm g{(const bf16*)(ws + WS_H), (const bf16*)(ws + WS_W1T), 512, 512, 512};
        pg8::EpiMoe1 E{(unsigned char*)(ws + WS_A2), inp(26), F.lds + BIASL_OFF};
        pg8::gemm_phase<pg8::EpiMoe1, MoeSched, true, true, true>(F.lds + RING_OFF, g, S, E, F.wave);

    }
__device__ __forceinline__ void phase8(Frame& F, unsigned char* lds, unsigned char* ws) {
        if (MK_PER_PHASE) moe_tables(F);
        MoeSched S; S.tile_e = (const LAS unsigned char*)(F.lds + TILE_E_OFF); S.tile0 = (const LAS int*)(F.lds + TILE0_OFF); S.rowtab = (const LAS unsigned*)(F.lds + ROWTAB_OFF);
        S.T = __builtin_amdgcn_readfirstlane(((const LAS int*)(F.lds + MOE_T_OFF))[0]); S.nN = 4; S.G = F.G; S.c = (int)blockIdx.x; S.rev = 1; S.a_mask = -1; S.e_mask = -1; S.tA = (size_t)256 * 1024; S.tBe = (size_t)1024 * 1024; S.tB = (size_t)256 * 1024;
        pg8::Gemm g{(const bf16*)(ws + WS_A2), (const bf16*)(ws + WS_W2T), 512, 512, 512};
        pg8::EpiMoe2 E{(unsigned char*)(ws + WS_Y2), inp(28), -1, F.lds + BIASL_OFF};
        pg8::gemm_phase<pg8::EpiMoe2, MoeSched, true, false, true>(F.lds + RING_OFF, g, S, E, F.wave);

    }
__device__ __forceinline__ void phase9(Frame& F, unsigned char* lds, unsigned char* ws) { p9_final(F); }
__device__ __forceinline__ bool relaunder(Frame& F) { F.lane = lane_id_opaque(); F.tid = F.wave * 64 + F.lane; return true; }
struct Args { const float* in[30]; float* out; unsigned char* ws; int ph_lo, ph_hi; };
__global__ void __launch_bounds__(NWAVES * 64, 2) mega_fwd(Args args) {
    extern __shared__ __attribute__((aligned(16))) unsigned char lds[];
    Frame F;
    F.lds = (LAS unsigned char*)lds;
    F.tid = threadIdx.x; F.lane = F.tid & 63; F.wave = __builtin_amdgcn_readfirstlane(F.tid >> 6);
    F.G = gridDim.x; { const int bx = blockIdx.x; F.vcu = (F.G % 8 == 0) ? (bx % 8) * (F.G / 8) + bx / 8 : bx; }
    F.ws = args.ws; F.out = args.out; F.ctl = (gu32*)(args.ws + WS_CTL);
    volatile LAS unsigned* MISC = (volatile LAS unsigned*)(F.lds + MISC_OFF);
    for (int u = F.tid; u < (LDS_BYTES - LDSCTL_OFF) / 4; u += NWAVES * 64) ((LAS unsigned*)(F.lds + LDSCTL_OFF))[u] = 0u;
    __syncthreads();
    XcdBarrier bar; bar.bar = (unsigned*)(F.ctl + CW_BAR); bar.x = 0; bar.st = nullptr;
    if (!MK_PER_PHASE) bar = xcd_barrier_post((unsigned*)(F.ctl + CW_BAR), MISC + 8);
    const int lo = args.ph_lo, hi = args.ph_hi;
#ifndef MK_MASK
#define MK_MASK 0x3ff
#endif
#define IN(k) (((MK_MASK >> (k)) & 1) && lo <= (k) && (k) < hi && relaunder(F))
#define SEAM(k) do { if (IN(k) && IN((k) + 1)) xcd_barrier(bar, F.wave); } while (0)
    unsigned char* ws = args.ws;

    if (IN(0)) { phase0(F, lds, ws); }
#if MK_DUP == 0
    if (IN(0)) { phase0(F, lds, ws); SEAM(0); }
#endif
    if (IN(1)) { phase1(F, lds, ws); SEAM(1); }
#if MK_DUP == 1
    if (IN(1)) { phase1(F, lds, ws); SEAM(1); }
#endif
    if (IN(2)) { phase2(F, lds, ws); SEAM(2); }
#if MK_DUP == 2
    if (IN(2)) { phase2(F, lds, ws); SEAM(2); }
#endif
#if MK_DUP == 18
    if (IN(2)) { for (int rr = 0; rr < 8; ++rr) { phase2(F, lds, ws); xcd_barrier(bar, F.wave); } }
#endif
    if (IN(3)) { phase3(F, lds, ws); }
#if MK_DUP == 3
    if (IN(3)) { phase3(F, lds, ws); SEAM(3); }
#endif
    if (IN(4)) { phase4(F, lds, ws); SEAM(4); }
#if MK_DUP == 4
    if (IN(4)) { phase4(F, lds, ws); SEAM(4); }
#endif
    if (IN(5)) { phase5(F, lds, ws); if (!MK_PER_PHASE && IN(6)) p6_fill(F); SEAM(5); }
#if MK_DUP == 5
    if (IN(5)) { phase5(F, lds, ws); SEAM(5); }
#endif
#if MK_DUP == 6
    if (IN(6)) { p6_router(F, true); xcd_barrier(bar, F.wave); }
#endif
    if (IN(6)) { phase6(F, lds, ws); SEAM(6); }
    if (IN(7)) { phase7(F, lds, ws); SEAM(7); }
#if MK_DUP == 7
    if (IN(7)) { phase7(F, lds, ws); SEAM(7); }
#endif
    if (IN(8)) { phase8(F, lds, ws); SEAM(8); }
#if MK_DUP == 8
    if (IN(8)) { phase8(F, lds, ws); SEAM(8); }
#endif
#if MK_DUP == 9
    if (IN(9)) { p9_final(F, true); xcd_barrier(bar, F.wave); }
#endif
#if MK_DUP == 16 || MK_DUP == 17
    if (IN(8)) {
        moe_tables(F);
        MoeSched S; S.tile_e = (const LAS unsigned char*)(F.lds + TILE_E_OFF); S.tile0 = (const LAS int*)(F.lds + TILE0_OFF); S.rowtab = (const LAS unsigned*)(F.lds + ROWTAB_OFF);
        S.T = __builtin_amdgcn_readfirstlane(((const LAS int*)(F.lds + MOE_T_OFF))[0]); S.nN = 4; S.G = F.G; S.c = (int)blockIdx.x; S.rev = 1; S.e_mask = (MK_DUP == 16) ? 0 : -1; S.a_mask = (MK_DUP == 16) ? 0 : -1; S.tA = (size_t)256 * 1024; S.tBe = (size_t)1024 * 1024; S.tB = (size_t)256 * 1024;
        pg8::Gemm g{(const bf16*)(ws + WS_A2), (const bf16*)(ws + WS_W2T), 512, 512, 512};
        pg8::EpiMoe2 E{(unsigned char*)(ws + WS_W1T), inp(28), 127};
        pg8::gemm_phase<pg8::EpiMoe2, MoeSched, true, false, true>(F.lds + RING_OFF, g, S, E, F.wave);
        xcd_barrier(bar, F.wave);
    }
#endif
    if (IN(9)) { phase9(F, lds, ws); }
#if MK_DUP == 19
    if (IN(9)) { xcd_barrier(bar, F.wave); phase7(F, lds, ws); }
#endif
#if MK_DUP == 20
    if (IN(9)) { xcd_barrier(bar, F.wave); phase8(F, lds, ws); }
#endif
#if MK_DUP == 10
    if (IN(9)) { xcd_barrier(bar, F.wave); phase0(F, lds, ws); }
#endif
#if MK_DUP == 11
    if (IN(9)) { xcd_barrier(bar, F.wave); p0_prologue(F, 1); }
#endif
#if MK_DUP == 13
    if (IN(9)) { xcd_barrier(bar, F.wave); p0_prologue(F, 3); }
#endif
#if MK_DUP == 14
    if (IN(9)) { xcd_barrier(bar, F.wave); p0_prologue(F, 4); }
#endif
#if MK_DUP == 15
    if (IN(9)) { xcd_barrier(bar, F.wave); }
#endif
#if MK_DUP == 12
    if (IN(9)) { xcd_barrier(bar, F.wave); p0_prologue(F, 2); }
#endif
#undef IN
#undef SEAM
}

extern "C" void kernel_launch(void* const* d_in, const int* in_sizes, int n_in, void* d_out, int out_size, void* d_ws, size_t ws_size, hipStream_t stream) {
    static int grid = 0;
    if (grid == 0) {
        if (n_in != 30 || in_sizes[0] != NTOK * DM || out_size != NTOK * DM || ws_size < WS_END) { fprintf(stderr, "kernel_launch: unexpected shapes (n_in %d, in0 %d, out %d, ws %zu); nothing launched\n", n_in, n_in > 0 ? in_sizes[0] : -1, out_size, ws_size); grid = -1; return; }
        int dev = 0, cus = 0;
        if (hipGetDevice(&dev) != hipSuccess || hipDeviceGetAttribute(&cus, hipDeviceAttributeMultiprocessorCount, dev) != hipSuccess) { fprintf(stderr, "kernel_launch: device query failed\n"); grid = -1; return; }
        if (hipFuncSetAttribute((const void*)mega_fwd, hipFuncAttributeMaxDynamicSharedMemorySize, LDS_BYTES) != hipSuccess) { fprintf(stderr, "kernel_launch: hipFuncSetAttribute failed\n"); grid = -1; return; }
        (void)hipGetLastError();
        grid = cus;
        if (grid != 256) { fprintf(stderr, "kernel_launch: built for a 256-CU device, found %d CUs; nothing launched\n", grid); grid = -1; return; }
    }
    if (grid < 0) return;
    if (hipMemsetAsync((char*)d_ws + WS_CTL, 0, CTL_ZERO_BYTES, stream) != hipSuccess) { fprintf(stderr, "kernel_launch: memset failed\n"); return; }
    Args a{};
    for (int i = 0; i < 30; ++i) a.in[i] = (const float*)d_in[i];
    a.out = (float*)d_out; a.ws = (unsigned char*)d_ws;
#if MK_PER_PHASE
    for (int p = 0; p < N_PHASES; ++p) { a.ph_lo = p; a.ph_hi = p + 1; hipLaunchKernelGGL(mega_fwd, dim3(grid), dim3(NWAVES * 64), LDS_BYTES, stream, a); }
#else
    a.ph_lo = 0; a.ph_hi = N_PHASES; hipLaunchKernelGGL(mega_fwd, dim3(grid), dim3(NWAVES * 64), LDS_BYTES, stream, a);
#endif
    const hipError_t le = hipPeekAtLastError();
    if (le != hipSuccess) fprintf(stderr, "kernel_launch: launch failed: %s\n", hipGetErrorName(le));
}
```

```cpp
#include <hip/hip_runtime.h>
#include <hip/hip_bf16.h>
#include <cstdio>
#include <cstdint>
#include <cmath>

#ifndef MK_PER_PHASE
#define MK_PER_PHASE 0
#endif

#ifdef MK_EPI2
#define MK_EPI2V MK_EPI2
#else
#define MK_EPI2V (-1)
#endif
#ifndef MK_DUP
#define MK_DUP (-1)
#endif

#define LAS __attribute__((address_space(3)))
#define GAS __attribute__((address_space(1)))

__device__ __forceinline__ int lane_id_opaque() { int l = (int)__builtin_amdgcn_mbcnt_hi(~0u, __builtin_amdgcn_mbcnt_lo(~0u, 0u)); asm volatile("" : "+v"(l)); return l; }

namespace pg8 {
typedef unsigned short bf16_t;
typedef short bf16x8 __attribute__((ext_vector_type(8)));
typedef float f32x4 __attribute__((ext_vector_type(4)));
typedef unsigned u32x4 __attribute__((ext_vector_type(4)));
typedef float f32x2 __attribute__((ext_vector_type(2)));
typedef int i32x4 __attribute__((ext_vector_type(4)));
typedef int i32x8 __attribute__((ext_vector_type(8)));
typedef int i32x2 __attribute__((ext_vector_type(2)));
constexpr int BM = 256, BK = 64, HALF = 128, HTB = HALF * BK * 2, STAGE_BYTES = 8 * HTB, NXCD = 8, WGM = 8;

__host__ __device__ __forceinline__ int lds_byte(int r, int c) { const int st = (r >> 4) * 2 + (c >> 5), rr = r & 15, cc = c & 31, ob = rr * 64 + cc * 2; return st * 1024 + (ob ^ (((ob >> 9) & 1) << 5)); }
__host__ __device__ __forceinline__ void stage_rc(int b, int& R, int& C) { const int st = b / 1024, sb = b % 1024, swz = sb ^ (((sb >> 9) & 1) << 5); R = (st >> 1) * 16 + swz / 64; C = (st & 1) * 32 + (swz % 64) / 2; }
__host__ __device__ __forceinline__ int perm32(int rho) { const int n = rho >> 4, i = rho & 15; return 8 * (i >> 2) + 4 * n + (i & 3); }

struct Unit { int pm, pn, e; };
struct Gemm { const bf16_t* A; const bf16_t* Bt; int K, lda, ldb; };

struct StaticOrder {
    int nM, nN, nwg, G, c; size_t tA, tB;
    __device__ __forceinline__ void init(int M, int N, int G_, int c_, int lda, int ldb) { nM = M / BM; nN = N / BM; nwg = nM * nN; G = G_; c = c_; tA = (size_t)BM * lda * 2; tB = (size_t)BM * ldb * 2; }
    __device__ __forceinline__ bool next(int i, Unit& u) const {
        const long L = (long)i * G + c; if (L >= nwg) return false;
        int wgid = (int)L; { const int q = nwg / NXCD, r = nwg % NXCD, xcd = wgid % NXCD, off = wgid / NXCD; wgid = (xcd < r ? xcd * (q + 1) : r * (q + 1) + (xcd - r) * q) + off; }
        const int nig = WGM * nN, gid = wgid / nig, fm = gid * WGM, gsz = (nM - fm) < WGM ? (nM - fm) : WGM;
        u.pm = fm + ((wgid % nig) % gsz); u.pn = (wgid % nig) / gsz; u.e = 0; return true;
    }
    __device__ __forceinline__ size_t aoff(const Unit& u) const { return (size_t)u.pm * tA; }
    __device__ __forceinline__ size_t boff(const Unit& u) const { return (size_t)u.pn * tB; }
    __device__ __forceinline__ unsigned rowoff(int, int) const { return 0u; }
};
struct SingleUnit {
    __device__ __forceinline__ bool next(int i, Unit& u) const { if (i > 0) return false; u.pm = 0; u.pn = 0; u.e = 0; return true; }
    __device__ __forceinline__ size_t aoff(const Unit&) const { return 0; }
    __device__ __forceinline__ size_t boff(const Unit&) const { return 0; }
    __device__ __forceinline__ unsigned rowoff(int, int) const { return 0u; }
};

__device__ __forceinline__ unsigned cvt_pk_bf16(float lo, float hi) { unsigned r; asm volatile("v_cvt_pk_bf16_f32 %0, %1, %2" : "=v"(r) : "v"(lo), "v"(hi)); return r; }
__device__ __forceinline__ float sigm(float x) { return __builtin_amdgcn_rcpf(1.0f + __builtin_amdgcn_exp2f(-1.4426950408889634f * x)); }
__device__ __forceinline__ float gelu_tanh(float y) { return y * sigm(1.5957691216057308f * (y + 0.044715f * y * y * y)); }
__device__ __forceinline__ f32x2 gelu_tanh2(f32x2 y) {
    const f32x2 y2 = y * y, u = y * __builtin_elementwise_fma(y2, (f32x2){0.044715f, 0.044715f}, (f32x2){1.f, 1.f}), ea = u * (-1.5957691216057308f * 1.4426950408889634f);
    f32x2 d; d.x = __builtin_amdgcn_exp2f(ea.x); d.y = __builtin_amdgcn_exp2f(ea.y); d = d + 1.0f; f32x2 r; r.x = __builtin_amdgcn_rcpf(d.x); r.y = __builtin_amdgcn_rcpf(d.y); return y * r; }
__device__ __forceinline__ u32x4 pack8(const f32x4& a, const f32x4& b) { u32x4 w; w.x = cvt_pk_bf16(a[0], a[1]); w.y = cvt_pk_bf16(a[2], a[3]); w.z = cvt_pk_bf16(b[0], b[1]); w.w = cvt_pk_bf16(b[2], b[3]); return w; }
__device__ __forceinline__ float clamp_fp8(float v) { return __builtin_amdgcn_fmed3f(v, -448.0f, 448.0f); }
__device__ __forceinline__ i32x2 pack8_fp8(const f32x4& a, const f32x4& c) {
    int w0 = __builtin_amdgcn_cvt_pk_fp8_f32(clamp_fp8(a[0]), clamp_fp8(a[1]), 0, false); w0 = __builtin_amdgcn_cvt_pk_fp8_f32(clamp_fp8(a[2]), clamp_fp8(a[3]), w0, true);
    int w1 = __builtin_amdgcn_cvt_pk_fp8_f32(clamp_fp8(c[0]), clamp_fp8(c[1]), 0, false); w1 = __builtin_amdgcn_cvt_pk_fp8_f32(clamp_fp8(c[2]), clamp_fp8(c[3]), w1, true);
    return (i32x2){w0, w1};
}

struct EpiQKVU {
    static constexpr bool PERM = true, AFTER_DRAIN = false, PROBE2 = (MK_EPI2V == 2);
    bf16_t* QKV; size_t stride; bf16_t* UA; float scale0;
    __device__ __forceinline__ void operator()(const f32x4 (&acc)[2][2][4][2], const Unit& u, int wr, int wc, int fr, int fq) const {
        const int t = u.pn >> 1, colt = (u.pn & 1) * 256 + wc * 32 + 8 * fq, row0 = u.pm * BM + wr * 64 + fr;
        if (t < 3) {
            bf16_t* base = QKV + (size_t)t * stride; const float sc = (t == 0) ? scale0 : 1.f;
#pragma unroll
            for (int ai = 0; ai < 2; ++ai)
#pragma unroll
                for (int m = 0; m < 4; ++m) { bf16_t* rowp = base + (size_t)(row0 + ai * HALF + m * 16) * 512 + colt;
#pragma unroll
                    for (int bj = 0; bj < 2; ++bj) *(u32x4*)(rowp + bj * HALF) = pack8(acc[ai][bj][m][0] * sc, acc[ai][bj][m][1] * sc); }
        } else {
#pragma unroll
            for (int ai = 0; ai < 2; ++ai)
#pragma unroll
                for (int m = 0; m < 4; ++m) { const int r = row0 + ai * HALF + m * 16, b = r >> 12, tt = r & 4095, chunk = tt >> 4, j = tt & 15;
#pragma unroll
                    for (int bj = 0; bj < 2; ++bj) { const int cu = colt + bj * HALF, g = cu >> 4, c0 = cu & 15;
                        *(u32x4*)(UA + ((size_t)((g * 8 + b) * 256 + chunk)) * 384 + j * 16 + c0) = pack8(acc[ai][bj][m][0], acc[ai][bj][m][1]); } }
        }
    }
};
constexpr int XS = 132;
struct EpiX {
    static constexpr bool PERM = false, AFTER_DRAIN = true, PROBE2 = false, HALF_N = true;
    __device__ __forceinline__ void fused(const f32x4 (&acc)[2][2][4][2], const Unit&, int wr, int wc, int fr, int fq, LAS unsigned char* lds, int, int) const {
        LAS float* X = (LAS float*)lds;
#pragma unroll
        for (int ai = 0; ai < 2; ++ai)
#pragma unroll
            for (int m = 0; m < 4; ++m) { const int row = ai * HALF + wr * 64 + m * 16 + fr;
#pragma unroll
                for (int n = 0; n < 2; ++n) *(LAS f32x4*)(X + row * XS + wc * 32 + n * 16 + 4 * fq) = acc[ai][0][m][n]; }
    }
};
struct EpiY {
    static constexpr bool PERM = true, AFTER_DRAIN = false, PROBE2 = false;
    bf16_t* Z; int g, b;
    __device__ __forceinline__ void operator()(const f32x4 (&acc)[2][2][4][2], const Unit&, int wr, int wc, int fr, int fq) const {
#pragma unroll
        for (int ai = 0; ai < 2; ++ai)
#pragma unroll
            for (int m = 0; m < 4; ++m) { const int chunk = ai * HALF + wr * 64 + m * 16 + fr;
#pragma unroll
                for (int bj = 0; bj < 2; ++bj) { const int col0 = bj * HALF + wc * 32 + 8 * fq, s = col0 >> 4, c0 = col0 & 15;
                    f32x4 v0 = acc[ai][bj][m][0], v1 = acc[ai][bj][m][1];
#pragma unroll
                    for (int q = 0; q < 4; q += 2) { const f32x2 a = gelu_tanh2((f32x2){v0[q], v0[q + 1]}), c = gelu_tanh2((f32x2){v1[q], v1[q + 1]}); v0[q] = a.x; v0[q + 1] = a.y; v1[q] = c.x; v1[q + 1] = c.y; }
                    *(u32x4*)(Z + (size_t)(b * 4096 + chunk * 16 + s) * 512 + g * 16 + c0) = pack8(v0, v1); }
                __builtin_amdgcn_sched_barrier(0); }
    }
};
__device__ __forceinline__ float bf_lo(unsigned w) { return __uint_as_float(w << 16); }
__device__ __forceinline__ float bf_hi(unsigned w) { return __uint_as_float(w & 0xffff0000u); }
struct EpiGLU {
    static constexpr bool PERM = true, AFTER_DRAIN = false, PROBE2 = false;
    const bf16_t* Z; bf16_t* MIX; const float* bias;
    __device__ __forceinline__ void operator()(const f32x4 (&acc)[2][2][4][2], const Unit& u, int wr, int wc, int fr, int fq) const {
        const int row0 = u.pm * BM + wr * 64 + fr, col0 = u.pn * BM + wc * 32 + 8 * fq;
        f32x4 bv[2][2];
#pragma unroll
        for (int bj = 0; bj < 2; ++bj)
#pragma unroll
            for (int n = 0; n < 2; ++n) bv[bj][n] = *(const f32x4*)(bias + col0 + bj * HALF + 4 * n);
#pragma unroll
        for (int ai = 0; ai < 2; ++ai)
        { u32x4 zv[4][2];
#pragma unroll
            for (int m = 0; m < 4; ++m)
#pragma unroll
                for (int bj = 0; bj < 2; ++bj) zv[m][bj] = *(const u32x4*)(Z + (size_t)(row0 + ai * HALF + m * 16) * 512 + col0 + bj * HALF);
#pragma unroll
            for (int m = 0; m < 4; ++m) { const size_t row = (size_t)(row0 + ai * HALF + m * 16);
#pragma unroll
                for (int bj = 0; bj < 2; ++bj) { const int col = col0 + bj * HALF; const u32x4 zz = zv[m][bj];
                    const f32x4 a0 = acc[ai][bj][m][0] + bv[bj][0], a1 = acc[ai][bj][m][1] + bv[bj][1];
                    f32x4 o0, o1;
                    o0[0] = bf_lo(zz.x) * sigm(a0[0]); o0[1] = bf_hi(zz.x) * sigm(a0[1]); o0[2] = bf_lo(zz.y) * sigm(a0[2]); o0[3] = bf_hi(zz.y) * sigm(a0[3]);
                    o1[0] = bf_lo(zz.z) * sigm(a1[0]); o1[1] = bf_hi(zz.z) * sigm(a1[1]); o1[2] = bf_lo(zz.w) * sigm(a1[2]); o1[3] = bf_hi(zz.w) * sigm(a1[3]);
                    *(i32x2*)((unsigned char*)MIX + row * 1024 + 512 + col) = pack8_fp8(o0 * 4.0f, o1 * 4.0f); }
                __builtin_amdgcn_sched_barrier(0); } }
    }
};
struct EpiOut {
    static constexpr bool PERM = true, AFTER_DRAIN = false, PROBE2 = (MK_EPI2V == 5);
    const float* X; bf16_t* X1; const float* g1; LAS unsigned char* stg;
    __device__ __forceinline__ void operator()(const f32x4 (&acc)[2][2][4][2], const Unit& u, int wr, int wc, int fr, int fq) const {
        const int col0 = wc * 32 + 8 * fq, b = (u.pm * BM) >> 12, t = (wr * 4 + wc) * 64 + fq * 16 + fr, rs = t >> 4, ch = t & 15;
        f32x4 gv[2][2];
#pragma unroll
        for (int bj = 0; bj < 2; ++bj)
#pragma unroll
            for (int n = 0; n < 2; ++n) gv[bj][n] = *(const f32x4*)(g1 + (size_t)b * 6144 + u.pn * BM + col0 + bj * HALF + 4 * n) * (1.0f / 128.0f);
        LAS unsigned char* wp = stg + (16 * wr + fr) * 528 + col0 * 2; const LAS unsigned char* rp = stg + rs * 528 + ch * 32;
        const size_t off0 = (size_t)(u.pm * BM + 64 * (rs >> 4) + (rs & 15)) * 1024 + u.pn * BM + 16 * ch;
        f32x4 xv[4], xn[4];
#pragma unroll
        for (int q = 0; q < 4; ++q) xv[q] = *(const f32x4*)(X + off0 + 4 * q);
#pragma unroll
        for (int sidx = 0; sidx < 8; ++sidx) { const int ai = sidx >> 2, m = sidx & 3; const size_t off = off0 + (size_t)(ai * HALF + 16 * m) * 1024;
            if (sidx < 7) { const size_t offn = off0 + (size_t)(((sidx + 1) >> 2) * HALF + 16 * ((sidx + 1) & 3)) * 1024;
#pragma unroll
                for (int q = 0; q < 4; ++q) xn[q] = *(const f32x4*)(X + offn + 4 * q); }
#pragma unroll
            for (int bj = 0; bj < 2; ++bj) *(LAS u32x4*)(wp + bj * 256) = pack8(gv[bj][0] * acc[ai][bj][m][0], gv[bj][1] * acc[ai][bj][m][1]);
            asm volatile("s_waitcnt lgkmcnt(0)" ::: "memory"); __builtin_amdgcn_s_barrier(); asm volatile("" ::: "memory");
            const u32x4 m0 = *(const LAS u32x4*)(rp), m1 = *(const LAS u32x4*)(rp + 16);
            f32x4 o0, o1, o2, o3;
            o0 = xv[0] + (f32x4){bf_lo(m0.x), bf_hi(m0.x), bf_lo(m0.y), bf_hi(m0.y)}; o1 = xv[1] + (f32x4){bf_lo(m0.z), bf_hi(m0.z), bf_lo(m0.w), bf_hi(m0.w)};
            o2 = xv[2] + (f32x4){bf_lo(m1.x), bf_hi(m1.x), bf_lo(m1.y), bf_hi(m1.y)}; o3 = xv[3] + (f32x4){bf_lo(m1.z), bf_hi(m1.z), bf_lo(m1.w), bf_hi(m1.w)};
            *(u32x4*)(X1 + off) = pack8(o0, o1); *(u32x4*)(X1 + off + 8) = pack8(o2, o3);
            asm volatile("s_waitcnt lgkmcnt(0)" ::: "memory"); __builtin_amdgcn_s_barrier(); asm volatile("" ::: "memory");
#pragma unroll
            for (int q = 0; q < 4; ++q) xv[q] = xn[q]; }
    }
};
constexpr float F8_ACT = 4.0f, F8_W = 32.0f, F8_UNDO = 1.0f / (4.0f * 32.0f);
struct EpiMoe1 {
    static constexpr bool PERM = true, AFTER_DRAIN = false, PROBE2 = (MK_EPI2V == 7), BIAS_LDS = true;
    unsigned char* A2; const float* b1; LAS unsigned char* bl; mutable int par = 0;
    __device__ __forceinline__ const float* bias_src(const Unit& u, int wc, int lane16, unsigned& voff) const { voff = (unsigned)(((lane16 >> 3) * 1024 + u.pn * 128 + wc * 32 + (lane16 & 7) * 4) * 4); return b1 + (size_t)u.e * 2048; }
    __device__ __forceinline__ void operator()(const f32x4 (&acc)[2][2][4][2], const Unit& u, int wr, int wc, int fr, int fq) const {
        asm volatile("" : "+v"(fr), "+v"(fq));
        const int row0 = u.pm * BM + wr * 64 + fr, jc = u.pn * 128 + wc * 32 + 8 * fq;
        f32x4 bg[2], bu[2];
#pragma unroll
        for (int n = 0; n < 2; ++n) { const LAS unsigned char* bp = bl + par * 2048 + (wr * 4 + wc) * 256 + fq * 32 + n * 16; bg[n] = *(const LAS f32x4*)(bp); bu[n] = *(const LAS f32x4*)(bp + 128); }
#pragma unroll
        for (int ai = 0; ai < 2; ++ai)
#pragma unroll
            for (int m = 0; m < 4; ++m) { f32x4 o[2];
#pragma unroll
                for (int n = 0; n < 2; ++n) {
#pragma unroll
                    for (int hq = 0; hq < 2; ++hq) { const f32x2 ag = {acc[ai][0][m][n][2 * hq], acc[ai][0][m][n][2 * hq + 1]}, au = {acc[ai][1][m][n][2 * hq], acc[ai][1][m][n][2 * hq + 1]};
                        const f32x2 vbg = {bg[n][2 * hq], bg[n][2 * hq + 1]}, vbu = {bu[n][2 * hq], bu[n][2 * hq + 1]}, k7 = {7.0f, 7.0f}, km7 = {-7.0f, -7.0f}, kund = {F8_UNDO, F8_UNDO};
                        const f32x2 g = __builtin_elementwise_min(__builtin_elementwise_fma(ag, kund, vbg), k7), uu = __builtin_elementwise_min(__builtin_elementwise_max(__builtin_elementwise_fma(au, kund, vbu), km7), k7);
                        const f32x2 ea = g * (-1.702f * 1.4426950408889634f); f32x2 den; den.x = __builtin_amdgcn_exp2f(ea.x); den.y = __builtin_amdgcn_exp2f(ea.y); den = den + 1.0f;
                        f32x2 sg; sg.x = __builtin_amdgcn_rcpf(den.x); sg.y = __builtin_amdgcn_rcpf(den.y);
                        const f32x2 r = __builtin_elementwise_fma(uu, (f32x2){F8_ACT, F8_ACT}, (f32x2){F8_ACT, F8_ACT}) * (g * sg); o[n][2 * hq] = r.x; o[n][2 * hq + 1] = r.y; } }
                *(i32x2*)(A2 + (size_t)(row0 + ai * HALF + m * 16) * 1024 + jc) = pack8_fp8(o[0], o[1]);
                __builtin_amdgcn_sched_barrier(0); }
    }
};
struct EpiMoe2 {
    static constexpr bool PERM = true, AFTER_DRAIN = false, PROBE2 = (MK_EPI2V == 8), BIAS_LDS = true;
    unsigned char* Y2; const float* b2; int pm_mask; LAS unsigned char* bl; mutable int par = 0;
    __device__ __forceinline__ const float* bias_src(const Unit& u, int wc, int lane16, unsigned& voff) const { voff = (unsigned)((u.pn * BM + (lane16 >> 3) * HALF + wc * 32 + (lane16 & 7) * 4) * 4); return b2 + (size_t)u.e * 1024; }
    __device__ __forceinline__ void operator()(const f32x4 (&acc)[2][2][4][2], const Unit& u, int wr, int wc, int fr, int fq) const {
        asm volatile("" : "+v"(fr), "+v"(fq));
        const int row0 = (u.pm & pm_mask) * BM + wr * 64 + fr, col0 = u.pn * BM + wc * 32 + 8 * fq;
        f32x4 bv[2][2];
#pragma unroll
        for (int bj = 0; bj < 2; ++bj)
#pragma unroll
            for (int n = 0; n < 2; ++n) bv[bj][n] = *(const LAS f32x4*)(bl + par * 2048 + (wr * 4 + wc) * 256 + bj * 128 + fq * 32 + n * 16);
#pragma unroll
        for (int ai = 0; ai < 2; ++ai)
#pragma unroll
            for (int m = 0; m < 4; ++m) { unsigned char* rowp = Y2 + (size_t)(row0 + ai * HALF + m * 16) * 1024 + col0;
#pragma unroll
                for (int bj = 0; bj < 2; ++bj) *(i32x2*)(rowp + bj * HALF) = pack8_fp8((acc[ai][bj][m][0] * F8_UNDO + bv[bj][0]) * 8.0f, (acc[ai][bj][m][1] * F8_UNDO + bv[bj][1]) * 8.0f); }
    }
};

template <class E, class = void> struct epi_bias_lds { static constexpr bool value = false; };
template <class E> struct epi_bias_lds<E, decltype((void)E::BIAS_LDS)> { static constexpr bool value = E::BIAS_LDS; };
template <class E, class = void> struct epi_half_n { static constexpr bool value = false; };
template <class E> struct epi_half_n<E, decltype((void)E::HALF_N)> { static constexpr bool value = E::HALF_N; };
template <class Epi, class Sched, bool ALIGN_EPI, bool GATHER, bool F8 = false>
__device__ __forceinline__ void gemm_phase(LAS unsigned char* lds, const Gemm g, const Sched& S, const Epi& E, const int wave) {
    const int tid = wave * 64 + lane_id_opaque(), wid = __builtin_amdgcn_readfirstlane(tid >> 6), lane = tid & 63,
              wr = wid >> 2, wc = wid & 3, fr = lane & 15, fq = lane >> 4;
    const int nt = g.K / BK; constexpr bool HN = epi_half_n<Epi>::value; constexpr bool BL = epi_bias_lds<Epi>::value;
    unsigned voffB[2], vA[2][2];
#pragma unroll
    for (int i = 0; i < 2; ++i) { int R, C; stage_rc(tid * 16 + i * 8192, R, C); const int Rb = Epi::PERM ? ((R & ~31) + perm32(R & 31)) : R;
        voffB[i] = (unsigned)(Rb * g.ldb + C) * 2u;
#pragma unroll
        for (int h = 0; h < 2; ++h) vA[h][i] = (unsigned)((R + h * HALF) * g.lda + C) * 2u; }
    const size_t kstep = (size_t)(BK * 2);
    const size_t hstepB = (size_t)HALF * g.ldb * 2;
    const unsigned ldsw = (unsigned)wid * 1024u;
    const unsigned ldsbase = (unsigned)__builtin_amdgcn_readfirstlane((int)((unsigned)(uintptr_t)lds + ldsw));
    const int aoff = lds_byte(wr * 64 + fr, fq * 8), boff = lds_byte(wc * 32 + fr, fq * 8);
#define PG8_SA(b, h) (((b) * 2 + (h)) * HTB)
#define PG8_SB(b, h) ((4 + (b) * 2 + (h)) * HTB)
#define PG8_STAGE(bufoff, gbase, voff) do { if constexpr (F8) { _Pragma("unroll") for (int _i = 0; _i < 2; ++_i) { unsigned keep_; \
            asm volatile("s_mov_b32 %0, m0\n\ts_mov_b32 m0, %3\n\ts_nop 0\n\tglobal_load_lds_dwordx4 %1, %2\n\ts_mov_b32 m0, %0" : "=&s"(keep_) : "v"((voff)[_i]), "s"((const char*)(gbase)), "s"(ldsbase + (unsigned)((bufoff) + _i * 8192)) : "memory"); } } \
        else { _Pragma("unroll") for (int _i = 0; _i < 2; ++_i) \
        __builtin_amdgcn_global_load_lds((const unsigned*)((const char*)(gbase) + (voff)[_i]), (LAS unsigned*)(lds + (bufoff) + ldsw + _i * 8192), 16, 0, 0); } } while (0)
#define PG8_LDA(dst, b, h) do { if constexpr (F8) { _Pragma("unroll") for (int m = 0; m < 4; ++m) dst##8[m] = PG8_F8CAT(*(const LAS bf16x8*)(lds + PG8_SA(b, h) + aoff + m * 2048), *(const LAS bf16x8*)(lds + PG8_SA(b, h) + aoff + m * 2048 + 1024)); } \
        else { _Pragma("unroll") for (int m = 0; m < 4; ++m) _Pragma("unroll") for (int k = 0; k < 2; ++k) dst[m][k] = *(const LAS bf16x8*)(lds + PG8_SA(b, h) + aoff + m * 2048 + k * 1024); } } while (0)
#define PG8_LDB(dst, b, h) do { if constexpr (F8) { _Pragma("unroll") for (int n = 0; n < 2; ++n) dst##8[n] = PG8_F8CAT(*(const LAS bf16x8*)(lds + PG8_SB(b, h) + boff + n * 2048), *(const LAS bf16x8*)(lds + PG8_SB(b, h) + boff + n * 2048 + 1024)); } \
        else { _Pragma("unroll") for (int n = 0; n < 2; ++n) _Pragma("unroll") for (int k = 0; k < 2; ++k) dst[n][k] = *(const LAS bf16x8*)(lds + PG8_SB(b, h) + boff + n * 2048 + k * 1024); } } while (0)
#define PG8_F8CAT(lo, hi) __builtin_shufflevector(__builtin_bit_cast(i32x4, (lo)), __builtin_bit_cast(i32x4, (hi)), 0, 1, 2, 3, 4, 5, 6, 7)
#define PG8_MMA(ai, bj, At, Bt) do { __builtin_amdgcn_s_setprio(1); \
        if constexpr (F8) { _Pragma("unroll") for (int m = 0; m < 4; ++m) _Pragma("unroll") for (int n = 0; n < 2; ++n) \
            acc[ai][bj][m][n] = __builtin_amdgcn_mfma_scale_f32_16x16x128_f8f6f4(Bt##8[n], At##8[m], acc[ai][bj][m][n], 0, 0, 0, 0x7F7F7F7F, 0, 0x7F7F7F7F); } \
        else { _Pragma("unroll") for (int m = 0; m < 4; ++m) _Pragma("unroll") for (int n = 0; n < 2; ++n) _Pragma("unroll") for (int k = 0; k < 2; ++k) \
            acc[ai][bj][m][n] = __builtin_amdgcn_mfma_f32_16x16x32_bf16(Bt[n][k], At[m][k], acc[ai][bj][m][n], 0, 0, 0); } \
        __builtin_amdgcn_s_setprio(0); } while (0)
#define PG8_WAIT_V(n) asm volatile("s_waitcnt vmcnt(" #n ")" ::: "memory")
#define PG8_WAIT_L(n) asm volatile("s_waitcnt lgkmcnt(" #n ")" ::: "memory")
#define PG8_BAR __builtin_amdgcn_s_barrier()
#define PG8_SCHED __builtin_amdgcn_sched_barrier(0)
#define PG8_GOFF(u_, h, i) ({ const int tq_ = wid * 64 + lane_id_opaque(); int R_, C_; stage_rc(tq_ * 16 + (i) * 8192, R_, C_); S.rowoff((u_), (h) * HALF + R_) + (unsigned)C_ * 2u; })
    Unit cur, nxt; int ui = 0;
    if (!S.next(0, cur)) return;
#define PG8_BIAS_DMA(u_, par_) do { const int tl_ = lane_id_opaque(); unsigned bvo_; const float* bsrc0_ = E.bias_src((u_), wc, tl_ & 15, bvo_); \
        const uintptr_t bq_ = (uintptr_t)bsrc0_; const char* bsrc_ = (const char*)(((uintptr_t)(unsigned)__builtin_amdgcn_readfirstlane((int)(unsigned)(bq_ >> 32)) << 32) | (uintptr_t)(unsigned)__builtin_amdgcn_readfirstlane((int)(unsigned)bq_)); \
        const unsigned bdst_ = (unsigned)__builtin_amdgcn_readfirstlane((int)((unsigned)(uintptr_t)E.bl + (unsigned)(par_) * 2048u + (unsigned)wid * 256u)); \
        if (tl_ < 16) { unsigned keep_; \
            asm volatile("s_mov_b32 %0, m0\n\ts_mov_b32 m0, %3\n\ts_nop 0\n\tglobal_load_lds_dwordx4 %1, %2\n\ts_mov_b32 m0, %0" : "=&s"(keep_) : "v"(bvo_), "s"(bsrc_), "s"(bdst_) : "memory"); } } while (0)
    if constexpr (BL) PG8_BIAS_DMA(cur, 0);
    if constexpr (GATHER) {
#pragma unroll
        for (int h = 0; h < 2; ++h)
#pragma unroll
            for (int i = 0; i < 2; ++i) vA[h][i] = PG8_GOFF(0, h, i);
    }
    f32x4 acc[2][2][4][2];
#pragma unroll
    for (int a = 0; a < 2; ++a)
#pragma unroll
        for (int b = 0; b < 2; ++b)
#pragma unroll
            for (int m = 0; m < 4; ++m)
#pragma unroll
                for (int n = 0; n < 2; ++n) acc[a][b][m][n] = (f32x4){0.f, 0.f, 0.f, 0.f};
    bf16x8 At[4][2], B0[2][2], B1[2][2]; i32x8 At8[4], B08[2], B18[2];
    const char* cA = (const char*)g.A + S.aoff(cur); const char* cB = (const char*)g.Bt + S.boff(cur);
    PG8_STAGE(PG8_SB(0, 0), cB, voffB); PG8_STAGE(PG8_SB(0, 1), cB + hstepB, voffB); PG8_STAGE(PG8_SA(0, 0), cA, vA[0]); PG8_STAGE(PG8_SA(0, 1), cA, vA[1]);
    if (wr == 1) PG8_BAR;
    PG8_WAIT_V(2); PG8_BAR;
    PG8_STAGE(PG8_SB(1, 0), cB + kstep, voffB); PG8_STAGE(PG8_SA(1, 0), cA + kstep, vA[0]); PG8_STAGE(PG8_SB(1, 1), cB + hstepB + kstep, voffB);
    PG8_WAIT_V(6); PG8_BAR;
    for (;;) {
        const bool has_next = S.next(ui + 1, nxt);
        const char* nA = has_next ? (const char*)g.A + S.aoff(nxt) : cA; const char* nB = has_next ? (const char*)g.Bt + S.boff(nxt) : cB;
#pragma unroll 1
        for (int t = 0; t < nt; t += 2) {
            const bool last = (t == nt - 2);
            const char* a1 = cA + (size_t)(t + 1) * kstep;
            const char* a2 = last ? nA : cA + (size_t)(t + 2) * kstep; const char* b2 = last ? nB : cB + (size_t)(t + 2) * kstep;
            const char* a3 = a2 + kstep; const char* b3 = b2 + kstep;
            unsigned w0[2], w1[2];
            if constexpr (GATHER) { const bool nx_ = last && has_next;
                if (nx_) { w0[0] = PG8_GOFF(ui + 1, 0, 0); w0[1] = PG8_GOFF(ui + 1, 0, 1); w1[0] = PG8_GOFF(ui + 1, 1, 0); w1[1] = PG8_GOFF(ui + 1, 1, 1); }
                else { w0[0] = vA[0][0]; w0[1] = vA[0][1]; w1[0] = vA[1][0]; w1[1] = vA[1][1]; } }
            else { w0[0] = vA[0][0]; w0[1] = vA[0][1]; w1[0] = vA[1][0]; w1[1] = vA[1][1]; }
            PG8_LDB(B0, 0, 0); if constexpr (!HN) PG8_LDB(B1, 0, 1); PG8_SCHED; PG8_LDA(At, 0, 0); PG8_STAGE(PG8_SA(1, 1), a1, vA[1]);
            PG8_WAIT_V(8); PG8_WAIT_L(0); PG8_BAR; PG8_MMA(0, 0, At, B0); if constexpr (!HN) PG8_MMA(0, 1, At, B1); PG8_BAR; PG8_SCHED;
            PG8_LDA(At, 0, 1); PG8_STAGE(PG8_SB(0, 0), b2, voffB); PG8_STAGE(PG8_SB(0, 1), b2 + hstepB, voffB); PG8_STAGE(PG8_SA(0, 0), a2, w0);
            PG8_WAIT_V(8); PG8_WAIT_L(0); PG8_BAR; PG8_MMA(1, 0, At, B0); if constexpr (!HN) PG8_MMA(1, 1, At, B1); PG8_BAR; PG8_SCHED;
            PG8_LDB(B0, 1, 0); if constexpr (!HN) PG8_LDB(B1, 1, 1); PG8_SCHED; PG8_LDA(At, 1, 0); PG8_STAGE(PG8_SA(0, 1), a2, w1);
            PG8_WAIT_V(8); PG8_WAIT_L(0); PG8_BAR; PG8_MMA(0, 0, At, B0); if constexpr (!HN) PG8_MMA(0, 1, At, B1); PG8_BAR; PG8_SCHED;
            PG8_LDA(At, 1, 1); PG8_STAGE(PG8_SB(1, 0), b3, voffB); PG8_STAGE(PG8_SB(1, 1), b3 + hstepB, voffB); PG8_STAGE(PG8_SA(1, 0), a3, w0);
            PG8_WAIT_V(8); PG8_WAIT_L(0); PG8_BAR; PG8_MMA(1, 0, At, B0); if constexpr (!HN) PG8_MMA(1, 1, At, B1); PG8_BAR; PG8_SCHED;
        }
        if constexpr (ALIGN_EPI) { if (wr == 0) PG8_BAR; }
        if constexpr (BL) { if (has_next) PG8_BIAS_DMA(nxt, (ui + 1) & 1); }
        if constexpr (!Epi::AFTER_DRAIN) { const int te_ = lane_id_opaque(); const int fre = te_ & 15, fqe = (te_ >> 4) & 3;
            if constexpr (BL) E.par = ui & 1;
            E(acc, cur, wr, wc, fre, fqe);
#ifdef MK_EPI2
            if constexpr (Epi::PROBE2) { asm volatile("" ::: "memory"); E(acc, cur, wr, wc, fr, fq); }
#endif
        }
        if (!has_next) break;
#pragma unroll
        for (int a = 0; a < 2; ++a)
#pragma unroll
            for (int b = 0; b < 2; ++b)
#pragma unroll
                for (int m = 0; m < 4; ++m)
#pragma unroll
                    for (int n = 0; n < 2; ++n) acc[a][b][m][n] = (f32x4){0.f, 0.f, 0.f, 0.f};
        cur = nxt; cA = nA; cB = nB; ++ui;
        if constexpr (GATHER) {
#pragma unroll
            for (int h = 0; h < 2; ++h)
#pragma unroll
                for (int i = 0; i < 2; ++i) vA[h][i] = PG8_GOFF(ui, h, i);
        }
        if constexpr (ALIGN_EPI) { if (wr == 1) PG8_BAR; }
    }
    PG8_WAIT_V(0);
    if constexpr (!ALIGN_EPI) { if (wr == 0) PG8_BAR; }
    PG8_BAR;
    if constexpr (Epi::AFTER_DRAIN) { E.fused(acc, cur, wr, wc, fr, fq, lds, wid, lane); }
#undef PG8_BIAS_DMA
#undef PG8_SA
#undef PG8_SB
#undef PG8_STAGE
#undef PG8_LDA
#undef PG8_LDB
#undef PG8_MMA
#undef PG8_GOFF
#undef PG8_F8CAT
#undef PG8_WAIT_V
#undef PG8_WAIT_L
#undef PG8_BAR
#undef PG8_SCHED
}
}

namespace attn_body {
using bf16=__hip_bfloat16;
using bf16x8=__attribute__((ext_vector_type(8)))short;
using s16x4=__attribute__((ext_vector_type(4)))short;
using f32x16=__attribute__((ext_vector_type(16)))float;
using u32x4=__attribute__((ext_vector_type(4)))unsigned;
constexpr int SEQ=4096,D=64,DMI=512,DMO=1024;
constexpr int NW=8,QBLK=32,QB=QBLK*NW,KVBLK=64,NQB=SEQ/QB;
__device__ __forceinline__ int crow(int r,int hi){return (r&3)+8*(r>>2)+4*hi;}
#define SBAR() __builtin_amdgcn_sched_barrier(0)
__device__ __forceinline__ void cmask(f32x16&p0,f32x16&p1,int jb,int qrel,int hi){
  const float NEG=-INFINITY; int kb=64*jb+4*hi;
  #pragma unroll
  for(int r=0;r<16;++r){int kv=kb+(r&3)+8*(r>>2); if(kv>qrel)p0[r]=NEG; if(kv+32>qrel)p1[r]=NEG;}
}
constexpr int NSLOT=3, SLOTB=8192;
constexpr int LDS_K=0, LDS_V=NSLOT*SLOTB, LDS_WS=2*NSLOT*SLOTB, LDS_OST=LDS_WS+NW*64*4, LDS_BYTES=LDS_OST+NW*4096;
constexpr float C2=0.125f*1.4426950408889634f;
__device__ __forceinline__ void glds16(const void*gsrc,unsigned lds_dst){unsigned keep;
  asm volatile("s_mov_b32 %0, m0\n\ts_mov_b32 m0, %2\n\ts_nop 0\n\tglobal_load_lds_dwordx4 %1, off\n\ts_mov_b32 m0, %0":"=&s"(keep):"v"(gsrc),"s"(lds_dst):"memory");}
__device__ __forceinline__ float max3f(float a,float b,float c){float r;asm("v_max3_f32 %0, %1, %2, %3":"=v"(r):"v"(a),"v"(b),"v"(c));return r;}
__device__ __forceinline__ float max2f(float a,float b){float r;asm("v_max_f32_e32 %0, %1, %2":"=v"(r):"v"(a),"v"(b));return r;}
__device__ __forceinline__ float fadd_s(float a,float b){float r;asm("v_add_f32_e32 %0, %1, %2":"=v"(r):"v"(a),"v"(b));return r;}
__device__ __forceinline__ float fsub_s(float a,float b){float r;asm("v_sub_f32_e32 %0, %1, %2":"=v"(r):"v"(a),"v"(b));return r;}
typedef float f32x2_t __attribute__((ext_vector_type(2))); typedef __bf16 bf16x2_t __attribute__((ext_vector_type(2)));
__device__ __forceinline__ unsigned cvtpk_s(float lo,float hi){f32x2_t v={lo,hi};bf16x2_t b=__builtin_convertvector(v,bf16x2_t);return __builtin_bit_cast(unsigned,b);}
#define WAIT_BAR(N) asm volatile("s_waitcnt vmcnt(" #N ") lgkmcnt(0)\n\ts_barrier":::"memory")

__device__ __forceinline__ void qkt(f32x16&p0,f32x16&p1,const char*Kslot,const bf16x8*qr,const f32x16&negm,int r32,int hi){
  const char*kb=Kslot+hi*1024+r32*16;
  #pragma unroll
  for(int d0=0;d0<4;++d0){
    const bf16x8 b0=*reinterpret_cast<const bf16x8*>(kb+d0*2048);
    const bf16x8 b1=*reinterpret_cast<const bf16x8*>(kb+d0*2048+512);
    if(d0==0){p0=__builtin_amdgcn_mfma_f32_32x32x16_bf16(b0,qr[0],negm,0,0,0);p1=__builtin_amdgcn_mfma_f32_32x32x16_bf16(b1,qr[0],negm,0,0,0);}
    else{p0=__builtin_amdgcn_mfma_f32_32x32x16_bf16(b0,qr[d0],p0,0,0,0);p1=__builtin_amdgcn_mfma_f32_32x32x16_bf16(b1,qr[d0],p1,0,0,0);}}
}
typedef __attribute__((address_space(3))) const char* lds_cptr;
typedef short v4i16_t __attribute__((ext_vector_type(4)));
__device__ __forceinline__ void kload8(bf16x8*kf,lds_cptr kp){
  kf[0]=*(const __attribute__((address_space(3))) bf16x8*)(kp);      kf[1]=*(const __attribute__((address_space(3))) bf16x8*)(kp+512);
  kf[2]=*(const __attribute__((address_space(3))) bf16x8*)(kp+2048); kf[3]=*(const __attribute__((address_space(3))) bf16x8*)(kp+2560);
  kf[4]=*(const __attribute__((address_space(3))) bf16x8*)(kp+4096); kf[5]=*(const __attribute__((address_space(3))) bf16x8*)(kp+4608);
  kf[6]=*(const __attribute__((address_space(3))) bf16x8*)(kp+6144); kf[7]=*(const __attribute__((address_space(3))) bf16x8*)(kp+6656);
}
__device__ __forceinline__ void kload2(bf16x8*kf,lds_cptr kp,int j){ kf[2*j]=*(const __attribute__((address_space(3))) bf16x8*)(kp+j*2048); kf[2*j+1]=*(const __attribute__((address_space(3))) bf16x8*)(kp+j*2048+512); }
__device__ __forceinline__ s16x4 vtr(lds_cptr p){ return __builtin_bit_cast(s16x4,__builtin_amdgcn_ds_read_tr16_b64_v4i16((__attribute__((address_space(3))) v4i16_t*)p)); }
__device__ __forceinline__ float rowmax(const f32x16&p0,const f32x16&p1){
  float a=max3f(p0[0],p0[1],p1[0]),b=max3f(p0[2],p0[3],p1[1]);a=max3f(a,p1[2],p1[3]);
  #pragma unroll
  for(int r=4;r<16;r+=4){a=max3f(a,p0[r],p0[r+1]);b=max3f(b,p0[r+2],p0[r+3]);a=max3f(a,p1[r],p1[r+1]);b=max3f(b,p1[r+2],p1[r+3]);}
  const float m=max2f(a,b);
  auto rr=__builtin_amdgcn_permlane32_swap(__float_as_uint(m),__float_as_uint(m),false,false);
  return max2f(__uint_as_float(rr[0]),__uint_as_float(rr[1]));
}
__device__ __forceinline__ void pv(f32x16*o,int vb,bf16x8 pa0,bf16x8 pa1,bf16x8 pa2,bf16x8 pa3){
  #pragma unroll
  for(int d0=0;d0<2;++d0){s16x4 lo[4],hi[4];
    #pragma unroll
    for(int ks=0;ks<4;++ks){
      asm volatile("ds_read_b64_tr_b16 %0,%1 offset:%c2":"=&v"(lo[ks]):"v"(vb),"i"(d0*4096+ks*1024):"memory");
      asm volatile("ds_read_b64_tr_b16 %0,%1 offset:%c2":"=&v"(hi[ks]):"v"(vb),"i"(d0*4096+ks*1024+512):"memory");}
    asm volatile("s_waitcnt lgkmcnt(0)":::"memory");SBAR();
    #define PK(k) (bf16x8){lo[k][0],lo[k][1],lo[k][2],lo[k][3],hi[k][0],hi[k][1],hi[k][2],hi[k][3]}
    o[d0]=__builtin_amdgcn_mfma_f32_32x32x16_bf16(pa0,PK(0),o[d0],0,0,0);
    o[d0]=__builtin_amdgcn_mfma_f32_32x32x16_bf16(pa1,PK(1),o[d0],0,0,0);
    o[d0]=__builtin_amdgcn_mfma_f32_32x32x16_bf16(pa2,PK(2),o[d0],0,0,0);
    o[d0]=__builtin_amdgcn_mfma_f32_32x32x16_bf16(pa3,PK(3),o[d0],0,0,0);
    #undef PK
  }
}
#define ATTN_STORE16(p,v) (*(u32x4*)(p)=(v))
template<int THRL> __device__ __forceinline__ void attn_unit(int qb,const bf16*Qh,const bf16*__restrict__ Kh,const bf16*__restrict__ Vh,bf16*Oh,char*shm){
  int tid_=threadIdx.x; asm volatile("":"+v"(tid_));
  const int tid=tid_,lane=tid&63,r32=lane&31,hi=lane>>5; const int wid=__builtin_amdgcn_readfirstlane(tid>>6);
  const int q0=qb*QB;
  const bf16*Qw=Qh+(long)(q0+wid*QBLK)*DMI;
  const unsigned lds0=(unsigned)(uintptr_t)shm;
  float*wsf=(float*)(shm+LDS_WS)+wid*64;
  const bf16*ksrc=Kh+(long)lane*DMI+wid*8;
  const bf16*vsrc=Vh+(long)(16*(wid&3)+(lane>>2))*DMI+(wid>>2)*32+(lane&3)*8;
  const unsigned kdst=lds0+LDS_K+wid*1024, vdst=lds0+LDS_V+wid*1024;
  #define DMA_K(t,slot) glds16(ksrc+(long)(t)*KVBLK*DMI,(unsigned)__builtin_amdgcn_readfirstlane(kdst+(slot)))
  #define DMA_V(t,slot) glds16(vsrc+(long)(t)*KVBLK*DMI,(unsigned)__builtin_amdgcn_readfirstlane(vdst+(slot)))
  const int vb0=(int)(lds0+LDS_V)+((lane>>4)&1)*32+(lane&3)*8+(4*hi+((lane&15)>>2))*64;
  const char*Kbase=shm+LDS_K; bf16x8 kf[8];
  const lds_cptr shm3=(lds_cptr)shm; const lds_cptr kp0=shm3+LDS_K+hi*1024+r32*16; const lds_cptr vp0=shm3+LDS_V+((lane>>4)&1)*32+(lane&3)*8+(4*hi+((lane&15)>>2))*64;
  const int NT=(q0+QB)/KVBLK;
  DMA_K(0,0);DMA_V(0,0);DMA_K(1,SLOTB);
  bf16x8 qr[4];
  #pragma unroll
  for(int d0=0;d0<4;++d0)qr[d0]=*reinterpret_cast<const bf16x8*>(&Qw[(long)r32*DMI+d0*16+hi*8]);
  float mhat=0.f,l_reg=0.f;f32x16 o[2];o[0]=f32x16{};o[1]=f32x16{};f32x16 negm=f32x16{};asm volatile("":"+v"(negm));
  const int qrel=wid*QBLK+r32;
  #define CMASK(P0,P1,t) do{int jb_=(t)-(NT-4); if(jb_>=0)cmask(P0,P1,jb_,qrel,hi);}while(0)
  bool resc=false;
  #define START(P0,P1) do{ const float rm=rowmax(P0,P1); resc=false; \
    { const float dl=rm; mhat=fadd_s(mhat,dl); \
      _Pragma("unroll") for(int r=0;r<16;++r){P0[r]=fsub_s(P0[r],dl);P1[r]=fsub_s(P1[r],dl);} \
      _Pragma("unroll") for(int r=0;r<16;++r)negm[r]=-mhat; asm volatile("":"+v"(negm)); } \
    _Pragma("unroll") for(int r=0;r<16;++r)P0[r]=__builtin_amdgcn_exp2f(P0[r]); }while(0)
  #define RESC() do{ if(resc){ asm volatile("s_waitcnt lgkmcnt(0)":::"memory"); \
      _Pragma("unroll") for(int d_=0;d_<2;++d_) _Pragma("unroll") for(int r=0;r<16;++r)o[d_][r]*=wsf[crow(r,hi)]; } }while(0)
  f32x16 pA0,pA1,pB0,pB1;
  int sl_prev=0,sl_cur=0,sl_next=SLOTB;
  #define ROT() do{sl_prev=sl_cur;sl_cur=sl_next;sl_next=(sl_next==(NSLOT-1)*SLOTB)?0:sl_next+SLOTB;}while(0)
  DMA_K(2,2*SLOTB);
  WAIT_BAR(3);
  qkt(pA0,pA1,Kbase,qr,negm,r32,hi);asm volatile("s_nop 15\n\ts_nop 7":"+v"(pA0),"+v"(pA1));CMASK(pA0,pA1,0);
  START(pA0,pA1);
  _Pragma("unroll") for(int r=0;r<16;++r)pA1[r]=__builtin_amdgcn_exp2f(pA1[r]);
  WAIT_BAR(0);
  DMA_K(3,0);DMA_V(1,SLOTB);
  ROT();
  kload8(kf,kp0+sl_cur);
  WAIT_BAR(2);
  s16x4 vlo[8],vhi[8]; u32x4 pw0,pw1,pw2,pw3;
  #define PKW(P,B) cvtpk_s(P[B],P[B+1])
  #define PAF(k) __builtin_bit_cast(bf16x8,pw##k)
  #define VFR(i) (bf16x8){vlo[i][0],vlo[i][1],vlo[i][2],vlo[i][3],vhi[i][0],vhi[i][1],vhi[i][2],vhi[i][3]}
  #define PIN(x) asm volatile("":"+v"(x))
  #define MX3(a,b,c) __builtin_fmaxf(__builtin_fmaxf((a),(b)),(c))
  #define GAPA(MF,A0,A1,A2,A3,W0,W1,PW) do{ MF; sacc+=A0; sacc+=A1; sacc+=A2; sacc+=A3; PIN(sacc); W0; W1; PIN(PW); SBAR(); }while(0)
  #define EX(v) __builtin_amdgcn_exp2f(v)
  #define GAPB(MF,X,B) do{ MF; X[B]=EX(X[B]); X[B+1]=EX(X[B+1]); X[B+2]=EX(X[B+2]); X[B+3]=EX(X[B+3]); PIN(X); SBAR(); }while(0)
  #define VRD(i) do{ vlo[i]=vtr(vp_+(((i)>>2)*4096+((i)&3)*1024)); vhi[i]=vtr(vp_+(((i)>>2)*4096+((i)&3)*1024+512)); }while(0)
  #define KRD(G,j) do{ if(G){ kload2(kf,kp0+sl_next,j); SBAR(); } }while(0)
  #define STEP(C0,C1,P0,P1,t,GK,GV,GL) do{ SBAR(); \
    const lds_cptr vp_=vp0+sl_prev; \
    VRD(0); SBAR(); float sacc=(P0[0]+P0[1]); \
    GAPA(C0=__builtin_amdgcn_mfma_f32_32x32x16_bf16(kf[0],qr[0],negm,0,0,0), P0[2],P0[3],P0[4],P0[5],     pw0[0]=PKW(P0,0), pw0[1]=PKW(P0,2), pw0); \
    VRD(4); SBAR(); GAPA(C1=__builtin_amdgcn_mfma_f32_32x32x16_bf16(kf[1],qr[0],negm,0,0,0), P0[6],P0[7],P0[8],P0[9],     pw0[2]=PKW(P0,4), pw0[3]=PKW(P0,6), pw0); \
    VRD(1); SBAR(); GAPA(C0=__builtin_amdgcn_mfma_f32_32x32x16_bf16(kf[2],qr[1],C0,0,0,0),   P0[10],P0[11],P0[12],P0[13], pw1[0]=PKW(P0,8), pw1[1]=PKW(P0,10), pw1); \
    VRD(5); SBAR(); GAPA(C1=__builtin_amdgcn_mfma_f32_32x32x16_bf16(kf[3],qr[1],C1,0,0,0),   P0[14],P0[15],P1[0],P1[1],   pw1[2]=PKW(P0,12),pw1[3]=PKW(P0,14), pw1); \
    VRD(2); SBAR(); GAPA(C0=__builtin_amdgcn_mfma_f32_32x32x16_bf16(kf[4],qr[2],C0,0,0,0),   P1[2],P1[3],P1[4],P1[5],     pw2[0]=PKW(P1,0), pw2[1]=PKW(P1,2), pw2); \
    VRD(6); SBAR(); GAPA(C1=__builtin_amdgcn_mfma_f32_32x32x16_bf16(kf[5],qr[2],C1,0,0,0),   P1[6],P1[7],P1[8],P1[9],     pw2[2]=PKW(P1,4), pw2[3]=PKW(P1,6), pw2); \
    VRD(3); SBAR(); GAPA(C0=__builtin_amdgcn_mfma_f32_32x32x16_bf16(kf[6],qr[3],C0,0,0,0),   P1[10],P1[11],P1[12],P1[13], pw3[0]=PKW(P1,8), pw3[1]=PKW(P1,10), pw3); \
    VRD(7); SBAR(); GAPA(C1=__builtin_amdgcn_mfma_f32_32x32x16_bf16(kf[7],qr[3],C1,0,0,0),   P1[14],P1[15],0.f,0.f,       pw3[2]=PKW(P1,12),pw3[3]=PKW(P1,14), pw3); \
    l_reg+=sacc; \
    if(GK){DMA_K((t)+3,sl_cur);} if(GV){DMA_V((t)+1,sl_next);} \
    CMASK(C0,C1,t); \
    { float a=MX3(C0[0],C0[1],C1[0]),b=MX3(C0[2],C0[3],C1[1]); a=MX3(a,C1[2],C1[3]); \
      _Pragma("unroll") for(int r=4;r<16;r+=4){a=MX3(a,C0[r],C0[r+1]);b=MX3(b,C0[r+2],C0[r+3]);a=MX3(a,C1[r],C1[r+1]);b=MX3(b,C1[r+2],C1[r+3]);} \
      float rm=__builtin_fmaxf(a,b); { auto rr=__builtin_amdgcn_permlane32_swap(__float_as_uint(rm),__float_as_uint(rm),false,false); rm=__builtin_fmaxf(__uint_as_float(rr[0]),__uint_as_float(rr[1])); } \
      resc=false; \
      if(__builtin_expect(__any(rm>(float)THRL),0)){ const float dl=__builtin_fmaxf(rm,0.f); mhat+=dl; \
        _Pragma("unroll") for(int r=0;r<16;++r){C0[r]-=dl;C1[r]-=dl;} \
        _Pragma("unroll") for(int r=0;r<16;++r)negm[r]=-mhat; asm volatile("":"+v"(negm)); \
        const float f=__builtin_amdgcn_exp2f(-dl); l_reg*=f; if(hi==0)wsf[r32]=f; resc=true; } } \
    SBAR(); \
    GAPB(o[0]=__builtin_amdgcn_mfma_f32_32x32x16_bf16(PAF(0),VFR(0),o[0],0,0,0), C0,0); \
    GAPB(o[1]=__builtin_amdgcn_mfma_f32_32x32x16_bf16(PAF(0),VFR(4),o[1],0,0,0), C0,4); \
    KRD(GL,0); GAPB(o[0]=__builtin_amdgcn_mfma_f32_32x32x16_bf16(PAF(1),VFR(1),o[0],0,0,0), C0,8); \
    KRD(GL,1); GAPB(o[1]=__builtin_amdgcn_mfma_f32_32x32x16_bf16(PAF(1),VFR(5),o[1],0,0,0), C0,12); \
    KRD(GL,2); GAPB(o[0]=__builtin_amdgcn_mfma_f32_32x32x16_bf16(PAF(2),VFR(2),o[0],0,0,0), C1,0); \
    KRD(GL,3); GAPB(o[1]=__builtin_amdgcn_mfma_f32_32x32x16_bf16(PAF(2),VFR(6),o[1],0,0,0), C1,4); \
    GAPB(o[0]=__builtin_amdgcn_mfma_f32_32x32x16_bf16(PAF(3),VFR(3),o[0],0,0,0), C1,8); \
    GAPB(o[1]=__builtin_amdgcn_mfma_f32_32x32x16_bf16(PAF(3),VFR(7),o[1],0,0,0), C1,12); \
    }while(0)
  int t=1;
  #undef CMASK
  #define CMASK(P0,P1,t) do{}while(0)
  for(;t+5<NT;t+=2){
    STEP(pB0,pB1,pA0,pA1,t,true,true,true);     WAIT_BAR(2); RESC(); ROT();
    STEP(pA0,pA1,pB0,pB1,t+1,true,true,true);   WAIT_BAR(2); RESC(); ROT();
  }
  #undef CMASK
  #define CMASK(P0,P1,t) do{int jb_=(t)-(NT-4); if(jb_>=0)cmask(P0,P1,jb_,qrel,hi);}while(0)
  #define ENDW(tt) do{ if((tt)+3<NT){WAIT_BAR(2);} else if((tt)+2<NT){WAIT_BAR(1);} else {WAIT_BAR(0);} }while(0)
  for(;t+1<NT;t+=2){
    STEP(pB0,pB1,pA0,pA1,t,(t+3<NT),(t+1<NT),(t+1<NT));       ENDW(t);   RESC(); ROT();
    STEP(pA0,pA1,pB0,pB1,t+1,(t+4<NT),(t+2<NT),(t+2<NT));     ENDW(t+1); RESC(); ROT();
  }
  STEP(pB0,pB1,pA0,pA1,NT-1,false,false,false); RESC();
  { float sacc=pB0[0]+pB0[1]; _Pragma("unroll") for(int r=2;r<16;++r)sacc+=pB0[r]; _Pragma("unroll") for(int r=0;r<16;++r)sacc+=pB1[r]; l_reg+=sacc;
    pw0=(u32x4){PKW(pB0,0),PKW(pB0,2),PKW(pB0,4),PKW(pB0,6)};pw1=(u32x4){PKW(pB0,8),PKW(pB0,10),PKW(pB0,12),PKW(pB0,14)};pw2=(u32x4){PKW(pB1,0),PKW(pB1,2),PKW(pB1,4),PKW(pB1,6)};pw3=(u32x4){PKW(pB1,8),PKW(pB1,10),PKW(pB1,12),PKW(pB1,14)};
    SBAR(); pv(o,vb0+sl_cur,PAF(0),PAF(1),PAF(2),PAF(3)); }
  #undef PKW
  #undef PAF
  #undef VFR
  #undef PIN
  #undef MX3
  #undef GAPA
  #undef GAPB
  #undef EX
  #undef VRD
  #undef KRD
  #undef STEP
  #undef ENDW
  {auto rr=__builtin_amdgcn_permlane32_swap(__float_as_uint(l_reg),__float_as_uint(l_reg),false,false);l_reg=__uint_as_float(rr[0])+__uint_as_float(rr[1]);}
  if(hi==0)wsf[32+r32]=l_reg;asm volatile("s_waitcnt lgkmcnt(0)":::"memory");
  float rli[16];
  #pragma unroll
  for(int r=0;r<16;++r)rli[r]=__builtin_amdgcn_rcpf(wsf[32+crow(r,hi)]);
  bf16*Ow=Oh+(long)(q0+wid*QBLK)*DMO;
  { bf16*stg=(bf16*)(shm+LDS_OST)+wid*2048;
    #pragma unroll
    for(int r=0;r<16;++r){const int orow=crow(r,hi);
      #pragma unroll
      for(int d0=0;d0<2;++d0)stg[orow*64+d0*32+r32]=__float2bfloat16(o[d0][r]*rli[r]);}
    asm volatile("s_waitcnt lgkmcnt(0)":::"memory");
    #pragma unroll
    for(int i=0;i<4;++i){const int row=i*8+(lane>>3),ch=lane&7; const u32x4 v=*(const u32x4*)(stg+row*64+ch*8); ATTN_STORE16(Ow+(long)row*DMO+ch*8,v);} }
  asm volatile("s_waitcnt lgkmcnt(0)\n\ts_barrier":::"memory");
  #undef DMA_K
  #undef DMA_V
  #undef CMASK
  #undef START
  #undef RESC
  #undef ROT
}
constexpr int LDS2_K=0, LDS2_V=4*SLOTB, LDS2_WS=LDS2_V+NSLOT*2*SLOTB, LDS2_OST=LDS2_WS+NW*64*4, LDS2_BYTES=LDS2_OST+NW*8192;
__device__ __forceinline__ void pv4(f32x16*o,int vb,bf16x8 pa0,bf16x8 pa1,bf16x8 pa2,bf16x8 pa3){
  #pragma unroll
  for(int d0=0;d0<4;++d0){s16x4 lo[4],hi[4];
    #pragma unroll
    for(int ks=0;ks<4;++ks){
      asm volatile("ds_read_b64_tr_b16 %0,%1 offset:%c2":"=&v"(lo[ks]):"v"(vb),"i"(d0*4096+ks*1024):"memory");
      asm volatile("ds_read_b64_tr_b16 %0,%1 offset:%c2":"=&v"(hi[ks]):"v"(vb),"i"(d0*4096+ks*1024+512):"memory");}
    asm volatile("s_waitcnt lgkmcnt(0)":::"memory");SBAR();
    #define PK(k) (bf16x8){lo[k][0],lo[k][1],lo[k][2],lo[k][3],hi[k][0],hi[k][1],hi[k][2],hi[k][3]}
    o[d0]=__builtin_amdgcn_mfma_f32_32x32x16_bf16(pa0,PK(0),o[d0],0,0,0);
    o[d0]=__builtin_amdgcn_mfma_f32_32x32x16_bf16(pa1,PK(1),o[d0],0,0,0);
    o[d0]=__builtin_amdgcn_mfma_f32_32x32x16_bf16(pa2,PK(2),o[d0],0,0,0);
    o[d0]=__builtin_amdgcn_mfma_f32_32x32x16_bf16(pa3,PK(3),o[d0],0,0,0);
    #undef PK
  }
}
template<int THRL> __device__ __forceinline__ void attn_unit2(int qb,const bf16*Qh,const bf16*__restrict__ Kh,const bf16*__restrict__ Vh,bf16*Oh,char*shm,const int wave){
  const int tid=wave*64+lane_id_opaque(),lane=tid&63,r32=lane&31,hi=lane>>5; const int wid=__builtin_amdgcn_readfirstlane(tid>>6);
  const int q0=qb*QB;
  const bf16*Qw=Qh+(long)(q0+wid*QBLK)*DMI;
  const unsigned lds0=(unsigned)(uintptr_t)shm;
  float*wsf=(float*)(shm+LDS2_WS)+wid*64;
  const bf16*ksrc=Kh+(long)lane*DMI+wid*8;
  const bf16*vsrc=Vh+(long)(16*(wid&3)+(lane>>2))*DMI+(wid>>2)*32+(lane&3)*8;
  const unsigned kdst=lds0+LDS2_K+wid*1024, vdst=lds0+LDS2_V+(wid>>2)*4096+(wid&3)*1024;
  #define DMA_K(t,slot) glds16(ksrc+(long)(t)*KVBLK*DMI,(unsigned)__builtin_amdgcn_readfirstlane(kdst+(slot)))
  #define DMA_V(t,slot) do{ glds16(vsrc+(long)(t)*KVBLK*DMI,(unsigned)__builtin_amdgcn_readfirstlane(vdst+2*(slot))); glds16(vsrc+(long)(t)*KVBLK*DMI+64,(unsigned)__builtin_amdgcn_readfirstlane(vdst+2*(slot)+8192)); }while(0)
  const int vb0=(int)(lds0+LDS2_V)+((lane>>4)&1)*32+(lane&3)*8+(4*hi+((lane&15)>>2))*64;
  const char*Kbase=shm+LDS2_K; bf16x8 kf[8];
  const lds_cptr shm3=(lds_cptr)shm; const lds_cptr kp0=shm3+LDS2_K+hi*1024+r32*16; const lds_cptr vp0=shm3+LDS2_V+((lane>>4)&1)*32+(lane&3)*8+(4*hi+((lane&15)>>2))*64;
  const int NT=(q0+QB)/KVBLK;
  DMA_K(0,0);DMA_V(0,0);DMA_K(1,SLOTB);DMA_K(2,2*SLOTB);
  bf16x8 qr[4];
  #pragma unroll
  for(int d0=0;d0<4;++d0)qr[d0]=*reinterpret_cast<const bf16x8*>(&Qw[(long)r32*DMI+d0*16+hi*8]);
  float zf_=0.f; asm volatile("":"+v"(zf_)); f32x16 zz_; _Pragma("unroll") for(int r=0;r<16;++r)zz_[r]=zf_;
  float mhat=0.f,l_reg=0.f;f32x16 o[4];o[0]=zz_;o[1]=zz_;o[2]=zz_;o[3]=zz_;f32x16 negm=zz_;asm volatile("":"+v"(negm));
  const int qrel=wid*QBLK+r32;
  #define CMASK(P0,P1,t) do{int jb_=(t)-(NT-4); if(jb_>=0)cmask(P0,P1,jb_,qrel,hi);}while(0)
  bool resc=false;
  #define START(P0,P1) do{ const float rm=rowmax(P0,P1); resc=false; \
    { const float dl=rm; mhat=fadd_s(mhat,dl); \
      _Pragma("unroll") for(int r=0;r<16;++r){P0[r]=fsub_s(P0[r],dl);P1[r]=fsub_s(P1[r],dl);} \
      _Pragma("unroll") for(int r=0;r<16;++r)negm[r]=-mhat; asm volatile("":"+v"(negm)); } \
    _Pragma("unroll") for(int r=0;r<16;++r)P0[r]=__builtin_amdgcn_exp2f(P0[r]); }while(0)
  #define RESC() do{ if(resc){ asm volatile("s_waitcnt lgkmcnt(0)":::"memory"); \
      _Pragma("unroll") for(int d_=0;d_<4;++d_) _Pragma("unroll") for(int r=0;r<16;++r)o[d_][r]*=wsf[crow(r,hi)]; } }while(0)
  f32x16 pA0,pA1,pB0,pB1;
  int sl_prev=0,sl_cur=0,sl_next=SLOTB;
  int kc=0,kn=SLOTB,kp=3*SLOTB;
  #define ROT() do{sl_prev=sl_cur;sl_cur=sl_next;sl_next=(sl_next==(NSLOT-1)*SLOTB)?0:sl_next+SLOTB; kp=kc;kc=kn;kn=(kn==3*SLOTB)?0:kn+SLOTB;}while(0)
  WAIT_BAR(4);
  qkt(pA0,pA1,Kbase,qr,negm,r32,hi);asm volatile("s_nop 15\n\ts_nop 7":"+v"(pA0),"+v"(pA1));CMASK(pA0,pA1,0);
  START(pA0,pA1);
  _Pragma("unroll") for(int r=0;r<16;++r)pA1[r]=__builtin_amdgcn_exp2f(pA1[r]);
  DMA_K(3,3*SLOTB);DMA_V(1,SLOTB);
  WAIT_BAR(3);
  ROT();
  kload2(kf,kp0+kc,0); kload2(kf,kp0+kc,1);
  s16x4 vlo[16],vhi[16]; u32x4 pw0,pw1,pw2,pw3;
  #define PKW(P,B) cvtpk_s(P[B],P[B+1])
  #define PAF(k) __builtin_bit_cast(bf16x8,pw##k)
  #define VFR(i) (bf16x8){vlo[i][0],vlo[i][1],vlo[i][2],vlo[i][3],vhi[i][0],vhi[i][1],vhi[i][2],vhi[i][3]}
  #define PIN(x) asm volatile("":"+v"(x))
  #define MX3(a,b,c) __builtin_fmaxf(__builtin_fmaxf((a),(b)),(c))
  #define GAPA(MF,A0,A1,A2,A3,W0,W1,PW) do{ MF; sacc+=A0; sacc+=A1; sacc+=A2; sacc+=A3; PIN(sacc); W0; W1; PIN(PW); SBAR(); }while(0)
  #define EX(v) __builtin_amdgcn_exp2f(v)
  #define GAPB(MF,X,B) do{ MF; X[B]=EX(X[B]); X[B+1]=EX(X[B+1]); PIN(X); SBAR(); }while(0)
  #define VRD(i) do{ vlo[i]=vtr(vp_+(((i)>>2)*4096+((i)&3)*1024)); vhi[i]=vtr(vp_+(((i)>>2)*4096+((i)&3)*1024+512)); }while(0)
  #define STEP(C0,C1,P0,P1,t,GK,GV,GL) do{ SBAR(); \
    const lds_cptr vp_=vp0+2*sl_prev; \
    VRD(0); SBAR(); float sacc=(P0[0]+P0[1]); \
    GAPA(C0=__builtin_amdgcn_mfma_f32_32x32x16_bf16(kf[0],qr[0],negm,0,0,0), P0[2],P0[3],P0[4],P0[5],     pw0[0]=PKW(P0,0), pw0[1]=PKW(P0,2), pw0); \
    VRD(4); kload2(kf,kp0+kc,2); SBAR(); GAPA(C1=__builtin_amdgcn_mfma_f32_32x32x16_bf16(kf[1],qr[0],negm,0,0,0), P0[6],P0[7],P0[8],P0[9],     pw0[2]=PKW(P0,4), pw0[3]=PKW(P0,6), pw0); \
    VRD(1); SBAR(); GAPA(C0=__builtin_amdgcn_mfma_f32_32x32x16_bf16(kf[2],qr[1],C0,0,0,0),   P0[10],P0[11],P0[12],P0[13], pw1[0]=PKW(P0,8), pw1[1]=PKW(P0,10), pw1); \
    VRD(5); kload2(kf,kp0+kc,3); SBAR(); GAPA(C1=__builtin_amdgcn_mfma_f32_32x32x16_bf16(kf[3],qr[1],C1,0,0,0),   P0[14],P0[15],P1[0],P1[1],   pw1[2]=PKW(P0,12),pw1[3]=PKW(P0,14), pw1); \
    VRD(2); SBAR(); GAPA(C0=__builtin_amdgcn_mfma_f32_32x32x16_bf16(kf[4],qr[2],C0,0,0,0),   P1[2],P1[3],P1[4],P1[5],     pw2[0]=PKW(P1,0), pw2[1]=PKW(P1,2), pw2); \
    VRD(6); SBAR(); GAPA(C1=__builtin_amdgcn_mfma_f32_32x32x16_bf16(kf[5],qr[2],C1,0,0,0),   P1[6],P1[7],P1[8],P1[9],     pw2[2]=PKW(P1,4), pw2[3]=PKW(P1,6), pw2); \
    VRD(3); SBAR(); GAPA(C0=__builtin_amdgcn_mfma_f32_32x32x16_bf16(kf[6],qr[3],C0,0,0,0),   P1[10],P1[11],P1[12],P1[13], pw3[0]=PKW(P1,8), pw3[1]=PKW(P1,10), pw3); \
    VRD(7); SBAR(); GAPA(C1=__builtin_amdgcn_mfma_f32_32x32x16_bf16(kf[7],qr[3],C1,0,0,0),   P1[14],P1[15],0.f,0.f,       pw3[2]=PKW(P1,12),pw3[3]=PKW(P1,14), pw3); \
    l_reg+=sacc; \
    if(GK){DMA_K((t)+3,kp);} if(GV){DMA_V((t)+1,sl_next);} \
    CMASK(C0,C1,t); \
    { float a=MX3(C0[0],C0[1],C1[0]),b=MX3(C0[2],C0[3],C1[1]); a=MX3(a,C1[2],C1[3]); \
      _Pragma("unroll") for(int r=4;r<16;r+=4){a=MX3(a,C0[r],C0[r+1]);b=MX3(b,C0[r+2],C0[r+3]);a=MX3(a,C1[r],C1[r+1]);b=MX3(b,C1[r+2],C1[r+3]);} \
      float rm=__builtin_fmaxf(a,b); { auto rr=__builtin_amdgcn_permlane32_swap(__float_as_uint(rm),__float_as_uint(rm),false,false); rm=__builtin_fmaxf(__uint_as_float(rr[0]),__uint_as_float(rr[1])); } \
      resc=false; \
      if(__builtin_expect(__any(rm>(float)THRL),0)){ const float dl=__builtin_fmaxf(rm,0.f); mhat+=dl; \
        _Pragma("unroll") for(int r=0;r<16;++r){C0[r]-=dl;C1[r]-=dl;} \
        _Pragma("unroll") for(int r=0;r<16;++r)negm[r]=-mhat; asm volatile("":"+v"(negm)); \
        const float f=__builtin_amdgcn_exp2f(-dl); l_reg*=f; if(hi==0)wsf[r32]=f; resc=true; } } \
    SBAR(); \
    VRD(8);  SBAR(); GAPB(o[0]=__builtin_amdgcn_mfma_f32_32x32x16_bf16(PAF(0),VFR(0),o[0],0,0,0), C0,0); \
    VRD(12); SBAR(); GAPB(o[1]=__builtin_amdgcn_mfma_f32_32x32x16_bf16(PAF(0),VFR(4),o[1],0,0,0), C0,2); \
    VRD(9);  SBAR(); GAPB(o[0]=__builtin_amdgcn_mfma_f32_32x32x16_bf16(PAF(1),VFR(1),o[0],0,0,0), C0,4); \
    VRD(13); SBAR(); GAPB(o[1]=__builtin_amdgcn_mfma_f32_32x32x16_bf16(PAF(1),VFR(5),o[1],0,0,0), C0,6); \
    VRD(10); SBAR(); GAPB(o[0]=__builtin_amdgcn_mfma_f32_32x32x16_bf16(PAF(2),VFR(2),o[0],0,0,0), C0,8); \
    VRD(14); SBAR(); GAPB(o[1]=__builtin_amdgcn_mfma_f32_32x32x16_bf16(PAF(2),VFR(6),o[1],0,0,0), C0,10); \
    VRD(11); SBAR(); GAPB(o[0]=__builtin_amdgcn_mfma_f32_32x32x16_bf16(PAF(3),VFR(3),o[0],0,0,0), C0,12); \
    VRD(15); SBAR(); GAPB(o[1]=__builtin_amdgcn_mfma_f32_32x32x16_bf16(PAF(3),VFR(7),o[1],0,0,0), C0,14); \
    GAPB(o[2]=__builtin_amdgcn_mfma_f32_32x32x16_bf16(PAF(0),VFR(8),o[2],0,0,0),  C1,0); \
    GAPB(o[3]=__builtin_amdgcn_mfma_f32_32x32x16_bf16(PAF(0),VFR(12),o[3],0,0,0), C1,2); \
    GAPB(o[2]=__builtin_amdgcn_mfma_f32_32x32x16_bf16(PAF(1),VFR(9),o[2],0,0,0),  C1,4); \
    GAPB(o[3]=__builtin_amdgcn_mfma_f32_32x32x16_bf16(PAF(1),VFR(13),o[3],0,0,0), C1,6); \
    GAPB(o[2]=__builtin_amdgcn_mfma_f32_32x32x16_bf16(PAF(2),VFR(10),o[2],0,0,0), C1,8); \
    GAPB(o[3]=__builtin_amdgcn_mfma_f32_32x32x16_bf16(PAF(2),VFR(14),o[3],0,0,0), C1,10); \
    GAPB(o[2]=__builtin_amdgcn_mfma_f32_32x32x16_bf16(PAF(3),VFR(11),o[2],0,0,0), C1,12); \
    GAPB(o[3]=__builtin_amdgcn_mfma_f32_32x32x16_bf16(PAF(3),VFR(15),o[3],0,0,0), C1,14); \
    if(GL){ kload2(kf,kp0+kn,0); kload2(kf,kp0+kn,1); SBAR(); } \
    }while(0)
  int t=1;
  #undef CMASK
  #define CMASK(P0,P1,t) do{}while(0)
  for(;t+5<NT;t+=2){
    STEP(pB0,pB1,pA0,pA1,t,true,true,true);     WAIT_BAR(3); RESC(); ROT();
    STEP(pA0,pA1,pB0,pB1,t+1,true,true,true);   WAIT_BAR(3); RESC(); ROT();
  }
  #undef CMASK
  #define CMASK(P0,P1,t) do{int jb_=(t)-(NT-4); if(jb_>=0)cmask(P0,P1,jb_,qrel,hi);}while(0)
  #define ENDW(tt) do{ if((tt)+3<NT){WAIT_BAR(3);} else if((tt)+2<NT){WAIT_BAR(2);} else {WAIT_BAR(0);} }while(0)
  for(;t+1<NT;t+=2){
    STEP(pB0,pB1,pA0,pA1,t,(t+3<NT),(t+1<NT),(t+1<NT));       ENDW(t);   RESC(); ROT();
    STEP(pA0,pA1,pB0,pB1,t+1,(t+4<NT),(t+2<NT),(t+2<NT));     ENDW(t+1); RESC(); ROT();
  }
  STEP(pB0,pB1,pA0,pA1,NT-1,false,false,false); RESC();
  { float sacc=pB0[0]+pB0[1]; _Pragma("unroll") for(int r=2;r<16;++r)sacc+=pB0[r]; _Pragma("unroll") for(int r=0;r<16;++r)sacc+=pB1[r]; l_reg+=sacc;
    pw0=(u32x4){PKW(pB0,0),PKW(pB0,2),PKW(pB0,4),PKW(pB0,6)};pw1=(u32x4){PKW(pB0,8),PKW(pB0,10),PKW(pB0,12),PKW(pB0,14)};pw2=(u32x4){PKW(pB1,0),PKW(pB1,2),PKW(pB1,4),PKW(pB1,6)};pw3=(u32x4){PKW(pB1,8),PKW(pB1,10),PKW(pB1,12),PKW(pB1,14)};
    SBAR(); pv4(o,vb0+2*sl_cur,PAF(0),PAF(1),PAF(2),PAF(3)); }
  #undef PKW
  #undef PAF
  #undef VFR
  #undef PIN
  #undef MX3
  #undef GAPA
  #undef GAPB
  #undef EX
  #undef VRD
  #undef STEP
  #undef ENDW
  {auto rr=__builtin_amdgcn_permlane32_swap(__float_as_uint(l_reg),__float_as_uint(l_reg),false,false);l_reg=__uint_as_float(rr[0])+__uint_as_float(rr[1]);}
  if(hi==0)wsf[32+r32]=l_reg;asm volatile("s_waitcnt lgkmcnt(0)":::"memory");
  float rli[16];
  #pragma unroll
  for(int r=0;r<16;++r)rli[r]=__builtin_amdgcn_rcpf(wsf[32+crow(r,hi)]);
  bf16*Ow=Oh+(long)(q0+wid*QBLK)*DMO;
  { bf16*stg=(bf16*)(shm+LDS2_OST)+wid*4096;
    #pragma unroll
    for(int r=0;r<16;++r){const int orow=crow(r,hi);
      #pragma unroll
      for(int d0=0;d0<4;++d0)stg[orow*128+d0*32+r32]=__float2bfloat16(o[d0][r]*rli[r]);}
    asm volatile("s_waitcnt lgkmcnt(0)":::"memory");
    #pragma unroll
    for(int i=0;i<8;++i){const int row=i*4+(lane>>4),ch=lane&15; const u32x4 v=*(const u32x4*)(stg+row*128+ch*8); ATTN_STORE16(Ow+(long)row*DMO+ch*8,v);} }
  asm volatile("s_waitcnt lgkmcnt(0)\n\ts_barrier":::"memory");
  #undef DMA_K
  #undef DMA_V
  #undef CMASK
  #undef START
  #undef RESC
  #undef ROT
}
constexpr int ATTN_LDS_BYTES=LDS_BYTES;
#undef SBAR
#undef WAIT_BAR
}

constexpr int NWAVES = 8;
constexpr int NTOK = 32768, DM = 1024, SEQ = 4096, NB = 8, NEXP = 32, TOPK = 4;
constexpr int N_PHASES = 10;
constexpr size_t MiB = 1u << 20;
constexpr size_t WS_CTL = 0, CTL_ZERO_BYTES = 32768;
constexpr size_t WS_MODP = 864 * MiB;
constexpr size_t WS_MODF = 3 * MiB;
constexpr size_t WS_LAM16 = 3 * MiB + 512 * 1024;
constexpr size_t WS_WRH = 3 * MiB + 640 * 1024, WS_WRL = 3 * MiB + 704 * 1024;
constexpr size_t WS_WIN = 4 * MiB;
constexpr size_t WS_WOUT = 8 * MiB;
constexpr size_t WS_WGLU = 10 * MiB;
constexpr size_t WS_WM = 11 * MiB;
constexpr size_t WS_TV = 15 * MiB;
constexpr size_t WS_W1T = 22 * MiB;
constexpr size_t WS_W2T = 150 * MiB;
constexpr size_t WS_H = 214 * MiB;
constexpr size_t WS_Q = 278 * MiB, WS_K = 310 * MiB, WS_V = 342 * MiB;
constexpr size_t WS_UA = 374 * MiB;
constexpr size_t WS_Z = 422 * MiB;
constexpr size_t WS_OB = 454 * MiB;
constexpr size_t WS_MIX = 518 * MiB;
constexpr size_t WS_PTOK = 582 * MiB;
constexpr size_t WS_SLOT = 586 * MiB;
constexpr size_t WS_GATE = 587 * MiB;
constexpr size_t WS_A2 = 278 * MiB;
constexpr size_t WS_Y2 = 590 * MiB;
constexpr size_t WS_X1B = 872 * MiB;
constexpr size_t WS_END = 936 * MiB;
constexpr int MAXTILES = 544;
static_assert(WS_A2 + (size_t)MAXTILES * 256 * 1024 * 2 <= WS_PTOK && WS_Y2 + (size_t)MAXTILES * 256 * 1024 * 2 <= WS_MODP, "ws map");
constexpr int CW_TMO = 0, CW_CNT = 1024  , CW_BAR = 4096;
constexpr int CW_DEP0 = 7680  , CW_DEPB = 7744  ;
constexpr int RING_OFF = 0, RING_BYTES = 131072;
constexpr int VEC_OFF = 132096;
constexpr int BIASL_OFF = 132096;
constexpr int TILE_E_OFF = 140288;
constexpr int TILE0_OFF = 140928;
constexpr int CNTL_OFF = 141056;
constexpr int MOE_T_OFF = 141184;
constexpr int ROWTAB_OFF = 141312;
constexpr int LDSCTL_OFF = 159744, MISC_OFF = LDSCTL_OFF;
constexpr int LDS_BYTES = 163840;

typedef unsigned short bf16;
typedef unsigned v4u __attribute__((ext_vector_type(4)));
typedef unsigned v2u __attribute__((ext_vector_type(2)));
typedef float f32x4 __attribute__((ext_vector_type(4)));
typedef GAS unsigned gu32;
#define RLX_AGENT __ATOMIC_RELAXED, __HIP_MEMORY_SCOPE_AGENT
#define LDS_WAIT() asm volatile("s_waitcnt lgkmcnt(0)" ::: "memory")
#define VM_WAIT() asm volatile("s_waitcnt vmcnt(0)" ::: "memory")
__device__ __forceinline__ unsigned f2bf(float f) { unsigned u = __builtin_bit_cast(unsigned, f); return (u + 0x7fffu + ((u >> 16) & 1u)) >> 16; }
__device__ __forceinline__ unsigned pk2(float lo, float hi) { return f2bf(lo) | (f2bf(hi) << 16); }

#define XB_TMO      128
#define XB_XCNT(j)  (256  + 64 * (j))
#define XB_XSUB(j)  (1280 + 64 * (j))
#define XB_XGEN(j)  (2304 + 64 * (j))
#define XB_TOP      3328
#define XB_TOPGEN   3392
#define XCD_BAR_WORDS 3456
#define XB_SPIN_CAP (1u << 18)
__device__ __forceinline__ unsigned xb_ld(unsigned* p)              { return __hip_atomic_load(p, __ATOMIC_RELAXED, __HIP_MEMORY_SCOPE_AGENT); }
__device__ __forceinline__ unsigned xb_add(unsigned* p, unsigned v) { return __hip_atomic_fetch_add(p, v, __ATOMIC_RELAXED, __HIP_MEMORY_SCOPE_AGENT); }
__device__ __forceinline__ unsigned xb_xcc_id() { return (unsigned)__builtin_amdgcn_s_getreg((3 << 11) | 20) & 0xFu; }
#define XB_SPIN(cond, bar) do { unsigned _sp = 0; while (cond) { __builtin_amdgcn_s_sleep(1); \
    if ((++_sp & 255u) == 0u) { if (xb_ld(&(bar)[XB_TMO])) break; if (_sp > XB_SPIN_CAP) { atomicAdd(&(bar)[XB_TMO], 1u); break; } } } } while (0)
struct XcdBarrier { unsigned* bar; unsigned x; volatile LAS unsigned* st; };
__device__ __forceinline__ XcdBarrier xcd_barrier_post(unsigned* bar, volatile LAS unsigned* st) {
    XcdBarrier b; b.bar = bar; b.x = xb_xcc_id(); b.st = st;
    if (threadIdx.x == 0) (void)xb_add(&bar[XB_XCNT(b.x)], 1u);
    return b;
}
__device__ __forceinline__ void xcd_barrier_complete(unsigned* bar, unsigned x, unsigned& nloc, unsigned& nx) {
    const unsigned G = gridDim.x * gridDim.y * gridDim.z;
    unsigned sum, cnt, mine, sp = 0u;
    for (;;) {
        sum = 0u; cnt = 0u; mine = 0u;
#pragma unroll
        for (unsigned j = 0; j < 16; ++j) { const unsigned c = xb_ld(&bar[XB_XCNT(j)]); sum += c; cnt += (c > 0u) ? 1u : 0u; mine = (j == x) ? c : mine; }
        if (sum == G) break;
        __builtin_amdgcn_s_sleep(1);
        if ((++sp & 255u) == 0u) { if (xb_ld(&bar[XB_TMO])) break; if (sp > XB_SPIN_CAP) { atomicAdd(&bar[XB_TMO], 1u); break; } }
    }
    nloc = mine > 0u ? mine : 1u; nx = cnt > 0u ? cnt : 1u;
}
__device__ __forceinline__ void xcd_barrier(const XcdBarrier& b, const int wave) {
    asm volatile("s_waitcnt vmcnt(0)" ::: "memory");
    __syncthreads();
    if (wave == 0 && lane_id_opaque() == 0) {
        unsigned* bar = b.bar;
        __builtin_amdgcn_s_waitcnt(0);
        unsigned nloc = b.st[0], nx = b.st[1];
        if (nloc == 0u) { xcd_barrier_complete(bar, b.x, nloc, nx); b.st[0] = nloc; b.st[1] = nx; }
        const unsigned old = xb_add(&bar[XB_XSUB(b.x)], 1u);
        const unsigned gen = old / nloc;
        if (old + 1u == (gen + 1u) * nloc) {
            __builtin_amdgcn_fence(__ATOMIC_RELEASE, "agent");
            asm volatile("s_waitcnt vmcnt(0)" ::: "memory");
            const unsigned og = xb_add(&bar[XB_TOP], 1u);
            const unsigned tg = og / nx;
            if (og + 1u == (tg + 1u) * nx) xb_add(&bar[XB_TOPGEN], 1u);
            else XB_SPIN(xb_ld(&bar[XB_TOPGEN]) == tg, bar);
            __builtin_amdgcn_fence(__ATOMIC_ACQUIRE, "agent");
            xb_add(&bar[XB_XGEN(b.x)], 1u);
            asm volatile("s_waitcnt vmcnt(0)" ::: "memory");
        } else {
            XB_SPIN(xb_ld(&bar[XB_XGEN(b.x)]) == gen, bar);
            __builtin_amdgcn_fence(__ATOMIC_ACQUIRE, "agent");
            asm volatile("s_waitcnt vmcnt(0)" ::: "memory");
        }
    }
    __syncthreads();
}

struct Frame {
    LAS unsigned char* lds;
    gu32* ctl;
    int tid, lane, wave, vcu, G;
    float* out; unsigned char* ws;
};
typedef const float* cfptr_t;
__device__ __forceinline__ const float* inp(int i) { const __attribute__((address_space(4))) cfptr_t* kp = (const __attribute__((address_space(4))) cfptr_t*)__builtin_amdgcn_kernarg_segment_ptr(); asm volatile("" : "+s"(kp)); return kp[i]; }
__device__ __forceinline__ float wave_sum(float v) {
#pragma unroll
    for (int o = 1; o < 64; o <<= 1) v += __shfl_xor(v, o);
    return v;
}
__device__ __forceinline__ float wave_max(float v) {
#pragma unroll
    for (int o = 1; o < 64; o <<= 1) v = fmaxf(v, __shfl_xor(v, o));
    return v;
}
__device__ __forceinline__ int wave_min_i(int v) {
#pragma unroll
    for (int o = 1; o < 64; o <<= 1) { const int w = __shfl_xor(v, o); v = w < v ? w : v; }
    return v;
}

#define DPP_F(v, ctrl) __builtin_bit_cast(float, __builtin_amdgcn_update_dpp(__builtin_bit_cast(int, (v)), __builtin_bit_cast(int, (v)), (ctrl), 0xF, 0xF, false))
#define DPP_I(v, ctrl) __builtin_amdgcn_update_dpp((v), (v), (ctrl), 0xF, 0xF, false)
__device__ __forceinline__ float wave_max_u(float v) {
    v = fmaxf(v, DPP_F(v, 0xB1)); v = fmaxf(v, DPP_F(v, 0x4E)); v = fmaxf(v, DPP_F(v, 0x141)); v = fmaxf(v, DPP_F(v, 0x140));
    const int b = __builtin_bit_cast(int, v);
    return fmaxf(fmaxf(__builtin_bit_cast(float, __builtin_amdgcn_readlane(b, 15)), __builtin_bit_cast(float, __builtin_amdgcn_readlane(b, 31))), fmaxf(__builtin_bit_cast(float, __builtin_amdgcn_readlane(b, 47)), __builtin_bit_cast(float, __builtin_amdgcn_readlane(b, 63))));
}
__device__ __forceinline__ int wave_min_iu(int v) {
    int w;
    w = DPP_I(v, 0xB1); v = w < v ? w : v; w = DPP_I(v, 0x4E); v = w < v ? w : v; w = DPP_I(v, 0x141); v = w < v ? w : v; w = DPP_I(v, 0x140); v = w < v ? w : v;
    const int a = __builtin_amdgcn_readlane(v, 15), b = __builtin_amdgcn_readlane(v, 31), c = __builtin_amdgcn_readlane(v, 47), d = __builtin_amdgcn_readlane(v, 63);
    const int ab = a < b ? a : b, cd = c < d ? c : d; return ab < cd ? ab : cd;
}
__device__ __forceinline__ float wave_sum_u(float v) {
    v += DPP_F(v, 0xB1); v += DPP_F(v, 0x4E); v += DPP_F(v, 0x141); v += DPP_F(v, 0x140);
    const int b = __builtin_bit_cast(int, v);
    return (__builtin_bit_cast(float, __builtin_amdgcn_readlane(b, 15)) + __builtin_bit_cast(float, __builtin_amdgcn_readlane(b, 31))) + (__builtin_bit_cast(float, __builtin_amdgcn_readlane(b, 47)) + __builtin_bit_cast(float, __builtin_amdgcn_readlane(b, 63)));
}
struct TrItem { const float* W; bf16* WT; int ldw, ldt; };
__device__ __forceinline__ void tr_dma(const TrItem& d, LAS float* buf, int lane) {
    const int kr = lane >> 3, q = lane & 7;
#pragma unroll
    for (int i = 0; i < 8; ++i) __builtin_amdgcn_global_load_lds((const unsigned*)(d.W + (size_t)(8 * i + kr) * d.ldw + 4 * ((q - i) & 7)), (LAS unsigned*)(buf + i * 256), 16, 0, 2);
}
__device__ __forceinline__ void tr_out(const TrItem& d, const LAS float* buf, int lane) {
    const int c = lane & 7;
#pragma unroll
    for (int j = 0; j < 4; ++j) { const int n = (lane >> 3) + 8 * j; const LAS float* s = buf + (8 * c) * 32 + 4 * (((n >> 2) + c) & 7) + (n & 3);
        if (d.ldt < 0) { const f32x4 a = (f32x4){s[0 * 32], s[1 * 32], s[2 * 32], s[3 * 32]} * pg8::F8_W, e = (f32x4){s[4 * 32], s[5 * 32], s[6 * 32], s[7 * 32]} * pg8::F8_W;
            __builtin_nontemporal_store(pg8::pack8_fp8(a, e), (pg8::i32x2*)((unsigned char*)d.WT + (size_t)n * (size_t)(-d.ldt) + 8 * c)); }
        else { v4u o; o.x = pg8::cvt_pk_bf16(s[0 * 32], s[1 * 32]); o.y = pg8::cvt_pk_bf16(s[2 * 32], s[3 * 32]); o.z = pg8::cvt_pk_bf16(s[4 * 32], s[5 * 32]); o.w = pg8::cvt_pk_bf16(s[6 * 32], s[7 * 32]);
            *(GAS v4u*)(d.WT + (size_t)n * d.ldt + 8 * c) = o; } }
}
__device__ __forceinline__ void dsincos(double x, double& s, double& c) {
    const double k = rint(x * 0.63661977236758134308);
    double r = fma(-k, 1.57079632673412561417e+00, x); r = fma(-k, 6.07710050650619224932e-11, r);
    const int q = ((int)k) & 3; const double r2 = r * r;
    const double sp = r + r * r2 * (-1.66666666666666324348e-01 + r2 * (8.33333333332248946124e-03 + r2 * (-1.98412698298579493134e-04 + r2 * (2.75573137070700676789e-06 + r2 * (-2.50507602534068634195e-08 + r2 * 1.58969099521155010221e-10)))));
    const double cp = 1.0 - 0.5 * r2 + r2 * r2 * (4.16666666666666019037e-02 + r2 * (-1.38888888888741095749e-03 + r2 * (2.48015872894767294178e-05 + r2 * (-2.75573143513906633035e-07 + r2 * (2.08757232129817482790e-09 + r2 * -1.13596475577881948265e-11)))));
    s = (q == 0) ? sp : (q == 1) ? cp : (q == 2) ? -sp : -cp;
    c = (q == 0) ? cp : (q == 1) ? -sp : (q == 2) ? -cp : sp;
}
__device__ __forceinline__ double dexp(double x) {
    const double k = rint(x * 1.44269504088896340736); const double r = fma(-k, 6.93147180369123816490e-01, x) - k * 1.90821492927058770002e-10;
    double p = 1.0 / 6227020800.0;
    p = p * r + 1.0 / 479001600.0; p = p * r + 1.0 / 39916800.0; p = p * r + 1.0 / 3628800.0; p = p * r + 1.0 / 362880.0; p = p * r + 1.0 / 40320.0; p = p * r + 1.0 / 5040.0;
    p = p * r + 1.0 / 720.0; p = p * r + 1.0 / 120.0; p = p * r + 1.0 / 24.0; p = p * r + 1.0 / 6.0; p = p * r + 0.5; p = p * r + 1.0; p = p * r + 1.0;
    return ldexp(p, (int)k);
}
__device__ __forceinline__ void ssm_tables_item(Frame& F, int g, int r) {
    LAS float* pwr = (LAS float*)(F.lds); LAS float* pwi = pwr + 17 * 64;
    LAS float* ccr = pwi + 17 * 64; LAS float* cci = ccr + 1040;
    LAS float* bbr = cci + 1040; LAS float* bbi = bbr + 1024;
    LAS float* kt = bbi + 1024;
    LAS double* lb1 = (LAS double*)(kt + 4096);
    const float* a_re = inp(11); const float* a_im = inp(12); const float* log_dt = inp(13);
    const float* b_re = inp(14); const float* b_im = inp(15); const float* c_re = inp(16); const float* c_im = inp(17); const float* dsk = inp(18);
    const int tid = F.tid;
    const double dtv = dexp((double)log_dt[g]);
    for (int idx = tid; idx < 17 * 64; idx += 512) { const int t = idx >> 6, p = idx & 63;
        const double re = fmin((double)a_re[g * 64 + p], -1e-4), im = (double)a_im[g * 64 + p];
        const double mag = dexp(re * dtv * (double)t); double s, c; dsincos(im * dtv * (double)t, s, c);
        pwr[idx] = (float)(mag * c); pwi[idx] = (float)(mag * s); if (t == 1) { lb1[2 * p] = mag * c - 1.0; lb1[2 * p + 1] = mag * s; } }
    for (int idx = tid; idx < 1024; idx += 512) { const int c = idx >> 6, p = idx & 63; ccr[c * 65 + p] = c_re[(g * 16 + c) * 64 + p]; cci[c * 65 + p] = c_im[(g * 16 + c) * 64 + p]; }
    __syncthreads();
    for (int idx = tid; idx < 1024; idx += 512) { const int p = idx >> 4, c1 = idx & 15;
        const double re = fmin((double)a_re[g * 64 + p], -1e-4), im = (double)a_im[g * 64 + p];
        const double nr = lb1[2 * p], ni = lb1[2 * p + 1], den = re * re + im * im;
        const double qr = (nr * re + ni * im) / den, qi = (ni * re - nr * im) / den;
        const double br = (double)b_re[(g * 64 + p) * 16 + c1], bi = (double)b_im[(g * 64 + p) * 16 + c1];
        bbr[idx] = (float)(qr * br - qi * bi); bbi[idx] = (float)(qr * bi + qi * br); }
    __syncthreads();
    { const int t = tid >> 5, c = (tid >> 1) & 15, h8 = (tid & 1) * 8; float acc[8];
#pragma unroll
      for (int q = 0; q < 8; ++q) acc[q] = 0.f;
      for (int p = 0; p < 64; ++p) { const float cr = ccr[c * 65 + p], ci = cci[c * 65 + p], pr = pwr[t * 64 + p], pi = pwi[t * 64 + p]; const float mr = cr * pr - ci * pi, mi = cr * pi + ci * pr;
          const f32x4 r0 = *(const LAS f32x4*)(bbr + p * 16 + h8), r1 = *(const LAS f32x4*)(bbr + p * 16 + h8 + 4), i0 = *(const LAS f32x4*)(bbi + p * 16 + h8), i1 = *(const LAS f32x4*)(bbi + p * 16 + h8 + 4);
          acc[0] += mr * r0.x - mi * i0.x; acc[1] += mr * r0.y - mi * i0.y; acc[2] += mr * r0.z - mi * i0.z; acc[3] += mr * r0.w - mi * i0.w;
          acc[4] += mr * r1.x - mi * i1.x; acc[5] += mr * r1.y - mi * i1.y; acc[6] += mr * r1.z - mi * i1.z; acc[7] += mr * r1.w - mi * i1.w; }
#pragma unroll
      for (int q = 0; q < 8; ++q) kt[(t * 16 + c) * 16 + h8 + q] = acc[q]; }
    __syncthreads();
    bf16* TV = (bf16*)(F.ws + WS_TV) + (size_t)g * 256 * 384; bf16* WM = (bf16*)(F.ws + WS_WM) + (size_t)g * 256 * 256;
    for (int idx = tid; idx < 32 * 192; idx += 512) { const int row = 32 * r + idx / 192, col = 2 * (idx % 192), s = row >> 4, c = row & 15; float v[2];
#pragma unroll
        for (int q = 0; q < 2; ++q) { const int cq = col + q;
            if (cq < 256) { const int j = cq >> 4, c1 = cq & 15; v[q] = (j <= s) ? kt[((s - j) * 16 + c) * 16 + c1] : 0.f; if (j == s && c == c1) v[q] += dsk[g * 16 + c]; }
            else { const int p = (cq - 256) & 63; const float cr = ccr[c * 65 + p], ci = cci[c * 65 + p], pr = pwr[(s + 1) * 64 + p], pi = pwi[(s + 1) * 64 + p];
                v[q] = (cq < 320) ? (cr * pr - ci * pi) : -(cr * pi + ci * pr); } }
        *(unsigned*)(TV + (size_t)row * 384 + col) = pk2(v[0], v[1]); }
    for (int idx = tid; idx < 16 * 128; idx += 512) { const int row = 16 * r + (idx >> 7), col = 2 * (idx & 127), p = row & 63, ri = row >> 6, j = col >> 4, c1 = col & 15;
        const float pr = pwr[(15 - j) * 64 + p], pi = pwi[(15 - j) * 64 + p]; float v[2];
#pragma unroll
        for (int q = 0; q < 2; ++q) { const float br = bbr[p * 16 + c1 + q], bi = bbi[p * 16 + c1 + q]; v[q] = ri == 0 ? (pr * br - pi * bi) : (pr * bi + pi * br); }
        *(unsigned*)(WM + (size_t)row * 256 + col) = pk2(v[0], v[1]); *(unsigned*)(WM + (size_t)(128 + row) * 256 + col) = 0u; }
    if (r == 0 && tid < 64) { float* L16 = (float*)(F.ws + WS_LAM16) + (g * 64 + tid) * 2; L16[0] = pwr[16 * 64 + tid]; L16[1] = pwi[16 * 64 + tid]; }
    __syncthreads();
}
constexpr int MOD_NKS = 32;
__device__ __forceinline__ void modp_item(Frame& F, int it) {
    const int ng = it % 6, ks = it / 6, tid = F.tid;
    LAS float* cact = (LAS float*)F.lds;
    LAS f32x4* red = (LAS f32x4*)(cact + 256);
    const float* cin = inp(1); const float* w = inp(2);
    if (tid < 256) { const int b = tid >> 5, kk = tid & 31; const float c = cin[b * 1024 + ks * 32 + kk]; cact[tid] = c / (1.0f + __expf(-c)); }
    __syncthreads();
    const int c4 = tid & 255, kq = tid >> 8, col = ng * 1024 + 4 * c4; f32x4 wv[16], acc[8];
#pragma unroll
    for (int i = 0; i < 16; ++i) wv[i] = *(const GAS f32x4*)(w + (size_t)(ks * 32 + kq * 16 + i) * 6144 + col);
#pragma unroll
    for (int b = 0; b < 8; ++b) { acc[b] = (f32x4){0.f, 0.f, 0.f, 0.f};
#pragma unroll
        for (int i = 0; i < 16; ++i) acc[b] += wv[i] * cact[b * 32 + kq * 16 + i]; }
    if (kq == 1) {
#pragma unroll
        for (int b = 0; b < 8; ++b) red[b * 256 + c4] = acc[b]; }
    __syncthreads();
    if (kq == 0) { float* mp = (float*)(F.ws + WS_MODP);
#pragma unroll
        for (int b = 0; b < 8; ++b) *(GAS f32x4*)(mp + (size_t)(ks * 8 + b) * 6144 + col) = acc[b] + red[b * 256 + c4]; }
    __syncthreads();
}
__device__ __forceinline__ float mod_value(Frame& F, const float* b_ada, int b, int n) {
    const float* mp = (const float*)(F.ws + WS_MODP); float v = b_ada[n];
    float t[MOD_NKS];
#pragma unroll
    for (int ks = 0; ks < MOD_NKS; ++ks) t[ks] = mp[(size_t)(ks * 8 + b) * 6144 + n];
#pragma unroll
    for (int ks = 0; ks < MOD_NKS; ++ks) v += t[ks];
    return v;
}
#ifndef TR_HOSTED
#define TR_HOSTED 32768
#endif
constexpr int TR_I_W1 = 32 * 16 * 64, TR_I_W2 = 32 * 16 * 32, TR_I_IN = 16 * 64, TR_I_OUT = 16 * 32, TR_I_GLU = 8 * 16, TR_NITEMS = TR_I_W1 + TR_I_W2 + TR_I_IN + TR_I_OUT + TR_I_GLU;
__device__ __forceinline__ void tr_run(Frame& F, const int lo, const int hi, const int gw, const int NGW) {
    LAS float* scr = (LAS float*)(F.lds + RING_OFF + F.wave * 16384);
    constexpr int I_W1 = TR_I_W1, I_W2 = TR_I_W2, I_IN = TR_I_IN, I_OUT = TR_I_OUT;
    const int NITEMS = hi;
    const float* w1p = inp(25); const float* w2p = inp(27); const float* winp = inp(5); const float* woutp = inp(21); const float* wglup = inp(19);
    bf16* w1t = (bf16*)(F.ws + WS_W1T); bf16* w2t = (bf16*)(F.ws + WS_W2T); bf16* wint = (bf16*)(F.ws + WS_WIN); bf16* woutt = (bf16*)(F.ws + WS_WOUT); bf16* wglut = (bf16*)(F.ws + WS_WGLU);
#define TR_DESC(d, item) do { int r = (item); \
        if (r < I_W1) { const int e = r >> 10, rr = r & 1023, kb = rr >> 6, nb = rr & 63, n0 = 32 * nb, bj = n0 >> 10, rem = n0 & 1023, pn = rem >> 7, jj = rem & 127; \
            d.W = w1p + (size_t)e * 1024 * 2048 + (size_t)(64 * kb) * 2048 + n0; d.WT = (bf16*)((unsigned char*)w1t + (size_t)e * 2048 * 1024 + (size_t)(pn * 256 + bj * 128 + jj) * 1024 + 64 * kb); d.ldw = 2048; d.ldt = -1024; } \
        else if ((r -= I_W1) < I_W2) { const int e = r >> 9, rr = r & 511, kb = rr >> 5, nb = rr & 31; \
            d.W = w2p + (size_t)e * 1024 * 1024 + (size_t)(64 * kb) * 1024 + 32 * nb; d.WT = (bf16*)((unsigned char*)w2t + (size_t)e * 1024 * 1024 + (size_t)(32 * nb) * 1024 + 64 * kb); d.ldw = 1024; d.ldt = -1024; } \
        else if ((r -= I_W2) < I_IN) { const int kb = r >> 6, nb = r & 63; d.W = winp + (size_t)(64 * kb) * 2048 + 32 * nb; d.WT = wint + (size_t)(32 * nb) * 1024 + 64 * kb; d.ldw = 2048; d.ldt = 1024; } \
        else if ((r -= I_IN) < I_OUT) { const int kb = r >> 5, nb = r & 31; d.W = woutp + (size_t)(64 * kb) * 1024 + 32 * nb; d.WT = (bf16*)((unsigned char*)woutt + (size_t)(32 * nb) * 1024 + 64 * kb); d.ldw = 1024; d.ldt = -1024; } \
        else { r -= I_OUT; const int kb = r >> 4, nb = r & 15; d.W = wglup + (size_t)(64 * kb) * 512 + 32 * nb; d.WT = wglut + (size_t)(32 * nb) * 512 + 64 * kb; d.ldw = 512; d.ldt = 512; } } while (0)
    { TrItem dc, dn; int it = lo + gw, par = 0;
      if (it < NITEMS) { TR_DESC(dc, it); tr_dma(dc, scr, F.lane); }
      while (it < NITEMS) { const int nx = it + NGW;
          if (nx < NITEMS) { TR_DESC(dn, nx); tr_dma(dn, scr + (par ^ 1) * 2048, F.lane); asm volatile("s_waitcnt vmcnt(8)" ::: "memory"); }
          else { asm volatile("s_waitcnt vmcnt(0)" ::: "memory"); }
          tr_out(dc, scr + par * 2048, F.lane);
          LDS_WAIT(); asm volatile("" ::: "memory");
          dc = dn; it = nx; par ^= 1; }
      asm volatile("s_waitcnt vmcnt(0)" ::: "memory"); }
}
__device__ __forceinline__ void trq_load(v4u (&r)[8], const TrItem& d, int lane) {
    const int kr = lane >> 3, q = lane & 7;
#pragma unroll
    for (int i = 0; i < 8; ++i) { const float* p = d.W + (size_t)(8 * i) * d.ldw; const unsigned voff = (unsigned)(kr * d.ldw + 4 * ((q - i) & 7)) * 4u;
        asm volatile("global_load_dwordx4 %0, %1, %2 nt" : "=v"(r[i]) : "v"(voff), "s"(p) : "memory"); }
}
__device__ __forceinline__ void tr_run_deep(Frame& F, const int lo, const int hi, const int gw, const int NGW) {
    LAS float* scr = (LAS float*)(F.lds + RING_OFF + F.wave * 16384);
    constexpr int I_W1 = TR_I_W1, I_W2 = TR_I_W2, I_IN = TR_I_IN, I_OUT = TR_I_OUT;
    const float* w1p = inp(25); const float* w2p = inp(27); const float* winp = inp(5); const float* woutp = inp(21); const float* wglup = inp(19);
    bf16* w1t = (bf16*)(F.ws + WS_W1T); bf16* w2t = (bf16*)(F.ws + WS_W2T); bf16* wint = (bf16*)(F.ws + WS_WIN); bf16* woutt = (bf16*)(F.ws + WS_WOUT); bf16* wglut = (bf16*)(F.ws + WS_WGLU);
    if (lo + gw >= hi) return;
    const int n_it = (hi - lo - gw + NGW - 1) / NGW;
#define TRQ_DESC(d, j) do { const int jc_ = (j) < n_it ? (j) : n_it - 1; TR_DESC(d, lo + gw + jc_ * NGW); } while (0)
#define TRQ_STEP(r, d, j, par) do { \
        asm volatile("s_waitcnt vmcnt(16)" : "+v"(r[0]), "+v"(r[1]), "+v"(r[2]), "+v"(r[3]), "+v"(r[4]), "+v"(r[5]), "+v"(r[6]), "+v"(r[7]) :: "memory"); \
        LAS float* buf_ = scr + (par) * 2048; const bool live_ = (j) < n_it; \
        if (live_) { _Pragma("unroll") for (int i_ = 0; i_ < 8; ++i_) *(LAS v4u*)(buf_ + i_ * 256 + F.lane * 4) = r[i_]; } \
        LDS_WAIT(); TrItem dn_; TRQ_DESC(dn_, (j) + 3); trq_load(r, dn_, F.lane); \
        if (live_) tr_out(d, buf_, F.lane); \
        d = dn_; } while (0)
    v4u r0[8], r1[8], r2[8]; TrItem d0, d1, d2;
    TRQ_DESC(d0, 0); trq_load(r0, d0, F.lane); TRQ_DESC(d1, 1); trq_load(r1, d1, F.lane); TRQ_DESC(d2, 2); trq_load(r2, d2, F.lane);
    for (int j = 0; j < n_it; j += 6) {
        TRQ_STEP(r0, d0, j, 0); TRQ_STEP(r1, d1, j + 1, 1); TRQ_STEP(r2, d2, j + 2, 0);
        TRQ_STEP(r0, d0, j + 3, 1); TRQ_STEP(r1, d1, j + 4, 0); TRQ_STEP(r2, d2, j + 5, 1); }
    asm volatile("s_waitcnt vmcnt(0)" : "+v"(r0[0]), "+v"(r0[1]), "+v"(r0[2]), "+v"(r0[3]), "+v"(r0[4]), "+v"(r0[5]), "+v"(r0[6]), "+v"(r0[7]) :: "memory");
    asm volatile("" : "+v"(r1[0]), "+v"(r1[1]), "+v"(r1[2]), "+v"(r1[3]), "+v"(r1[4]), "+v"(r1[5]), "+v"(r1[6]), "+v"(r1[7]) :: "memory");
    asm volatile("" : "+v"(r2[0]), "+v"(r2[1]), "+v"(r2[2]), "+v"(r2[3]), "+v"(r2[4]), "+v"(r2[5]), "+v"(r2[6]), "+v"(r2[7]) :: "memory");
#undef TRQ_STEP
#undef TRQ_DESC
}
#undef TR_DESC
__device__ __forceinline__ void dep_signal(Frame& F, int word);
__device__ __forceinline__ void p0_prologue(Frame& F, int mode = 0) {
    { const float* wr = inp(23); bf16* wh = (bf16*)(F.ws + WS_WRH); bf16* wl = (bf16*)(F.ws + WS_WRL);
      for (int idx = F.vcu * 512 + F.tid; idx < 32768; idx += F.G * 512) { const int k = idx >> 5, e = idx & 31; const float w = wr[idx]; const unsigned hi = f2bf(w);
          wh[e * 1024 + k] = (bf16)hi; wl[e * 1024 + k] = (bf16)f2bf(w - __builtin_bit_cast(float, hi << 16)); } }
    const bool tab_last = (mode == 0) && !(F.vcu & 1);
    if (mode != 2 && mode != 4 && !tab_last) { for (int it = F.vcu; it < 256; it += F.G) ssm_tables_item(F, it >> 3, it & 7); }
    if (mode != 2 && mode != 3) { for (int it = F.vcu; it < 192; it += F.G) modp_item(F, it); }
    if (mode == 0) dep_signal(F, CW_DEP0);
    if (mode == 1 || mode == 3 || mode == 4) return;
    if (F.G == 256) tr_run(F, TR_HOSTED, TR_NITEMS, F.vcu * NWAVES + F.wave, F.G * NWAVES);
    else tr_run(F, 0, TR_NITEMS, F.vcu * NWAVES + F.wave, F.G * NWAVES);
    if (tab_last) { LDS_WAIT(); __syncthreads(); for (int it = F.vcu; it < 256; it += F.G) ssm_tables_item(F, it >> 3, it & 7); }
}
__device__ __forceinline__ void p1_h1(Frame& F) {
    const int bx = blockIdx.x, rows_per = NTOK / F.G, row_base = bx * rows_per, b = row_base >> 12;
    LAS float* vec = (LAS float*)(F.lds + VEC_OFF);
    const float* b_ada = inp(3); const float* n1g = inp(4); const float* xin = inp(0);
    for (int n = F.tid; n < 2048; n += 512) { float v = mod_value(F, b_ada, b, n); if (n >= 1024) v = (1.0f + v) * n1g[n - 1024]; vec[n] = v; }
    { const int per = (NB * 6144) / F.G; float* mf = (float*)(F.ws + WS_MODF);
      for (int i = F.tid; i < per; i += 512) { const int idx = bx * per + i; mf[idx] = mod_value(F, b_ada, idx / 6144, idx % 6144); } }
    __syncthreads();
    bf16* H = (bf16*)(F.ws + WS_H);
    for (int r = F.wave; r < rows_per; r += NWAVES) { const size_t row = (size_t)(row_base + r);
        const GAS f32x4* xr = (const GAS f32x4*)(xin + row * DM) + F.lane; f32x4 v[4]; float s = 0.f;
#pragma unroll
        for (int j = 0; j < 4; ++j) { v[j] = __builtin_nontemporal_load((const f32x4*)(xr + 64 * j)); s += (v[j].x * v[j].x + v[j].y * v[j].y) + (v[j].z * v[j].z + v[j].w * v[j].w); }
        const float rs = 1.0f / sqrtf(wave_sum_u(s) * (1.f / DM) + 1e-6f);
        GAS v2u* o8 = (GAS v2u*)(H + row * DM) + F.lane;
#pragma unroll
        for (int j = 0; j < 4; ++j) { const int c = 256 * j + 4 * F.lane; const f32x4 sh = *(LAS f32x4*)(vec + c), sc = *(LAS f32x4*)(vec + 1024 + c); const f32x4 h = v[j] * rs * sc + sh;
            v2u w; w.x = pk2(h.x, h.y); w.y = pk2(h.z, h.w); o8[64 * j] = w; } }
}
__device__ __forceinline__ void p4_combine(Frame& F) {
    const float lam = __expf(wave_sum(inp(6)[F.lane] * inp(7)[F.lane])) - __expf(wave_sum(inp(8)[F.lane] * inp(9)[F.lane])) + 0.2f;
    const bf16* OB = (const bf16*)(F.ws + WS_OB); bf16* MIX = (bf16*)(F.ws + WS_MIX);
    const int h = F.lane >> 4, d0 = (F.lane & 15) * 8; const float* sg = inp(10) + d0;
    float gs[8];
#pragma unroll
    for (int j = 0; j < 8; ++j) gs[j] = sg[j] * 0.8f;
    const int gw = F.vcu * NWAVES + F.wave, NGW = F.G * NWAVES;
    for (int tok = gw; tok < NTOK; tok += NGW) {
        const v4u a0 = *(const GAS v4u*)(OB + (size_t)tok * 1024 + (h * 2) * 128 + d0), a1 = *(const GAS v4u*)(OB + (size_t)tok * 1024 + (h * 2 + 1) * 128 + d0);
        float a[8];
        a[0] = pg8::bf_lo(a0.x) - lam * pg8::bf_lo(a1.x); a[1] = pg8::bf_hi(a0.x) - lam * pg8::bf_hi(a1.x); a[2] = pg8::bf_lo(a0.y) - lam * pg8::bf_lo(a1.y); a[3] = pg8::bf_hi(a0.y) - lam * pg8::bf_hi(a1.y);
        a[4] = pg8::bf_lo(a0.z) - lam * pg8::bf_lo(a1.z); a[5] = pg8::bf_hi(a0.z) - lam * pg8::bf_hi(a1.z); a[6] = pg8::bf_lo(a0.w) - lam * pg8::bf_lo(a1.w); a[7] = pg8::bf_hi(a0.w) - lam * pg8::bf_hi(a1.w);
        float ss = 0.f;
#pragma unroll
        for (int j = 0; j < 8; ++j) ss += a[j] * a[j];
        ss += __shfl_xor(ss, 1); ss += __shfl_xor(ss, 2); ss += __shfl_xor(ss, 4); ss += __shfl_xor(ss, 8);
        const float rs = 1.0f / sqrtf(ss * (1.f / 128.f) + 1e-6f);
        v4u o; o.x = pk2(a[0] * rs * gs[0], a[1] * rs * gs[1]); o.y = pk2(a[2] * rs * gs[2], a[3] * rs * gs[3]); o.z = pk2(a[4] * rs * gs[4], a[5] * rs * gs[5]); o.w = pk2(a[6] * rs * gs[6], a[7] * rs * gs[7]);
        *(GAS v4u*)(MIX + (size_t)tok * 1024 + h * 128 + d0) = o;
    }
}
constexpr int WRB = 2064;
constexpr int SEL_OFF = 140288;
static_assert(4 * 16 * WRB <= VEC_OFF, "router weights in LDS");
__device__ __forceinline__ void ins4(float v, int i, float (&tv)[4], int (&ti)[4]) {
#pragma unroll
    for (int k = 0; k < 4; ++k) { const bool better = v > tv[k] || (v == tv[k] && i < ti[k]); const float ov = tv[k]; const int oi = ti[k]; tv[k] = better ? v : ov; ti[k] = better ? i : oi; v = better ? ov : v; i = better ? oi : i; }
}
__device__ __forceinline__ void p6_fill(Frame& F) {
    const int bx = blockIdx.x, rows_per = NTOK / F.G, row_base = bx * rows_per, b = row_base >> 12;
    LAS float* vec = (LAS float*)(F.lds + VEC_OFF);
    LAS unsigned* hist = (LAS unsigned*)(F.lds + SEL_OFF) + 1536;
    const float* n2g = inp(22); const float* mf = (const float*)(F.ws + WS_MODF) + (size_t)b * 6144;
    __syncthreads();
    { const unsigned char* wsrc = F.ws + WS_WRH;
      for (int c = F.tid; c < 8192; c += 512) { const int row = c >> 7, col = c & 127; *(LAS v4u*)(F.lds + RING_OFF + row * WRB + col * 16) = *(const GAS v4u*)(wsrc + (size_t)row * 2048 + col * 16); } }
    for (int n = F.tid; n < 1024; n += 512) { vec[n] = mf[3072 + n]; vec[1024 + n] = (1.0f + mf[4096 + n]) * n2g[n]; }
    if (F.tid < 32) hist[F.tid] = 0u;
    __syncthreads();
}
__device__ __forceinline__ void p6_router(Frame& F, bool dummy = false, bool filled = false) {
    const int bx = blockIdx.x, rows_per = NTOK / F.G, row_base = bx * rows_per;
    LAS float* vec = (LAS float*)(F.lds + VEC_OFF);
    LAS unsigned* sel_e = (LAS unsigned*)(F.lds + SEL_OFF); LAS unsigned* sel_r = sel_e + 512; LAS float* sel_g = (LAS float*)(sel_r + 512); LAS unsigned* hist = (LAS unsigned*)(sel_g + 512); LAS unsigned* base = hist + 32;
    if (!filled) p6_fill(F);
    unsigned char* H = (unsigned char*)(F.ws + WS_H); const bf16* X1 = (const bf16*)(F.ws + WS_X1B);
    int* ptok = (int*)(F.ws + (dummy ? WS_Q : WS_PTOK)); unsigned* slot = (unsigned*)(F.ws + (dummy ? WS_Q + 8 * MiB : WS_SLOT)); float* gate = (float*)(F.ws + (dummy ? WS_Q + 16 * MiB : WS_GATE));
    const int cwc = dummy ? CW_CNT + 2048 : CW_CNT;
    const int t = F.lane & 15, kg = F.lane >> 4;
    for (int r0 = 16 * F.wave; r0 < rows_per; r0 += 16 * NWAVES) { const int tok = row_base + r0 + t;
        const GAS v4u* xp = (const GAS v4u*)(X1 + (size_t)tok * DM + 8 * kg);
        v4u xr[32]; float ss = 0.f;
#pragma unroll
        for (int s = 0; s < 32; ++s) xr[s] = xp[4 * s];
#pragma unroll
        for (int s = 0; s < 32; ++s) { const float x0 = pg8::bf_lo(xr[s].x), x1 = pg8::bf_hi(xr[s].x), x2 = pg8::bf_lo(xr[s].y), x3 = pg8::bf_hi(xr[s].y), x4 = pg8::bf_lo(xr[s].z), x5 = pg8::bf_hi(xr[s].z), x6 = pg8::bf_lo(xr[s].w), x7 = pg8::bf_hi(xr[s].w);
            ss += ((x0 * x0 + x1 * x1) + (x2 * x2 + x3 * x3)) + ((x4 * x4 + x5 * x5) + (x6 * x6 + x7 * x7)); }
        ss += __shfl_xor(ss, 16); ss += __shfl_xor(ss, 32);
        const float rs = 1.0f / sqrtf(ss * (1.f / DM) + 1e-6f);
        f32x4 acc0 = {0.f, 0.f, 0.f, 0.f}, acc1 = {0.f, 0.f, 0.f, 0.f};
        GAS unsigned char* hp = (GAS unsigned char*)(H + (size_t)tok * DM + 8 * kg);
        const LAS unsigned char* wa = F.lds + RING_OFF + t * WRB + 16 * kg;
        const LAS float* vp = vec + 8 * kg;
#pragma unroll
        for (int s = 0; s < 32; ++s) {
            const f32x4 sh0 = *(const LAS f32x4*)(vp), sh1 = *(const LAS f32x4*)(vp + 4), sc0 = *(const LAS f32x4*)(vp + 1024), sc1 = *(const LAS f32x4*)(vp + 1024 + 4);
            v4u xs = xr[s]; asm volatile("" : "+v"(xs));
            const f32x4 xa = {pg8::bf_lo(xs.x), pg8::bf_hi(xs.x), pg8::bf_lo(xs.y), pg8::bf_hi(xs.y)}, xb = {pg8::bf_lo(xs.z), pg8::bf_hi(xs.z), pg8::bf_lo(xs.w), pg8::bf_hi(xs.w)};
            const f32x4 h0 = xa * rs * sc0 + sh0, h1 = xb * rs * sc1 + sh1;
            const pg8::u32x4 bh = pg8::pack8(h0, h1);
            const f32x4 d0 = h0 - (f32x4){pg8::bf_lo(bh.x), pg8::bf_hi(bh.x), pg8::bf_lo(bh.y), pg8::bf_hi(bh.y)}, d1 = h1 - (f32x4){pg8::bf_lo(bh.z), pg8::bf_hi(bh.z), pg8::bf_lo(bh.w), pg8::bf_hi(bh.w)};
            const pg8::u32x4 bl = pg8::pack8(d0, d1);
            *(GAS pg8::i32x2*)(hp + 32 * s) = pg8::pack8_fp8(h0 * pg8::F8_ACT, h1 * pg8::F8_ACT);
            const pg8::bf16x8 Bh = __builtin_bit_cast(pg8::bf16x8, bh), Bl = __builtin_bit_cast(pg8::bf16x8, bl);
            const pg8::bf16x8 Ah0 = *(const LAS pg8::bf16x8*)(wa), Ah1 = *(const LAS pg8::bf16x8*)(wa + 16 * WRB), Al0 = *(const LAS pg8::bf16x8*)(wa + 32 * WRB), Al1 = *(const LAS pg8::bf16x8*)(wa + 48 * WRB);
            acc0 = __builtin_amdgcn_mfma_f32_16x16x32_bf16(Ah0, Bh, acc0, 0, 0, 0); acc1 = __builtin_amdgcn_mfma_f32_16x16x32_bf16(Ah1, Bh, acc1, 0, 0, 0);
            acc0 = __builtin_amdgcn_mfma_f32_16x16x32_bf16(Ah0, Bl, acc0, 0, 0, 0); acc1 = __builtin_amdgcn_mfma_f32_16x16x32_bf16(Ah1, Bl, acc1, 0, 0, 0);
            acc0 = __builtin_amdgcn_mfma_f32_16x16x32_bf16(Al0, Bh, acc0, 0, 0, 0); acc1 = __builtin_amdgcn_mfma_f32_16x16x32_bf16(Al1, Bh, acc1, 0, 0, 0);
            wa += 64; vp += 32;
            asm volatile("" : "+v"(wa), "+v"(vp), "+v"(acc0), "+v"(acc1)); }
        const float* br = inp(24) + 4 * kg;
        float tv[4] = {-INFINITY, -INFINITY, -INFINITY, -INFINITY}; int ti[4] = {99, 99, 99, 99};
#pragma unroll
        for (int r = 0; r < 4; ++r) ins4(acc0[r] + br[r], 4 * kg + r, tv, ti);
#pragma unroll
        for (int r = 0; r < 4; ++r) ins4(acc1[r] + br[16 + r], 16 + 4 * kg + r, tv, ti);
#pragma unroll
        for (int xr_ = 16; xr_ <= 32; xr_ <<= 1) { float ov[4]; int oi[4];
#pragma unroll
            for (int k = 0; k < 4; ++k) { ov[k] = __shfl_xor(tv[k], xr_); oi[k] = __shfl_xor(ti[k], xr_); }
#pragma unroll
            for (int k = 0; k < 4; ++k) ins4(ov[k], oi[k], tv, ti); }
        { const int k = kg;
          const float e1 = __expf(tv[1] - tv[0]), e2 = __expf(tv[2] - tv[0]), e3 = __expf(tv[3] - tv[0]); const float inv = 1.0f / (1.0f + e1 + e2 + e3);
          const int ek = k == 0 ? ti[0] : k == 1 ? ti[1] : k == 2 ? ti[2] : ti[3]; const float gk = (k == 0 ? 1.0f : k == 1 ? e1 : k == 2 ? e2 : e3) * inv;
          const unsigned rank = __hip_atomic_fetch_add(hist + ek, 1u, __ATOMIC_RELAXED, __HIP_MEMORY_SCOPE_WORKGROUP);
          const int q = (r0 + t) * 4 + k; sel_e[q] = (unsigned)ek; sel_r[q] = rank; sel_g[q] = gk; }
    }
    LDS_WAIT(); __syncthreads();
    if (F.tid < 32) base[F.tid] = __hip_atomic_fetch_add((unsigned*)(F.ctl + cwc + 64 * F.tid), hist[F.tid], RLX_AGENT);
    LDS_WAIT(); __syncthreads();
    { const int q = F.tid, tok = row_base + (q >> 2), k = q & 3; const unsigned ek = sel_e[q], pos = base[ek] + sel_r[q];
      ptok[(size_t)ek * NTOK + pos] = tok; slot[(size_t)tok * 4 + k] = (ek << 16) | pos; gate[(size_t)tok * 4 + k] = sel_g[q]; }
}
__device__ __forceinline__ void moe_tables(Frame& F) {
    LAS unsigned char* tile_e = (LAS unsigned char*)(F.lds + TILE_E_OFF); LAS int* tile0 = (LAS int*)(F.lds + TILE0_OFF); LAS int* cntl = (LAS int*)(F.lds + CNTL_OFF); LAS int* Tp = (LAS int*)(F.lds + MOE_T_OFF);
    if (F.tid < 32) { const int c = (int)__hip_atomic_load((unsigned*)(F.ctl + CW_CNT + 64 * F.tid), RLX_AGENT); const int nt = (c + 255) >> 8; int incl = nt;
#pragma unroll
        for (int o = 1; o < 32; o <<= 1) { const int w = __shfl_up(incl, o); if (F.tid >= o) incl += w; }
        const int excl = incl - nt; tile0[F.tid] = excl; cntl[F.tid] = c; if (F.tid == 31) Tp[0] = incl;
        for (int k = 0; k < nt; ++k) tile_e[excl + k] = (unsigned char)F.tid; }
    __syncthreads();
}
struct MoeSched {
    const LAS unsigned char* tile_e; const LAS int* tile0; const LAS unsigned* rowtab; int T, nN, G, c, rev, a_mask, e_mask; size_t tA, tBe, tB;
    __device__ __forceinline__ bool next(int i, pg8::Unit& u) const { const int x = c & 7, y = c >> 3, tpx = 32 / nN, t = (i * 8 + x) * tpx + (y % tpx); if (t >= T) return false; u.pm = rev ? T - 1 - t : t; u.pn = y / tpx; u.e = __builtin_amdgcn_readfirstlane((int)tile_e[u.pm]); return true; }
    __device__ __forceinline__ size_t aoff(const pg8::Unit& u) const { return (size_t)(u.pm & a_mask) * tA; }
    __device__ __forceinline__ size_t boff(const pg8::Unit& u) const { return (size_t)(u.e & e_mask) * tBe + (size_t)u.pn * tB; }
    __device__ __forceinline__ unsigned rowoff(int i, int r) const { return rowtab[i * 256 + r]; }
};
__device__ __forceinline__ void p9_final(Frame& F, bool dummy = false) {
    const int bx = blockIdx.x, rows_per = NTOK / F.G, row_base = bx * rows_per, b = row_base >> 12;
    if (MK_PER_PHASE || dummy) moe_tables(F);
    const LAS int* tile0 = (const LAS int*)(F.lds + TILE0_OFF);
    const float* g2 = (const float*)(F.ws + WS_MODF) + (size_t)b * 6144 + 5120; const float* fg = inp(29);
    const unsigned char* Y2 = (const unsigned char*)(F.ws + WS_Y2); const unsigned* slot = (const unsigned*)(F.ws + WS_SLOT); const float* gate = (const float*)(F.ws + WS_GATE);
    f32x4 g2v[4], fgv[4];
#pragma unroll
    for (int j = 0; j < 4; ++j) { g2v[j] = *(const f32x4*)(g2 + 256 * j + 4 * F.lane); fgv[j] = *(const f32x4*)(fg + 256 * j + 4 * F.lane); }
    for (int r = F.wave; r < rows_per; r += NWAVES) { const int tok = row_base + r;
        f32x4 acc[4];
#pragma unroll
        for (int j = 0; j < 4; ++j) acc[j] = (f32x4){0.f, 0.f, 0.f, 0.f};
#pragma unroll
        for (int k = 0; k < 4; ++k) { const unsigned sw = slot[(size_t)tok * 4 + k]; const float gk = gate[(size_t)tok * 4 + k]; const size_t p = (size_t)tile0[sw >> 16] * 256 + (sw & 0xffffu);
            const GAS int* yr = (const GAS int*)(Y2 + p * 1024) + F.lane; const float g8 = gk * 0.125f; typedef float f32x2 __attribute__((ext_vector_type(2)));
#pragma unroll
            for (int j = 0; j < 4; ++j) { const int w = yr[64 * j]; const f32x2 lo = __builtin_amdgcn_cvt_pk_f32_fp8(w, false), hi = __builtin_amdgcn_cvt_pk_f32_fp8(w, true);
                acc[j].x += g8 * lo.x; acc[j].y += g8 * lo.y; acc[j].z += g8 * hi.x; acc[j].w += g8 * hi.y; } }
        const GAS v2u* xr = (const GAS v2u*)((const bf16*)(F.ws + WS_X1B) + (size_t)tok * DM) + F.lane;
        GAS f32x4* xw = (GAS f32x4*)((dummy ? (float*)(F.ws + WS_A2) : F.out) + (size_t)tok * DM) + F.lane; f32x4 v[4]; float s = 0.f;
#pragma unroll
        for (int j = 0; j < 4; ++j) { const v2u wx = xr[64 * j]; v[j] = (f32x4){pg8::bf_lo(wx.x), pg8::bf_hi(wx.x), pg8::bf_lo(wx.y), pg8::bf_hi(wx.y)} + g2v[j] * acc[j]; s += (v[j].x * v[j].x + v[j].y * v[j].y) + (v[j].z * v[j].z + v[j].w * v[j].w); }
        const float rs = 1.0f / sqrtf(wave_sum_u(s) * (1.f / DM) + 1e-6f);
#pragma unroll
        for (int j = 0; j < 4; ++j) __builtin_nontemporal_store(v[j] * rs * fgv[j], (f32x4*)(xw + 64 * j));
    }
}

__device__ __forceinline__ void dep_signal(Frame& F, int word) {
    asm volatile("s_waitcnt vmcnt(0)" ::: "memory"); __syncthreads();
    if (F.wave == 0 && lane_id_opaque() == 0) { __builtin_amdgcn_fence(__ATOMIC_RELEASE, "agent"); asm volatile("s_waitcnt vmcnt(0)" ::: "memory"); (void)xb_add((unsigned*)(F.ctl + word), 1u); }
}
__device__ __forceinline__ void dep_wait(Frame& F, int word, unsigned need) {
    if (F.wave == 0 && lane_id_opaque() == 0) { unsigned* p = (unsigned*)(F.ctl + word); unsigned* bar = (unsigned*)(F.ctl + CW_BAR); XB_SPIN(xb_ld(p) < need, bar);
        __builtin_amdgcn_fence(__ATOMIC_ACQUIRE, "agent"); asm volatile("s_waitcnt vmcnt(0)" ::: "memory"); }
    __syncthreads();
}
#ifndef P2_NG
#define P2_NG 176
#endif
__device__ __forceinline__ void phase0(Frame& F, unsigned char* lds, unsigned char* ws) { p0_prologue(F);  }
__device__ __forceinline__ void phase1(Frame& F, unsigned char* lds, unsigned char* ws) { dep_wait(F, CW_DEP0, (unsigned)F.G); p1_h1(F);  }
__device__ __forceinline__ void phase2(Frame& F, unsigned char* lds, unsigned char* ws) {
        pg8::Gemm g{(const bf16*)(ws + WS_H), (const bf16*)(ws + WS_WIN), 1024, 1024, 1024}; const bool hosted = (F.G == 256); const int ng = hosted ? P2_NG : F.G;
        pg8::StaticOrder S; S.init(NTOK, 2048, ng, (int)blockIdx.x, 1024, 1024);
        pg8::EpiQKVU E{(bf16*)(ws + WS_Q), (size_t)(WS_K - WS_Q) / 2, (bf16*)(ws + WS_UA), attn_body::C2};
        if ((int)blockIdx.x < ng) pg8::gemm_phase<pg8::EpiQKVU, pg8::StaticOrder, true, false>(F.lds + RING_OFF, g, S, E, F.wave);
        else tr_run(F, 0, TR_HOSTED, ((int)blockIdx.x - ng) * NWAVES + F.wave, (F.G - ng) * NWAVES);

    }
__device__ __forceinline__ void phase4_glu(Frame& F, unsigned char* ws) {
        pg8::Gemm g{(const bf16*)(ws + WS_Z), (const bf16*)(ws + WS_WGLU), 512, 512, 512}; pg8::StaticOrder S; S.init(NTOK, 512, F.G, (int)blockIdx.x, 512, 512);
        { pg8::Unit u; const bool one = (F.G == 256) && S.next(0, u);
          if (one) dep_wait(F, CW_DEPB + 16 * (u.pm >> 4), 32u);
          else { for (int bb = 0; bb < NB; ++bb) dep_wait(F, CW_DEPB + 16 * bb, 32u); } }
        pg8::EpiGLU E{(const bf16*)(ws + WS_Z), (bf16*)(ws + WS_MIX), inp(20)};
        pg8::gemm_phase<pg8::EpiGLU, pg8::StaticOrder, true, false>(F.lds + RING_OFF, g, S, E, F.wave);
        __syncthreads();
    }
__device__ __forceinline__ void phase3(Frame& F, unsigned char* lds, unsigned char* ws) {
        for (int it = F.vcu; it < 256; it += F.G) { const int g = it >> 3, b = it & 7;
            bf16* UAgb = (bf16*)(ws + WS_UA) + (size_t)((g * 8 + b) * 256) * 384;
            { pg8::Gemm gx{UAgb, (const bf16*)(ws + WS_WM) + (size_t)g * 256 * 256, 256, 384, 256}; pg8::SingleUnit S; pg8::EpiX E;
              pg8::gemm_phase<pg8::EpiX, pg8::SingleUnit, false, false>(F.lds + RING_OFF, gx, S, E, F.wave); }
            LDS_WAIT(); __syncthreads();
            {
                const int p = lane_id_opaque(), c0 = F.wave * 32; const float* L16 = (const float*)(ws + WS_LAM16) + (g * 64 + p) * 2; const float lr = L16[0], li = L16[1];
                LAS float* X = (LAS float*)(F.lds + RING_OFF); LAS float* EW = X + 256 * pg8::XS;
                float hr = 0.f, hi2 = 0.f;
#pragma unroll 8
                for (int k = 0; k < 32; ++k) { LAS float* xc = X + (c0 + k) * pg8::XS + p; const float xr = xc[0], xi = xc[64]; xc[0] = hr; xc[64] = hi2;
                    const float nr = lr * hr - li * hi2 + xr, ni = lr * hi2 + li * hr + xi; hr = nr; hi2 = ni; }
                EW[F.wave * 128 + p] = hr; EW[F.wave * 128 + 64 + p] = hi2;
                float qr = lr, qi = li;
#pragma unroll
                for (int sq = 0; sq < 5; ++sq) { const float t = qr * qr - qi * qi; qi = 2.f * qr * qi; qr = t; }
                LDS_WAIT(); __syncthreads();
                float cr = 0.f, ci = 0.f;
                for (int v = 0; v < F.wave; ++v) { const float er = EW[v * 128 + p], ei = EW[v * 128 + 64 + p]; const float nr = qr * cr - qi * ci + er, ni = qr * ci + qi * cr + ei; cr = nr; ci = ni; }
                bf16* hrow = UAgb + (size_t)c0 * 384 + 256 + p; float pr = 1.f, pi = 0.f;
#pragma unroll 8
                for (int k = 0; k < 32; ++k) { const LAS float* xc = X + (c0 + k) * pg8::XS + p; const float hr2 = xc[0] + (pr * cr - pi * ci), hi3 = xc[64] + (pr * ci + pi * cr);
                    hrow[(size_t)k * 384] = (bf16)f2bf(hr2); hrow[(size_t)k * 384 + 64] = (bf16)f2bf(hi3);
                    const float t = pr * lr - pi * li; pi = pr * li + pi * lr; pr = t; }
                VM_WAIT(); if (F.wave == 0) { __builtin_amdgcn_fence(__ATOMIC_ACQUIRE, "agent"); VM_WAIT(); } }
            LDS_WAIT(); __syncthreads();
            { pg8::Gemm gy{UAgb, (const bf16*)(ws + WS_TV) + (size_t)g * 256 * 384, 384, 384, 384}; pg8::SingleUnit S; pg8::EpiY E{(bf16*)(ws + WS_Z), g, b};
              pg8::gemm_phase<pg8::EpiY, pg8::SingleUnit, false, false>(F.lds + RING_OFF, gy, S, E, F.wave); }
            dep_signal(F, CW_DEPB + 16 * b);
        }
        static_assert(attn_body::LDS2_BYTES <= LDSCTL_OFF, "attention LDS vs control words");
        for (int it = F.vcu; it < 256; it += F.G) { const int bh = it >> 3, sdx = it & 7, b = bh >> 2, h = bh & 3;
            for (int i4 = 0; i4 < 4; ++i4) { const int qb = (i4 >> 1) ? 15 - sdx : sdx;
                { const int m = i4 & 1, hm = h * 2 + m;
                    const attn_body::bf16* q_ = (const attn_body::bf16*)(ws + WS_Q) + (size_t)b * SEQ * 512 + hm * 64; const attn_body::bf16* k_ = (const attn_body::bf16*)(ws + WS_K) + (size_t)b * SEQ * 512 + hm * 64;
                    const attn_body::bf16* v_ = (const attn_body::bf16*)(ws + WS_V) + (size_t)b * SEQ * 512 + h * 128; attn_body::bf16* o_ = (attn_body::bf16*)(ws + WS_OB) + (size_t)b * SEQ * 1024 + hm * 128;
                    asm volatile("" : "+s"(q_), "+s"(k_), "+s"(v_), "+s"(o_));
                    attn_body::attn_unit2<8>(qb, q_, k_, v_, o_, (char*)lds + RING_OFF, F.wave); }
                if (i4 & 1) { VM_WAIT(); __syncthreads();
 const int ln = lane_id_opaque(), t16 = F.wave * 4 + (ln >> 4), d0 = (ln & 15) * 8; const float* sg = inp(10) + d0;
                  const float lam = __expf(wave_sum(inp(6)[ln] * inp(7)[ln])) - __expf(wave_sum(inp(8)[ln] * inp(9)[ln])) + 0.2f;
                  const bf16* OB = (const bf16*)(ws + WS_OB); bf16* MIX = (bf16*)(ws + WS_MIX);
                  v4u a0v[8], a1v[8];
#pragma unroll
                  for (int p = 0; p < 8; ++p) { const size_t tok = (size_t)b * SEQ + qb * 256 + p * 32 + t16; a0v[p] = *(const GAS v4u*)(OB + tok * 1024 + (h * 2) * 128 + d0); a1v[p] = *(const GAS v4u*)(OB + tok * 1024 + (h * 2 + 1) * 128 + d0); }
#pragma unroll
                  for (int p = 0; p < 8; ++p) { const size_t tok = (size_t)b * SEQ + qb * 256 + p * 32 + t16;
                      const v4u a0 = a0v[p], a1 = a1v[p];
                      float a[8];
                      a[0] = pg8::bf_lo(a0.x) - lam * pg8::bf_lo(a1.x); a[1] = pg8::bf_hi(a0.x) - lam * pg8::bf_hi(a1.x); a[2] = pg8::bf_lo(a0.y) - lam * pg8::bf_lo(a1.y); a[3] = pg8::bf_hi(a0.y) - lam * pg8::bf_hi(a1.y);
                      a[4] = pg8::bf_lo(a0.z) - lam * pg8::bf_lo(a1.z); a[5] = pg8::bf_hi(a0.z) - lam * pg8::bf_hi(a1.z); a[6] = pg8::bf_lo(a0.w) - lam * pg8::bf_lo(a1.w); a[7] = pg8::bf_hi(a0.w) - lam * pg8::bf_hi(a1.w);
                      float ss = 0.f;
#pragma unroll
                      for (int j = 0; j < 8; ++j) ss += a[j] * a[j];
                      ss += __shfl_xor(ss, 1); ss += __shfl_xor(ss, 2); ss += __shfl_xor(ss, 4); ss += __shfl_xor(ss, 8);
                      const float rs = 0.8f / sqrtf(ss * (1.f / 128.f) + 1e-6f);
                      const float r4 = rs * 4.0f; const pg8::f32x4 q0 = {a[0] * r4 * sg[0], a[1] * r4 * sg[1], a[2] * r4 * sg[2], a[3] * r4 * sg[3]}, q1 = {a[4] * r4 * sg[4], a[5] * r4 * sg[5], a[6] * r4 * sg[6], a[7] * r4 * sg[7]};
                      *(GAS pg8::i32x2*)((unsigned char*)MIX + tok * 1024 + h * 128 + d0) = pg8::pack8_fp8(q0, q1); } }
            }
        }
        __syncthreads(); phase4_glu(F, ws);
}
__device__ __forceinline__ void phase4(Frame& F, unsigned char* lds, unsigned char* ws) { }
__device__ __forceinline__ void phase5(Frame& F, unsigned char* lds, unsigned char* ws) {
        pg8::Gemm g{(const bf16*)(ws + WS_MIX), (const bf16*)(ws + WS_WOUT), 512, 512, 512}; pg8::StaticOrder S; S.init(NTOK, 1024, F.G, (int)blockIdx.x, 512, 512);
        pg8::EpiOut E{inp(0), (bf16*)(ws + WS_X1B), (const float*)(ws + WS_MODF) + 2048, F.lds + VEC_OFF};
        pg8::gemm_phase<pg8::EpiOut, pg8::StaticOrder, true, false, true>(F.lds + RING_OFF, g, S, E, F.wave);

    }
__device__ __forceinline__ void phase6(Frame& F, unsigned char* lds, unsigned char* ws) { p6_router(F, false, !MK_PER_PHASE);  }
__device__ __forceinline__ void phase7(Frame& F, unsigned char* lds, unsigned char* ws) {
        moe_tables(F);
        MoeSched S; S.tile_e = (const LAS unsigned char*)(F.lds + TILE_E_OFF); S.tile0 = (const LAS int*)(F.lds + TILE0_OFF); S.rowtab = (const LAS unsigned*)(F.lds + ROWTAB_OFF);
        S.T = __builtin_amdgcn_readfirstlane(((const LAS int*)(F.lds + MOE_T_OFF))[0]); S.nN = 8; S.G = F.G; S.c = (int)blockIdx.x; S.rev = 0; S.a_mask = -1; S.e_mask = -1; S.tA = 0; S.tBe = (size_t)2048 * 1024; S.tB = (size_t)256 * 1024;
        { const LAS int* cntl = (const LAS int*)(F.lds + CNTL_OFF); LAS unsigned* rt = (LAS unsigned*)(F.lds + ROWTAB_OFF); const int* ptok = (const int*)(ws + WS_PTOK);
          int tokv[18]; bool live[18];
#pragma unroll
          for (int i = 0; i < 18; ++i) { pg8::Unit u; live[i] = S.next(i, u); tokv[i] = 0;
              if (live[i] && F.tid < 256) { const int e = u.e, pos = (u.pm - S.tile0[e]) * 256 + F.tid; tokv[i] = ptok[(size_t)e * NTOK + (pos < cntl[e] ? pos : 0)]; } }
#pragma unroll
          for (int i = 0; i < 18; ++i) if (live[i] && F.tid < 256) rt[i * 256 + F.tid] = (unsigned)tokv[i] * 1024u; }
        VM_WAIT(); LDS_WAIT(); __syncthreads();
        pg8::Gemm g{(const bf16*)(ws + WS_H), (const bf16*)(ws + WS_W1T), 512, 512, 512};
        pg8::EpiMoe1 E{(unsigned char*)(ws + WS_A2), inp(26), F.lds + BIASL_OFF};
        pg8::gemm_phase<pg8::EpiMoe1, MoeSched, true, true, true>(F.lds + RING_OFF, g, S, E, F.wave);

    }
__device__ __forceinline__ void phase8(Frame& F, unsigned char* lds, unsigned char* ws) {
        if (MK_PER_PHASE) moe_tables(F);
        MoeSched S; S.tile_e = (const LAS unsigned char*)(F.lds + TILE_E_OFF); S.tile0 = (const LAS int*)(F.lds + TILE0_OFF); S.rowtab = (const LAS unsigned*)(F.lds + ROWTAB_OFF);
        S.T = __builtin_amdgcn_readfirstlane(((const LAS int*)(F.lds + MOE_T_OFF))[0]); S.nN = 4; S.G = F.G; S.c = (int)blockIdx.x; S.rev = 1; S.a_mask = -1; S.e_mask = -1; S.tA = (size_t)256 * 1024; S.tBe = (size_t)1024 * 1024; S.tB = (size_t)256 * 1024;
        pg8::Gemm g{(const bf16*)(ws + WS_A2), (const bf16*)(ws + WS_W2T), 512, 512, 512};
        pg8::EpiMoe2 E{(unsigned char*)(ws + WS_Y2), inp(28), -1, F.lds + BIASL_OFF};
        pg8::gemm_phase<pg8::EpiMoe2, MoeSched, true, false, true>(F.lds + RING_OFF, g, S, E, F.wave);

    }
__device__ __forceinline__ void phase9(Frame& F, unsigned char* lds, unsigned char* ws) { p9_final(F); }
__device__ __forceinline__ bool relaunder(Frame& F) { F.lane = lane_id_opaque(); F.tid = F.wave * 64 + F.lane; return true; }
struct Args { const float* in[30]; float* out; unsigned char* ws; int ph_lo, ph_hi; };
__global__ void __launch_bounds__(NWAVES * 64, 2) mega_fwd(Args args) {
    extern __shared__ __attribute__((aligned(16))) unsigned char lds[];
    Frame F;
    F.lds = (LAS unsigned char*)lds;
    F.tid = threadIdx.x; F.lane = F.tid & 63; F.wave = __builtin_amdgcn_readfirstlane(F.tid >> 6);
    F.G = gridDim.x; { const int bx = blockIdx.x; F.vcu = (F.G % 8 == 0) ? (bx % 8) * (F.G / 8) + bx / 8 : bx; }
    F.ws = args.ws; F.out = args.out; F.ctl = (gu32*)(args.ws + WS_CTL);
    volatile LAS unsigned* MISC = (volatile LAS unsigned*)(F.lds + MISC_OFF);
    for (int u = F.tid; u < (LDS_BYTES - LDSCTL_OFF) / 4; u += NWAVES * 64) ((LAS unsigned*)(F.lds + LDSCTL_OFF))[u] = 0u;
    __syncthreads();
    XcdBarrier bar; bar.bar = (unsigned*)(F.ctl + CW_BAR); bar.x = 0; bar.st = nullptr;
    if (!MK_PER_PHASE) bar = xcd_barrier_post((unsigned*)(F.ctl + CW_BAR), MISC + 8);
    const int lo = args.ph_lo, hi = args.ph_hi;
#ifndef MK_MASK
#define MK_MASK 0x3ff
#endif
#define IN(k) (((MK_MASK >> (k)) & 1) && lo <= (k) && (k) < hi && relaunder(F))
#define SEAM(k) do { if (IN(k) && IN((k) + 1)) xcd_barrier(bar, F.wave); } while (0)
    unsigned char* ws = args.ws;

    if (IN(0)) { phase0(F, lds, ws); }
#if MK_DUP == 0
    if (IN(0)) { phase0(F, lds, ws); SEAM(0); }
#endif
    if (IN(1)) { phase1(F, lds, ws); SEAM(1); }
#if MK_DUP == 1
    if (IN(1)) { phase1(F, lds, ws); SEAM(1); }
#endif
    if (IN(2)) { phase2(F, lds, ws); SEAM(2); }
#if MK_DUP == 2
    if (IN(2)) { phase2(F, lds, ws); SEAM(2); }
#endif
#if MK_DUP == 18
    if (IN(2)) { for (int rr = 0; rr < 8; ++rr) { phase2(F, lds, ws); xcd_barrier(bar, F.wave); } }
#endif
    if (IN(3)) { phase3(F, lds, ws); }
#if MK_DUP == 3
    if (IN(3)) { phase3(F, lds, ws); SEAM(3); }
#endif
    if (IN(4)) { phase4(F, lds, ws); SEAM(4); }
#if MK_DUP == 4
    if (IN(4)) { phase4(F, lds, ws); SEAM(4); }
#endif
    if (IN(5)) { phase5(F, lds, ws); if (!MK_PER_PHASE && IN(6)) p6_fill(F); SEAM(5); }
#if MK_DUP == 5
    if (IN(5)) { phase5(F, lds, ws); SEAM(5); }
#endif
#if MK_DUP == 6
    if (IN(6)) { p6_router(F, true); xcd_barrier(bar, F.wave); }
#endif
    if (IN(6)) { phase6(F, lds, ws); SEAM(6); }
    if (IN(7)) { phase7(F, lds, ws); SEAM(7); }
#if MK_DUP == 7
    if (IN(7)) { phase7(F, lds, ws); SEAM(7); }
#endif
    if (IN(8)) { phase8(F, lds, ws); SEAM(8); }
#if MK_DUP == 8
    if (IN(8)) { phase8(F, lds, ws); SEAM(8); }
#endif
#if MK_DUP == 9
    if (IN(9)) { p9_final(F, true); xcd_barrier(bar, F.wave); }
#endif
#if MK_DUP == 16 || MK_DUP == 17
    if (IN(8)) {
        moe_tables(F);
        MoeSched S; S.tile_e = (const LAS unsigned char*)(F.lds + TILE_E_OFF); S.tile0 = (const LAS int*)(F.lds + TILE0_OFF); S.rowtab = (const LAS unsigned*)(F.lds + ROWTAB_OFF);
        S.T = __builtin_amdgcn_readfirstlane(((const LAS int*)(F.lds + MOE_T_OFF))[0]); S.nN = 4; S.G = F.G; S.c = (int)blockIdx.x; S.rev = 1; S.e_mask = (MK_DUP == 16) ? 0 : -1; S.a_mask = (MK_DUP == 16) ? 0 : -1; S.tA = (size_t)256 * 1024; S.tBe = (size_t)1024 * 1024; S.tB = (size_t)256 * 1024;
        pg8::Gemm g{(const bf16*)(ws + WS_A2), (const bf16*)(ws + WS_W2T), 512, 512, 512};
        pg8::EpiMoe2 E{(unsigned char*)(ws + WS_W1T), inp(28), 127};
        pg8::gemm_phase<pg8::EpiMoe2, MoeSched, true, false, true>(F.lds + RING_OFF, g, S, E, F.wave);
        xcd_barrier(bar, F.wave);
    }
#endif
    if (IN(9)) { phase9(F, lds, ws); }
#if MK_DUP == 19
    if (IN(9)) { xcd_barrier(bar, F.wave); phase7(F, lds, ws); }
#endif
#if MK_DUP == 20
    if (IN(9)) { xcd_barrier(bar, F.wave); phase8(F, lds, ws); }
#endif
#if MK_DUP == 10
    if (IN(9)) { xcd_barrier(bar, F.wave); phase0(F, lds, ws); }
#endif
#if MK_DUP == 11
    if (IN(9)) { xcd_barrier(bar, F.wave); p0_prologue(F, 1); }
#endif
#if MK_DUP == 13
    if (IN(9)) { xcd_barrier(bar, F.wave); p0_prologue(F, 3); }
#endif
#if MK_DUP == 14
    if (IN(9)) { xcd_barrier(bar, F.wave); p0_prologue(F, 4); }
#endif
#if MK_DUP == 15
    if (IN(9)) { xcd_barrier(bar, F.wave); }
#endif
#if MK_DUP == 12
    if (IN(9)) { xcd_barrier(bar, F.wave); p0_prologue(F, 2); }
#endif
#undef IN
#undef SEAM
}

extern "C" void kernel_launch(void* const* d_in, const int* in_sizes, int n_in, void* d_out, int out_size, void* d_ws, size_t ws_size, hipStream_t stream) {
    static int grid = 0;
    if (grid == 0) {
        if (n_in != 30 || in_sizes[0] != NTOK * DM || out_size != NTOK * DM || ws_size < WS_END) { fprintf(stderr, "kernel_launch: unexpected shapes (n_in %d, in0 %d, out %d, ws %zu); nothing launched\n", n_in, n_in > 0 ? in_sizes[0] : -1, out_size, ws_size); grid = -1; return; }
        int dev = 0, cus = 0;
        if (hipGetDevice(&dev) != hipSuccess || hipDeviceGetAttribute(&cus, hipDeviceAttributeMultiprocessorCount, dev) != hipSuccess) { fprintf(stderr, "kernel_launch: device query failed\n"); grid = -1; return; }
        if (hipFuncSetAttribute((const void*)mega_fwd, hipFuncAttributeMaxDynamicSharedMemorySize, LDS_BYTES) != hipSuccess) { fprintf(stderr, "kernel_launch: hipFuncSetAttribute failed\n"); grid = -1; return; }
        (void)hipGetLastError();
        grid = cus;
        if (grid != 256) { fprintf(stderr, "kernel_launch: built for a 256-CU device, found %d CUs; nothing launched\n", grid); grid = -1; return; }
    }
    if (grid < 0) return;
    if (hipMemsetAsync((char*)d_ws + WS_CTL, 0, CTL_ZERO_BYTES, stream) != hipSuccess) { fprintf(stderr, "kernel_launch: memset failed\n"); return; }
    Args a{};
    for (int i = 0; i < 30; ++i) a.in[i] = (const float*)d_in[i];
    a.out = (float*)d_out; a.ws = (unsigned char*)d_ws;
#if MK_PER_PHASE
    for (int p = 0; p < N_PHASES; ++p) { a.ph_lo = p; a.ph_hi = p + 1; hipLaunchKernelGGL(mega_fwd, dim3(grid), dim3(NWAVES * 64), LDS_BYTES, stream, a); }
#else
    a.ph_lo = 0; a.ph_hi = N_PHASES; hipLaunchKernelGGL(mega_fwd, dim3(grid), dim3(NWAVES * 64), LDS_BYTES, stream, a);
#endif
    const hipError_t le = hipPeekAtLastError();
    if (le != hipSuccess) fprintf(stderr, "kernel_launch: launch failed: %s\n", hipGetErrorName(le));
}
```

```cpp
#include <hip/hip_runtime.h>
#include <hip/hip_bf16.h>
#include <cstdio>
#include <cstdint>
#include <cmath>

#ifndef MK_PER_PHASE
#define MK_PER_PHASE 0
#endif

#ifdef MK_EPI2
#define MK_EPI2V MK_EPI2
#else
#define MK_EPI2V (-1)
#endif
#ifndef MK_DUP
#define MK_DUP (-1)
#endif

#define LAS __attribute__((address_space(3)))
#define GAS __attribute__((address_space(1)))

__device__ __forceinline__ int lane_id_opaque() { int l = (int)__builtin_amdgcn_mbcnt_hi(~0u, __builtin_amdgcn_mbcnt_lo(~0u, 0u)); asm volatile("" : "+v"(l)); return l; }

namespace pg8 {
typedef unsigned short bf16_t;
typedef short bf16x8 __attribute__((ext_vector_type(8)));
typedef float f32x4 __attribute__((ext_vector_type(4)));
typedef unsigned u32x4 __attribute__((ext_vector_type(4)));
typedef float f32x2 __attribute__((ext_vector_type(2)));
typedef int i32x4 __attribute__((ext_vector_type(4)));
typedef int i32x8 __attribute__((ext_vector_type(8)));
typedef int i32x2 __attribute__((ext_vector_type(2)));
constexpr int BM = 256, BK = 64, HALF = 128, HTB = HALF * BK * 2, STAGE_BYTES = 8 * HTB, NXCD = 8, WGM = 8;

__host__ __device__ __forceinline__ int lds_byte(int r, int c) { const int st = (r >> 4) * 2 + (c >> 5), rr = r & 15, cc = c & 31, ob = rr * 64 + cc * 2; return st * 1024 + (ob ^ (((ob >> 9) & 1) << 5)); }
__host__ __device__ __forceinline__ void stage_rc(int b, int& R, int& C) { const int st = b / 1024, sb = b % 1024, swz = sb ^ (((sb >> 9) & 1) << 5); R = (st >> 1) * 16 + swz / 64; C = (st & 1) * 32 + (swz % 64) / 2; }
__host__ __device__ __forceinline__ int perm32(int rho) { const int n = rho >> 4, i = rho & 15; return 8 * (i >> 2) + 4 * n + (i & 3); }

struct Unit { int pm, pn, e; };
struct Gemm { const bf16_t* A; const bf16_t* Bt; int K, lda, ldb; };

struct StaticOrder {
    int nM, nN, nwg, G, c; size_t tA, tB;
    __device__ __forceinline__ void init(int M, int N, int G_, int c_, int lda, int ldb) { nM = M / BM; nN = N / BM; nwg = nM * nN; G = G_; c = c_; tA = (size_t)BM * lda * 2; tB = (size_t)BM * ldb * 2; }
    __device__ __forceinline__ bool next(int i, Unit& u) const {
        const long L = (long)i * G + c; if (L >= nwg) return false;
        int wgid = (int)L; { const int q = nwg / NXCD, r = nwg % NXCD, xcd = wgid % NXCD, off = wgid / NXCD; wgid = (xcd < r ? xcd * (q + 1) : r * (q + 1) + (xcd - r) * q) + off; }
        const int nig = WGM * nN, gid = wgid / nig, fm = gid * WGM, gsz = (nM - fm) < WGM ? (nM - fm) : WGM;
        u.pm = fm + ((wgid % nig) % gsz); u.pn = (wgid % nig) / gsz; u.e = 0; return true;
    }
    __device__ __forceinline__ size_t aoff(const Unit& u) const { return (size_t)u.pm * tA; }
    __device__ __forceinline__ size_t boff(const Unit& u) const { return (size_t)u.pn * tB; }
    __device__ __forceinline__ unsigned rowoff(int, int) const { return 0u; }
};
struct SingleUnit {
    __device__ __forceinline__ bool next(int i, Unit& u) const { if (i > 0) return false; u.pm = 0; u.pn = 0; u.e = 0; return true; }
    __device__ __forceinline__ size_t aoff(const Unit&) const { return 0; }
    __device__ __forceinline__ size_t boff(const Unit&) const { return 0; }
    __device__ __forceinline__ unsigned rowoff(int, int) const { return 0u; }
};

__device__ __forceinline__ unsigned cvt_pk_bf16(float lo, float hi) { unsigned r; asm volatile("v_cvt_pk_bf16_f32 %0, %1, %2" : "=v"(r) : "v"(lo), "v"(hi)); return r; }
__device__ __forceinline__ float sigm(float x) { return __builtin_amdgcn_rcpf(1.0f + __builtin_amdgcn_exp2f(-1.4426950408889634f * x)); }
__device__ __forceinline__ float gelu_tanh(float y) { return y * sigm(1.5957691216057308f * (y + 0.044715f * y * y * y)); }
__device__ __forceinline__ f32x2 gelu_tanh2(f32x2 y) {
    const f32x2 y2 = y * y, u = y * __builtin_elementwise_fma(y2, (f32x2){0.044715f, 0.044715f}, (f32x2){1.f, 1.f}), ea = u * (-1.5957691216057308f * 1.4426950408889634f);
    f32x2 d; d.x = __builtin_amdgcn_exp2f(ea.x); d.y = __builtin_amdgcn_exp2f(ea.y); d = d + 1.0f; f32x2 r; r.x = __builtin_amdgcn_rcpf(d.x); r.y = __builtin_amdgcn_rcpf(d.y); return y * r; }
__device__ __forceinline__ u32x4 pack8(const f32x4& a, const f32x4& b) { u32x4 w; w.x = cvt_pk_bf16(a[0], a[1]); w.y = cvt_pk_bf16(a[2], a[3]); w.z = cvt_pk_bf16(b[0], b[1]); w.w = cvt_pk_bf16(b[2], b[3]); return w; }
__device__ __forceinline__ float clamp_fp8(float v) { return __builtin_amdgcn_fmed3f(v, -448.0f, 448.0f); }
__device__ __forceinline__ i32x2 pack8_fp8(const f32x4& a, const f32x4& c) {
    int w0 = __builtin_amdgcn_cvt_pk_fp8_f32(clamp_fp8(a[0]), clamp_fp8(a[1]), 0, false); w0 = __builtin_amdgcn_cvt_pk_fp8_f32(clamp_fp8(a[2]), clamp_fp8(a[3]), w0, true);
    int w1 = __builtin_amdgcn_cvt_pk_fp8_f32(clamp_fp8(c[0]), clamp_fp8(c[1]), 0, false); w1 = __builtin_amdgcn_cvt_pk_fp8_f32(clamp_fp8(c[2]), clamp_fp8(c[3]), w1, true);
    return (i32x2){w0, w1};
}

struct EpiQKVU {
    static constexpr bool PERM = true, AFTER_DRAIN = false, PROBE2 = (MK_EPI2V == 2);
    bf16_t* QKV; size_t stride; bf16_t* UA; float scale0;
    __device__ __forceinline__ void operator()(const f32x4 (&acc)[2][2][4][2], const Unit& u, int wr, int wc, int fr, int fq) const {
        const int t = u.pn >> 1, colt = (u.pn & 1) * 256 + wc * 32 + 8 * fq, row0 = u.pm * BM + wr * 64 + fr;
        if (t < 3) {
            bf16_t* base = QKV + (size_t)t * stride; const float sc = (t == 0) ? scale0 : 1.f;
#pragma unroll
            for (int ai = 0; ai < 2; ++ai)
#pragma unroll
                for (int m = 0; m < 4; ++m) { bf16_t* rowp = base + (size_t)(row0 + ai * HALF + m * 16) * 512 + colt;
#pragma unroll
                    for (int bj = 0; bj < 2; ++bj) *(u32x4*)(rowp + bj * HALF) = pack8(acc[ai][bj][m][0] * sc, acc[ai][bj][m][1] * sc); }
        } else {
#pragma unroll
            for (int ai = 0; ai < 2; ++ai)
#pragma unroll
                for (int m = 0; m < 4; ++m) { const int r = row0 + ai * HALF + m * 16, b = r >> 12, tt = r & 4095, chunk = tt >> 4, j = tt & 15;
#pragma unroll
                    for (int bj = 0; bj < 2; ++bj) { const int cu = colt + bj * HALF, g = cu >> 4, c0 = cu & 15;
                        *(u32x4*)(UA + ((size_t)((g * 8 + b) * 256 + chunk)) * 384 + j * 16 + c0) = pack8(acc[ai][bj][m][0], acc[ai][bj][m][1]); } }
        }
    }
};
constexpr int XS = 132;
struct EpiX {
    static constexpr bool PERM = false, AFTER_DRAIN = true, PROBE2 = false, HALF_N = true;
    __device__ __forceinline__ void fused(const f32x4 (&acc)[2][2][4][2], const Unit&, int wr, int wc, int fr, int fq, LAS unsigned char* lds, int, int) const {
        LAS float* X = (LAS float*)lds;
#pragma unroll
        for (int ai = 0; ai < 2; ++ai)
#pragma unroll
            for (int m = 0; m < 4; ++m) { const int row = ai * HALF + wr * 64 + m * 16 + fr;
#pragma unroll
                for (int n = 0; n < 2; ++n) *(LAS f32x4*)(X + row * XS + wc * 32 + n * 16 + 4 * fq) = acc[ai][0][m][n]; }
    }
};
struct EpiY {
    static constexpr bool PERM = true, AFTER_DRAIN = false, PROBE2 = false;
    bf16_t* Z; int g, b;
    __device__ __forceinline__ void operator()(const f32x4 (&acc)[2][2][4][2], const Unit&, int wr, int wc, int fr, int fq) const {
#pragma unroll
        for (int ai = 0; ai < 2; ++ai)
#pragma unroll
            for (int m = 0; m < 4; ++m) { const int chunk = ai * HALF + wr * 64 + m * 16 + fr;
#pragma unroll
                for (int bj = 0; bj < 2; ++bj) { const int col0 = bj * HALF + wc * 32 + 8 * fq, s = col0 >> 4, c0 = col0 & 15;
                    f32x4 v0 = acc[ai][bj][m][0], v1 = acc[ai][bj][m][1];
#pragma unroll
                    for (int q = 0; q < 4; q += 2) { const f32x2 a = gelu_tanh2((f32x2){v0[q], v0[q + 1]}), c = gelu_tanh2((f32x2){v1[q], v1[q + 1]}); v0[q] = a.x; v0[q + 1] = a.y; v1[q] = c.x; v1[q + 1] = c.y; }
                    *(u32x4*)(Z + (size_t)(b * 4096 + chunk * 16 + s) * 512 + g * 16 + c0) = pack8(v0, v1); }
                __builtin_amdgcn_sched_barrier(0); }
    }
};
__device__ __forceinline__ float bf_lo(unsigned w) { return __uint_as_float(w << 16); }
__device__ __forceinline__ float bf_hi(unsigned w) { return __uint_as_float(w & 0xffff0000u); }
struct EpiGLU {
    static constexpr bool PERM = true, AFTER_DRAIN = false, PROBE2 = false;
    const bf16_t* Z; bf16_t* MIX; const float* bias;
    __device__ __forceinline__ void operator()(const f32x4 (&acc)[2][2][4][2], const Unit& u, int wr, int wc, int fr, int fq) const {
        const int row0 = u.pm * BM + wr * 64 + fr, col0 = u.pn * BM + wc * 32 + 8 * fq;
        f32x4 bv[2][2];
#pragma unroll
        for (int bj = 0; bj < 2; ++bj)
#pragma unroll
            for (int n = 0; n < 2; ++n) bv[bj][n] = *(const f32x4*)(bias + col0 + bj * HALF + 4 * n);
#pragma unroll
        for (int ai = 0; ai < 2; ++ai)
        { u32x4 zv[4][2];
#pragma unroll
            for (int m = 0; m < 4; ++m)
#pragma unroll
                for (int bj = 0; bj < 2; ++bj) zv[m][bj] = *(const u32x4*)(Z + (size_t)(row0 + ai * HALF + m * 16) * 512 + col0 + bj * HALF);
#pragma unroll
            for (int m = 0; m < 4; ++m) { const size_t row = (size_t)(row0 + ai * HALF + m * 16);
#pragma unroll
                for (int bj = 0; bj < 2; ++bj) { const int col = col0 + bj * HALF; const u32x4 zz = zv[m][bj];
                    const f32x4 a0 = acc[ai][bj][m][0] + bv[bj][0], a1 = acc[ai][bj][m][1] + bv[bj][1];
                    f32x4 o0, o1;
                    o0[0] = bf_lo(zz.x) * sigm(a0[0]); o0[1] = bf_hi(zz.x) * sigm(a0[1]); o0[2] = bf_lo(zz.y) * sigm(a0[2]); o0[3] = bf_hi(zz.y) * sigm(a0[3]);
                    o1[0] = bf_lo(zz.z) * sigm(a1[0]); o1[1] = bf_hi(zz.z) * sigm(a1[1]); o1[2] = bf_lo(zz.w) * sigm(a1[2]); o1[3] = bf_hi(zz.w) * sigm(a1[3]);
                    *(i32x2*)((unsigned char*)MIX + row * 1024 + 512 + col) = pack8_fp8(o0 * 4.0f, o1 * 4.0f); }
                __builtin_amdgcn_sched_barrier(0); } }
    }
};
struct EpiOut {
    static constexpr bool PERM = true, AFTER_DRAIN = false, PROBE2 = (MK_EPI2V == 5);
    const float* X; bf16_t* X1; const float* g1; LAS unsigned char* stg;
    __device__ __forceinline__ void operator()(const f32x4 (&acc)[2][2][4][2], const Unit& u, int wr, int wc, int fr, int fq) const {
        const int col0 = wc * 32 + 8 * fq, b = (u.pm * BM) >> 12, t = (wr * 4 + wc) * 64 + fq * 16 + fr, rs = t >> 4, ch = t & 15;
        f32x4 gv[2][2];
#pragma unroll
        for (int bj = 0; bj < 2; ++bj)
#pragma unroll
            for (int n = 0; n < 2; ++n) gv[bj][n] = *(const f32x4*)(g1 + (size_t)b * 6144 + u.pn * BM + col0 + bj * HALF + 4 * n) * (1.0f / 128.0f);
        LAS unsigned char* wp = stg + (16 * wr + fr) * 528 + col0 * 2; const LAS unsigned char* rp = stg + rs * 528 + ch * 32;
        const size_t off0 = (size_t)(u.pm * BM + 64 * (rs >> 4) + (rs & 15)) * 1024 + u.pn * BM + 16 * ch;
        f32x4 xv[4], xn[4];
#pragma unroll
        for (int q = 0; q < 4; ++q) xv[q] = *(const f32x4*)(X + off0 + 4 * q);
#pragma unroll
        for (int sidx = 0; sidx < 8; ++sidx) { const int ai = sidx >> 2, m = sidx & 3; const size_t off = off0 + (size_t)(ai * HALF + 16 * m) * 1024;
            if (sidx < 7) { const size_t offn = off0 + (size_t)(((sidx + 1) >> 2) * HALF + 16 * ((sidx + 1) & 3)) * 1024;
#pragma unroll
                for (int q = 0; q < 4; ++q) xn[q] = *(const f32x4*)(X + offn + 4 * q); }
#pragma unroll
            for (int bj = 0; bj < 2; ++bj) *(LAS u32x4*)(wp + bj * 256) = pack8(gv[bj][0] * acc[ai][bj][m][0], gv[bj][1] * acc[ai][bj][m][1]);
            asm volatile("s_waitcnt lgkmcnt(0)" ::: "memory"); __builtin_amdgcn_s_barrier(); asm volatile("" ::: "memory");
            const u32x4 m0 = *(const LAS u32x4*)(rp), m1 = *(const LAS u32x4*)(rp + 16);
            f32x4 o0, o1, o2, o3;
            o0 = xv[0] + (f32x4){bf_lo(m0.x), bf_hi(m0.x), bf_lo(m0.y), bf_hi(m0.y)}; o1 = xv[1] + (f32x4){bf_lo(m0.z), bf_hi(m0.z), bf_lo(m0.w), bf_hi(m0.w)};
            o2 = xv[2] + (f32x4){bf_lo(m1.x), bf_hi(m1.x), bf_lo(m1.y), bf_hi(m1.y)}; o3 = xv[3] + (f32x4){bf_lo(m1.z), bf_hi(m1.z), bf_lo(m1.w), bf_hi(m1.w)};
            *(u32x4*)(X1 + off) = pack8(o0, o1); *(u32x4*)(X1 + off + 8) = pack8(o2, o3);
            asm volatile("s_waitcnt lgkmcnt(0)" ::: "memory"); __builtin_amdgcn_s_barrier(); asm volatile("" ::: "memory");
#pragma unroll
            for (int q = 0; q < 4; ++q) xv[q] = xn[q]; }
    }
};
constexpr float F8_ACT = 4.0f, F8_W = 32.0f, F8_UNDO = 1.0f / (4.0f * 32.0f);
struct EpiMoe1 {
    static constexpr bool PERM = true, AFTER_DRAIN = false, PROBE2 = (MK_EPI2V == 7), BIAS_LDS = true;
    unsigned char* A2; const float* b1; LAS unsigned char* bl; mutable int par = 0;
    __device__ __forceinline__ const float* bias_src(const Unit& u, int wc, int lane16, unsigned& voff) const { voff = (unsigned)(((lane16 >> 3) * 1024 + u.pn * 128 + wc * 32 + (lane16 & 7) * 4) * 4); return b1 + (size_t)u.e * 2048; }
    __device__ __forceinline__ void operator()(const f32x4 (&acc)[2][2][4][2], const Unit& u, int wr, int wc, int fr, int fq) const {
        asm volatile("" : "+v"(fr), "+v"(fq));
        const int row0 = u.pm * BM + wr * 64 + fr, jc = u.pn * 128 + wc * 32 + 8 * fq;
        f32x4 bg[2], bu[2];
#pragma unroll
        for (int n = 0; n < 2; ++n) { const LAS unsigned char* bp = bl + par * 2048 + (wr * 4 + wc) * 256 + fq * 32 + n * 16; bg[n] = *(const LAS f32x4*)(bp); bu[n] = *(const LAS f32x4*)(bp + 128); }
#pragma unroll
        for (int ai = 0; ai < 2; ++ai)
#pragma unroll
            for (int m = 0; m < 4; ++m) { f32x4 o[2];
#pragma unroll
                for (int n = 0; n < 2; ++n) {
#pragma unroll
                    for (int hq = 0; hq < 2; ++hq) { const f32x2 ag = {acc[ai][0][m][n][2 * hq], acc[ai][0][m][n][2 * hq + 1]}, au = {acc[ai][1][m][n][2 * hq], acc[ai][1][m][n][2 * hq + 1]};
                        const f32x2 vbg = {bg[n][2 * hq], bg[n][2 * hq + 1]}, vbu = {bu[n][2 * hq], bu[n][2 * hq + 1]}, k7 = {7.0f, 7.0f}, km7 = {-7.0f, -7.0f}, kund = {F8_UNDO, F8_UNDO};
                        const f32x2 g = __builtin_elementwise_min(__builtin_elementwise_fma(ag, kund, vbg), k7), uu = __builtin_elementwise_min(__builtin_elementwise_max(__builtin_elementwise_fma(au, kund, vbu), km7), k7);
                        const f32x2 ea = g * (-1.702f * 1.4426950408889634f); f32x2 den; den.x = __builtin_amdgcn_exp2f(ea.x); den.y = __builtin_amdgcn_exp2f(ea.y); den = den + 1.0f;
                        f32x2 sg; sg.x = __builtin_amdgcn_rcpf(den.x); sg.y = __builtin_amdgcn_rcpf(den.y);
                        const f32x2 r = __builtin_elementwise_fma(uu, (f32x2){F8_ACT, F8_ACT}, (f32x2){F8_ACT, F8_ACT}) * (g * sg); o[n][2 * hq] = r.x; o[n][2 * hq + 1] = r.y; } }
                *(i32x2*)(A2 + (size_t)(row0 + ai * HALF + m * 16) * 1024 + jc) = pack8_fp8(o[0], o[1]);
                __builtin_amdgcn_sched_barrier(0); }
    }
};
struct EpiMoe2 {
    static constexpr bool PERM = true, AFTER_DRAIN = false, PROBE2 = (MK_EPI2V == 8), BIAS_LDS = true;
    unsigned char* Y2; const float* b2; int pm_mask; LAS unsigned char* bl; mutable int par = 0;
    __device__ __forceinline__ const float* bias_src(const Unit& u, int wc, int lane16, unsigned& voff) const { voff = (unsigned)((u.pn * BM + (lane16 >> 3) * HALF + wc * 32 + (lane16 & 7) * 4) * 4); return b2 + (size_t)u.e * 1024; }
    __device__ __forceinline__ void operator()(const f32x4 (&acc)[2][2][4][2], const Unit& u, int wr, int wc, int fr, int fq) const {
        asm volatile("" : "+v"(fr), "+v"(fq));
        const int row0 = (u.pm & pm_mask) * BM + wr * 64 + fr, col0 = u.pn * BM + wc * 32 + 8 * fq;
        f32x4 bv[2][2];
#pragma unroll
        for (int bj = 0; bj < 2; ++bj)
#pragma unroll
            for (int n = 0; n < 2; ++n) bv[bj][n] = *(const LAS f32x4*)(bl + par * 2048 + (wr * 4 + wc) * 256 + bj * 128 + fq * 32 + n * 16);
#pragma unroll
        for (int ai = 0; ai < 2; ++ai)
#pragma unroll
            for (int m = 0; m < 4; ++m) { unsigned char* rowp = Y2 + (size_t)(row0 + ai * HALF + m * 16) * 1024 + col0;
#pragma unroll
                for (int bj = 0; bj < 2; ++bj) *(i32x2*)(rowp + bj * HALF) = pack8_fp8((acc[ai][bj][m][0] * F8_UNDO + bv[bj][0]) * 8.0f, (acc[ai][bj][m][1] * F8_UNDO + bv[bj][1]) * 8.0f); }
    }
};

template <class E, class = void> struct epi_bias_lds { static constexpr bool value = false; };
template <class E> struct epi_bias_lds<E, decltype((void)E::BIAS_LDS)> { static constexpr bool value = E::BIAS_LDS; };
template <class E, class = void> struct epi_half_n { static constexpr bool value = false; };
template <class E> struct epi_half_n<E, decltype((void)E::HALF_N)> { static constexpr bool value = E::HALF_N; };
template <class Epi, class Sched, bool ALIGN_EPI, bool GATHER, bool F8 = false>
__device__ __forceinline__ void gemm_phase(LAS unsigned char* lds, const Gemm g, const Sched& S, const Epi& E, const int wave) {
    const int tid = wave * 64 + lane_id_opaque(), wid = __builtin_amdgcn_readfirstlane(tid >> 6), lane = tid & 63,
              wr = wid >> 2, wc = wid & 3, fr = lane & 15, fq = lane >> 4;
    const int nt = g.K / BK; constexpr bool HN = epi_half_n<Epi>::value; constexpr bool BL = epi_bias_lds<Epi>::value;
    unsigned voffB[2], vA[2][2];
#pragma unroll
    for (int i = 0; i < 2; ++i) { int R, C; stage_rc(tid * 16 + i * 8192, R, C); const int Rb = Epi::PERM ? ((R & ~31) + perm32(R & 31)) : R;
        voffB[i] = (unsigned)(Rb * g.ldb + C) * 2u;
#pragma unroll
        for (int h = 0; h < 2; ++h) vA[h][i] = (unsigned)((R + h * HALF) * g.lda + C) * 2u; }
    const size_t kstep = (size_t)(BK * 2);
    const size_t hstepB = (size_t)HALF * g.ldb * 2;
    const unsigned ldsw = (unsigned)wid * 1024u;
    const unsigned ldsbase = (unsigned)__builtin_amdgcn_readfirstlane((int)((unsigned)(uintptr_t)lds + ldsw));
    const int aoff = lds_byte(wr * 64 + fr, fq * 8), boff = lds_byte(wc * 32 + fr, fq * 8);
#define PG8_SA(b, h) (((b) * 2 + (h)) * HTB)
#define PG8_SB(b, h) ((4 + (b) * 2 + (h)) * HTB)
#define PG8_STAGE(bufoff, gbase, voff) do { if constexpr (F8) { _Pragma("unroll") for (int _i = 0; _i < 2; ++_i) { unsigned keep_; \
            asm volatile("s_mov_b32 %0, m0\n\ts_mov_b32 m0, %3\n\ts_nop 0\n\tglobal_load_lds_dwordx4 %1, %2\n\ts_mov_b32 m0, %0" : "=&s"(keep_) : "v"((voff)[_i]), "s"((const char*)(gbase)), "s"(ldsbase + (unsigned)((bufoff) + _i * 8192)) : "memory"); } } \
        else { _Pragma("unroll") for (int _i = 0; _i < 2; ++_i) \
        __builtin_amdgcn_global_load_lds((const unsigned*)((const char*)(gbase) + (voff)[_i]), (LAS unsigned*)(lds + (bufoff) + ldsw + _i * 8192), 16, 0, 0); } } while (0)
#define PG8_LDA(dst, b, h) do { if constexpr (F8) { _Pragma("unroll") for (int m = 0; m < 4; ++m) dst##8[m] = PG8_F8CAT(*(const LAS bf16x8*)(lds + PG8_SA(b, h) + aoff + m * 2048), *(const LAS bf16x8*)(lds + PG8_SA(b, h) + aoff + m * 2048 + 1024)); } \
        else { _Pragma("unroll") for (int m = 0; m < 4; ++m) _Pragma("unroll") for (int k = 0; k < 2; ++k) dst[m][k] = *(const LAS bf16x8*)(lds + PG8_SA(b, h) + aoff + m * 2048 + k * 1024); } } while (0)
#define PG8_LDB(dst, b, h) do { if constexpr (F8) { _Pragma("unroll") for (int n = 0; n < 2; ++n) dst##8[n] = PG8_F8CAT(*(const LAS bf16x8*)(lds + PG8_SB(b, h) + boff + n * 2048), *(const LAS bf16x8*)(lds + PG8_SB(b, h) + boff + n * 2048 + 1024)); } \
        else { _Pragma("unroll") for (int n = 0; n < 2; ++n) _Pragma("unroll") for (int k = 0; k < 2; ++k) dst[n][k] = *(const LAS bf16x8*)(lds + PG8_SB(b, h) + boff + n * 2048 + k * 1024); } } while (0)
#define PG8_F8CAT(lo, hi) __builtin_shufflevector(__builtin_bit_cast(i32x4, (lo)), __builtin_bit_cast(i32x4, (hi)), 0, 1, 2, 3, 4, 5, 6, 7)
#define PG8_MMA(ai, bj, At, Bt) do { __builtin_amdgcn_s_setprio(1); \
        if constexpr (F8) { _Pragma("unroll") for (int m = 0; m < 4; ++m) _Pragma("unroll") for (int n = 0; n < 2; ++n) \
            acc[ai][bj][m][n] = __builtin_amdgcn_mfma_scale_f32_16x16x128_f8f6f4(Bt##8[n], At##8[m], acc[ai][bj][m][n], 0, 0, 0, 0x7F7F7F7F, 0, 0x7F7F7F7F); } \
        else { _Pragma("unroll") for (int m = 0; m < 4; ++m) _Pragma("unroll") for (int n = 0; n < 2; ++n) _Pragma("unroll") for (int k = 0; k < 2; ++k) \
            acc[ai][bj][m][n] = __builtin_amdgcn_mfma_f32_16x16x32_bf16(Bt[n][k], At[m][k], acc[ai][bj][m][n], 0, 0, 0); } \
        __builtin_amdgcn_s_setprio(0); } while (0)
#define PG8_WAIT_V(n) asm volatile("s_waitcnt vmcnt(" #n ")" ::: "memory")
#define PG8_WAIT_L(n) asm volatile("s_waitcnt lgkmcnt(" #n ")" ::: "memory")
#define PG8_BAR __builtin_amdgcn_s_barrier()
#define PG8_SCHED __builtin_amdgcn_sched_barrier(0)
#define PG8_GOFF(u_, h, i) ({ const int tq_ = wid * 64 + lane_id_opaque(); int R_, C_; stage_rc(tq_ * 16 + (i) * 8192, R_, C_); S.rowoff((u_), (h) * HALF + R_) + (unsigned)C_ * 2u; })
    Unit cur, nxt; int ui = 0;
    if (!S.next(0, cur)) return;
#define PG8_BIAS_DMA(u_, par_) do { const int tl_ = lane_id_opaque(); unsigned bvo_; const float* bsrc0_ = E.bias_src((u_), wc, tl_ & 15, bvo_); \
        const uintptr_t bq_ = (uintptr_t)bsrc0_; const char* bsrc_ = (const char*)(((uintptr_t)(unsigned)__builtin_amdgcn_readfirstlane((int)(unsigned)(bq_ >> 32)) << 32) | (uintptr_t)(unsigned)__builtin_amdgcn_readfirstlane((int)(unsigned)bq_)); \
        const unsigned bdst_ = (unsigned)__builtin_amdgcn_readfirstlane((int)((unsigned)(uintptr_t)E.bl + (unsigned)(par_) * 2048u + (unsigned)wid * 256u)); \
        if (tl_ < 16) { unsigned keep_; \
            asm volatile("s_mov_b32 %0, m0\n\ts_mov_b32 m0, %3\n\ts_nop 0\n\tglobal_load_lds_dwordx4 %1, %2\n\ts_mov_b32 m0, %0" : "=&s"(keep_) : "v"(bvo_), "s"(bsrc_), "s"(bdst_) : "memory"); } } while (0)
    if constexpr (BL) PG8_BIAS_DMA(cur, 0);
    if constexpr (GATHER) {
#pragma unroll
        for (int h = 0; h < 2; ++h)
#pragma unroll
            for (int i = 0; i < 2; ++i) vA[h][i] = PG8_GOFF(0, h, i);
    }
    f32x4 acc[2][2][4][2];
#pragma unroll
    for (int a = 0; a < 2; ++a)
#pragma unroll
        for (int b = 0; b < 2; ++b)
#pragma unroll
            for (int m = 0; m < 4; ++m)
#pragma unroll
                for (int n = 0; n < 2; ++n) acc[a][b][m][n] = (f32x4){0.f, 0.f, 0.f, 0.f};
    bf16x8 At[4][2], B0[2][2], B1[2][2]; i32x8 At8[4], B08[2], B18[2];
    const char* cA = (const char*)g.A + S.aoff(cur); const char* cB = (const char*)g.Bt + S.boff(cur);
    PG8_STAGE(PG8_SB(0, 0), cB, voffB); PG8_STAGE(PG8_SB(0, 1), cB + hstepB, voffB); PG8_STAGE(PG8_SA(0, 0), cA, vA[0]); PG8_STAGE(PG8_SA(0, 1), cA, vA[1]);
    if (wr == 1) PG8_BAR;
    PG8_WAIT_V(2); PG8_BAR;
    PG8_STAGE(PG8_SB(1, 0), cB + kstep, voffB); PG8_STAGE(PG8_SA(1, 0), cA + kstep, vA[0]); PG8_STAGE(PG8_SB(1, 1), cB + hstepB + kstep, voffB);
    PG8_WAIT_V(6); PG8_BAR;
    for (;;) {
        const bool has_next = S.next(ui + 1, nxt);
        const char* nA = has_next ? (const char*)g.A + S.aoff(nxt) : cA; const char* nB = has_next ? (const char*)g.Bt + S.boff(nxt) : cB;
#pragma unroll 1
        for (int t = 0; t < nt; t += 2) {
            const bool last = (t == nt - 2);
            const char* a1 = cA + (size_t)(t + 1) * kstep;
            const char* a2 = last ? nA : cA + (size_t)(t + 2) * kstep; const char* b2 = last ? nB : cB + (size_t)(t + 2) * kstep;
            const char* a3 = a2 + kstep; const char* b3 = b2 + kstep;
            unsigned w0[2], w1[2];
            if constexpr (GATHER) { const bool nx_ = last && has_next;
                if (nx_) { w0[0] = PG8_GOFF(ui + 1, 0, 0); w0[1] = PG8_GOFF(ui + 1, 0, 1); w1[0] = PG8_GOFF(ui + 1, 1, 0); w1[1] = PG8_GOFF(ui + 1, 1, 1); }
                else { w0[0] = vA[0][0]; w0[1] = vA[0][1]; w1[0] = vA[1][0]; w1[1] = vA[1][1]; } }
            else { w0[0] = vA[0][0]; w0[1] = vA[0][1]; w1[0] = vA[1][0]; w1[1] = vA[1][1]; }
            PG8_LDB(B0, 0, 0); if constexpr (!HN) PG8_LDB(B1, 0, 1); PG8_SCHED; PG8_LDA(At, 0, 0); PG8_STAGE(PG8_SA(1, 1), a1, vA[1]);
            PG8_WAIT_V(8); PG8_WAIT_L(0); PG8_BAR; PG8_MMA(0, 0, At, B0); if constexpr (!HN) PG8_MMA(0, 1, At, B1); PG8_BAR; PG8_SCHED;
            PG8_LDA(At, 0, 1); PG8_STAGE(PG8_SB(0, 0), b2, voffB); PG8_STAGE(PG8_SB(0, 1), b2 + hstepB, voffB); PG8_STAGE(PG8_SA(0, 0), a2, w0);
            PG8_WAIT_V(8); PG8_WAIT_L(0); PG8_BAR; PG8_MMA(1, 0, At, B0); if constexpr (!HN) PG8_MMA(1, 1, At, B1); PG8_BAR; PG8_SCHED;
            PG8_LDB(B0, 1, 0); if constexpr (!HN) PG8_LDB(B1, 1, 1); PG8_SCHED; PG8_LDA(At, 1, 0); PG8_STAGE(PG8_SA(0, 1), a2, w1);
            PG8_WAIT_V(8); PG8_WAIT_L(0); PG8_BAR; PG8_MMA(0, 0, At, B0); if constexpr (!HN) PG8_MMA(0, 1, At, B1); PG8_BAR; PG8_SCHED;
            PG8_LDA(At, 1, 1); PG8_STAGE(PG8_SB(1, 0), b3, voffB); PG8_STAGE(PG8_SB(1, 1), b3 + hstepB, voffB); PG8_STAGE(PG8_SA(1, 0), a3, w0);
            PG8_WAIT_V(8); PG8_WAIT_L(0); PG8_BAR; PG8_MMA(1, 0, At, B0); if constexpr (!HN) PG8_MMA(1, 1, At, B1); PG8_BAR; PG8_SCHED;
        }
        if constexpr (ALIGN_EPI) { if (wr == 0) PG8_BAR; }
        if constexpr (BL) { if (has_next) PG8_BIAS_DMA(nxt, (ui + 1) & 1); }
        if constexpr (!Epi::AFTER_DRAIN) { const int te_ = lane_id_opaque(); const int fre = te_ & 15, fqe = (te_ >> 4) & 3;
            if constexpr (BL) E.par = ui & 1;
            E(acc, cur, wr, wc, fre, fqe);
#ifdef MK_EPI2
            if constexpr (Epi::PROBE2) { asm volatile("" ::: "memory"); E(acc, cur, wr, wc, fr, fq); }
#endif
        }
        if (!has_next) break;
#pragma unroll
        for (int a = 0; a < 2; ++a)
#pragma unroll
            for (int b = 0; b < 2; ++b)
#pragma unroll
                for (int m = 0; m < 4; ++m)
#pragma unroll
                    for (int n = 0; n < 2; ++n) acc[a][b][m][n] = (f32x4){0.f, 0.f, 0.f, 0.f};
        cur = nxt; cA = nA; cB = nB; ++ui;
        if constexpr (GATHER) {
#pragma unroll
            for (int h = 0; h < 2; ++h)
#pragma unroll
                for (int i = 0; i < 2; ++i) vA[h][i] = PG8_GOFF(ui, h, i);
        }
        if constexpr (ALIGN_EPI) { if (wr == 1) PG8_BAR; }
    }
    PG8_WAIT_V(0);
    if constexpr (!ALIGN_EPI) { if (wr == 0) PG8_BAR; }
    PG8_BAR;
    if constexpr (Epi::AFTER_DRAIN) { E.fused(acc, cur, wr, wc, fr, fq, lds, wid, lane); }
#undef PG8_BIAS_DMA
#undef PG8_SA
#undef PG8_SB
#undef PG8_STAGE
#undef PG8_LDA
#undef PG8_LDB
#undef PG8_MMA
#undef PG8_GOFF
#undef PG8_F8CAT
#undef PG8_WAIT_V
#undef PG8_WAIT_L
#undef PG8_BAR
#undef PG8_SCHED
}
}

namespace attn_body {
using bf16=__hip_bfloat16;
using bf16x8=__attribute__((ext_vector_type(8)))short;
using s16x4=__attribute__((ext_vector_type(4)))short;
using f32x16=__attribute__((ext_vector_type(16)))float;
using u32x4=__attribute__((ext_vector_type(4)))unsigned;
constexpr int SEQ=4096,D=64,DMI=512,DMO=1024;
constexpr int NW=8,QBLK=32,QB=QBLK*NW,KVBLK=64,NQB=SEQ/QB;
__device__ __forceinline__ int crow(int r,int hi){return (r&3)+8*(r>>2)+4*hi;}
#define SBAR() __builtin_amdgcn_sched_barrier(0)
__device__ __forceinline__ void cmask(f32x16&p0,f32x16&p1,int jb,int qrel,int hi){
  const float NEG=-INFINITY; int kb=64*jb+4*hi;
  #pragma unroll
  for(int r=0;r<16;++r){int kv=kb+(r&3)+8*(r>>2); if(kv>qrel)p0[r]=NEG; if(kv+32>qrel)p1[r]=NEG;}
}
constexpr int NSLOT=3, SLOTB=8192;
constexpr int LDS_K=0, LDS_V=NSLOT*SLOTB, LDS_WS=2*NSLOT*SLOTB, LDS_OST=LDS_WS+NW*64*4, LDS_BYTES=LDS_OST+NW*4096;
constexpr float C2=0.125f*1.4426950408889634f;
__device__ __forceinline__ void glds16(const void*gsrc,unsigned lds_dst){unsigned keep;
  asm volatile("s_mov_b32 %0, m0\n\ts_mov_b32 m0, %2\n\ts_nop 0\n\tglobal_load_lds_dwordx4 %1, off\n\ts_mov_b32 m0, %0":"=&s"(keep):"v"(gsrc),"s"(lds_dst):"memory");}
__device__ __forceinline__ float max3f(float a,float b,float c){float r;asm("v_max3_f32 %0, %1, %2, %3":"=v"(r):"v"(a),"v"(b),"v"(c));return r;}
__device__ __forceinline__ float max2f(float a,float b){float r;asm("v_max_f32_e32 %0, %1, %2":"=v"(r):"v"(a),"v"(b));return r;}
__device__ __forceinline__ float fadd_s(float a,float b){float r;asm("v_add_f32_e32 %0, %1, %2":"=v"(r):"v"(a),"v"(b));return r;}
__device__ __forceinline__ float fsub_s(float a,float b){float r;asm("v_sub_f32_e32 %0, %1, %2":"=v"(r):"v"(a),"v"(b));return r;}
typedef float f32x2_t __attribute__((ext_vector_type(2))); typedef __bf16 bf16x2_t __attribute__((ext_vector_type(2)));
__device__ __forceinline__ unsigned cvtpk_s(float lo,float hi){f32x2_t v={lo,hi};bf16x2_t b=__builtin_convertvector(v,bf16x2_t);return __builtin_bit_cast(unsigned,b);}
#define WAIT_BAR(N) asm volatile("s_waitcnt vmcnt(" #N ") lgkmcnt(0)\n\ts_barrier":::"memory")

__device__ __forceinline__ void qkt(f32x16&p0,f32x16&p1,const char*Kslot,const bf16x8*qr,const f32x16&negm,int r32,int hi){
  const char*kb=Kslot+hi*1024+r32*16;
  #pragma unroll
  for(int d0=0;d0<4;++d0){
    const bf16x8 b0=*reinterpret_cast<const bf16x8*>(kb+d0*2048);
    const bf16x8 b1=*reinterpret_cast<const bf16x8*>(kb+d0*2048+512);
    if(d0==0){p0=__builtin_amdgcn_mfma_f32_32x32x16_bf16(b0,qr[0],negm,0,0,0);p1=__builtin_amdgcn_mfma_f32_32x32x16_bf16(b1,qr[0],negm,0,0,0);}
    else{p0=__builtin_amdgcn_mfma_f32_32x32x16_bf16(b0,qr[d0],p0,0,0,0);p1=__builtin_amdgcn_mfma_f32_32x32x16_bf16(b1,qr[d0],p1,0,0,0);}}
}
typedef __attribute__((address_space(3))) const char* lds_cptr;
typedef short v4i16_t __attribute__((ext_vector_type(4)));
__device__ __forceinline__ void kload8(bf16x8*kf,lds_cptr kp){
  kf[0]=*(const __attribute__((address_space(3))) bf16x8*)(kp);      kf[1]=*(const __attribute__((address_space(3))) bf16x8*)(kp+512);
  kf[2]=*(const __attribute__((address_space(3))) bf16x8*)(kp+2048); kf[3]=*(const __attribute__((address_space(3))) bf16x8*)(kp+2560);
  kf[4]=*(const __attribute__((address_space(3))) bf16x8*)(kp+4096); kf[5]=*(const __attribute__((address_space(3))) bf16x8*)(kp+4608);
  kf[6]=*(const __attribute__((address_space(3))) bf16x8*)(kp+6144); kf[7]=*(const __attribute__((address_space(3))) bf16x8*)(kp+6656);
}
__device__ __forceinline__ void kload2(bf16x8*kf,lds_cptr kp,int j){ kf[2*j]=*(const __attribute__((address_space(3))) bf16x8*)(kp+j*2048); kf[2*j+1]=*(const __attribute__((address_space(3))) bf16x8*)(kp+j*2048+512); }
__device__ __forceinline__ s16x4 vtr(lds_cptr p){ return __builtin_bit_cast(s16x4,__builtin_amdgcn_ds_read_tr16_b64_v4i16((__attribute__((address_space(3))) v4i16_t*)p)); }
__device__ __forceinline__ float rowmax(const f32x16&p0,const f32x16&p1){
  float a=max3f(p0[0],p0[1],p1[0]),b=max3f(p0[2],p0[3],p1[1]);a=max3f(a,p1[2],p1[3]);
  #pragma unroll
  for(int r=4;r<16;r+=4){a=max3f(a,p0[r],p0[r+1]);b=max3f(b,p0[r+2],p0[r+3]);a=max3f(a,p1[r],p1[r+1]);b=max3f(b,p1[r+2],p1[r+3]);}
  const float m=max2f(a,b);
  auto rr=__builtin_amdgcn_permlane32_swap(__float_as_uint(m),__float_as_uint(m),false,false);
  return max2f(__uint_as_float(rr[0]),__uint_as_float(rr[1]));
}
__device__ __forceinline__ void pv(f32x16*o,int vb,bf16x8 pa0,bf16x8 pa1,bf16x8 pa2,bf16x8 pa3){
  #pragma unroll
  for(int d0=0;d0<2;++d0){s16x4 lo[4],hi[4];
    #pragma unroll
    for(int ks=0;ks<4;++ks){
      asm volatile("ds_read_b64_tr_b16 %0,%1 offset:%c2":"=&v"(lo[ks]):"v"(vb),"i"(d0*4096+ks*1024):"memory");
      asm volatile("ds_read_b64_tr_b16 %0,%1 offset:%c2":"=&v"(hi[ks]):"v"(vb),"i"(d0*4096+ks*1024+512):"memory");}
    asm volatile("s_waitcnt lgkmcnt(0)":::"memory");SBAR();
    #define PK(k) (bf16x8){lo[k][0],lo[k][1],lo[k][2],lo[k][3],hi[k][0],hi[k][1],hi[k][2],hi[k][3]}
    o[d0]=__builtin_amdgcn_mfma_f32_32x32x16_bf16(pa0,PK(0),o[d0],0,0,0);
    o[d0]=__builtin_amdgcn_mfma_f32_32x32x16_bf16(pa1,PK(1),o[d0],0,0,0);
    o[d0]=__builtin_amdgcn_mfma_f32_32x32x16_bf16(pa2,PK(2),o[d0],0,0,0);
    o[d0]=__builtin_amdgcn_mfma_f32_32x32x16_bf16(pa3,PK(3),o[d0],0,0,0);
    #undef PK
  }
}
#define ATTN_STORE16(p,v) (*(u32x4*)(p)=(v))
template<int THRL> __device__ __forceinline__ void attn_unit(int qb,const bf16*Qh,const bf16*__restrict__ Kh,const bf16*__restrict__ Vh,bf16*Oh,char*shm){
  int tid_=threadIdx.x; asm volatile("":"+v"(tid_));
  const int tid=tid_,lane=tid&63,r32=lane&31,hi=lane>>5; const int wid=__builtin_amdgcn_readfirstlane(tid>>6);
  const int q0=qb*QB;
  const bf16*Qw=Qh+(long)(q0+wid*QBLK)*DMI;
  const unsigned lds0=(unsigned)(uintptr_t)shm;
  float*wsf=(float*)(shm+LDS_WS)+wid*64;
  const bf16*ksrc=Kh+(long)lane*DMI+wid*8;
  const bf16*vsrc=Vh+(long)(16*(wid&3)+(lane>>2))*DMI+(wid>>2)*32+(lane&3)*8;
  const unsigned kdst=lds0+LDS_K+wid*1024, vdst=lds0+LDS_V+wid*1024;
  #define DMA_K(t,slot) glds16(ksrc+(long)(t)*KVBLK*DMI,(unsigned)__builtin_amdgcn_readfirstlane(kdst+(slot)))
  #define DMA_V(t,slot) glds16(vsrc+(long)(t)*KVBLK*DMI,(unsigned)__builtin_amdgcn_readfirstlane(vdst+(slot)))
  const int vb0=(int)(lds0+LDS_V)+((lane>>4)&1)*32+(lane&3)*8+(4*hi+((lane&15)>>2))*64;
  const char*Kbase=shm+LDS_K; bf16x8 kf[8];
  const lds_cptr shm3=(lds_cptr)shm; const lds_cptr kp0=shm3+LDS_K+hi*1024+r32*16; const lds_cptr vp0=shm3+LDS_V+((lane>>4)&1)*32+(lane&3)*8+(4*hi+((lane&15)>>2))*64;
  const int NT=(q0+QB)/KVBLK;
  DMA_K(0,0);DMA_V(0,0);DMA_K(1,SLOTB);
  bf16x8 qr[4];
  #pragma unroll
  for(int d0=0;d0<4;++d0)qr[d0]=*reinterpret_cast<const bf16x8*>(&Qw[(long)r32*DMI+d0*16+hi*8]);
  float mhat=0.f,l_reg=0.f;f32x16 o[2];o[0]=f32x16{};o[1]=f32x16{};f32x16 negm=f32x16{};asm volatile("":"+v"(negm));
  const int qrel=wid*QBLK+r32;
  #define CMASK(P0,P1,t) do{int jb_=(t)-(NT-4); if(jb_>=0)cmask(P0,P1,jb_,qrel,hi);}while(0)
  bool resc=false;
  #define START(P0,P1) do{ const float rm=rowmax(P0,P1); resc=false; \
    { const float dl=rm; mhat=fadd_s(mhat,dl); \
      _Pragma("unroll") for(int r=0;r<16;++r){P0[r]=fsub_s(P0[r],dl);P1[r]=fsub_s(P1[r],dl);} \
      _Pragma("unroll") for(int r=0;r<16;++r)negm[r]=-mhat; asm volatile("":"+v"(negm)); } \
    _Pragma("unroll") for(int r=0;r<16;++r)P0[r]=__builtin_amdgcn_exp2f(P0[r]); }while(0)
  #define RESC() do{ if(resc){ asm volatile("s_waitcnt lgkmcnt(0)":::"memory"); \
      _Pragma("unroll") for(int d_=0;d_<2;++d_) _Pragma("unroll") for(int r=0;r<16;++r)o[d_][r]*=wsf[crow(r,hi)]; } }while(0)
  f32x16 pA0,pA1,pB0,pB1;
  int sl_prev=0,sl_cur=0,sl_next=SLOTB;
  #define ROT() do{sl_prev=sl_cur;sl_cur=sl_next;sl_next=(sl_next==(NSLOT-1)*SLOTB)?0:sl_next+SLOTB;}while(0)
  DMA_K(2,2*SLOTB);
  WAIT_BAR(3);
  qkt(pA0,pA1,Kbase,qr,negm,r32,hi);asm volatile("s_nop 15\n\ts_nop 7":"+v"(pA0),"+v"(pA1));CMASK(pA0,pA1,0);
  START(pA0,pA1);
  _Pragma("unroll") for(int r=0;r<16;++r)pA1[r]=__builtin_amdgcn_exp2f(pA1[r]);
  WAIT_BAR(0);
  DMA_K(3,0);DMA_V(1,SLOTB);
  ROT();
  kload8(kf,kp0+sl_cur);
  WAIT_BAR(2);
  s16x4 vlo[8],vhi[8]; u32x4 pw0,pw1,pw2,pw3;
  #define PKW(P,B) cvtpk_s(P[B],P[B+1])
  #define PAF(k) __builtin_bit_cast(bf16x8,pw##k)
  #define VFR(i) (bf16x8){vlo[i][0],vlo[i][1],vlo[i][2],vlo[i][3],vhi[i][0],vhi[i][1],vhi[i][2],vhi[i][3]}
  #define PIN(x) asm volatile("":"+v"(x))
  #define MX3(a,b,c) __builtin_fmaxf(__builtin_fmaxf((a),(b)),(c))
  #define GAPA(MF,A0,A1,A2,A3,W0,W1,PW) do{ MF; sacc+=A0; sacc+=A1; sacc+=A2; sacc+=A3; PIN(sacc); W0; W1; PIN(PW); SBAR(); }while(0)
  #define EX(v) __builtin_amdgcn_exp2f(v)
  #define GAPB(MF,X,B) do{ MF; X[B]=EX(X[B]); X[B+1]=EX(X[B+1]); X[B+2]=EX(X[B+2]); X[B+3]=EX(X[B+3]); PIN(X); SBAR(); }while(0)
  #define VRD(i) do{ vlo[i]=vtr(vp_+(((i)>>2)*4096+((i)&3)*1024)); vhi[i]=vtr(vp_+(((i)>>2)*4096+((i)&3)*1024+512)); }while(0)
  #define KRD(G,j) do{ if(G){ kload2(kf,kp0+sl_next,j); SBAR(); } }while(0)
  #define STEP(C0,C1,P0,P1,t,GK,GV,GL) do{ SBAR(); \
    const lds_cptr vp_=vp0+sl_prev; \
    VRD(0); SBAR(); float sacc=(P0[0]+P0[1]); \
    GAPA(C0=__builtin_amdgcn_mfma_f32_32x32x16_bf16(kf[0],qr[0],negm,0,0,0), P0[2],P0[3],P0[4],P0[5],     pw0[0]=PKW(P0,0), pw0[1]=PKW(P0,2), pw0); \
    VRD(4); SBAR(); GAPA(C1=__builtin_amdgcn_mfma_f32_32x32x16_bf16(kf[1],qr[0],negm,0,0,0), P0[6],P0[7],P0[8],P0[9],     pw0[2]=PKW(P0,4), pw0[3]=PKW(P0,6), pw0); \
    VRD(1); SBAR(); GAPA(C0=__builtin_amdgcn_mfma_f32_32x32x16_bf16(kf[2],qr[1],C0,0,0,0),   P0[10],P0[11],P0[12],P0[13], pw1[0]=PKW(P0,8), pw1[1]=PKW(P0,10), pw1); \
    VRD(5); SBAR(); GAPA(C1=__builtin_amdgcn_mfma_f32_32x32x16_bf16(kf[3],qr[1],C1,0,0,0),   P0[14],P0[15],P1[0],P1[1],   pw1[2]=PKW(P0,12),pw1[3]=PKW(P0,14), pw1); \
    VRD(2); SBAR(); GAPA(C0=__builtin_amdgcn_mfma_f32_32x32x16_bf16(kf[4],qr[2],C0,0,0,0),   P1[2],P1[3],P1[4],P1[5],     pw2[0]=PKW(P1,0), pw2[1]=PKW(P1,2), pw2); \
    VRD(6); SBAR(); GAPA(C1=__builtin_amdgcn_mfma_f32_32x32x16_bf16(kf[5],qr[2],C1,0,0,0),   P1[6],P1[7],P1[8],P1[9],     pw2[2]=PKW(P1,4), pw2[3]=PKW(P1,6), pw2); \
    VRD(3); SBAR(); GAPA(C0=__builtin_amdgcn_mfma_f32_32x32x16_bf16(kf[6],qr[3],C0,0,0,0),   P1[10],P1[11],P1[12],P1[13], pw3[0]=PKW(P1,8), pw3[1]=PKW(P1,10), pw3); \
    VRD(7); SBAR(); GAPA(C1=__builtin_amdgcn_mfma_f32_32x32x16_bf16(kf[7],qr[3],C1,0,0,0),   P1[14],P1[15],0.f,0.f,       pw3[2]=PKW(P1,12),pw3[3]=PKW(P1,14), pw3); \
    l_reg+=sacc; \
    if(GK){DMA_K((t)+3,sl_cur);} if(GV){DMA_V((t)+1,sl_next);} \
    CMASK(C0,C1,t); \
    { float a=MX3(C0[0],C0[1],C1[0]),b=MX3(C0[2],C0[3],C1[1]); a=MX3(a,C1[2],C1[3]); \
      _Pragma("unroll") for(int r=4;r<16;r+=4){a=MX3(a,C0[r],C0[r+1]);b=MX3(b,C0[r+2],C0[r+3]);a=MX3(a,C1[r],C1[r+1]);b=MX3(b,C1[r+2],C1[r+3]);} \
      float rm=__builtin_fmaxf(a,b); { auto rr=__builtin_amdgcn_permlane32_swap(__float_as_uint(rm),__float_as_uint(rm),false,false); rm=__builtin_fmaxf(__uint_as_float(rr[0]),__uint_as_float(rr[1])); } \
      resc=false; \
      if(__builtin_expect(__any(rm>(float)THRL),0)){ const float dl=__builtin_fmaxf(rm,0.f); mhat+=dl; \
        _Pragma("unroll") for(int r=0;r<16;++r){C0[r]-=dl;C1[r]-=dl;} \
        _Pragma("unroll") for(int r=0;r<16;++r)negm[r]=-mhat; asm volatile("":"+v"(negm)); \
        const float f=__builtin_amdgcn_exp2f(-dl); l_reg*=f; if(hi==0)wsf[r32]=f; resc=true; } } \
    SBAR(); \
    GAPB(o[0]=__builtin_amdgcn_mfma_f32_32x32x16_bf16(PAF(0),VFR(0),o[0],0,0,0), C0,0); \
    GAPB(o[1]=__builtin_amdgcn_mfma_f32_32x32x16_bf16(PAF(0),VFR(4),o[1],0,0,0), C0,4); \
    KRD(GL,0); GAPB(o[0]=__builtin_amdgcn_mfma_f32_32x32x16_bf16(PAF(1),VFR(1),o[0],0,0,0), C0,8); \
    KRD(GL,1); GAPB(o[1]=__builtin_amdgcn_mfma_f32_32x32x16_bf16(PAF(1),VFR(5),o[1],0,0,0), C0,12); \
    KRD(GL,2); GAPB(o[0]=__builtin_amdgcn_mfma_f32_32x32x16_bf16(PAF(2),VFR(2),o[0],0,0,0), C1,0); \
    KRD(GL,3); GAPB(o[1]=__builtin_amdgcn_mfma_f32_32x32x16_bf16(PAF(2),VFR(6),o[1],0,0,0), C1,4); \
    GAPB(o[0]=__builtin_amdgcn_mfma_f32_32x32x16_bf16(PAF(3),VFR(3),o[0],0,0,0), C1,8); \
    GAPB(o[1]=__builtin_amdgcn_mfma_f32_32x32x16_bf16(PAF(3),VFR(7),o[1],0,0,0), C1,12); \
    }while(0)
  int t=1;
  #undef CMASK
  #define CMASK(P0,P1,t) do{}while(0)
  for(;t+5<NT;t+=2){
    STEP(pB0,pB1,pA0,pA1,t,true,true,true);     WAIT_BAR(2); RESC(); ROT();
    STEP(pA0,pA1,pB0,pB1,t+1,true,true,true);   WAIT_BAR(2); RESC(); ROT();
  }
  #undef CMASK
  #define CMASK(P0,P1,t) do{int jb_=(t)-(NT-4); if(jb_>=0)cmask(P0,P1,jb_,qrel,hi);}while(0)
  #define ENDW(tt) do{ if((tt)+3<NT){WAIT_BAR(2);} else if((tt)+2<NT){WAIT_BAR(1);} else {WAIT_BAR(0);} }while(0)
  for(;t+1<NT;t+=2){
    STEP(pB0,pB1,pA0,pA1,t,(t+3<NT),(t+1<NT),(t+1<NT));       ENDW(t);   RESC(); ROT();
    STEP(pA0,pA1,pB0,pB1,t+1,(t+4<NT),(t+2<NT),(t+2<NT));     ENDW(t+1); RESC(); ROT();
  }
  STEP(pB0,pB1,pA0,pA1,NT-1,false,false,false); RESC();
  { float sacc=pB0[0]+pB0[1]; _Pragma("unroll") for(int r=2;r<16;++r)sacc+=pB0[r]; _Pragma("unroll") for(int r=0;r<16;++r)sacc+=pB1[r]; l_reg+=sacc;
    pw0=(u32x4){PKW(pB0,0),PKW(pB0,2),PKW(pB0,4),PKW(pB0,6)};pw1=(u32x4){PKW(pB0,8),PKW(pB0,10),PKW(pB0,12),PKW(pB0,14)};pw2=(u32x4){PKW(pB1,0),PKW(pB1,2),PKW(pB1,4),PKW(pB1,6)};pw3=(u32x4){PKW(pB1,8),PKW(pB1,10),PKW(pB1,12),PKW(pB1,14)};
    SBAR(); pv(o,vb0+sl_cur,PAF(0),PAF(1),PAF(2),PAF(3)); }
  #undef PKW
  #undef PAF
  #undef VFR
  #undef PIN
  #undef MX3
  #undef GAPA
  #undef GAPB
  #undef EX
  #undef VRD
  #undef KRD
  #undef STEP
  #undef ENDW
  {auto rr=__builtin_amdgcn_permlane32_swap(__float_as_uint(l_reg),__float_as_uint(l_reg),false,false);l_reg=__uint_as_float(rr[0])+__uint_as_float(rr[1]);}
  if(hi==0)wsf[32+r32]=l_reg;asm volatile("s_waitcnt lgkmcnt(0)":::"memory");
  float rli[16];
  #pragma unroll
  for(int r=0;r<16;++r)rli[r]=__builtin_amdgcn_rcpf(wsf[32+crow(r,hi)]);
  bf16*Ow=Oh+(long)(q0+wid*QBLK)*DMO;
  { bf16*stg=(bf16*)(shm+LDS_OST)+wid*2048;
    #pragma unroll
    for(int r=0;r<16;++r){const int orow=crow(r,hi);
      #pragma unroll
      for(int d0=0;d0<2;++d0)stg[orow*64+d0*32+r32]=__float2bfloat16(o[d0][r]*rli[r]);}
    asm volatile("s_waitcnt lgkmcnt(0)":::"memory");
    #pragma unroll
    for(int i=0;i<4;++i){const int row=i*8+(lane>>3),ch=lane&7; const u32x4 v=*(const u32x4*)(stg+row*64+ch*8); ATTN_STORE16(Ow+(long)row*DMO+ch*8,v);} }
  asm volatile("s_waitcnt lgkmcnt(0)\n\ts_barrier":::"memory");
  #undef DMA_K
  #undef DMA_V
  #undef CMASK
  #undef START
  #undef RESC
  #undef ROT
}
constexpr int LDS2_K=0, LDS2_V=4*SLOTB, LDS2_WS=LDS2_V+NSLOT*2*SLOTB, LDS2_OST=LDS2_WS+NW*64*4, LDS2_BYTES=LDS2_OST+NW*8192;
__device__ __forceinline__ void pv4(f32x16*o,int vb,bf16x8 pa0,bf16x8 pa1,bf16x8 pa2,bf16x8 pa3){
  #pragma unroll
  for(int d0=0;d0<4;++d0){s16x4 lo[4],hi[4];
    #pragma unroll
    for(int ks=0;ks<4;++ks){
      asm volatile("ds_read_b64_tr_b16 %0,%1 offset:%c2":"=&v"(lo[ks]):"v"(vb),"i"(d0*4096+ks*1024):"memory");
      asm volatile("ds_read_b64_tr_b16 %0,%1 offset:%c2":"=&v"(hi[ks]):"v"(vb),"i"(d0*4096+ks*1024+512):"memory");}
    asm volatile("s_waitcnt lgkmcnt(0)":::"memory");SBAR();
    #define PK(k) (bf16x8){lo[k][0],lo[k][1],lo[k][2],lo[k][3],hi[k][0],hi[k][1],hi[k][2],hi[k][3]}
    o[d0]=__builtin_amdgcn_mfma_f32_32x32x16_bf16(pa0,PK(0),o[d0],0,0,0);
    o[d0]=__builtin_amdgcn_mfma_f32_32x32x16_bf16(pa1,PK(1),o[d0],0,0,0);
    o[d0]=__builtin_amdgcn_mfma_f32_32x32x16_bf16(pa2,PK(2),o[d0],0,0,0);
    o[d0]=__builtin_amdgcn_mfma_f32_32x32x16_bf16(pa3,PK(3),o[d0],0,0,0);
    #undef PK
  }
}
template<int THRL> __device__ __forceinline__ void attn_unit2(int qb,const bf16*Qh,const bf16*__restrict__ Kh,const bf16*__restrict__ Vh,bf16*Oh,char*shm,const int wave){
  const int tid=wave*64+lane_id_opaque(),lane=tid&63,r32=lane&31,hi=lane>>5; const int wid=__builtin_amdgcn_readfirstlane(tid>>6);
  const int q0=qb*QB;
  const bf16*Qw=Qh+(long)(q0+wid*QBLK)*DMI;
  const unsigned lds0=(unsigned)(uintptr_t)shm;
  float*wsf=(float*)(shm+LDS2_WS)+wid*64;
  const bf16*ksrc=Kh+(long)lane*DMI+wid*8;
  const bf16*vsrc=Vh+(long)(16*(wid&3)+(lane>>2))*DMI+(wid>>2)*32+(lane&3)*8;
  const unsigned kdst=lds0+LDS2_K+wid*1024, vdst=lds0+LDS2_V+(wid>>2)*4096+(wid&3)*1024;
  #define DMA_K(t,slot) glds16(ksrc+(long)(t)*KVBLK*DMI,(unsigned)__builtin_amdgcn_readfirstlane(kdst+(slot)))
  #define DMA_V(t,slot) do{ glds16(vsrc+(long)(t)*KVBLK*DMI,(unsigned)__builtin_amdgcn_readfirstlane(vdst+2*(slot))); glds16(vsrc+(long)(t)*KVBLK*DMI+64,(unsigned)__builtin_amdgcn_readfirstlane(vdst+2*(slot)+8192)); }while(0)
  const int vb0=(int)(lds0+LDS2_V)+((lane>>4)&1)*32+(lane&3)*8+(4*hi+((lane&15)>>2))*64;
  const char*Kbase=shm+LDS2_K; bf16x8 kf[8];
  const lds_cptr shm3=(lds_cptr)shm; const lds_cptr kp0=shm3+LDS2_K+hi*1024+r32*16; const lds_cptr vp0=shm3+LDS2_V+((lane>>4)&1)*32+(lane&3)*8+(4*hi+((lane&15)>>2))*64;
  const int NT=(q0+QB)/KVBLK;
  DMA_K(0,0);DMA_V(0,0);DMA_K(1,SLOTB);DMA_K(2,2*SLOTB);
  bf16x8 qr[4];
  #pragma unroll
  for(int d0=0;d0<4;++d0)qr[d0]=*reinterpret_cast<const bf16x8*>(&Qw[(long)r32*DMI+d0*16+hi*8]);
  float zf_=0.f; asm volatile("":"+v"(zf_)); f32x16 zz_; _Pragma("unroll") for(int r=0;r<16;++r)zz_[r]=zf_;
  float mhat=0.f,l_reg=0.f;f32x16 o[4];o[0]=zz_;o[1]=zz_;o[2]=zz_;o[3]=zz_;f32x16 negm=zz_;asm volatile("":"+v"(negm));
  const int qrel=wid*QBLK+r32;
  #define CMASK(P0,P1,t) do{int jb_=(t)-(NT-4); if(jb_>=0)cmask(P0,P1,jb_,qrel,hi);}while(0)
  bool resc=false;
  #define START(P0,P1) do{ const float rm=rowmax(P0,P1); resc=false; \
    { const float dl=rm; mhat=fadd_s(mhat,dl); \
      _Pragma("unroll") for(int r=0;r<16;++r){P0[r]=fsub_s(P0[r],dl);P1[r]=fsub_s(P1[r],dl);} \
      _Pragma("unroll") for(int r=0;r<16;++r)negm[r]=-mhat; asm volatile("":"+v"(negm)); } \
    _Pragma("unroll") for(int r=0;r<16;++r)P0[r]=__builtin_amdgcn_exp2f(P0[r]); }while(0)
  #define RESC() do{ if(resc){ asm volatile("s_waitcnt lgkmcnt(0)":::"memory"); \
      _Pragma("unroll") for(int d_=0;d_<4;++d_) _Pragma("unroll") for(int r=0;r<16;++r)o[d_][r]*=wsf[crow(r,hi)]; } }while(0)
  f32x16 pA0,pA1,pB0,pB1;
  int sl_prev=0,sl_cur=0,sl_next=SLOTB;
  int kc=0,kn=SLOTB,kp=3*SLOTB;
  #define ROT() do{sl_prev=sl_cur;sl_cur=sl_next;sl_next=(sl_next==(NSLOT-1)*SLOTB)?0:sl_next+SLOTB; kp=kc;kc=kn;kn=(kn==3*SLOTB)?0:kn+SLOTB;}while(0)
  WAIT_BAR(4);
  qkt(pA0,pA1,Kbase,qr,negm,r32,hi);asm volatile("s_nop 15\n\ts_nop 7":"+v"(pA0),"+v"(pA1));CMASK(pA0,pA1,0);
  START(pA0,pA1);
  _Pragma("unroll") for(int r=0;r<16;++r)pA1[r]=__builtin_amdgcn_exp2f(pA1[r]);
  DMA_K(3,3*SLOTB);DMA_V(1,SLOTB);
  WAIT_BAR(3);
  ROT();
  kload2(kf,kp0+kc,0); kload2(kf,kp0+kc,1);
  s16x4 vlo[16],vhi[16]; u32x4 pw0,pw1,pw2,pw3;
  #define PKW(P,B) cvtpk_s(P[B],P[B+1])
  #define PAF(k) __builtin_bit_cast(bf16x8,pw##k)
  #define VFR(i) (bf16x8){vlo[i][0],vlo[i][1],vlo[i][2],vlo[i][3],vhi[i][0],vhi[i][1],vhi[i][2],vhi[i][3]}
  #define PIN(x) asm volatile("":"+v"(x))
  #define MX3(a,b,c) __builtin_fmaxf(__builtin_fmaxf((a),(b)),(c))
  #define GAPA(MF,A0,A1,A2,A3,W0,W1,PW) do{ MF; sacc+=A0; sacc+=A1; sacc+=A2; sacc+=A3; PIN(sacc); W0; W1; PIN(PW); SBAR(); }while(0)
  #define EX(v) __builtin_amdgcn_exp2f(v)
  #define GAPB(MF,X,B) do{ MF; X[B]=EX(X[B]); X[B+1]=EX(X[B+1]); PIN(X); SBAR(); }while(0)
  #define VRD(i) do{ vlo[i]=vtr(vp_+(((i)>>2)*4096+((i)&3)*1024)); vhi[i]=vtr(vp_+(((i)>>2)*4096+((i)&3)*1024+512)); }while(0)
  #define STEP(C0,C1,P0,P1,t,GK,GV,GL) do{ SBAR(); \
    const lds_cptr vp_=vp0+2*sl_prev; \
    VRD(0); SBAR(); float sacc=(P0[0]+P0[1]); \
    GAPA(C0=__builtin_amdgcn_mfma_f32_32x32x16_bf16(kf[0],qr[0],negm,0,0,0), P0[2],P0[3],P0[4],P0[5],     pw0[0]=PKW(P0,0), pw0[1]=PKW(P0,2), pw0); \
    VRD(4); kload2(kf,kp0+kc,2); SBAR(); GAPA(C1=__builtin_amdgcn_mfma_f32_32x32x16_bf16(kf[1],qr[0],negm,0,0,0), P0[6],P0[7],P0[8],P0[9],     pw0[2]=PKW(P0,4), pw0[3]=PKW(P0,6), pw0); \
    VRD(1); SBAR(); GAPA(C0=__builtin_amdgcn_mfma_f32_32x32x16_bf16(kf[2],qr[1],C0,0,0,0),   P0[10],P0[11],P0[12],P0[13], pw1[0]=PKW(P0,8), pw1[1]=PKW(P0,10), pw1); \
    VRD(5); kload2(kf,kp0+kc,3); SBAR(); GAPA(C1=__builtin_amdgcn_mfma_f32_32x32x16_bf16(kf[3],qr[1],C1,0,0,0),   P0[14],P0[15],P1[0],P1[1],   pw1[2]=PKW(P0,12),pw1[3]=PKW(P0,14), pw1); \
    VRD(2); SBAR(); GAPA(C0=__builtin_amdgcn_mfma_f32_32x32x16_bf16(kf[4],qr[2],C0,0,0,0),   P1[2],P1[3],P1[4],P1[5],     pw2[0]=PKW(P1,0), pw2[1]=PKW(P1,2), pw2); \
    VRD(6); SBAR(); GAPA(C1=__builtin_amdgcn_mfma_f32_32x32x16_bf16(kf[5],qr[2],C1,0,0,0),   P1[6],P1[7],P1[8],P1[9],     pw2[2]=PKW(P1,4), pw2[3]=PKW(P1,6), pw2); \
    VRD(3); SBAR(); GAPA(C0=__builtin_amdgcn_mfma_f32_32x32x16_bf16(kf[6],qr[3],C0,0,0,0),   P1[10],P1[11],P1[12],P1[13], pw3[0]=PKW(P1,8), pw3[1]=PKW(P1,10), pw3); \
    VRD(7); SBAR(); GAPA(C1=__builtin_amdgcn_mfma_f32_32x32x16_bf16(kf[7],qr[3],C1,0,0,0),   P1[14],P1[15],0.f,0.f,       pw3[2]=PKW(P1,12),pw3[3]=PKW(P1,14), pw3); \
    l_reg+=sacc; \
    if(GK){DMA_K((t)+3,kp);} if(GV){DMA_V((t)+1,sl_next);} \
    CMASK(C0,C1,t); \
    { float a=MX3(C0[0],C0[1],C1[0]),b=MX3(C0[2],C0[3],C1[1]); a=MX3(a,C1[2],C1[3]); \
      _Pragma("unroll") for(int r=4;r<16;r+=4){a=MX3(a,C0[r],C0[r+1]);b=MX3(b,C0[r+2],C0[r+3]);a=MX3(a,C1[r],C1[r+1]);b=MX3(b,C1[r+2],C1[r+3]);} \
      float rm=__builtin_fmaxf(a,b); { auto rr=__builtin_amdgcn_permlane32_swap(__float_as_uint(rm),__float_as_uint(rm),false,false); rm=__builtin_fmaxf(__uint_as_float(rr[0]),__uint_as_float(rr[1])); } \
      resc=false; \
      if(__builtin_expect(__any(rm>(float)THRL),0)){ const float dl=__builtin_fmaxf(rm,0.f); mhat+=dl; \
        _Pragma("unroll") for(int r=0;r<16;++r){C0[r]-=dl;C1[r]-=dl;} \
        _Pragma("unroll") for(int r=0;r<16;++r)negm[r]=-mhat; asm volatile("":"+v"(negm)); \
        const float f=__builtin_amdgcn_exp2f(-dl); l_reg*=f; if(hi==0)wsf[r32]=f; resc=true; } } \
    SBAR(); \
    VRD(8);  SBAR(); GAPB(o[0]=__builtin_amdgcn_mfma_f32_32x32x16_bf16(PAF(0),VFR(0),o[0],0,0,0), C0,0); \
    VRD(12); SBAR(); GAPB(o[1]=__builtin_amdgcn_mfma_f32_32x32x16_bf16(PAF(0),VFR(4),o[1],0,0,0), C0,2); \
    VRD(9);  SBAR(); GAPB(o[0]=__builtin_amdgcn_mfma_f32_32x32x16_bf16(PAF(1),VFR(1),o[0],0,0,0), C0,4); \
    VRD(13); SBAR(); GAPB(o[1]=__builtin_amdgcn_mfma_f32_32x32x16_bf16(PAF(1),VFR(5),o[1],0,0,0), C0,6); \
    VRD(10); SBAR(); GAPB(o[0]=__builtin_amdgcn_mfma_f32_32x32x16_bf16(PAF(2),VFR(2),o[0],0,0,0), C0,8); \
    VRD(14); SBAR(); GAPB(o[1]=__builtin_amdgcn_mfma_f32_32x32x16_bf16(PAF(2),VFR(6),o[1],0,0,0), C0,10); \
    VRD(11); SBAR(); GAPB(o[0]=__builtin_amdgcn_mfma_f32_32x32x16_bf16(PAF(3),VFR(3),o[0],0,0,0), C0,12); \
    VRD(15); SBAR(); GAPB(o[1]=__builtin_amdgcn_mfma_f32_32x32x16_bf16(PAF(3),VFR(7),o[1],0,0,0), C0,14); \
    GAPB(o[2]=__builtin_amdgcn_mfma_f32_32x32x16_bf16(PAF(0),VFR(8),o[2],0,0,0),  C1,0); \
    GAPB(o[3]=__builtin_amdgcn_mfma_f32_32x32x16_bf16(PAF(0),VFR(12),o[3],0,0,0), C1,2); \
    GAPB(o[2]=__builtin_amdgcn_mfma_f32_32x32x16_bf16(PAF(1),VFR(9),o[2],0,0,0),  C1,4); \
    GAPB(o[3]=__builtin_amdgcn_mfma_f32_32x32x16_bf16(PAF(1),VFR(13),o[3],0,0,0), C1,6); \
    GAPB(o[2]=__builtin_amdgcn_mfma_f32_32x32x16_bf16(PAF(2),VFR(10),o[2],0,0,0), C1,8); \
    GAPB(o[3]=__builtin_amdgcn_mfma_f32_32x32x16_bf16(PAF(2),VFR(14),o[3],0,0,0), C1,10); \
    GAPB(o[2]=__builtin_amdgcn_mfma_f32_32x32x16_bf16(PAF(3),VFR(11),o[2],0,0,0), C1,12); \
    GAPB(o[3]=__builtin_amdgcn_mfma_f32_32x32x16_bf16(PAF(3),VFR(15),o[3],0,0,0), C1,14); \
    if(GL){ kload2(kf,kp0+kn,0); kload2(kf,kp0+kn,1); SBAR(); } \
    }while(0)
  int t=1;
  #undef CMASK
  #define CMASK(P0,P1,t) do{}while(0)
  for(;t+5<NT;t+=2){
    STEP(pB0,pB1,pA0,pA1,t,true,true,true);     WAIT_BAR(3); RESC(); ROT();
    STEP(pA0,pA1,pB0,pB1,t+1,true,true,true);   WAIT_BAR(3); RESC(); ROT();
  }
  #undef CMASK
  #define CMASK(P0,P1,t) do{int jb_=(t)-(NT-4); if(jb_>=0)cmask(P0,P1,jb_,qrel,hi);}while(0)
  #define ENDW(tt) do{ if((tt)+3<NT){WAIT_BAR(3);} else if((tt)+2<NT){WAIT_BAR(2);} else {WAIT_BAR(0);} }while(0)
  for(;t+1<NT;t+=2){
    STEP(pB0,pB1,pA0,pA1,t,(t+3<NT),(t+1<NT),(t+1<NT));       ENDW(t);   RESC(); ROT();
    STEP(pA0,pA1,pB0,pB1,t+1,(t+4<NT),(t+2<NT),(t+2<NT));     ENDW(t+1); RESC(); ROT();
  }
  STEP(pB0,pB1,pA0,pA1,NT-1,false,false,false); RESC();
  { float sacc=pB0[0]+pB0[1]; _Pragma("unroll") for(int r=2;r<16;++r)sacc+=pB0[r]; _Pragma("unroll") for(int r=0;r<16;++r)sacc+=pB1[r]; l_reg+=sacc;
    pw0=(u32x4){PKW(pB0,0),PKW(pB0,2),PKW(pB0,4),PKW(pB0,6)};pw1=(u32x4){PKW(pB0,8),PKW(pB0,10),PKW(pB0,12),PKW(pB0,14)};pw2=(u32x4){PKW(pB1,0),PKW(pB1,2),PKW(pB1,4),PKW(pB1,6)};pw3=(u32x4){PKW(pB1,8),PKW(pB1,10),PKW(pB1,12),PKW(pB1,14)};
    SBAR(); pv4(o,vb0+2*sl_cur,PAF(0),PAF(1),PAF(2),PAF(3)); }
  #undef PKW
  #undef PAF
  #undef VFR
  #undef PIN
  #undef MX3
  #undef GAPA
  #undef GAPB
  #undef EX
  #undef VRD
  #undef STEP
  #undef ENDW
  {auto rr=__builtin_amdgcn_permlane32_swap(__float_as_uint(l_reg),__float_as_uint(l_reg),false,false);l_reg=__uint_as_float(rr[0])+__uint_as_float(rr[1]);}
  if(hi==0)wsf[32+r32]=l_reg;asm volatile("s_waitcnt lgkmcnt(0)":::"memory");
  float rli[16];
  #pragma unroll
  for(int r=0;r<16;++r)rli[r]=__builtin_amdgcn_rcpf(wsf[32+crow(r,hi)]);
  bf16*Ow=Oh+(long)(q0+wid*QBLK)*DMO;
  { bf16*stg=(bf16*)(shm+LDS2_OST)+wid*4096;
    #pragma unroll
    for(int r=0;r<16;++r){const int orow=crow(r,hi);
      #pragma unroll
      for(int d0=0;d0<4;++d0)stg[orow*128+d0*32+r32]=__float2bfloat16(o[d0][r]*rli[r]);}
    asm volatile("s_waitcnt lgkmcnt(0)":::"memory");
    #pragma unroll
    for(int i=0;i<8;++i){const int row=i*4+(lane>>4),ch=lane&15; const u32x4 v=*(const u32x4*)(stg+row*128+ch*8); ATTN_STORE16(Ow+(long)row*DMO+ch*8,v);} }
  asm volatile("s_waitcnt lgkmcnt(0)\n\ts_barrier":::"memory");
  #undef DMA_K
  #undef DMA_V
  #undef CMASK
  #undef START
  #undef RESC
  #undef ROT
}
constexpr int ATTN_LDS_BYTES=LDS_BYTES;
#undef SBAR
#undef WAIT_BAR
}

constexpr int NWAVES = 8;
constexpr int NTOK = 32768, DM = 1024, SEQ = 4096, NB = 8, NEXP = 32, TOPK = 4;
constexpr int N_PHASES = 10;
constexpr size_t MiB = 1u << 20;
constexpr size_t WS_CTL = 0, CTL_ZERO_BYTES = 32768;
constexpr size_t WS_MODP = 864 * MiB;
constexpr size_t WS_MODF = 3 * MiB;
constexpr size_t WS_LAM16 = 3 * MiB + 512 * 1024;
constexpr size_t WS_WRH = 3 * MiB + 640 * 1024, WS_WRL = 3 * MiB + 704 * 1024;
constexpr size_t WS_WIN = 4 * MiB;
constexpr size_t WS_WOUT = 8 * MiB;
constexpr size_t WS_WGLU = 10 * MiB;
constexpr size_t WS_WM = 11 * MiB;
constexpr size_t WS_TV = 15 * MiB;
constexpr size_t WS_W1T = 22 * MiB;
constexpr size_t WS_W2T = 150 * MiB;
constexpr size_t WS_H = 214 * MiB;
constexpr size_t WS_Q = 278 * MiB, WS_K = 310 * MiB, WS_V = 342 * MiB;
constexpr size_t WS_UA = 374 * MiB;
constexpr size_t WS_Z = 422 * MiB;
constexpr size_t WS_OB = 454 * MiB;
constexpr size_t WS_MIX = 518 * MiB;
constexpr size_t WS_PTOK = 582 * MiB;
constexpr size_t WS_SLOT = 586 * MiB;
constexpr size_t WS_GATE = 587 * MiB;
constexpr size_t WS_A2 = 278 * MiB;
constexpr size_t WS_Y2 = 590 * MiB;
constexpr size_t WS_X1B = 872 * MiB;
constexpr size_t WS_END = 936 * MiB;
constexpr int MAXTILES = 544;
static_assert(WS_A2 + (size_t)MAXTILES * 256 * 1024 * 2 <= WS_PTOK && WS_Y2 + (size_t)MAXTILES * 256 * 1024 * 2 <= WS_MODP, "ws map");
constexpr int CW_TMO = 0, CW_CNT = 1024  , CW_BAR = 4096;
constexpr int CW_DEP0 = 7680  , CW_DEPB = 7744  ;
constexpr int RING_OFF = 0, RING_BYTES = 131072;
constexpr int VEC_OFF = 132096;
constexpr int BIASL_OFF = 132096;
constexpr int TILE_E_OFF = 140288;
constexpr int TILE0_OFF = 140928;
constexpr int CNTL_OFF = 141056;
constexpr int MOE_T_OFF = 141184;
constexpr int ROWTAB_OFF = 141312;
constexpr int LDSCTL_OFF = 159744, MISC_OFF = LDSCTL_OFF;
constexpr int LDS_BYTES = 163840;

typedef unsigned short bf16;
typedef unsigned v4u __attribute__((ext_vector_type(4)));
typedef unsigned v2u __attribute__((ext_vector_type(2)));
typedef float f32x4 __attribute__((ext_vector_type(4)));
typedef GAS unsigned gu32;
#define RLX_AGENT __ATOMIC_RELAXED, __HIP_MEMORY_SCOPE_AGENT
#define LDS_WAIT() asm volatile("s_waitcnt lgkmcnt(0)" ::: "memory")
#define VM_WAIT() asm volatile("s_waitcnt vmcnt(0)" ::: "memory")
__device__ __forceinline__ unsigned f2bf(float f) { unsigned u = __builtin_bit_cast(unsigned, f); return (u + 0x7fffu + ((u >> 16) & 1u)) >> 16; }
__device__ __forceinline__ unsigned pk2(float lo, float hi) { return f2bf(lo) | (f2bf(hi) << 16); }

#define XB_TMO      128
#define XB_XCNT(j)  (256  + 64 * (j))
#define XB_XSUB(j)  (1280 + 64 * (j))
#define XB_XGEN(j)  (2304 + 64 * (j))
#define XB_TOP      3328
#define XB_TOPGEN   3392
#define XCD_BAR_WORDS 3456
#define XB_SPIN_CAP (1u << 18)
__device__ __forceinline__ unsigned xb_ld(unsigned* p)              { return __hip_atomic_load(p, __ATOMIC_RELAXED, __HIP_MEMORY_SCOPE_AGENT); }
__device__ __forceinline__ unsigned xb_add(unsigned* p, unsigned v) { return __hip_atomic_fetch_add(p, v, __ATOMIC_RELAXED, __HIP_MEMORY_SCOPE_AGENT); }
__device__ __forceinline__ unsigned xb_xcc_id() { return (unsigned)__builtin_amdgcn_s_getreg((3 << 11) | 20) & 0xFu; }
#define XB_SPIN(cond, bar) do { unsigned _sp = 0; while (cond) { __builtin_amdgcn_s_sleep(1); \
    if ((++_sp & 255u) == 0u) { if (xb_ld(&(bar)[XB_TMO])) break; if (_sp > XB_SPIN_CAP) { atomicAdd(&(bar)[XB_TMO], 1u); break; } } } } while (0)
struct XcdBarrier { unsigned* bar; unsigned x; volatile LAS unsigned* st; };
__device__ __forceinline__ XcdBarrier xcd_barrier_post(unsigned* bar, volatile LAS unsigned* st) {
    XcdBarrier b; b.bar = bar; b.x = xb_xcc_id(); b.st = st;
    if (threadIdx.x == 0) (void)xb_add(&bar[XB_XCNT(b.x)], 1u);
    return b;
}
__device__ __forceinline__ void xcd_barrier_complete(unsigned* bar, unsigned x, unsigned& nloc, unsigned& nx) {
    const unsigned G = gridDim.x * gridDim.y * gridDim.z;
    unsigned sum, cnt, mine, sp = 0u;
    for (;;) {
        sum = 0u; cnt = 0u; mine = 0u;
#pragma unroll
        for (unsigned j = 0; j < 16; ++j) { const unsigned c = xb_ld(&bar[XB_XCNT(j)]); sum += c; cnt += (c > 0u) ? 1u : 0u; mine = (j == x) ? c : mine; }
        if (sum == G) break;
        __builtin_amdgcn_s_sleep(1);
        if ((++sp & 255u) == 0u) { if (xb_ld(&bar[XB_TMO])) break; if (sp > XB_SPIN_CAP) { atomicAdd(&bar[XB_TMO], 1u); break; } }
    }
    nloc = mine > 0u ? mine : 1u; nx = cnt > 0u ? cnt : 1u;
}
__device__ __forceinline__ void xcd_barrier(const XcdBarrier& b, const int wave) {
    asm volatile("s_waitcnt vmcnt(0)" ::: "memory");
    __syncthreads();
    if (wave == 0 && lane_id_opaque() == 0) {
        unsigned* bar = b.bar;
        __builtin_amdgcn_s_waitcnt(0);
        unsigned nloc = b.st[0], nx = b.st[1];
        if (nloc == 0u) { xcd_barrier_complete(bar, b.x, nloc, nx); b.st[0] = nloc; b.st[1] = nx; }
        const unsigned old = xb_add(&bar[XB_XSUB(b.x)], 1u);
        const unsigned gen = old / nloc;
        if (old + 1u == (gen + 1u) * nloc) {
            __builtin_amdgcn_fence(__ATOMIC_RELEASE, "agent");
            asm volatile("s_waitcnt vmcnt(0)" ::: "memory");
            const unsigned og = xb_add(&bar[XB_TOP], 1u);
            const unsigned tg = og / nx;
            if (og + 1u == (tg + 1u) * nx) xb_add(&bar[XB_TOPGEN], 1u);
            else XB_SPIN(xb_ld(&bar[XB_TOPGEN]) == tg, bar);
            __builtin_amdgcn_fence(__ATOMIC_ACQUIRE, "agent");
            xb_add(&bar[XB_XGEN(b.x)], 1u);
            asm volatile("s_waitcnt vmcnt(0)" ::: "memory");
        } else {
            XB_SPIN(xb_ld(&bar[XB_XGEN(b.x)]) == gen, bar);
            __builtin_amdgcn_fence(__ATOMIC_ACQUIRE, "agent");
            asm volatile("s_waitcnt vmcnt(0)" ::: "memory");
        }
    }
    __syncthreads();
}

struct Frame {
    LAS unsigned char* lds;
    gu32* ctl;
    int tid, lane, wave, vcu, G;
    float* out; unsigned char* ws;
};
typedef const float* cfptr_t;
__device__ __forceinline__ const float* inp(int i) { const __attribute__((address_space(4))) cfptr_t* kp = (const __attribute__((address_space(4))) cfptr_t*)__builtin_amdgcn_kernarg_segment_ptr(); asm volatile("" : "+s"(kp)); return kp[i]; }
__device__ __forceinline__ float wave_sum(float v) {
#pragma unroll
    for (int o = 1; o < 64; o <<= 1) v += __shfl_xor(v, o);
    return v;
}
__device__ __forceinline__ float wave_max(float v) {
#pragma unroll
    for (int o = 1; o < 64; o <<= 1) v = fmaxf(v, __shfl_xor(v, o));
    return v;
}
__device__ __forceinline__ int wave_min_i(int v) {
#pragma unroll
    for (int o = 1; o < 64; o <<= 1) { const int w = __shfl_xor(v, o); v = w < v ? w : v; }
    return v;
}

#define DPP_F(v, ctrl) __builtin_bit_cast(float, __builtin_amdgcn_update_dpp(__builtin_bit_cast(int, (v)), __builtin_bit_cast(int, (v)), (ctrl), 0xF, 0xF, false))
#define DPP_I(v, ctrl) __builtin_amdgcn_update_dpp((v), (v), (ctrl), 0xF, 0xF, false)
__device__ __forceinline__ float wave_max_u(float v) {
    v = fmaxf(v, DPP_F(v, 0xB1)); v = fmaxf(v, DPP_F(v, 0x4E)); v = fmaxf(v, DPP_F(v, 0x141)); v = fmaxf(v, DPP_F(v, 0x140));
    const int b = __builtin_bit_cast(int, v);
    return fmaxf(fmaxf(__builtin_bit_cast(float, __builtin_amdgcn_readlane(b, 15)), __builtin_bit_cast(float, __builtin_amdgcn_readlane(b, 31))), fmaxf(__builtin_bit_cast(float, __builtin_amdgcn_readlane(b, 47)), __builtin_bit_cast(float, __builtin_amdgcn_readlane(b, 63))));
}
__device__ __forceinline__ int wave_min_iu(int v) {
    int w;
    w = DPP_I(v, 0xB1); v = w < v ? w : v; w = DPP_I(v, 0x4E); v = w < v ? w : v; w = DPP_I(v, 0x141); v = w < v ? w : v; w = DPP_I(v, 0x140); v = w < v ? w : v;
    const int a = __builtin_amdgcn_readlane(v, 15), b = __builtin_amdgcn_readlane(v, 31), c = __builtin_amdgcn_readlane(v, 47), d = __builtin_amdgcn_readlane(v, 63);
    const int ab = a < b ? a : b, cd = c < d ? c : d; return ab < cd ? ab : cd;
}
__device__ __forceinline__ float wave_sum_u(float v) {
    v += DPP_F(v, 0xB1); v += DPP_F(v, 0x4E); v += DPP_F(v, 0x141); v += DPP_F(v, 0x140);
    const int b = __builtin_bit_cast(int, v);
    return (__builtin_bit_cast(float, __builtin_amdgcn_readlane(b, 15)) + __builtin_bit_cast(float, __builtin_amdgcn_readlane(b, 31))) + (__builtin_bit_cast(float, __builtin_amdgcn_readlane(b, 47)) + __builtin_bit_cast(float, __builtin_amdgcn_readlane(b, 63)));
}
struct TrItem { const float* W; bf16* WT; int ldw, ldt; };
__device__ __forceinline__ void tr_dma(const TrItem& d, LAS float* buf, int lane) {
    const int kr = lane >> 3, q = lane & 7;
#pragma unroll
    for (int i = 0; i < 8; ++i) __builtin_amdgcn_global_load_lds((const unsigned*)(d.W + (size_t)(8 * i + kr) * d.ldw + 4 * ((q - i) & 7)), (LAS unsigned*)(buf + i * 256), 16, 0, 2);
}
__device__ __forceinline__ void tr_out(const TrItem& d, const LAS float* buf, int lane) {
    const int c = lane & 7;
#pragma unroll
    for (int j = 0; j < 4; ++j) { const int n = (lane >> 3) + 8 * j; const LAS float* s = buf + (8 * c) * 32 + 4 * (((n >> 2) + c) & 7) + (n & 3);
        if (d.ldt < 0) { const f32x4 a = (f32x4){s[0 * 32], s[1 * 32], s[2 * 32], s[3 * 32]} * pg8::F8_W, e = (f32x4){s[4 * 32], s[5 * 32], s[6 * 32], s[7 * 32]} * pg8::F8_W;
            __builtin_nontemporal_store(pg8::pack8_fp8(a, e), (pg8::i32x2*)((unsigned char*)d.WT + (size_t)n * (size_t)(-d.ldt) + 8 * c)); }
        else { v4u o; o.x = pg8::cvt_pk_bf16(s[0 * 32], s[1 * 32]); o.y = pg8::cvt_pk_bf16(s[2 * 32], s[3 * 32]); o.z = pg8::cvt_pk_bf16(s[4 * 32], s[5 * 32]); o.w = pg8::cvt_pk_bf16(s[6 * 32], s[7 * 32]);
            *(GAS v4u*)(d.WT + (size_t)n * d.ldt + 8 * c) = o; } }
}
__device__ __forceinline__ void dsincos(double x, double& s, double& c) {
    const double k = rint(x * 0.63661977236758134308);
    double r = fma(-k, 1.57079632673412561417e+00, x); r = fma(-k, 6.07710050650619224932e-11, r);
    const int q = ((int)k) & 3; const double r2 = r * r;
    const double sp = r + r * r2 * (-1.66666666666666324348e-01 + r2 * (8.33333333332248946124e-03 + r2 * (-1.98412698298579493134e-04 + r2 * (2.75573137070700676789e-06 + r2 * (-2.50507602534068634195e-08 + r2 * 1.58969099521155010221e-10)))));
    const double cp = 1.0 - 0.5 * r2 + r2 * r2 * (4.16666666666666019037e-02 + r2 * (-1.38888888888741095749e-03 + r2 * (2.48015872894767294178e-05 + r2 * (-2.75573143513906633035e-07 + r2 * (2.08757232129817482790e-09 + r2 * -1.13596475577881948265e-11)))));
    s = (q == 0) ? sp : (q == 1) ? cp : (q == 2) ? -sp : -cp;
    c = (q == 0) ? cp : (q == 1) ? -sp : (q == 2) ? -cp : sp;
}
__device__ __forceinline__ double dexp(double x) {
    const double k = rint(x * 1.44269504088896340736); const double r = fma(-k, 6.93147180369123816490e-01, x) - k * 1.90821492927058770002e-10;
    double p = 1.0 / 6227020800.0;
    p = p * r + 1.0 / 479001600.0; p = p * r + 1.0 / 39916800.0; p = p * r + 1.0 / 3628800.0; p = p * r + 1.0 / 362880.0; p = p * r + 1.0 / 40320.0; p = p * r + 1.0 / 5040.0;
    p = p * r + 1.0 / 720.0; p = p * r + 1.0 / 120.0; p = p * r + 1.0 / 24.0; p = p * r + 1.0 / 6.0; p = p * r + 0.5; p = p * r + 1.0; p = p * r + 1.0;
    return ldexp(p, (int)k);
}
__device__ __forceinline__ void ssm_tables_item(Frame& F, int g, int r) {
    LAS float* pwr = (LAS float*)(F.lds); LAS float* pwi = pwr + 17 * 64;
    LAS float* ccr = pwi + 17 * 64; LAS float* cci = ccr + 1040;
    LAS float* bbr = cci + 1040; LAS float* bbi = bbr + 1024;
    LAS float* kt = bbi + 1024;
    LAS double* lb1 = (LAS double*)(kt + 4096);
    const float* a_re = inp(11); const float* a_im = inp(12); const float* log_dt = inp(13);
    const float* b_re = inp(14); const float* b_im = inp(15); const float* c_re = inp(16); const float* c_im = inp(17); const float* dsk = inp(18);
    const int tid = F.tid;
    const double dtv = dexp((double)log_dt[g]);
    for (int idx = tid; idx < 17 * 64; idx += 512) { const int t = idx >> 6, p = idx & 63;
        const double re = fmin((double)a_re[g * 64 + p], -1e-4), im = (double)a_im[g * 64 + p];
        const double mag = dexp(re * dtv * (double)t); double s, c; dsincos(im * dtv * (double)t, s, c);
        pwr[idx] = (float)(mag * c); pwi[idx] = (float)(mag * s); if (t == 1) { lb1[2 * p] = mag * c - 1.0; lb1[2 * p + 1] = mag * s; } }
    for (int idx = tid; idx < 1024; idx += 512) { const int c = idx >> 6, p = idx & 63; ccr[c * 65 + p] = c_re[(g * 16 + c) * 64 + p]; cci[c * 65 + p] = c_im[(g * 16 + c) * 64 + p]; }
    __syncthreads();
    for (int idx = tid; idx < 1024; idx += 512) { const int p = idx >> 4, c1 = idx & 15;
        const double re = fmin((double)a_re[g * 64 + p], -1e-4), im = (double)a_im[g * 64 + p];
        const double nr = lb1[2 * p], ni = lb1[2 * p + 1], den = re * re + im * im;
        const double qr = (nr * re + ni * im) / den, qi = (ni * re - nr * im) / den;
        const double br = (double)b_re[(g * 64 + p) * 16 + c1], bi = (double)b_im[(g * 64 + p) * 16 + c1];
        bbr[idx] = (float)(qr * br - qi * bi); bbi[idx] = (float)(qr * bi + qi * br); }
    __syncthreads();
    { const int t = tid >> 5, c = (tid >> 1) & 15, h8 = (tid & 1) * 8; float acc[8];
#pragma unroll
      for (int q = 0; q < 8; ++q) acc[q] = 0.f;
      for (int p = 0; p < 64; ++p) { const float cr = ccr[c * 65 + p], ci = cci[c * 65 + p], pr = pwr[t * 64 + p], pi = pwi[t * 64 + p]; const float mr = cr * pr - ci * pi, mi = cr * pi + ci * pr;
          const f32x4 r0 = *(const LAS f32x4*)(bbr + p * 16 + h8), r1 = *(const LAS f32x4*)(bbr + p * 16 + h8 + 4), i0 = *(const LAS f32x4*)(bbi + p * 16 + h8), i1 = *(const LAS f32x4*)(bbi + p * 16 + h8 + 4);
          acc[0] += mr * r0.x - mi * i0.x; acc[1] += mr * r0.y - mi * i0.y; acc[2] += mr * r0.z - mi * i0.z; acc[3] += mr * r0.w - mi * i0.w;
          acc[4] += mr * r1.x - mi * i1.x; acc[5] += mr * r1.y - mi * i1.y; acc[6] += mr * r1.z - mi * i1.z; acc[7] += mr * r1.w - mi * i1.w; }
#pragma unroll
      for (int q = 0; q < 8; ++q) kt[(t * 16 + c) * 16 + h8 + q] = acc[q]; }
    __syncthreads();
    bf16* TV = (bf16*)(F.ws + WS_TV) + (size_t)g * 256 * 384; bf16* WM = (bf16*)(F.ws + WS_WM) + (size_t)g * 256 * 256;
    for (int idx = tid; idx < 32 * 192; idx += 512) { const int row = 32 * r + idx / 192, col = 2 * (idx % 192), s = row >> 4, c = row & 15; float v[2];
#pragma unroll
        for (int q = 0; q < 2; ++q) { const int cq = col + q;
            if (cq < 256) { const int j = cq >> 4, c1 = cq & 15; v[q] = (j <= s) ? kt[((s - j) * 16 + c) * 16 + c1] : 0.f; if (j == s && c == c1) v[q] += dsk[g * 16 + c]; }
            else { const int p = (cq - 256) & 63; const float cr = ccr[c * 65 + p], ci = cci[c * 65 + p], pr = pwr[(s + 1) * 64 + p], pi = pwi[(s + 1) * 64 + p];
                v[q] = (cq < 320) ? (cr * pr - ci * pi) : -(cr * pi + ci * pr); } }
        *(unsigned*)(TV + (size_t)row * 384 + col) = pk2(v[0], v[1]); }
    for (int idx = tid; idx < 16 * 128; idx += 512) { const int row = 16 * r + (idx >> 7), col = 2 * (idx & 127), p = row & 63, ri = row >> 6, j = col >> 4, c1 = col & 15;
        const float pr = pwr[(15 - j) * 64 + p], pi = pwi[(15 - j) * 64 + p]; float v[2];
#pragma unroll
        for (int q = 0; q < 2; ++q) { const float br = bbr[p * 16 + c1 + q], bi = bbi[p * 16 + c1 + q]; v[q] = ri == 0 ? (pr * br - pi * bi) : (pr * bi + pi * br); }
        *(unsigned*)(WM + (size_t)row * 256 + col) = pk2(v[0], v[1]); *(unsigned*)(WM + (size_t)(128 + row) * 256 + col) = 0u; }
    if (r == 0 && tid < 64) { float* L16 = (float*)(F.ws + WS_LAM16) + (g * 64 + tid) * 2; L16[0] = pwr[16 * 64 + tid]; L16[1] = pwi[16 * 64 + tid]; }
    __syncthreads();
}
constexpr int MOD_NKS = 32;
__device__ __forceinline__ void modp_item(Frame& F, int it) {
    const int ng = it % 6, ks = it / 6, tid = F.tid;
    LAS float* cact = (LAS float*)F.lds;
    LAS f32x4* red = (LAS f32x4*)(cact + 256);
    const float* cin = inp(1); const float* w = inp(2);
    if (tid < 256) { const int b = tid >> 5, kk = tid & 31; const float c = cin[b * 1024 + ks * 32 + kk]; cact[tid] = c / (1.0f + __expf(-c)); }
    __syncthreads();
    const int c4 = tid & 255, kq = tid >> 8, col = ng * 1024 + 4 * c4; f32x4 wv[16], acc[8];
#pragma unroll
    for (int i = 0; i < 16; ++i) wv[i] = *(const GAS f32x4*)(w + (size_t)(ks * 32 + kq * 16 + i) * 6144 + col);
#pragma unroll
    for (int b = 0; b < 8; ++b) { acc[b] = (f32x4){0.f, 0.f, 0.f, 0.f};
#pragma unroll
        for (int i = 0; i < 16; ++i) acc[b] += wv[i] * cact[b * 32 + kq * 16 + i]; }
    if (kq == 1) {
#pragma unroll
        for (int b = 0; b < 8; ++b) red[b * 256 + c4] = acc[b]; }
    __syncthreads();
    if (kq == 0) { float* mp = (float*)(F.ws + WS_MODP);
#pragma unroll
        for (int b = 0; b < 8; ++b) *(GAS f32x4*)(mp + (size_t)(ks * 8 + b) * 6144 + col) = acc[b] + red[b * 256 + c4]; }
    __syncthreads();
}
__device__ __forceinline__ float mod_value(Frame& F, const float* b_ada, int b, int n) {
    const float* mp = (const float*)(F.ws + WS_MODP); float v = b_ada[n];
    float t[MOD_NKS];
#pragma unroll
    for (int ks = 0; ks < MOD_NKS; ++ks) t[ks] = mp[(size_t)(ks * 8 + b) * 6144 + n];
#pragma unroll
    for (int ks = 0; ks < MOD_NKS; ++ks) v += t[ks];
    return v;
}
#ifndef TR_HOSTED
#define TR_HOSTED 32768
#endif
constexpr int TR_I_W1 = 32 * 16 * 64, TR_I_W2 = 32 * 16 * 32, TR_I_IN = 16 * 64, TR_I_OUT = 16 * 32, TR_I_GLU = 8 * 16, TR_NITEMS = TR_I_W1 + TR_I_W2 + TR_I_IN + TR_I_OUT + TR_I_GLU;
__device__ __forceinline__ void tr_run(Frame& F, const int lo, const int hi, const int gw, const int NGW) {
    LAS float* scr = (LAS float*)(F.lds + RING_OFF + F.wave * 16384);
    constexpr int I_W1 = TR_I_W1, I_W2 = TR_I_W2, I_IN = TR_I_IN, I_OUT = TR_I_OUT;
    const int NITEMS = hi;
    const float* w1p = inp(25); const float* w2p = inp(27); const float* winp = inp(5); const float* woutp = inp(21); const float* wglup = inp(19);
    bf16* w1t = (bf16*)(F.ws + WS_W1T); bf16* w2t = (bf16*)(F.ws + WS_W2T); bf16* wint = (bf16*)(F.ws + WS_WIN); bf16* woutt = (bf16*)(F.ws + WS_WOUT); bf16* wglut = (bf16*)(F.ws + WS_WGLU);
#define TR_DESC(d, item) do { int r = (item); \
        if (r < I_W1) { const int e = r >> 10, rr = r & 1023, kb = rr >> 6, nb = rr & 63, n0 = 32 * nb, bj = n0 >> 10, rem = n0 & 1023, pn = rem >> 7, jj = rem & 127; \
            d.W = w1p + (size_t)e * 1024 * 2048 + (size_t)(64 * kb) * 2048 + n0; d.WT = (bf16*)((unsigned char*)w1t + (size_t)e * 2048 * 1024 + (size_t)(pn * 256 + bj * 128 + jj) * 1024 + 64 * kb); d.ldw = 2048; d.ldt = -1024; } \
        else if ((r -= I_W1) < I_W2) { const int e = r >> 9, rr = r & 511, kb = rr >> 5, nb = rr & 31; \
            d.W = w2p + (size_t)e * 1024 * 1024 + (size_t)(64 * kb) * 1024 + 32 * nb; d.WT = (bf16*)((unsigned char*)w2t + (size_t)e * 1024 * 1024 + (size_t)(32 * nb) * 1024 + 64 * kb); d.ldw = 1024; d.ldt = -1024; } \
        else if ((r -= I_W2) < I_IN) { const int kb = r >> 6, nb = r & 63; d.W = winp + (size_t)(64 * kb) * 2048 + 32 * nb; d.WT = wint + (size_t)(32 * nb) * 1024 + 64 * kb; d.ldw = 2048; d.ldt = 1024; } \
        else if ((r -= I_IN) < I_OUT) { const int kb = r >> 5, nb = r & 31; d.W = woutp + (size_t)(64 * kb) * 1024 + 32 * nb; d.WT = (bf16*)((unsigned char*)woutt + (size_t)(32 * nb) * 1024 + 64 * kb); d.ldw = 1024; d.ldt = -1024; } \
        else { r -= I_OUT; const int kb = r >> 4, nb = r & 15; d.W = wglup + (size_t)(64 * kb) * 512 + 32 * nb; d.WT = wglut + (size_t)(32 * nb) * 512 + 64 * kb; d.ldw = 512; d.ldt = 512; } } while (0)
    { TrItem dc, dn; int it = lo + gw, par = 0;
      if (it < NITEMS) { TR_DESC(dc, it); tr_dma(dc, scr, F.lane); }
      while (it < NITEMS) { const int nx = it + NGW;
          if (nx < NITEMS) { TR_DESC(dn, nx); tr_dma(dn, scr + (par ^ 1) * 2048, F.lane); asm volatile("s_waitcnt vmcnt(8)" ::: "memory"); }
          else { asm volatile("s_waitcnt vmcnt(0)" ::: "memory"); }
          tr_out(dc, scr + par * 2048, F.lane);
          LDS_WAIT(); asm volatile("" ::: "memory");
          dc = dn; it = nx; par ^= 1; }
      asm volatile("s_waitcnt vmcnt(0)" ::: "memory"); }
}
__device__ __forceinline__ void trq_load(v4u (&r)[8], const TrItem& d, int lane) {
    const int kr = lane >> 3, q = lane & 7;
#pragma unroll
    for (int i = 0; i < 8; ++i) { const float* p = d.W + (size_t)(8 * i) * d.ldw; const unsigned voff = (unsigned)(kr * d.ldw + 4 * ((q - i) & 7)) * 4u;
        asm volatile("global_load_dwordx4 %0, %1, %2 nt" : "=v"(r[i]) : "v"(voff), "s"(p) : "memory"); }
}
__device__ __forceinline__ void tr_run_deep(Frame& F, const int lo, const int hi, const int gw, const int NGW) {
    LAS float* scr = (LAS float*)(F.lds + RING_OFF + F.wave * 16384);
    constexpr int I_W1 = TR_I_W1, I_W2 = TR_I_W2, I_IN = TR_I_IN, I_OUT = TR_I_OUT;
    const float* w1p = inp(25); const float* w2p = inp(27); const float* winp = inp(5); const float* woutp = inp(21); const float* wglup = inp(19);
    bf16* w1t = (bf16*)(F.ws + WS_W1T); bf16* w2t = (bf16*)(F.ws + WS_W2T); bf16* wint = (bf16*)(F.ws + WS_WIN); bf16* woutt = (bf16*)(F.ws + WS_WOUT); bf16* wglut = (bf16*)(F.ws + WS_WGLU);
    if (lo + gw >= hi) return;
    const int n_it = (hi - lo - gw + NGW - 1) / NGW;
#define TRQ_DESC(d, j) do { const int jc_ = (j) < n_it ? (j) : n_it - 1; TR_DESC(d, lo + gw + jc_ * NGW); } while (0)
#define TRQ_STEP(r, d, j, par) do { \
        asm volatile("s_waitcnt vmcnt(16)" : "+v"(r[0]), "+v"(r[1]), "+v"(r[2]), "+v"(r[3]), "+v"(r[4]), "+v"(r[5]), "+v"(r[6]), "+v"(r[7]) :: "memory"); \
        LAS float* buf_ = scr + (par) * 2048; const bool live_ = (j) < n_it; \
        if (live_) { _Pragma("unroll") for (int i_ = 0; i_ < 8; ++i_) *(LAS v4u*)(buf_ + i_ * 256 + F.lane * 4) = r[i_]; } \
        LDS_WAIT(); TrItem dn_; TRQ_DESC(dn_, (j) + 3); trq_load(r, dn_, F.lane); \
        if (live_) tr_out(d, buf_, F.lane); \
        d = dn_; } while (0)
    v4u r0[8], r1[8], r2[8]; TrItem d0, d1, d2;
    TRQ_DESC(d0, 0); trq_load(r0, d0, F.lane); TRQ_DESC(d1, 1); trq_load(r1, d1, F.lane); TRQ_DESC(d2, 2); trq_load(r2, d2, F.lane);
    for (int j = 0; j < n_it; j += 6) {
        TRQ_STEP(r0, d0, j, 0); TRQ_STEP(r1, d1, j + 1, 1); TRQ_STEP(r2, d2, j + 2, 0);
        TRQ_STEP(r0, d0, j + 3, 1); TRQ_STEP(r1, d1, j + 4, 0); TRQ_STEP(r2, d2, j + 5, 1); }
    asm volatile("s_waitcnt vmcnt(0)" : "+v"(r0[0]), "+v"(r0[1]), "+v"(r0[2]), "+v"(r0[3]), "+v"(r0[4]), "+v"(r0[5]), "+v"(r0[6]), "+v"(r0[7]) :: "memory");
    asm volatile("" : "+v"(r1[0]), "+v"(r1[1]), "+v"(r1[2]), "+v"(r1[3]), "+v"(r1[4]), "+v"(r1[5]), "+v"(r1[6]), "+v"(r1[7]) :: "memory");
    asm volatile("" : "+v"(r2[0]), "+v"(r2[1]), "+v"(r2[2]), "+v"(r2[3]), "+v"(r2[4]), "+v"(r2[5]), "+v"(r2[6]), "+v"(r2[7]) :: "memory");
#undef TRQ_STEP
#undef TRQ_DESC
}
#undef TR_DESC
__device__ __forceinline__ void dep_signal(Frame& F, int word);
__device__ __forceinline__ void p0_prologue(Frame& F, int mode = 0) {
    { const float* wr = inp(23); bf16* wh = (bf16*)(F.ws + WS_WRH); bf16* wl = (bf16*)(F.ws + WS_WRL);
      for (int idx = F.vcu * 512 + F.tid; idx < 32768; idx += F.G * 512) { const int k = idx >> 5, e = idx & 31; const float w = wr[idx]; const unsigned hi = f2bf(w);
          wh[e * 1024 + k] = (bf16)hi; wl[e * 1024 + k] = (bf16)f2bf(w - __builtin_bit_cast(float, hi << 16)); } }
    const bool tab_last = (mode == 0) && !(F.vcu & 1);
    if (mode != 2 && mode != 4 && !tab_last) { for (int it = F.vcu; it < 256; it += F.G) ssm_tables_item(F, it >> 3, it & 7); }
    if (mode != 2 && mode != 3) { for (int it = F.vcu; it < 192; it += F.G) modp_item(F, it); }
    if (mode == 0) dep_signal(F, CW_DEP0);
    if (mode == 1 || mode == 3 || mode == 4) return;
    if (F.G == 256) tr_run(F, TR_HOSTED, TR_NITEMS, F.vcu * NWAVES + F.wave, F.G * NWAVES);
    else tr_run(F, 0, TR_NITEMS, F.vcu * NWAVES + F.wave, F.G * NWAVES);
    if (tab_last) { LDS_WAIT(); __syncthreads(); for (int it = F.vcu; it < 256; it += F.G) ssm_tables_item(F, it >> 3, it & 7); }
}
__device__ __forceinline__ void p1_h1(Frame& F) {
    const int bx = blockIdx.x, rows_per = NTOK / F.G, row_base = bx * rows_per, b = row_base >> 12;
    LAS float* vec = (LAS float*)(F.lds + VEC_OFF);
    const float* b_ada = inp(3); const float* n1g = inp(4); const float* xin = inp(0);
    { float mv[4];
#pragma unroll
      for (int q = 0; q < 4; ++q) mv[q] = mod_value(F, b_ada, b, F.tid + 512 * q);
#pragma unroll
      for (int q = 0; q < 4; ++q) { const int n = F.tid + 512 * q; float v = mv[q]; if (n >= 1024) v = (1.0f + v) * n1g[n - 1024]; vec[n] = v; } }
    { const int per = (NB * 6144) / F.G; float* mf = (float*)(F.ws + WS_MODF);
      for (int i = F.tid; i < per; i += 512) { const int idx = bx * per + i; mf[idx] = mod_value(F, b_ada, idx / 6144, idx % 6144); } }
    __syncthreads();
    bf16* H = (bf16*)(F.ws + WS_H);
    for (int r = F.wave; r < rows_per; r += NWAVES) { const size_t row = (size_t)(row_base + r);
        const GAS f32x4* xr = (const GAS f32x4*)(xin + row * DM) + F.lane; f32x4 v[4]; float s = 0.f;
#pragma unroll
        for (int j = 0; j < 4; ++j) { v[j] = __builtin_nontemporal_load((const f32x4*)(xr + 64 * j)); s += (v[j].x * v[j].x + v[j].y * v[j].y) + (v[j].z * v[j].z + v[j].w * v[j].w); }
        const float rs = 1.0f / sqrtf(wave_sum_u(s) * (1.f / DM) + 1e-6f);
        GAS v2u* o8 = (GAS v2u*)(H + row * DM) + F.lane;
#pragma unroll
        for (int j = 0; j < 4; ++j) { const int c = 256 * j + 4 * F.lane; const f32x4 sh = *(LAS f32x4*)(vec + c), sc = *(LAS f32x4*)(vec + 1024 + c); const f32x4 h = v[j] * rs * sc + sh;
            v2u w; w.x = pk2(h.x, h.y); w.y = pk2(h.z, h.w); o8[64 * j] = w; } }
}
__device__ __forceinline__ void p4_combine(Frame& F) {
    const float lam = __expf(wave_sum(inp(6)[F.lane] * inp(7)[F.lane])) - __expf(wave_sum(inp(8)[F.lane] * inp(9)[F.lane])) + 0.2f;
    const bf16* OB = (const bf16*)(F.ws + WS_OB); bf16* MIX = (bf16*)(F.ws + WS_MIX);
    const int h = F.lane >> 4, d0 = (F.lane & 15) * 8; const float* sg = inp(10) + d0;
    float gs[8];
#pragma unroll
    for (int j = 0; j < 8; ++j) gs[j] = sg[j] * 0.8f;
    const int gw = F.vcu * NWAVES + F.wave, NGW = F.G * NWAVES;
    for (int tok = gw; tok < NTOK; tok += NGW) {
        const v4u a0 = *(const GAS v4u*)(OB + (size_t)tok * 1024 + (h * 2) * 128 + d0), a1 = *(const GAS v4u*)(OB + (size_t)tok * 1024 + (h * 2 + 1) * 128 + d0);
        float a[8];
        a[0] = pg8::bf_lo(a0.x) - lam * pg8::bf_lo(a1.x); a[1] = pg8::bf_hi(a0.x) - lam * pg8::bf_hi(a1.x); a[2] = pg8::bf_lo(a0.y) - lam * pg8::bf_lo(a1.y); a[3] = pg8::bf_hi(a0.y) - lam * pg8::bf_hi(a1.y);
        a[4] = pg8::bf_lo(a0.z) - lam * pg8::bf_lo(a1.z); a[5] = pg8::bf_hi(a0.z) - lam * pg8::bf_hi(a1.z); a[6] = pg8::bf_lo(a0.w) - lam * pg8::bf_lo(a1.w); a[7] = pg8::bf_hi(a0.w) - lam * pg8::bf_hi(a1.w);
        float ss = 0.f;
#pragma unroll
        for (int j = 0; j < 8; ++j) ss += a[j] * a[j];
        ss += __shfl_xor(ss, 1); ss += __shfl_xor(ss, 2); ss += __shfl_xor(ss, 4); ss += __shfl_xor(ss, 8);
        const float rs = 1.0f / sqrtf(ss * (1.f / 128.f) + 1e-6f);
        v4u o; o.x = pk2(a[0] * rs * gs[0], a[1] * rs * gs[1]); o.y = pk2(a[2] * rs * gs[2], a[3] * rs * gs[3]); o.z = pk2(a[4] * rs * gs[4], a[5] * rs * gs[5]); o.w = pk2(a[6] * rs * gs[6], a[7] * rs * gs[7]);
        *(GAS v4u*)(MIX + (size_t)tok * 1024 + h * 128 + d0) = o;
    }
}
constexpr int WRB = 2064;
constexpr int SEL_OFF = 140288;
static_assert(4 * 16 * WRB <= VEC_OFF, "router weights in LDS");
__device__ __forceinline__ void ins4(float v, int i, float (&tv)[4], int (&ti)[4]) {
#pragma unroll
    for (int k = 0; k < 4; ++k) { const bool better = v > tv[k] || (v == tv[k] && i < ti[k]); const float ov = tv[k]; const int oi = ti[k]; tv[k] = better ? v : ov; ti[k] = better ? i : oi; v = better ? ov : v; i = better ? oi : i; }
}
__device__ __forceinline__ void p6_fill(Frame& F) {
    const int bx = blockIdx.x, rows_per = NTOK / F.G, row_base = bx * rows_per, b = row_base >> 12;
    LAS float* vec = (LAS float*)(F.lds + VEC_OFF);
    LAS unsigned* hist = (LAS unsigned*)(F.lds + SEL_OFF) + 1536;
    const float* n2g = inp(22); const float* mf = (const float*)(F.ws + WS_MODF) + (size_t)b * 6144;
    __syncthreads();
    { const unsigned char* wsrc = F.ws + WS_WRH;
      v4u wt[16];
#pragma unroll
      for (int i = 0; i < 16; ++i) { const int c = F.tid + 512 * i, row = c >> 7, col = c & 127; wt[i] = *(const GAS v4u*)(wsrc + (size_t)row * 2048 + col * 16); }
#pragma unroll
      for (int i = 0; i < 16; ++i) { const int c = F.tid + 512 * i, row = c >> 7, col = c & 127; *(LAS v4u*)(F.lds + RING_OFF + row * WRB + col * 16) = wt[i]; } }
    for (int n = F.tid; n < 1024; n += 512) { vec[n] = mf[3072 + n]; vec[1024 + n] = (1.0f + mf[4096 + n]) * n2g[n]; }
    if (F.tid < 32) hist[F.tid] = 0u;
    __syncthreads();
}
__device__ __forceinline__ void p6_router(Frame& F, bool dummy = false, bool filled = false) {
    const int bx = blockIdx.x, rows_per = NTOK / F.G, row_base = bx * rows_per;
    LAS float* vec = (LAS float*)(F.lds + VEC_OFF);
    LAS unsigned* sel_e = (LAS unsigned*)(F.lds + SEL_OFF); LAS unsigned* sel_r = sel_e + 512; LAS float* sel_g = (LAS float*)(sel_r + 512); LAS unsigned* hist = (LAS unsigned*)(sel_g + 512); LAS unsigned* base = hist + 32;
    if (!filled) p6_fill(F);
    unsigned char* H = (unsigned char*)(F.ws + WS_H); const bf16* X1 = (const bf16*)(F.ws + WS_X1B);
    int* ptok = (int*)(F.ws + (dummy ? WS_Q : WS_PTOK)); unsigned* slot = (unsigned*)(F.ws + (dummy ? WS_Q + 8 * MiB : WS_SLOT)); float* gate = (float*)(F.ws + (dummy ? WS_Q + 16 * MiB : WS_GATE));
    const int cwc = dummy ? CW_CNT + 2048 : CW_CNT;
    const int t = F.lane & 15, kg = F.lane >> 4;
    for (int r0 = 16 * F.wave; r0 < rows_per; r0 += 16 * NWAVES) { const int tok = row_base + r0 + t;
        const GAS v4u* xp = (const GAS v4u*)(X1 + (size_t)tok * DM + 8 * kg);
        v4u xr[32]; float ss = 0.f;
#pragma unroll
        for (int s = 0; s < 32; ++s) xr[s] = xp[4 * s];
#pragma unroll
        for (int s = 0; s < 32; ++s) { const float x0 = pg8::bf_lo(xr[s].x), x1 = pg8::bf_hi(xr[s].x), x2 = pg8::bf_lo(xr[s].y), x3 = pg8::bf_hi(xr[s].y), x4 = pg8::bf_lo(xr[s].z), x5 = pg8::bf_hi(xr[s].z), x6 = pg8::bf_lo(xr[s].w), x7 = pg8::bf_hi(xr[s].w);
            ss += ((x0 * x0 + x1 * x1) + (x2 * x2 + x3 * x3)) + ((x4 * x4 + x5 * x5) + (x6 * x6 + x7 * x7)); }
        ss += __shfl_xor(ss, 16); ss += __shfl_xor(ss, 32);
        const float rs = 1.0f / sqrtf(ss * (1.f / DM) + 1e-6f);
        f32x4 acc0 = {0.f, 0.f, 0.f, 0.f}, acc1 = {0.f, 0.f, 0.f, 0.f};
        GAS unsigned char* hp = (GAS unsigned char*)(H + (size_t)tok * DM + 8 * kg);
        const LAS unsigned char* wa = F.lds + RING_OFF + t * WRB + 16 * kg;
        const LAS float* vp = vec + 8 * kg;
#pragma unroll
        for (int s = 0; s < 32; ++s) {
            const f32x4 sh0 = *(const LAS f32x4*)(vp), sh1 = *(const LAS f32x4*)(vp + 4), sc0 = *(const LAS f32x4*)(vp + 1024), sc1 = *(const LAS f32x4*)(vp + 1024 + 4);
            v4u xs = xr[s]; asm volatile("" : "+v"(xs));
            const f32x4 xa = {pg8::bf_lo(xs.x), pg8::bf_hi(xs.x), pg8::bf_lo(xs.y), pg8::bf_hi(xs.y)}, xb = {pg8::bf_lo(xs.z), pg8::bf_hi(xs.z), pg8::bf_lo(xs.w), pg8::bf_hi(xs.w)};
            const f32x4 h0 = xa * rs * sc0 + sh0, h1 = xb * rs * sc1 + sh1;
            const pg8::u32x4 bh = pg8::pack8(h0, h1);
            const f32x4 d0 = h0 - (f32x4){pg8::bf_lo(bh.x), pg8::bf_hi(bh.x), pg8::bf_lo(bh.y), pg8::bf_hi(bh.y)}, d1 = h1 - (f32x4){pg8::bf_lo(bh.z), pg8::bf_hi(bh.z), pg8::bf_lo(bh.w), pg8::bf_hi(bh.w)};
            const pg8::u32x4 bl = pg8::pack8(d0, d1);
            *(GAS pg8::i32x2*)(hp + 32 * s) = pg8::pack8_fp8(h0 * pg8::F8_ACT, h1 * pg8::F8_ACT);
            const pg8::bf16x8 Bh = __builtin_bit_cast(pg8::bf16x8, bh), Bl = __builtin_bit_cast(pg8::bf16x8, bl);
            const pg8::bf16x8 Ah0 = *(const LAS pg8::bf16x8*)(wa), Ah1 = *(const LAS pg8::bf16x8*)(wa + 16 * WRB), Al0 = *(const LAS pg8::bf16x8*)(wa + 32 * WRB), Al1 = *(const LAS pg8::bf16x8*)(wa + 48 * WRB);
            acc0 = __builtin_amdgcn_mfma_f32_16x16x32_bf16(Ah0, Bh, acc0, 0, 0, 0); acc1 = __builtin_amdgcn_mfma_f32_16x16x32_bf16(Ah1, Bh, acc1, 0, 0, 0);
            acc0 = __builtin_amdgcn_mfma_f32_16x16x32_bf16(Ah0, Bl, acc0, 0, 0, 0); acc1 = __builtin_amdgcn_mfma_f32_16x16x32_bf16(Ah1, Bl, acc1, 0, 0, 0);
            acc0 = __builtin_amdgcn_mfma_f32_16x16x32_bf16(Al0, Bh, acc0, 0, 0, 0); acc1 = __builtin_amdgcn_mfma_f32_16x16x32_bf16(Al1, Bh, acc1, 0, 0, 0);
            wa += 64; vp += 32;
            asm volatile("" : "+v"(wa), "+v"(vp), "+v"(acc0), "+v"(acc1)); }
        const float* br = inp(24) + 4 * kg;
        float tv[4] = {-INFINITY, -INFINITY, -INFINITY, -INFINITY}; int ti[4] = {99, 99, 99, 99};
#pragma unroll
        for (int r = 0; r < 4; ++r) ins4(acc0[r] + br[r], 4 * kg + r, tv, ti);
#pragma unroll
        for (int r = 0; r < 4; ++r) ins4(acc1[r] + br[16 + r], 16 + 4 * kg + r, tv, ti);
#pragma unroll
        for (int xr_ = 16; xr_ <= 32; xr_ <<= 1) { float ov[4]; int oi[4];
#pragma unroll
            for (int k = 0; k < 4; ++k) { ov[k] = __shfl_xor(tv[k], xr_); oi[k] = __shfl_xor(ti[k], xr_); }
#pragma unroll
            for (int k = 0; k < 4; ++k) ins4(ov[k], oi[k], tv, ti); }
        { const int k = kg;
          const float e1 = __expf(tv[1] - tv[0]), e2 = __expf(tv[2] - tv[0]), e3 = __expf(tv[3] - tv[0]); const float inv = 1.0f / (1.0f + e1 + e2 + e3);
          const int ek = k == 0 ? ti[0] : k == 1 ? ti[1] : k == 2 ? ti[2] : ti[3]; const float gk = (k == 0 ? 1.0f : k == 1 ? e1 : k == 2 ? e2 : e3) * inv;
          const unsigned rank = __hip_atomic_fetch_add(hist + ek, 1u, __ATOMIC_RELAXED, __HIP_MEMORY_SCOPE_WORKGROUP);
          const int q = (r0 + t) * 4 + k; sel_e[q] = (unsigned)ek; sel_r[q] = rank; sel_g[q] = gk; }
    }
    LDS_WAIT(); __syncthreads();
    if (F.tid < 32) base[F.tid] = __hip_atomic_fetch_add((unsigned*)(F.ctl + cwc + 64 * F.tid), hist[F.tid], RLX_AGENT);
    LDS_WAIT(); __syncthreads();
    { const int q = F.tid, tok = row_base + (q >> 2), k = q & 3; const unsigned ek = sel_e[q], pos = base[ek] + sel_r[q];
      ptok[(size_t)ek * NTOK + pos] = tok; slot[(size_t)tok * 4 + k] = (ek << 16) | pos; gate[(size_t)tok * 4 + k] = sel_g[q]; }
}
__device__ __forceinline__ void moe_tables(Frame& F) {
    LAS unsigned char* tile_e = (LAS unsigned char*)(F.lds + TILE_E_OFF); LAS int* tile0 = (LAS int*)(F.lds + TILE0_OFF); LAS int* cntl = (LAS int*)(F.lds + CNTL_OFF); LAS int* Tp = (LAS int*)(F.lds + MOE_T_OFF);
    if (F.tid < 32) { const int c = (int)__hip_atomic_load((unsigned*)(F.ctl + CW_CNT + 64 * F.tid), RLX_AGENT); const int nt = (c + 255) >> 8; int incl = nt;
#pragma unroll
        for (int o = 1; o < 32; o <<= 1) { const int w = __shfl_up(incl, o); if (F.tid >= o) incl += w; }
        const int excl = incl - nt; tile0[F.tid] = excl; cntl[F.tid] = c; if (F.tid == 31) Tp[0] = incl;
        for (int k = 0; k < nt; ++k) tile_e[excl + k] = (unsigned char)F.tid; }
    __syncthreads();
}
struct MoeSched {
    const LAS unsigned char* tile_e; const LAS int* tile0; const LAS unsigned* rowtab; int T, nN, G, c, rev, a_mask, e_mask; size_t tA, tBe, tB;
    __device__ __forceinline__ bool next(int i, pg8::Unit& u) const { const int x = c & 7, y = c >> 3, tpx = 32 / nN, t = (i * 8 + x) * tpx + (y % tpx); if (t >= T) return false; u.pm = rev ? T - 1 - t : t; u.pn = y / tpx; u.e = __builtin_amdgcn_readfirstlane((int)tile_e[u.pm]); return true; }
    __device__ __forceinline__ size_t aoff(const pg8::Unit& u) const { return (size_t)(u.pm & a_mask) * tA; }
    __device__ __forceinline__ size_t boff(const pg8::Unit& u) const { return (size_t)(u.e & e_mask) * tBe + (size_t)u.pn * tB; }
    __device__ __forceinline__ unsigned rowoff(int i, int r) const { return rowtab[i * 256 + r]; }
};
__device__ __forceinline__ void p9_final(Frame& F, bool dummy = false) {
    const int bx = blockIdx.x, rows_per = NTOK / F.G, row_base = bx * rows_per, b = row_base >> 12;
    if (MK_PER_PHASE || dummy) moe_tables(F);
    const LAS int* tile0 = (const LAS int*)(F.lds + TILE0_OFF);
    const float* g2 = (const float*)(F.ws + WS_MODF) + (size_t)b * 6144 + 5120; const float* fg = inp(29);
    const unsigned char* Y2 = (const unsigned char*)(F.ws + WS_Y2); const unsigned* slot = (const unsigned*)(F.ws + WS_SLOT); const float* gate = (const float*)(F.ws + WS_GATE);
    f32x4 g2v[4], fgv[4];
#pragma unroll
    for (int j = 0; j < 4; ++j) { g2v[j] = *(const f32x4*)(g2 + 256 * j + 4 * F.lane); fgv[j] = *(const f32x4*)(fg + 256 * j + 4 * F.lane); }
    for (int r = F.wave; r < rows_per; r += NWAVES) { const int tok = row_base + r;
        f32x4 acc[4];
#pragma unroll
        for (int j = 0; j < 4; ++j) acc[j] = (f32x4){0.f, 0.f, 0.f, 0.f};
#pragma unroll
        for (int k = 0; k < 4; ++k) { const unsigned sw = slot[(size_t)tok * 4 + k]; const float gk = gate[(size_t)tok * 4 + k]; const size_t p = (size_t)tile0[sw >> 16] * 256 + (sw & 0xffffu);
            const GAS int* yr = (const GAS int*)(Y2 + p * 1024) + F.lane; const float g8 = gk * 0.125f; typedef float f32x2 __attribute__((ext_vector_type(2)));
#pragma unroll
            for (int j = 0; j < 4; ++j) { const int w = yr[64 * j]; const f32x2 lo = __builtin_amdgcn_cvt_pk_f32_fp8(w, false), hi = __builtin_amdgcn_cvt_pk_f32_fp8(w, true);
                acc[j].x += g8 * lo.x; acc[j].y += g8 * lo.y; acc[j].z += g8 * hi.x; acc[j].w += g8 * hi.y; } }
        const GAS v2u* xr = (const GAS v2u*)((const bf16*)(F.ws + WS_X1B) + (size_t)tok * DM) + F.lane;
        GAS f32x4* xw = (GAS f32x4*)((dummy ? (float*)(F.ws + WS_A2) : F.out) + (size_t)tok * DM) + F.lane; f32x4 v[4]; float s = 0.f;
#pragma unroll
        for (int j = 0; j < 4; ++j) { const v2u wx = xr[64 * j]; v[j] = (f32x4){pg8::bf_lo(wx.x), pg8::bf_hi(wx.x), pg8::bf_lo(wx.y), pg8::bf_hi(wx.y)} + g2v[j] * acc[j]; s += (v[j].x * v[j].x + v[j].y * v[j].y) + (v[j].z * v[j].z + v[j].w * v[j].w); }
        const float rs = 1.0f / sqrtf(wave_sum_u(s) * (1.f / DM) + 1e-6f);
#pragma unroll
        for (int j = 0; j < 4; ++j) __builtin_nontemporal_store(v[j] * rs * fgv[j], (f32x4*)(xw + 64 * j));
    }
}

__device__ __forceinline__ void dep_signal(Frame& F, int word) {
    asm volatile("s_waitcnt vmcnt(0)" ::: "memory"); __syncthreads();
    if (F.wave == 0 && lane_id_opaque() == 0) { __builtin_amdgcn_fence(__ATOMIC_RELEASE, "agent"); asm volatile("s_waitcnt vmcnt(0)" ::: "memory"); (void)xb_add((unsigned*)(F.ctl + word), 1u); }
}
__device__ __forceinline__ void dep_wait(Frame& F, int word, unsigned need) {
    if (F.wave == 0 && lane_id_opaque() == 0) { unsigned* p = (unsigned*)(F.ctl + word); unsigned* bar = (unsigned*)(F.ctl + CW_BAR); XB_SPIN(xb_ld(p) < need, bar);
        __builtin_amdgcn_fence(__ATOMIC_ACQUIRE, "agent"); asm volatile("s_waitcnt vmcnt(0)" ::: "memory"); }
    __syncthreads();
}
#ifndef P2_NG
#define P2_NG 176
#endif
__device__ __forceinline__ void phase0(Frame& F, unsigned char* lds, unsigned char* ws) { p0_prologue(F);  }
__device__ __forceinline__ void phase1(Frame& F, unsigned char* lds, unsigned char* ws) { dep_wait(F, CW_DEP0, (unsigned)F.G); p1_h1(F);  }
__device__ __forceinline__ void phase2(Frame& F, unsigned char* lds, unsigned char* ws) {
        pg8::Gemm g{(const bf16*)(ws + WS_H), (const bf16*)(ws + WS_WIN), 1024, 1024, 1024}; const bool hosted = (F.G == 256); const int ng = hosted ? P2_NG : F.G;
        pg8::StaticOrder S; S.init(NTOK, 2048, ng, (int)blockIdx.x, 1024, 1024);
        pg8::EpiQKVU E{(bf16*)(ws + WS_Q), (size_t)(WS_K - WS_Q) / 2, (bf16*)(ws + WS_UA), attn_body::C2};
        if ((int)blockIdx.x < ng) pg8::gemm_phase<pg8::EpiQKVU, pg8::StaticOrder, true, false>(F.lds + RING_OFF, g, S, E, F.wave);
        else tr_run(F, 0, TR_HOSTED, ((int)blockIdx.x - ng) * NWAVES + F.wave, (F.G - ng) * NWAVES);

    }
__device__ __forceinline__ void phase4_glu(Frame& F, unsigned char* ws) {
        pg8::Gemm g{(const bf16*)(ws + WS_Z), (const bf16*)(ws + WS_WGLU), 512, 512, 512}; pg8::StaticOrder S; S.init(NTOK, 512, F.G, (int)blockIdx.x, 512, 512);
        { pg8::Unit u; const bool one = (F.G == 256) && S.next(0, u);
          if (one) dep_wait(F, CW_DEPB + 16 * (u.pm >> 4), 32u);
          else { for (int bb = 0; bb < NB; ++bb) dep_wait(F, CW_DEPB + 16 * bb, 32u); } }
        pg8::EpiGLU E{(const bf16*)(ws + WS_Z), (bf16*)(ws + WS_MIX), inp(20)};
        pg8::gemm_phase<pg8::EpiGLU, pg8::StaticOrder, true, false>(F.lds + RING_OFF, g, S, E, F.wave);
        __syncthreads();
    }
__device__ __forceinline__ void phase3(Frame& F, unsigned char* lds, unsigned char* ws) {
        for (int it = F.vcu; it < 256; it += F.G) { const int g = it >> 3, b = it & 7;
            bf16* UAgb = (bf16*)(ws + WS_UA) + (size_t)((g * 8 + b) * 256) * 384;
            { pg8::Gemm gx{UAgb, (const bf16*)(ws + WS_WM) + (size_t)g * 256 * 256, 256, 384, 256}; pg8::SingleUnit S; pg8::EpiX E;
              pg8::gemm_phase<pg8::EpiX, pg8::SingleUnit, false, false>(F.lds + RING_OFF, gx, S, E, F.wave); }
            LDS_WAIT(); __syncthreads();
            {
                const int p = lane_id_opaque(), c0 = F.wave * 32; const float* L16 = (const float*)(ws + WS_LAM16) + (g * 64 + p) * 2; const float lr = L16[0], li = L16[1];
                LAS float* X = (LAS float*)(F.lds + RING_OFF); LAS float* EW = X + 256 * pg8::XS;
                float hr = 0.f, hi2 = 0.f;
#pragma unroll 8
                for (int k = 0; k < 32; ++k) { LAS float* xc = X + (c0 + k) * pg8::XS + p; const float xr = xc[0], xi = xc[64]; xc[0] = hr; xc[64] = hi2;
                    const float nr = lr * hr - li * hi2 + xr, ni = lr * hi2 + li * hr + xi; hr = nr; hi2 = ni; }
                EW[F.wave * 128 + p] = hr; EW[F.wave * 128 + 64 + p] = hi2;
                float qr = lr, qi = li;
#pragma unroll
                for (int sq = 0; sq < 5; ++sq) { const float t = qr * qr - qi * qi; qi = 2.f * qr * qi; qr = t; }
                LDS_WAIT(); __syncthreads();
                float cr = 0.f, ci = 0.f;
                for (int v = 0; v < F.wave; ++v) { const float er = EW[v * 128 + p], ei = EW[v * 128 + 64 + p]; const float nr = qr * cr - qi * ci + er, ni = qr * ci + qi * cr + ei; cr = nr; ci = ni; }
                bf16* hrow = UAgb + (size_t)c0 * 384 + 256 + p; float pr = 1.f, pi = 0.f;
#pragma unroll 8
                for (int k = 0; k < 32; ++k) { const LAS float* xc = X + (c0 + k) * pg8::XS + p; const float hr2 = xc[0] + (pr * cr - pi * ci), hi3 = xc[64] + (pr * ci + pi * cr);
                    hrow[(size_t)k * 384] = (bf16)f2bf(hr2); hrow[(size_t)k * 384 + 64] = (bf16)f2bf(hi3);
                    const float t = pr * lr - pi * li; pi = pr * li + pi * lr; pr = t; }
                VM_WAIT(); if (F.wave == 0) { __builtin_amdgcn_fence(__ATOMIC_ACQUIRE, "agent"); VM_WAIT(); } }
            LDS_WAIT(); __syncthreads();
            { pg8::Gemm gy{UAgb, (const bf16*)(ws + WS_TV) + (size_t)g * 256 * 384, 384, 384, 384}; pg8::SingleUnit S; pg8::EpiY E{(bf16*)(ws + WS_Z), g, b};
              pg8::gemm_phase<pg8::EpiY, pg8::SingleUnit, false, false>(F.lds + RING_OFF, gy, S, E, F.wave); }
            dep_signal(F, CW_DEPB + 16 * b);
        }
        static_assert(attn_body::LDS2_BYTES <= LDSCTL_OFF, "attention LDS vs control words");
        for (int it = F.vcu; it < 256; it += F.G) { const int bh = it >> 3, sdx = it & 7, b = bh >> 2, h = bh & 3;
            for (int i4 = 0; i4 < 4; ++i4) { const int qb = (i4 >> 1) ? 15 - sdx : sdx;
                { const int m = i4 & 1, hm = h * 2 + m;
                    const attn_body::bf16* q_ = (const attn_body::bf16*)(ws + WS_Q) + (size_t)b * SEQ * 512 + hm * 64; const attn_body::bf16* k_ = (const attn_body::bf16*)(ws + WS_K) + (size_t)b * SEQ * 512 + hm * 64;
                    const attn_body::bf16* v_ = (const attn_body::bf16*)(ws + WS_V) + (size_t)b * SEQ * 512 + h * 128; attn_body::bf16* o_ = (attn_body::bf16*)(ws + WS_OB) + (size_t)b * SEQ * 1024 + hm * 128;
                    asm volatile("" : "+s"(q_), "+s"(k_), "+s"(v_), "+s"(o_));
                    attn_body::attn_unit2<8>(qb, q_, k_, v_, o_, (char*)lds + RING_OFF, F.wave); }
                if (i4 & 1) { VM_WAIT(); __syncthreads();
 const int ln = lane_id_opaque(), t16 = F.wave * 4 + (ln >> 4), d0 = (ln & 15) * 8; const float* sg = inp(10) + d0;
                  const float lam = __expf(wave_sum(inp(6)[ln] * inp(7)[ln])) - __expf(wave_sum(inp(8)[ln] * inp(9)[ln])) + 0.2f;
                  const bf16* OB = (const bf16*)(ws + WS_OB); bf16* MIX = (bf16*)(ws + WS_MIX);
                  v4u a0v[8], a1v[8];
#pragma unroll
                  for (int p = 0; p < 8; ++p) { const size_t tok = (size_t)b * SEQ + qb * 256 + p * 32 + t16; a0v[p] = *(const GAS v4u*)(OB + tok * 1024 + (h * 2) * 128 + d0); a1v[p] = *(const GAS v4u*)(OB + tok * 1024 + (h * 2 + 1) * 128 + d0); }
#pragma unroll
                  for (int p = 0; p < 8; ++p) { const size_t tok = (size_t)b * SEQ + qb * 256 + p * 32 + t16;
                      const v4u a0 = a0v[p], a1 = a1v[p];
                      float a[8];
                      a[0] = pg8::bf_lo(a0.x) - lam * pg8::bf_lo(a1.x); a[1] = pg8::bf_hi(a0.x) - lam * pg8::bf_hi(a1.x); a[2] = pg8::bf_lo(a0.y) - lam * pg8::bf_lo(a1.y); a[3] = pg8::bf_hi(a0.y) - lam * pg8::bf_hi(a1.y);
                      a[4] = pg8::bf_lo(a0.z) - lam * pg8::bf_lo(a1.z); a[5] = pg8::bf_hi(a0.z) - lam * pg8::bf_hi(a1.z); a[6] = pg8::bf_lo(a0.w) - lam * pg8::bf_lo(a1.w); a[7] = pg8::bf_hi(a0.w) - lam * pg8::bf_hi(a1.w);
                      float ss = 0.f;
#pragma unroll
                      for (int j = 0; j < 8; ++j) ss += a[j] * a[j];
                      ss += __shfl_xor(ss, 1); ss += __shfl_xor(ss, 2); ss += __shfl_xor(ss, 4); ss += __shfl_xor(ss, 8);
                      const float rs = 0.8f / sqrtf(ss * (1.f / 128.f) + 1e-6f);
                      const float r4 = rs * 4.0f; const pg8::f32x4 q0 = {a[0] * r4 * sg[0], a[1] * r4 * sg[1], a[2] * r4 * sg[2], a[3] * r4 * sg[3]}, q1 = {a[4] * r4 * sg[4], a[5] * r4 * sg[5], a[6] * r4 * sg[6], a[7] * r4 * sg[7]};
                      *(GAS pg8::i32x2*)((unsigned char*)MIX + tok * 1024 + h * 128 + d0) = pg8::pack8_fp8(q0, q1); } }
            }
        }
        __syncthreads(); phase4_glu(F, ws);
}
__device__ __forceinline__ void phase4(Frame& F, unsigned char* lds, unsigned char* ws) { }
__device__ __forceinline__ void phase5(Frame& F, unsigned char* lds, unsigned char* ws) {
        pg8::Gemm g{(const bf16*)(ws + WS_MIX), (const bf16*)(ws + WS_WOUT), 512, 512, 512}; pg8::StaticOrder S; S.init(NTOK, 1024, F.G, (int)blockIdx.x, 512, 512);
        pg8::EpiOut E{inp(0), (bf16*)(ws + WS_X1B), (const float*)(ws + WS_MODF) + 2048, F.lds + VEC_OFF};
        pg8::gemm_phase<pg8::EpiOut, pg8::StaticOrder, true, false, true>(F.lds + RING_OFF, g, S, E, F.wave);

    }
__device__ __forceinline__ void phase6(Frame& F, unsigned char* lds, unsigned char* ws) { p6_router(F, false, !MK_PER_PHASE);  }
__device__ __forceinline__ void phase7(Frame& F, unsigned char* lds, unsigned char* ws) {
        moe_tables(F);
        MoeSched S; S.tile_e = (const LAS unsigned char*)(F.lds + TILE_E_OFF); S.tile0 = (const LAS int*)(F.lds + TILE0_OFF); S.rowtab = (const LAS unsigned*)(F.lds + ROWTAB_OFF);
        S.T = __builtin_amdgcn_readfirstlane(((const LAS int*)(F.lds + MOE_T_OFF))[0]); S.nN = 8; S.G = F.G; S.c = (int)blockIdx.x; S.rev = 0; S.a_mask = -1; S.e_mask = -1; S.tA = 0; S.tBe = (size_t)2048 * 1024; S.tB = (size_t)256 * 1024;
        { const LAS int* cntl = (const LAS int*)(F.lds + CNTL_OFF); LAS unsigned* rt = (LAS unsigned*)(F.lds + ROWTAB_OFF); const int* ptok = (const int*)(ws + WS_PTOK);
          int tokv[18]; bool live[18];
#pragma unroll
          for (int i = 0; i < 18; ++i) { pg8::Unit u; live[i] = S.next(i, u); tokv[i] = 0;
              if (live[i] && F.tid < 256) { const int e = u.e, pos = (u.pm - S.tile0[e]) * 256 + F.tid; tokv[i] = ptok[(size_t)e * NTOK + (pos < cntl[e] ? pos : 0)]; } }
#pragma unroll
          for (int i = 0; i < 18; ++i) if (live[i] && F.tid < 256) rt[i * 256 + F.tid] = (unsigned)tokv[i] * 1024u; }
        VM_WAIT(); LDS_WAIT(); __syncthreads();
        pg8::Gemm g{(const bf16*)(ws + WS_H), (const bf16*)(ws + WS_W1T), 512, 512, 512};
        pg8::EpiMoe1 E{(unsigned char*)(ws + WS_A2), inp(26), F.lds + BIASL_OFF};
        pg8::gemm_phase<pg8::EpiMoe1, MoeSched, true, true, true>(F.lds + RING_OFF, g, S, E, F.wave);

    }
__device__ __forceinline__ void phase8(Frame& F, unsigned char* lds, unsigned char* ws) {
        if (MK_PER_PHASE) moe_tables(F);
        MoeSched S; S.tile_e = (const LAS unsigned char*)(F.lds + TILE_E_OFF); S.tile0 = (const LAS int*)(F.lds + TILE0_OFF); S.rowtab = (const LAS unsigned*)(F.lds + ROWTAB_OFF);
        S.T = __builtin_amdgcn_readfirstlane(((const LAS int*)(F.lds + MOE_T_OFF))[0]); S.nN = 4; S.G = F.G; S.c = (int)blockIdx.x; S.rev = 1; S.a_mask = -1; S.e_mask = -1; S.tA = (size_t)256 * 1024; S.tBe = (size_t)1024 * 1024; S.tB = (size_t)256 * 1024;
        pg8::Gemm g{(const bf16*)(ws + WS_A2), (const bf16*)(ws + WS_W2T), 512, 512, 512};
        pg8::EpiMoe2 E{(unsigned char*)(ws + WS_Y2), inp(28), -1, F.lds + BIASL_OFF};
        pg8::gemm_phase<pg8::EpiMoe2, MoeSched, true, false, true>(F.lds + RING_OFF, g, S, E, F.wave);

    }
__device__ __forceinline__ void phase9(Frame& F, unsigned char* lds, unsigned char* ws) { p9_final(F); }
__device__ __forceinline__ bool relaunder(Frame& F) { F.lane = lane_id_opaque(); F.tid = F.wave * 64 + F.lane; return true; }
struct Args { const float* in[30]; float* out; unsigned char* ws; int ph_lo, ph_hi; };
__global__ void __launch_bounds__(NWAVES * 64, 2) mega_fwd(Args args) {
    extern __shared__ __attribute__((aligned(16))) unsigned char lds[];
    Frame F;
    F.lds = (LAS unsigned char*)lds;
    F.tid = threadIdx.x; F.lane = F.tid & 63; F.wave = __builtin_amdgcn_readfirstlane(F.tid >> 6);
    F.G = gridDim.x; { const int bx = blockIdx.x; F.vcu = (F.G % 8 == 0) ? (bx % 8) * (F.G / 8) + bx / 8 : bx; }
    F.ws = args.ws; F.out = args.out; F.ctl = (gu32*)(args.ws + WS_CTL);
    volatile LAS unsigned* MISC = (volatile LAS unsigned*)(F.lds + MISC_OFF);
    for (int u = F.tid; u < (LDS_BYTES - LDSCTL_OFF) / 4; u += NWAVES * 64) ((LAS unsigned*)(F.lds + LDSCTL_OFF))[u] = 0u;
    __syncthreads();
    XcdBarrier bar; bar.bar = (unsigned*)(F.ctl + CW_BAR); bar.x = 0; bar.st = nullptr;
    if (!MK_PER_PHASE) bar = xcd_barrier_post((unsigned*)(F.ctl + CW_BAR), MISC + 8);
    const int lo = args.ph_lo, hi = args.ph_hi;
#ifndef MK_MASK
#define MK_MASK 0x3ff
#endif
#define IN(k) (((MK_MASK >> (k)) & 1) && lo <= (k) && (k) < hi && relaunder(F))
#define SEAM(k) do { if (IN(k) && IN((k) + 1)) xcd_barrier(bar, F.wave); } while (0)
    unsigned char* ws = args.ws;

    if (IN(0)) { phase0(F, lds, ws); }
#if MK_DUP == 0
    if (IN(0)) { phase0(F, lds, ws); SEAM(0); }
#endif
    if (IN(1)) { phase1(F, lds, ws); SEAM(1); }
#if MK_DUP == 1
    if (IN(1)) { phase1(F, lds, ws); SEAM(1); }
#endif
    if (IN(2)) { phase2(F, lds, ws); SEAM(2); }
#if MK_DUP == 2
    if (IN(2)) { phase2(F, lds, ws); SEAM(2); }
#endif
#if MK_DUP == 18
    if (IN(2)) { for (int rr = 0; rr < 8; ++rr) { phase2(F, lds, ws); xcd_barrier(bar, F.wave); } }
#endif
    if (IN(3)) { phase3(F, lds, ws); }
#if MK_DUP == 3
    if (IN(3)) { phase3(F, lds, ws); SEAM(3); }
#endif
    if (IN(4)) { phase4(F, lds, ws); SEAM(4); }
#if MK_DUP == 4
    if (IN(4)) { phase4(F, lds, ws); SEAM(4); }
#endif
    if (IN(5)) { phase5(F, lds, ws); if (!MK_PER_PHASE && IN(6)) p6_fill(F); SEAM(5); }
#if MK_DUP == 5
    if (IN(5)) { phase5(F, lds, ws); SEAM(5); }
#endif
#if MK_DUP == 6
    if (IN(6)) { p6_router(F, true); xcd_barrier(bar, F.wave); }
#endif
    if (IN(6)) { phase6(F, lds, ws); SEAM(6); }
    if (IN(7)) { phase7(F, lds, ws); SEAM(7); }
#if MK_DUP == 7
    if (IN(7)) { phase7(F, lds, ws); SEAM(7); }
#endif
    if (IN(8)) { phase8(F, lds, ws); SEAM(8); }
#if MK_DUP == 8
    if (IN(8)) { phase8(F, lds, ws); SEAM(8); }
#endif
#if MK_DUP == 9
    if (IN(9)) { p9_final(F, true); xcd_barrier(bar, F.wave); }
#endif
#if MK_DUP == 16 || MK_DUP == 17
    if (IN(8)) {
        moe_tables(F);
        MoeSched S; S.tile_e = (const LAS unsigned char*)(F.lds + TILE_E_OFF); S.tile0 = (const LAS int*)(F.lds + TILE0_OFF); S.rowtab = (const LAS unsigned*)(F.lds + ROWTAB_OFF);
        S.T = __builtin_amdgcn_readfirstlane(((const LAS int*)(F.lds + MOE_T_OFF))[0]); S.nN = 4; S.G = F.G; S.c = (int)blockIdx.x; S.rev = 1; S.e_mask = (MK_DUP == 16) ? 0 : -1; S.a_mask = (MK_DUP == 16) ? 0 : -1; S.tA = (size_t)256 * 1024; S.tBe = (size_t)1024 * 1024; S.tB = (size_t)256 * 1024;
        pg8::Gemm g{(const bf16*)(ws + WS_A2), (const bf16*)(ws + WS_W2T), 512, 512, 512};
        pg8::EpiMoe2 E{(unsigned char*)(ws + WS_W1T), inp(28), 127};
        pg8::gemm_phase<pg8::EpiMoe2, MoeSched, true, false, true>(F.lds + RING_OFF, g, S, E, F.wave);
        xcd_barrier(bar, F.wave);
    }
#endif
    if (IN(9)) { phase9(F, lds, ws); }
#if MK_DUP == 19
    if (IN(9)) { xcd_barrier(bar, F.wave); phase7(F, lds, ws); }
#endif
#if MK_DUP == 20
    if (IN(9)) { xcd_barrier(bar, F.wave); phase8(F, lds, ws); }
#endif
#if MK_DUP == 10
    if (IN(9)) { xcd_barrier(bar, F.wave); phase0(F, lds, ws); }
#endif
#if MK_DUP == 11
    if (IN(9)) { xcd_barrier(bar, F.wave); p0_prologue(F, 1); }
#endif
#if MK_DUP == 13
    if (IN(9)) { xcd_barrier(bar, F.wave); p0_prologue(F, 3); }
#endif
#if MK_DUP == 14
    if (IN(9)) { xcd_barrier(bar, F.wave); p0_prologue(F, 4); }
#endif
#if MK_DUP == 15
    if (IN(9)) { xcd_barrier(bar, F.wave); }
#endif
#if MK_DUP == 12
    if (IN(9)) { xcd_barrier(bar, F.wave); p0_prologue(F, 2); }
#endif
#undef IN
#undef SEAM
}

extern "C" void kernel_launch(void* const* d_in, const int* in_sizes, int n_in, void* d_out, int out_size, void* d_ws, size_t ws_size, hipStream_t stream) {
    static int grid = 0;
    if (grid == 0) {
        if (n_in != 30 || in_sizes[0] != NTOK * DM || out_size != NTOK * DM || ws_size < WS_END) { fprintf(stderr, "kernel_launch: unexpected shapes (n_in %d, in0 %d, out %d, ws %zu); nothing launched\n", n_in, n_in > 0 ? in_sizes[0] : -1, out_size, ws_size); grid = -1; return; }
        int dev = 0, cus = 0;
        if (hipGetDevice(&dev) != hipSuccess || hipDeviceGetAttribute(&cus, hipDeviceAttributeMultiprocessorCount, dev) != hipSuccess) { fprintf(stderr, "kernel_launch: device query failed\n"); grid = -1; return; }
        if (hipFuncSetAttribute((const void*)mega_fwd, hipFuncAttributeMaxDynamicSharedMemorySize, LDS_BYTES) != hipSuccess) { fprintf(stderr, "kernel_launch: hipFuncSetAttribute failed\n"); grid = -1; return; }
        (void)hipGetLastError();
        grid = cus;
        if (grid != 256) { fprintf(stderr, "kernel_launch: built for a 256-CU device, found %d CUs; nothing launched\n", grid); grid = -1; return; }
    }
    if (grid < 0) return;
    if (hipMemsetAsync((char*)d_ws + WS_CTL, 0, CTL_ZERO_BYTES, stream) != hipSuccess) { fprintf(stderr, "kernel_launch: memset failed\n"); return; }
    Args a{};
    for (int i = 0; i < 30; ++i) a.in[i] = (const float*)d_in[i];
    a.out = (float*)d_out; a.ws = (unsigned char*)d_ws;
#if MK_PER_PHASE
    for (int p = 0; p < N_PHASES; ++p) { a.ph_lo = p; a.ph_hi = p + 1; hipLaunchKernelGGL(mega_fwd, dim3(grid), dim3(NWAVES * 64), LDS_BYTES, stream, a); }
#else
    a.ph_lo = 0; a.ph_hi = N_PHASES; hipLaunchKernelGGL(mega_fwd, dim3(grid), dim3(NWAVES * 64), LDS_BYTES, stream, a);
#endif
    const hipError_t le = hipPeekAtLastError();
    if (le != hipSuccess) fprintf(stderr, "kernel_launch: launch failed: %s\n", hipGetErrorName(le));
}
```

```cpp
#include <hip/hip_runtime.h>
#include <hip/hip_bf16.h>
#include <cstdio>
#include <cstdint>
#include <cmath>

#ifndef MK_PER_PHASE
#define MK_PER_PHASE 0
#endif

#ifdef MK_EPI2
#define MK_EPI2V MK_EPI2
#else
#define MK_EPI2V (-1)
#endif
#ifndef MK_DUP
#define MK_DUP (-1)
#endif

#define LAS __attribute__((address_space(3)))
#define GAS __attribute__((address_space(1)))

__device__ __forceinline__ int lane_id_opaque() { int l = (int)__builtin_amdgcn_mbcnt_hi(~0u, __builtin_amdgcn_mbcnt_lo(~0u, 0u)); asm volatile("" : "+v"(l)); return l; }

namespace pg8 {
typedef unsigned short bf16_t;
typedef short bf16x8 __attribute__((ext_vector_type(8)));
typedef float f32x4 __attribute__((ext_vector_type(4)));
typedef unsigned u32x4 __attribute__((ext_vector_type(4)));
typedef float f32x2 __attribute__((ext_vector_type(2)));
typedef int i32x4 __attribute__((ext_vector_type(4)));
typedef int i32x8 __attribute__((ext_vector_type(8)));
typedef int i32x2 __attribute__((ext_vector_type(2)));
constexpr int BM = 256, BK = 64, HALF = 128, HTB = HALF * BK * 2, STAGE_BYTES = 8 * HTB, NXCD = 8, WGM = 8;

__host__ __device__ __forceinline__ int lds_byte(int r, int c) { const int st = (r >> 4) * 2 + (c >> 5), rr = r & 15, cc = c & 31, ob = rr * 64 + cc * 2; return st * 1024 + (ob ^ (((ob >> 9) & 1) << 5)); }
__host__ __device__ __forceinline__ void stage_rc(int b, int& R, int& C) { const int st = b / 1024, sb = b % 1024, swz = sb ^ (((sb >> 9) & 1) << 5); R = (st >> 1) * 16 + swz / 64; C = (st & 1) * 32 + (swz % 64) / 2; }
__host__ __device__ __forceinline__ int perm32(int rho) { const int n = rho >> 4, i = rho & 15; return 8 * (i >> 2) + 4 * n + (i & 3); }

struct Unit { int pm, pn, e; };
struct Gemm { const bf16_t* A; const bf16_t* Bt; int K, lda, ldb; };

struct StaticOrder {
    int nM, nN, nwg, G, c; size_t tA, tB;
    __device__ __forceinline__ void init(int M, int N, int G_, int c_, int lda, int ldb) { nM = M / BM; nN = N / BM; nwg = nM * nN; G = G_; c = c_; tA = (size_t)BM * lda * 2; tB = (size_t)BM * ldb * 2; }
    __device__ __forceinline__ bool next(int i, Unit& u) const {
        const long L = (long)i * G + c; if (L >= nwg) return false;
        int wgid = (int)L; { const int q = nwg / NXCD, r = nwg % NXCD, xcd = wgid % NXCD, off = wgid / NXCD; wgid = (xcd < r ? xcd * (q + 1) : r * (q + 1) + (xcd - r) * q) + off; }
        const int nig = WGM * nN, gid = wgid / nig, fm = gid * WGM, gsz = (nM - fm) < WGM ? (nM - fm) : WGM;
        u.pm = fm + ((wgid % nig) % gsz); u.pn = (wgid % nig) / gsz; u.e = 0; return true;
    }
    __device__ __forceinline__ size_t aoff(const Unit& u) const { return (size_t)u.pm * tA; }
    __device__ __forceinline__ size_t boff(const Unit& u) const { return (size_t)u.pn * tB; }
    __device__ __forceinline__ unsigned rowoff(int, int) const { return 0u; }
};
struct SingleUnit {
    __device__ __forceinline__ bool next(int i, Unit& u) const { if (i > 0) return false; u.pm = 0; u.pn = 0; u.e = 0; return true; }
    __device__ __forceinline__ size_t aoff(const Unit&) const { return 0; }
    __device__ __forceinline__ size_t boff(const Unit&) const { return 0; }
    __device__ __forceinline__ unsigned rowoff(int, int) const { return 0u; }
};

__device__ __forceinline__ unsigned cvt_pk_bf16(float lo, float hi) { unsigned r; asm volatile("v_cvt_pk_bf16_f32 %0, %1, %2" : "=v"(r) : "v"(lo), "v"(hi)); return r; }
__device__ __forceinline__ float sigm(float x) { return __builtin_amdgcn_rcpf(1.0f + __builtin_amdgcn_exp2f(-1.4426950408889634f * x)); }
__device__ __forceinline__ float gelu_tanh(float y) { return y * sigm(1.5957691216057308f * (y + 0.044715f * y * y * y)); }
__device__ __forceinline__ f32x2 gelu_tanh2(f32x2 y) {
    const f32x2 y2 = y * y, u = y * __builtin_elementwise_fma(y2, (f32x2){0.044715f, 0.044715f}, (f32x2){1.f, 1.f}), ea = u * (-1.5957691216057308f * 1.4426950408889634f);
    f32x2 d; d.x = __builtin_amdgcn_exp2f(ea.x); d.y = __builtin_amdgcn_exp2f(ea.y); d = d + 1.0f; f32x2 r; r.x = __builtin_amdgcn_rcpf(d.x); r.y = __builtin_amdgcn_rcpf(d.y); return y * r; }
__device__ __forceinline__ u32x4 pack8(const f32x4& a, const f32x4& b) { u32x4 w; w.x = cvt_pk_bf16(a[0], a[1]); w.y = cvt_pk_bf16(a[2], a[3]); w.z = cvt_pk_bf16(b[0], b[1]); w.w = cvt_pk_bf16(b[2], b[3]); return w; }
__device__ __forceinline__ float clamp_fp8(float v) { return __builtin_amdgcn_fmed3f(v, -448.0f, 448.0f); }
__device__ __forceinline__ i32x2 pack8_fp8(const f32x4& a, const f32x4& c) {
    int w0 = __builtin_amdgcn_cvt_pk_fp8_f32(clamp_fp8(a[0]), clamp_fp8(a[1]), 0, false); w0 = __builtin_amdgcn_cvt_pk_fp8_f32(clamp_fp8(a[2]), clamp_fp8(a[3]), w0, true);
    int w1 = __builtin_amdgcn_cvt_pk_fp8_f32(clamp_fp8(c[0]), clamp_fp8(c[1]), 0, false); w1 = __builtin_amdgcn_cvt_pk_fp8_f32(clamp_fp8(c[2]), clamp_fp8(c[3]), w1, true);
    return (i32x2){w0, w1};
}

struct EpiQKVU {
    static constexpr bool PERM = true, AFTER_DRAIN = false, PROBE2 = (MK_EPI2V == 2);
    bf16_t* QKV; size_t stride; bf16_t* UA; float scale0;
    __device__ __forceinline__ void operator()(const f32x4 (&acc)[2][2][4][2], const Unit& u, int wr, int wc, int fr, int fq) const {
        const int t = u.pn >> 1, colt = (u.pn & 1) * 256 + wc * 32 + 8 * fq, row0 = u.pm * BM + wr * 64 + fr;
        if (t < 3) {
            bf16_t* base = QKV + (size_t)t * stride; const float sc = (t == 0) ? scale0 : 1.f;
#pragma unroll
            for (int ai = 0; ai < 2; ++ai)
#pragma unroll
                for (int m = 0; m < 4; ++m) { bf16_t* rowp = base + (size_t)(row0 + ai * HALF + m * 16) * 512 + colt;
#pragma unroll
                    for (int bj = 0; bj < 2; ++bj) *(u32x4*)(rowp + bj * HALF) = pack8(acc[ai][bj][m][0] * sc, acc[ai][bj][m][1] * sc); }
        } else {
#pragma unroll
            for (int ai = 0; ai < 2; ++ai)
#pragma unroll
                for (int m = 0; m < 4; ++m) { const int r = row0 + ai * HALF + m * 16, b = r >> 12, tt = r & 4095, chunk = tt >> 4, j = tt & 15;
#pragma unroll
                    for (int bj = 0; bj < 2; ++bj) { const int cu = colt + bj * HALF, g = cu >> 4, c0 = cu & 15;
                        *(u32x4*)(UA + ((size_t)((g * 8 + b) * 256 + chunk)) * 384 + j * 16 + c0) = pack8(acc[ai][bj][m][0], acc[ai][bj][m][1]); } }
        }
    }
};
constexpr int XS = 132;
struct EpiX {
    static constexpr bool PERM = false, AFTER_DRAIN = true, PROBE2 = false, HALF_N = true;
    __device__ __forceinline__ void fused(const f32x4 (&acc)[2][2][4][2], const Unit&, int wr, int wc, int fr, int fq, LAS unsigned char* lds, int, int) const {
        LAS float* X = (LAS float*)lds;
#pragma unroll
        for (int ai = 0; ai < 2; ++ai)
#pragma unroll
            for (int m = 0; m < 4; ++m) { const int row = ai * HALF + wr * 64 + m * 16 + fr;
#pragma unroll
                for (int n = 0; n < 2; ++n) *(LAS f32x4*)(X + row * XS + wc * 32 + n * 16 + 4 * fq) = acc[ai][0][m][n]; }
    }
};
struct EpiY {
    static constexpr bool PERM = true, AFTER_DRAIN = false, PROBE2 = false;
    bf16_t* Z; int g, b;
    __device__ __forceinline__ void operator()(const f32x4 (&acc)[2][2][4][2], const Unit&, int wr, int wc, int fr, int fq) const {
#pragma unroll
        for (int ai = 0; ai < 2; ++ai)
#pragma unroll
            for (int m = 0; m < 4; ++m) { const int chunk = ai * HALF + wr * 64 + m * 16 + fr;
#pragma unroll
                for (int bj = 0; bj < 2; ++bj) { const int col0 = bj * HALF + wc * 32 + 8 * fq, s = col0 >> 4, c0 = col0 & 15;
                    f32x4 v0 = acc[ai][bj][m][0], v1 = acc[ai][bj][m][1];
#pragma unroll
                    for (int q = 0; q < 4; q += 2) { const f32x2 a = gelu_tanh2((f32x2){v0[q], v0[q + 1]}), c = gelu_tanh2((f32x2){v1[q], v1[q + 1]}); v0[q] = a.x; v0[q + 1] = a.y; v1[q] = c.x; v1[q + 1] = c.y; }
                    *(u32x4*)(Z + (size_t)(b * 4096 + chunk * 16 + s) * 512 + g * 16 + c0) = pack8(v0, v1); }
                __builtin_amdgcn_sched_barrier(0); }
    }
};
__device__ __forceinline__ float bf_lo(unsigned w) { return __uint_as_float(w << 16); }
__device__ __forceinline__ float bf_hi(unsigned w) { return __uint_as_float(w & 0xffff0000u); }
struct EpiGLU {
    static constexpr bool PERM = true, AFTER_DRAIN = false, PROBE2 = false;
    const bf16_t* Z; bf16_t* MIX; const float* bias;
    __device__ __forceinline__ void operator()(const f32x4 (&acc)[2][2][4][2], const Unit& u, int wr, int wc, int fr, int fq) const {
        const int row0 = u.pm * BM + wr * 64 + fr, col0 = u.pn * BM + wc * 32 + 8 * fq;
        f32x4 bv[2][2];
#pragma unroll
        for (int bj = 0; bj < 2; ++bj)
#pragma unroll
            for (int n = 0; n < 2; ++n) bv[bj][n] = *(const f32x4*)(bias + col0 + bj * HALF + 4 * n);
#pragma unroll
        for (int ai = 0; ai < 2; ++ai)
        { u32x4 zv[4][2];
#pragma unroll
            for (int m = 0; m < 4; ++m)
#pragma unroll
                for (int bj = 0; bj < 2; ++bj) zv[m][bj] = *(const u32x4*)(Z + (size_t)(row0 + ai * HALF + m * 16) * 512 + col0 + bj * HALF);
#pragma unroll
            for (int m = 0; m < 4; ++m) { const size_t row = (size_t)(row0 + ai * HALF + m * 16);
#pragma unroll
                for (int bj = 0; bj < 2; ++bj) { const int col = col0 + bj * HALF; const u32x4 zz = zv[m][bj];
                    const f32x4 a0 = acc[ai][bj][m][0] + bv[bj][0], a1 = acc[ai][bj][m][1] + bv[bj][1];
                    f32x4 o0, o1;
                    o0[0] = bf_lo(zz.x) * sigm(a0[0]); o0[1] = bf_hi(zz.x) * sigm(a0[1]); o0[2] = bf_lo(zz.y) * sigm(a0[2]); o0[3] = bf_hi(zz.y) * sigm(a0[3]);
                    o1[0] = bf_lo(zz.z) * sigm(a1[0]); o1[1] = bf_hi(zz.z) * sigm(a1[1]); o1[2] = bf_lo(zz.w) * sigm(a1[2]); o1[3] = bf_hi(zz.w) * sigm(a1[3]);
                    *(i32x2*)((unsigned char*)MIX + row * 1024 + 512 + col) = pack8_fp8(o0 * 4.0f, o1 * 4.0f); }
                __builtin_amdgcn_sched_barrier(0); } }
    }
};
struct EpiOut {
    static constexpr bool PERM = true, AFTER_DRAIN = false, PROBE2 = (MK_EPI2V == 5);
    const float* X; bf16_t* X1; const float* g1; LAS unsigned char* stg;
    __device__ __forceinline__ void operator()(const f32x4 (&acc)[2][2][4][2], const Unit& u, int wr, int wc, int fr, int fq) const {
        const int col0 = wc * 32 + 8 * fq, b = (u.pm * BM) >> 12, t = (wr * 4 + wc) * 64 + fq * 16 + fr, rs = t >> 4, ch = t & 15;
        f32x4 gv[2][2];
#pragma unroll
        for (int bj = 0; bj < 2; ++bj)
#pragma unroll
            for (int n = 0; n < 2; ++n) gv[bj][n] = *(const f32x4*)(g1 + (size_t)b * 6144 + u.pn * BM + col0 + bj * HALF + 4 * n) * (1.0f / 128.0f);
        LAS unsigned char* wp = stg + (16 * wr + fr) * 528 + col0 * 2; const LAS unsigned char* rp = stg + rs * 528 + ch * 32;
        const size_t off0 = (size_t)(u.pm * BM + 64 * (rs >> 4) + (rs & 15)) * 1024 + u.pn * BM + 16 * ch;
        f32x4 xv[4], xn[4];
#pragma unroll
        for (int q = 0; q < 4; ++q) xv[q] = *(const f32x4*)(X + off0 + 4 * q);
#pragma unroll
        for (int sidx = 0; sidx < 8; ++sidx) { const int ai = sidx >> 2, m = sidx & 3; const size_t off = off0 + (size_t)(ai * HALF + 16 * m) * 1024;
            if (sidx < 7) { const size_t offn = off0 + (size_t)(((sidx + 1) >> 2) * HALF + 16 * ((sidx + 1) & 3)) * 1024;
#pragma unroll
                for (int q = 0; q < 4; ++q) xn[q] = *(const f32x4*)(X + offn + 4 * q); }
#pragma unroll
            for (int bj = 0; bj < 2; ++bj) *(LAS u32x4*)(wp + bj * 256) = pack8(gv[bj][0] * acc[ai][bj][m][0], gv[bj][1] * acc[ai][bj][m][1]);
            asm volatile("s_waitcnt lgkmcnt(0)" ::: "memory"); __builtin_amdgcn_s_barrier(); asm volatile("" ::: "memory");
            const u32x4 m0 = *(const LAS u32x4*)(rp), m1 = *(const LAS u32x4*)(rp + 16);
            f32x4 o0, o1, o2, o3;
            o0 = xv[0] + (f32x4){bf_lo(m0.x), bf_hi(m0.x), bf_lo(m0.y), bf_hi(m0.y)}; o1 = xv[1] + (f32x4){bf_lo(m0.z), bf_hi(m0.z), bf_lo(m0.w), bf_hi(m0.w)};
            o2 = xv[2] + (f32x4){bf_lo(m1.x), bf_hi(m1.x), bf_lo(m1.y), bf_hi(m1.y)}; o3 = xv[3] + (f32x4){bf_lo(m1.z), bf_hi(m1.z), bf_lo(m1.w), bf_hi(m1.w)};
            *(u32x4*)(X1 + off) = pack8(o0, o1); *(u32x4*)(X1 + off + 8) = pack8(o2, o3);
            asm volatile("s_waitcnt lgkmcnt(0)" ::: "memory"); __builtin_amdgcn_s_barrier(); asm volatile("" ::: "memory");
#pragma unroll
            for (int q = 0; q < 4; ++q) xv[q] = xn[q]; }
    }
};
constexpr float F8_ACT = 4.0f, F8_W = 32.0f, F8_UNDO = 1.0f / (4.0f * 32.0f);
struct EpiMoe1 {
    static constexpr bool PERM = true, AFTER_DRAIN = false, PROBE2 = (MK_EPI2V == 7), BIAS_LDS = true;
    unsigned char* A2; const float* b1; LAS unsigned char* bl; mutable int par = 0;
    __device__ __forceinline__ const float* bias_src(const Unit& u, int wc, int lane16, unsigned& voff) const { voff = (unsigned)(((lane16 >> 3) * 1024 + u.pn * 128 + wc * 32 + (lane16 & 7) * 4) * 4); return b1 + (size_t)u.e * 2048; }
    __device__ __forceinline__ void operator()(const f32x4 (&acc)[2][2][4][2], const Unit& u, int wr, int wc, int fr, int fq) const {
        asm volatile("" : "+v"(fr), "+v"(fq));
        const int row0 = u.pm * BM + wr * 64 + fr, jc = u.pn * 128 + wc * 32 + 8 * fq;
        f32x4 bg[2], bu[2];
#pragma unroll
        for (int n = 0; n < 2; ++n) { const LAS unsigned char* bp = bl + par * 2048 + (wr * 4 + wc) * 256 + fq * 32 + n * 16; bg[n] = *(const LAS f32x4*)(bp); bu[n] = *(const LAS f32x4*)(bp + 128); }
#pragma unroll
        for (int ai = 0; ai < 2; ++ai)
#pragma unroll
            for (int m = 0; m < 4; ++m) { f32x4 o[2];
#pragma unroll
                for (int n = 0; n < 2; ++n) {
#pragma unroll
                    for (int hq = 0; hq < 2; ++hq) { const f32x2 ag = {acc[ai][0][m][n][2 * hq], acc[ai][0][m][n][2 * hq + 1]}, au = {acc[ai][1][m][n][2 * hq], acc[ai][1][m][n][2 * hq + 1]};
                        const f32x2 vbg = {bg[n][2 * hq], bg[n][2 * hq + 1]}, vbu = {bu[n][2 * hq], bu[n][2 * hq + 1]}, k7 = {7.0f, 7.0f}, km7 = {-7.0f, -7.0f}, kund = {F8_UNDO, F8_UNDO};
                        const f32x2 g = __builtin_elementwise_min(__builtin_elementwise_fma(ag, kund, vbg), k7), uu = __builtin_elementwise_min(__builtin_elementwise_max(__builtin_elementwise_fma(au, kund, vbu), km7), k7);
                        const f32x2 ea = g * (-1.702f * 1.4426950408889634f); f32x2 den; den.x = __builtin_amdgcn_exp2f(ea.x); den.y = __builtin_amdgcn_exp2f(ea.y); den = den + 1.0f;
                        f32x2 sg; sg.x = __builtin_amdgcn_rcpf(den.x); sg.y = __builtin_amdgcn_rcpf(den.y);
                        const f32x2 r = __builtin_elementwise_fma(uu, (f32x2){F8_ACT, F8_ACT}, (f32x2){F8_ACT, F8_ACT}) * (g * sg); o[n][2 * hq] = r.x; o[n][2 * hq + 1] = r.y; } }
                *(i32x2*)(A2 + (size_t)(row0 + ai * HALF + m * 16) * 1024 + jc) = pack8_fp8(o[0], o[1]);
                __builtin_amdgcn_sched_barrier(0); }
    }
};
struct EpiMoe2 {
    static constexpr bool PERM = true, AFTER_DRAIN = false, PROBE2 = (MK_EPI2V == 8), BIAS_LDS = true;
    unsigned char* Y2; const float* b2; int pm_mask; LAS unsigned char* bl; mutable int par = 0;
    __device__ __forceinline__ const float* bias_src(const Unit& u, int wc, int lane16, unsigned& voff) const { voff = (unsigned)((u.pn * BM + (lane16 >> 3) * HALF + wc * 32 + (lane16 & 7) * 4) * 4); return b2 + (size_t)u.e * 1024; }
    __device__ __forceinline__ void operator()(const f32x4 (&acc)[2][2][4][2], const Unit& u, int wr, int wc, int fr, int fq) const {
        asm volatile("" : "+v"(fr), "+v"(fq));
        const int row0 = (u.pm & pm_mask) * BM + wr * 64 + fr, col0 = u.pn * BM + wc * 32 + 8 * fq;
        f32x4 bv[2][2];
#pragma unroll
        for (int bj = 0; bj < 2; ++bj)
#pragma unroll
            for (int n = 0; n < 2; ++n) bv[bj][n] = *(const LAS f32x4*)(bl + par * 2048 + (wr * 4 + wc) * 256 + bj * 128 + fq * 32 + n * 16);
#pragma unroll
        for (int ai = 0; ai < 2; ++ai)
#pragma unroll
            for (int m = 0; m < 4; ++m) { unsigned char* rowp = Y2 + (size_t)(row0 + ai * HALF + m * 16) * 1024 + col0;
#pragma unroll
                for (int bj = 0; bj < 2; ++bj) *(i32x2*)(rowp + bj * HALF) = pack8_fp8((acc[ai][bj][m][0] * F8_UNDO + bv[bj][0]) * 8.0f, (acc[ai][bj][m][1] * F8_UNDO + bv[bj][1]) * 8.0f); }
    }
};

template <class E, class = void> struct epi_bias_lds { static constexpr bool value = false; };
template <class E> struct epi_bias_lds<E, decltype((void)E::BIAS_LDS)> { static constexpr bool value = E::BIAS_LDS; };
template <class E, class = void> struct epi_half_n { static constexpr bool value = false; };
template <class E> struct epi_half_n<E, decltype((void)E::HALF_N)> { static constexpr bool value = E::HALF_N; };
template <class Epi, class Sched, bool ALIGN_EPI, bool GATHER, bool F8 = false>
__device__ __forceinline__ void gemm_phase(LAS unsigned char* lds, const Gemm g, const Sched& S, const Epi& E, const int wave) {
    const int tid = wave * 64 + lane_id_opaque(), wid = __builtin_amdgcn_readfirstlane(tid >> 6), lane = tid & 63,
              wr = wid >> 2, wc = wid & 3, fr = lane & 15, fq = lane >> 4;
    const int nt = g.K / BK; constexpr bool HN = epi_half_n<Epi>::value; constexpr bool BL = epi_bias_lds<Epi>::value;
    unsigned voffB[2], vA[2][2];
#pragma unroll
    for (int i = 0; i < 2; ++i) { int R, C; stage_rc(tid * 16 + i * 8192, R, C); const int Rb = Epi::PERM ? ((R & ~31) + perm32(R & 31)) : R;
        voffB[i] = (unsigned)(Rb * g.ldb + C) * 2u;
#pragma unroll
        for (int h = 0; h < 2; ++h) vA[h][i] = (unsigned)((R + h * HALF) * g.lda + C) * 2u; }
    const size_t kstep = (size_t)(BK * 2);
    const size_t hstepB = (size_t)HALF * g.ldb * 2;
    const unsigned ldsw = (unsigned)wid * 1024u;
    const unsigned ldsbase = (unsigned)__builtin_amdgcn_readfirstlane((int)((unsigned)(uintptr_t)lds + ldsw));
    const int aoff = lds_byte(wr * 64 + fr, fq * 8), boff = lds_byte(wc * 32 + fr, fq * 8);
#define PG8_SA(b, h) (((b) * 2 + (h)) * HTB)
#define PG8_SB(b, h) ((4 + (b) * 2 + (h)) * HTB)
#define PG8_STAGE(bufoff, gbase, voff) do { if constexpr (F8) { _Pragma("unroll") for (int _i = 0; _i < 2; ++_i) { unsigned keep_; \
            asm volatile("s_mov_b32 %0, m0\n\ts_mov_b32 m0, %3\n\ts_nop 0\n\tglobal_load_lds_dwordx4 %1, %2\n\ts_mov_b32 m0, %0" : "=&s"(keep_) : "v"((voff)[_i]), "s"((const char*)(gbase)), "s"(ldsbase + (unsigned)((bufoff) + _i * 8192)) : "memory"); } } \
        else { _Pragma("unroll") for (int _i = 0; _i < 2; ++_i) \
        __builtin_amdgcn_global_load_lds((const unsigned*)((const char*)(gbase) + (voff)[_i]), (LAS unsigned*)(lds + (bufoff) + ldsw + _i * 8192), 16, 0, 0); } } while (0)
#define PG8_LDA(dst, b, h) do { if constexpr (F8) { _Pragma("unroll") for (int m = 0; m < 4; ++m) dst##8[m] = PG8_F8CAT(*(const LAS bf16x8*)(lds + PG8_SA(b, h) + aoff + m * 2048), *(const LAS bf16x8*)(lds + PG8_SA(b, h) + aoff + m * 2048 + 1024)); } \
        else { _Pragma("unroll") for (int m = 0; m < 4; ++m) _Pragma("unroll") for (int k = 0; k < 2; ++k) dst[m][k] = *(const LAS bf16x8*)(lds + PG8_SA(b, h) + aoff + m * 2048 + k * 1024); } } while (0)
#define PG8_LDB(dst, b, h) do { if constexpr (F8) { _Pragma("unroll") for (int n = 0; n < 2; ++n) dst##8[n] = PG8_F8CAT(*(const LAS bf16x8*)(lds + PG8_SB(b, h) + boff + n * 2048), *(const LAS bf16x8*)(lds + PG8_SB(b, h) + boff + n * 2048 + 1024)); } \
        else { _Pragma("unroll") for (int n = 0; n < 2; ++n) _Pragma("unroll") for (int k = 0; k < 2; ++k) dst[n][k] = *(const LAS bf16x8*)(lds + PG8_SB(b, h) + boff + n * 2048 + k * 1024); } } while (0)
#define PG8_F8CAT(lo, hi) __builtin_shufflevector(__builtin_bit_cast(i32x4, (lo)), __builtin_bit_cast(i32x4, (hi)), 0, 1, 2, 3, 4, 5, 6, 7)
#define PG8_MMA(ai, bj, At, Bt) do { __builtin_amdgcn_s_setprio(1); \
        if constexpr (F8) { _Pragma("unroll") for (int m = 0; m < 4; ++m) _Pragma("unroll") for (int n = 0; n < 2; ++n) \
            acc[ai][bj][m][n] = __builtin_amdgcn_mfma_scale_f32_16x16x128_f8f6f4(Bt##8[n], At##8[m], acc[ai][bj][m][n], 0, 0, 0, 0x7F7F7F7F, 0, 0x7F7F7F7F); } \
        else { _Pragma("unroll") for (int m = 0; m < 4; ++m) _Pragma("unroll") for (int n = 0; n < 2; ++n) _Pragma("unroll") for (int k = 0; k < 2; ++k) \
            acc[ai][bj][m][n] = __builtin_amdgcn_mfma_f32_16x16x32_bf16(Bt[n][k], At[m][k], acc[ai][bj][m][n], 0, 0, 0); } \
        __builtin_amdgcn_s_setprio(0); } while (0)
#define PG8_WAIT_V(n) asm volatile("s_waitcnt vmcnt(" #n ")" ::: "memory")
#define PG8_WAIT_L(n) asm volatile("s_waitcnt lgkmcnt(" #n ")" ::: "memory")
#define PG8_BAR __builtin_amdgcn_s_barrier()
#define PG8_SCHED __builtin_amdgcn_sched_barrier(0)
#define PG8_GOFF(u_, h, i) ({ const int tq_ = wid * 64 + lane_id_opaque(); int R_, C_; stage_rc(tq_ * 16 + (i) * 8192, R_, C_); S.rowoff((u_), (h) * HALF + R_) + (unsigned)C_ * 2u; })
    Unit cur, nxt; int ui = 0;
    if (!S.next(0, cur)) return;
#define PG8_BIAS_DMA(u_, par_) do { const int tl_ = lane_id_opaque(); unsigned bvo_; const float* bsrc0_ = E.bias_src((u_), wc, tl_ & 15, bvo_); \
        const uintptr_t bq_ = (uintptr_t)bsrc0_; const char* bsrc_ = (const char*)(((uintptr_t)(unsigned)__builtin_amdgcn_readfirstlane((int)(unsigned)(bq_ >> 32)) << 32) | (uintptr_t)(unsigned)__builtin_amdgcn_readfirstlane((int)(unsigned)bq_)); \
        const unsigned bdst_ = (unsigned)__builtin_amdgcn_readfirstlane((int)((unsigned)(uintptr_t)E.bl + (unsigned)(par_) * 2048u + (unsigned)wid * 256u)); \
        if (tl_ < 16) { unsigned keep_; \
            asm volatile("s_mov_b32 %0, m0\n\ts_mov_b32 m0, %3\n\ts_nop 0\n\tglobal_load_lds_dwordx4 %1, %2\n\ts_mov_b32 m0, %0" : "=&s"(keep_) : "v"(bvo_), "s"(bsrc_), "s"(bdst_) : "memory"); } } while (0)
    if constexpr (BL) PG8_BIAS_DMA(cur, 0);
    if constexpr (GATHER) {
#pragma unroll
        for (int h = 0; h < 2; ++h)
#pragma unroll
            for (int i = 0; i < 2; ++i) vA[h][i] = PG8_GOFF(0, h, i);
    }
    f32x4 acc[2][2][4][2];
#pragma unroll
    for (int a = 0; a < 2; ++a)
#pragma unroll
        for (int b = 0; b < 2; ++b)
#pragma unroll
            for (int m = 0; m < 4; ++m)
#pragma unroll
                for (int n = 0; n < 2; ++n) acc[a][b][m][n] = (f32x4){0.f, 0.f, 0.f, 0.f};
    bf16x8 At[4][2], B0[2][2], B1[2][2]; i32x8 At8[4], B08[2], B18[2];
    const char* cA = (const char*)g.A + S.aoff(cur); const char* cB = (const char*)g.Bt + S.boff(cur);
    PG8_STAGE(PG8_SB(0, 0), cB, voffB); PG8_STAGE(PG8_SB(0, 1), cB + hstepB, voffB); PG8_STAGE(PG8_SA(0, 0), cA, vA[0]); PG8_STAGE(PG8_SA(0, 1), cA, vA[1]);
    if (wr == 1) PG8_BAR;
    PG8_WAIT_V(2); PG8_BAR;
    PG8_STAGE(PG8_SB(1, 0), cB + kstep, voffB); PG8_STAGE(PG8_SA(1, 0), cA + kstep, vA[0]); PG8_STAGE(PG8_SB(1, 1), cB + hstepB + kstep, voffB);
    PG8_WAIT_V(6); PG8_BAR;
    for (;;) {
        const bool has_next = S.next(ui + 1, nxt);
        const char* nA = has_next ? (const char*)g.A + S.aoff(nxt) : cA; const char* nB = has_next ? (const char*)g.Bt + S.boff(nxt) : cB;
#pragma unroll 1
        for (int t = 0; t < nt; t += 2) {
            const bool last = (t == nt - 2);
            const char* a1 = cA + (size_t)(t + 1) * kstep;
            const char* a2 = last ? nA : cA + (size_t)(t + 2) * kstep; const char* b2 = last ? nB : cB + (size_t)(t + 2) * kstep;
            const char* a3 = a2 + kstep; const char* b3 = b2 + kstep;
            unsigned w0[2], w1[2];
            if constexpr (GATHER) { const bool nx_ = last && has_next;
                if (nx_) { w0[0] = PG8_GOFF(ui + 1, 0, 0); w0[1] = PG8_GOFF(ui + 1, 0, 1); w1[0] = PG8_GOFF(ui + 1, 1, 0); w1[1] = PG8_GOFF(ui + 1, 1, 1); }
                else { w0[0] = vA[0][0]; w0[1] = vA[0][1]; w1[0] = vA[1][0]; w1[1] = vA[1][1]; } }
            else { w0[0] = vA[0][0]; w0[1] = vA[0][1]; w1[0] = vA[1][0]; w1[1] = vA[1][1]; }
            PG8_LDB(B0, 0, 0); if constexpr (!HN) PG8_LDB(B1, 0, 1); PG8_SCHED; PG8_LDA(At, 0, 0); PG8_STAGE(PG8_SA(1, 1), a1, vA[1]);
            PG8_WAIT_V(8); PG8_WAIT_L(0); PG8_BAR; PG8_MMA(0, 0, At, B0); if constexpr (!HN) PG8_MMA(0, 1, At, B1); PG8_BAR; PG8_SCHED;
            PG8_LDA(At, 0, 1); PG8_STAGE(PG8_SB(0, 0), b2, voffB); PG8_STAGE(PG8_SB(0, 1), b2 + hstepB, voffB); PG8_STAGE(PG8_SA(0, 0), a2, w0);
            PG8_WAIT_V(8); PG8_WAIT_L(0); PG8_BAR; PG8_MMA(1, 0, At, B0); if constexpr (!HN) PG8_MMA(1, 1, At, B1); PG8_BAR; PG8_SCHED;
            PG8_LDB(B0, 1, 0); if constexpr (!HN) PG8_LDB(B1, 1, 1); PG8_SCHED; PG8_LDA(At, 1, 0); PG8_STAGE(PG8_SA(0, 1), a2, w1);
            PG8_WAIT_V(8); PG8_WAIT_L(0); PG8_BAR; PG8_MMA(0, 0, At, B0); if constexpr (!HN) PG8_MMA(0, 1, At, B1); PG8_BAR; PG8_SCHED;
            PG8_LDA(At, 1, 1); PG8_STAGE(PG8_SB(1, 0), b3, voffB); PG8_STAGE(PG8_SB(1, 1), b3 + hstepB, voffB); PG8_STAGE(PG8_SA(1, 0), a3, w0);
            PG8_WAIT_V(8); PG8_WAIT_L(0); PG8_BAR; PG8_MMA(1, 0, At, B0); if constexpr (!HN) PG8_MMA(1, 1, At, B1); PG8_BAR; PG8_SCHED;
        }
        if constexpr (ALIGN_EPI) { if (wr == 0) PG8_BAR; }
        if constexpr (BL) { if (has_next) PG8_BIAS_DMA(nxt, (ui + 1) & 1); }
        if constexpr (!Epi::AFTER_DRAIN) { const int te_ = lane_id_opaque(); const int fre = te_ & 15, fqe = (te_ >> 4) & 3;
            if constexpr (BL) E.par = ui & 1;
            E(acc, cur, wr, wc, fre, fqe);
#ifdef MK_EPI2
            if constexpr (Epi::PROBE2) { asm volatile("" ::: "memory"); E(acc, cur, wr, wc, fr, fq); }
#endif
        }
        if (!has_next) break;
#pragma unroll
        for (int a = 0; a < 2; ++a)
#pragma unroll
            for (int b = 0; b < 2; ++b)
#pragma unroll
                for (int m = 0; m < 4; ++m)
#pragma unroll
                    for (int n = 0; n < 2; ++n) acc[a][b][m][n] = (f32x4){0.f, 0.f, 0.f, 0.f};
        cur = nxt; cA = nA; cB = nB; ++ui;
        if constexpr (GATHER) {
#pragma unroll
            for (int h = 0; h < 2; ++h)
#pragma unroll
                for (int i = 0; i < 2; ++i) vA[h][i] = PG8_GOFF(ui, h, i);
        }
        if constexpr (ALIGN_EPI) { if (wr == 1) PG8_BAR; }
    }
    PG8_WAIT_V(0);
    if constexpr (!ALIGN_EPI) { if (wr == 0) PG8_BAR; }
    PG8_BAR;
    if constexpr (Epi::AFTER_DRAIN) { E.fused(acc, cur, wr, wc, fr, fq, lds, wid, lane); }
#undef PG8_BIAS_DMA
#undef PG8_SA
#undef PG8_SB
#undef PG8_STAGE
#undef PG8_LDA
#undef PG8_LDB
#undef PG8_MMA
#undef PG8_GOFF
#undef PG8_F8CAT
#undef PG8_WAIT_V
#undef PG8_WAIT_L
#undef PG8_BAR
#undef PG8_SCHED
}
}

namespace attn_body {
using bf16=__hip_bfloat16;
using bf16x8=__attribute__((ext_vector_type(8)))short;
using s16x4=__attribute__((ext_vector_type(4)))short;
using f32x16=__attribute__((ext_vector_type(16)))float;
using u32x4=__attribute__((ext_vector_type(4)))unsigned;
constexpr int SEQ=4096,D=64,DMI=512,DMO=1024;
constexpr int NW=8,QBLK=32,QB=QBLK*NW,KVBLK=64,NQB=SEQ/QB;
__device__ __forceinline__ int crow(int r,int hi){return (r&3)+8*(r>>2)+4*hi;}
#define SBAR() __builtin_amdgcn_sched_barrier(0)
__device__ __forceinline__ void cmask(f32x16&p0,f32x16&p1,int jb,int qrel,int hi){
  const float NEG=-INFINITY; int kb=64*jb+4*hi;
  #pragma unroll
  for(int r=0;r<16;++r){int kv=kb+(r&3)+8*(r>>2); if(kv>qrel)p0[r]=NEG; if(kv+32>qrel)p1[r]=NEG;}
}
constexpr int NSLOT=3, SLOTB=8192;
constexpr int LDS_K=0, LDS_V=NSLOT*SLOTB, LDS_WS=2*NSLOT*SLOTB, LDS_OST=LDS_WS+NW*64*4, LDS_BYTES=LDS_OST+NW*4096;
constexpr float C2=0.125f*1.4426950408889634f;
__device__ __forceinline__ void glds16(const void*gsrc,unsigned lds_dst){unsigned keep;
  asm volatile("s_mov_b32 %0, m0\n\ts_mov_b32 m0, %2\n\ts_nop 0\n\tglobal_load_lds_dwordx4 %1, off\n\ts_mov_b32 m0, %0":"=&s"(keep):"v"(gsrc),"s"(lds_dst):"memory");}
__device__ __forceinline__ float max3f(float a,float b,float c){float r;asm("v_max3_f32 %0, %1, %2, %3":"=v"(r):"v"(a),"v"(b),"v"(c));return r;}
__device__ __forceinline__ float max2f(float a,float b){float r;asm("v_max_f32_e32 %0, %1, %2":"=v"(r):"v"(a),"v"(b));return r;}
__device__ __forceinline__ float fadd_s(float a,float b){float r;asm("v_add_f32_e32 %0, %1, %2":"=v"(r):"v"(a),"v"(b));return r;}
__device__ __forceinline__ float fsub_s(float a,float b){float r;asm("v_sub_f32_e32 %0, %1, %2":"=v"(r):"v"(a),"v"(b));return r;}
typedef float f32x2_t __attribute__((ext_vector_type(2))); typedef __bf16 bf16x2_t __attribute__((ext_vector_type(2)));
__device__ __forceinline__ unsigned cvtpk_s(float lo,float hi){f32x2_t v={lo,hi};bf16x2_t b=__builtin_convertvector(v,bf16x2_t);return __builtin_bit_cast(unsigned,b);}
#define WAIT_BAR(N) asm volatile("s_waitcnt vmcnt(" #N ") lgkmcnt(0)\n\ts_barrier":::"memory")

__device__ __forceinline__ void qkt(f32x16&p0,f32x16&p1,const char*Kslot,const bf16x8*qr,const f32x16&negm,int r32,int hi){
  const char*kb=Kslot+hi*1024+r32*16;
  #pragma unroll
  for(int d0=0;d0<4;++d0){
    const bf16x8 b0=*reinterpret_cast<const bf16x8*>(kb+d0*2048);
    const bf16x8 b1=*reinterpret_cast<const bf16x8*>(kb+d0*2048+512);
    if(d0==0){p0=__builtin_amdgcn_mfma_f32_32x32x16_bf16(b0,qr[0],negm,0,0,0);p1=__builtin_amdgcn_mfma_f32_32x32x16_bf16(b1,qr[0],negm,0,0,0);}
    else{p0=__builtin_amdgcn_mfma_f32_32x32x16_bf16(b0,qr[d0],p0,0,0,0);p1=__builtin_amdgcn_mfma_f32_32x32x16_bf16(b1,qr[d0],p1,0,0,0);}}
}
typedef __attribute__((address_space(3))) const char* lds_cptr;
typedef short v4i16_t __attribute__((ext_vector_type(4)));
__device__ __forceinline__ void kload8(bf16x8*kf,lds_cptr kp){
  kf[0]=*(const __attribute__((address_space(3))) bf16x8*)(kp);      kf[1]=*(const __attribute__((address_space(3))) bf16x8*)(kp+512);
  kf[2]=*(const __attribute__((address_space(3))) bf16x8*)(kp+2048); kf[3]=*(const __attribute__((address_space(3))) bf16x8*)(kp+2560);
  kf[4]=*(const __attribute__((address_space(3))) bf16x8*)(kp+4096); kf[5]=*(const __attribute__((address_space(3))) bf16x8*)(kp+4608);
  kf[6]=*(const __attribute__((address_space(3))) bf16x8*)(kp+6144); kf[7]=*(const __attribute__((address_space(3))) bf16x8*)(kp+6656);
}
__device__ __forceinline__ void kload2(bf16x8*kf,lds_cptr kp,int j){ kf[2*j]=*(const __attribute__((address_space(3))) bf16x8*)(kp+j*2048); kf[2*j+1]=*(const __attribute__((address_space(3))) bf16x8*)(kp+j*2048+512); }
__device__ __forceinline__ s16x4 vtr(lds_cptr p){ return __builtin_bit_cast(s16x4,__builtin_amdgcn_ds_read_tr16_b64_v4i16((__attribute__((address_space(3))) v4i16_t*)p)); }
__device__ __forceinline__ float rowmax(const f32x16&p0,const f32x16&p1){
  float a=max3f(p0[0],p0[1],p1[0]),b=max3f(p0[2],p0[3],p1[1]);a=max3f(a,p1[2],p1[3]);
  #pragma unroll
  for(int r=4;r<16;r+=4){a=max3f(a,p0[r],p0[r+1]);b=max3f(b,p0[r+2],p0[r+3]);a=max3f(a,p1[r],p1[r+1]);b=max3f(b,p1[r+2],p1[r+3]);}
  const float m=max2f(a,b);
  auto rr=__builtin_amdgcn_permlane32_swap(__float_as_uint(m),__float_as_uint(m),false,false);
  return max2f(__uint_as_float(rr[0]),__uint_as_float(rr[1]));
}
__device__ __forceinline__ void pv(f32x16*o,int vb,bf16x8 pa0,bf16x8 pa1,bf16x8 pa2,bf16x8 pa3){
  #pragma unroll
  for(int d0=0;d0<2;++d0){s16x4 lo[4],hi[4];
    #pragma unroll
    for(int ks=0;ks<4;++ks){
      asm volatile("ds_read_b64_tr_b16 %0,%1 offset:%c2":"=&v"(lo[ks]):"v"(vb),"i"(d0*4096+ks*1024):"memory");
      asm volatile("ds_read_b64_tr_b16 %0,%1 offset:%c2":"=&v"(hi[ks]):"v"(vb),"i"(d0*4096+ks*1024+512):"memory");}
    asm volatile("s_waitcnt lgkmcnt(0)":::"memory");SBAR();
    #define PK(k) (bf16x8){lo[k][0],lo[k][1],lo[k][2],lo[k][3],hi[k][0],hi[k][1],hi[k][2],hi[k][3]}
    o[d0]=__builtin_amdgcn_mfma_f32_32x32x16_bf16(pa0,PK(0),o[d0],0,0,0);
    o[d0]=__builtin_amdgcn_mfma_f32_32x32x16_bf16(pa1,PK(1),o[d0],0,0,0);
    o[d0]=__builtin_amdgcn_mfma_f32_32x32x16_bf16(pa2,PK(2),o[d0],0,0,0);
    o[d0]=__builtin_amdgcn_mfma_f32_32x32x16_bf16(pa3,PK(3),o[d0],0,0,0);
    #undef PK
  }
}
#define ATTN_STORE16(p,v) (*(u32x4*)(p)=(v))
template<int THRL> __device__ __forceinline__ void attn_unit(int qb,const bf16*Qh,const bf16*__restrict__ Kh,const bf16*__restrict__ Vh,bf16*Oh,char*shm){
  int tid_=threadIdx.x; asm volatile("":"+v"(tid_));
  const int tid=tid_,lane=tid&63,r32=lane&31,hi=lane>>5; const int wid=__builtin_amdgcn_readfirstlane(tid>>6);
  const int q0=qb*QB;
  const bf16*Qw=Qh+(long)(q0+wid*QBLK)*DMI;
  const unsigned lds0=(unsigned)(uintptr_t)shm;
  float*wsf=(float*)(shm+LDS_WS)+wid*64;
  const bf16*ksrc=Kh+(long)lane*DMI+wid*8;
  const bf16*vsrc=Vh+(long)(16*(wid&3)+(lane>>2))*DMI+(wid>>2)*32+(lane&3)*8;
  const unsigned kdst=lds0+LDS_K+wid*1024, vdst=lds0+LDS_V+wid*1024;
  #define DMA_K(t,slot) glds16(ksrc+(long)(t)*KVBLK*DMI,(unsigned)__builtin_amdgcn_readfirstlane(kdst+(slot)))
  #define DMA_V(t,slot) glds16(vsrc+(long)(t)*KVBLK*DMI,(unsigned)__builtin_amdgcn_readfirstlane(vdst+(slot)))
  const int vb0=(int)(lds0+LDS_V)+((lane>>4)&1)*32+(lane&3)*8+(4*hi+((lane&15)>>2))*64;
  const char*Kbase=shm+LDS_K; bf16x8 kf[8];
  const lds_cptr shm3=(lds_cptr)shm; const lds_cptr kp0=shm3+LDS_K+hi*1024+r32*16; const lds_cptr vp0=shm3+LDS_V+((lane>>4)&1)*32+(lane&3)*8+(4*hi+((lane&15)>>2))*64;
  const int NT=(q0+QB)/KVBLK;
  DMA_K(0,0);DMA_V(0,0);DMA_K(1,SLOTB);
  bf16x8 qr[4];
  #pragma unroll
  for(int d0=0;d0<4;++d0)qr[d0]=*reinterpret_cast<const bf16x8*>(&Qw[(long)r32*DMI+d0*16+hi*8]);
  float mhat=0.f,l_reg=0.f;f32x16 o[2];o[0]=f32x16{};o[1]=f32x16{};f32x16 negm=f32x16{};asm volatile("":"+v"(negm));
  const int qrel=wid*QBLK+r32;
  #define CMASK(P0,P1,t) do{int jb_=(t)-(NT-4); if(jb_>=0)cmask(P0,P1,jb_,qrel,hi);}while(0)
  bool resc=false;
  #define START(P0,P1) do{ const float rm=rowmax(P0,P1); resc=false; \
    { const float dl=rm; mhat=fadd_s(mhat,dl); \
      _Pragma("unroll") for(int r=0;r<16;++r){P0[r]=fsub_s(P0[r],dl);P1[r]=fsub_s(P1[r],dl);} \
      _Pragma("unroll") for(int r=0;r<16;++r)negm[r]=-mhat; asm volatile("":"+v"(negm)); } \
    _Pragma("unroll") for(int r=0;r<16;++r)P0[r]=__builtin_amdgcn_exp2f(P0[r]); }while(0)
  #define RESC() do{ if(resc){ asm volatile("s_waitcnt lgkmcnt(0)":::"memory"); \
      _Pragma("unroll") for(int d_=0;d_<2;++d_) _Pragma("unroll") for(int r=0;r<16;++r)o[d_][r]*=wsf[crow(r,hi)]; } }while(0)
  f32x16 pA0,pA1,pB0,pB1;
  int sl_prev=0,sl_cur=0,sl_next=SLOTB;
  #define ROT() do{sl_prev=sl_cur;sl_cur=sl_next;sl_next=(sl_next==(NSLOT-1)*SLOTB)?0:sl_next+SLOTB;}while(0)
  DMA_K(2,2*SLOTB);
  WAIT_BAR(3);
  qkt(pA0,pA1,Kbase,qr,negm,r32,hi);asm volatile("s_nop 15\n\ts_nop 7":"+v"(pA0),"+v"(pA1));CMASK(pA0,pA1,0);
  START(pA0,pA1);
  _Pragma("unroll") for(int r=0;r<16;++r)pA1[r]=__builtin_amdgcn_exp2f(pA1[r]);
  WAIT_BAR(0);
  DMA_K(3,0);DMA_V(1,SLOTB);
  ROT();
  kload8(kf,kp0+sl_cur);
  WAIT_BAR(2);
  s16x4 vlo[8],vhi[8]; u32x4 pw0,pw1,pw2,pw3;
  #define PKW(P,B) cvtpk_s(P[B],P[B+1])
  #define PAF(k) __builtin_bit_cast(bf16x8,pw##k)
  #define VFR(i) (bf16x8){vlo[i][0],vlo[i][1],vlo[i][2],vlo[i][3],vhi[i][0],vhi[i][1],vhi[i][2],vhi[i][3]}
  #define PIN(x) asm volatile("":"+v"(x))
  #define MX3(a,b,c) __builtin_fmaxf(__builtin_fmaxf((a),(b)),(c))
  #define GAPA(MF,A0,A1,A2,A3,W0,W1,PW) do{ MF; sacc+=A0; sacc+=A1; sacc+=A2; sacc+=A3; PIN(sacc); W0; W1; PIN(PW); SBAR(); }while(0)
  #define EX(v) __builtin_amdgcn_exp2f(v)
  #define GAPB(MF,X,B) do{ MF; X[B]=EX(X[B]); X[B+1]=EX(X[B+1]); X[B+2]=EX(X[B+2]); X[B+3]=EX(X[B+3]); PIN(X); SBAR(); }while(0)
  #define VRD(i) do{ vlo[i]=vtr(vp_+(((i)>>2)*4096+((i)&3)*1024)); vhi[i]=vtr(vp_+(((i)>>2)*4096+((i)&3)*1024+512)); }while(0)
  #define KRD(G,j) do{ if(G){ kload2(kf,kp0+sl_next,j); SBAR(); } }while(0)
  #define STEP(C0,C1,P0,P1,t,GK,GV,GL) do{ SBAR(); \
    const lds_cptr vp_=vp0+sl_prev; \
    VRD(0); SBAR(); float sacc=(P0[0]+P0[1]); \
    GAPA(C0=__builtin_amdgcn_mfma_f32_32x32x16_bf16(kf[0],qr[0],negm,0,0,0), P0[2],P0[3],P0[4],P0[5],     pw0[0]=PKW(P0,0), pw0[1]=PKW(P0,2), pw0); \
    VRD(4); SBAR(); GAPA(C1=__builtin_amdgcn_mfma_f32_32x32x16_bf16(kf[1],qr[0],negm,0,0,0), P0[6],P0[7],P0[8],P0[9],     pw0[2]=PKW(P0,4), pw0[3]=PKW(P0,6), pw0); \
    VRD(1); SBAR(); GAPA(C0=__builtin_amdgcn_mfma_f32_32x32x16_bf16(kf[2],qr[1],C0,0,0,0),   P0[10],P0[11],P0[12],P0[13], pw1[0]=PKW(P0,8), pw1[1]=PKW(P0,10), pw1); \
    VRD(5); SBAR(); GAPA(C1=__builtin_amdgcn_mfma_f32_32x32x16_bf16(kf[3],qr[1],C1,0,0,0),   P0[14],P0[15],P1[0],P1[1],   pw1[2]=PKW(P0,12),pw1[3]=PKW(P0,14), pw1); \
    VRD(2); SBAR(); GAPA(C0=__builtin_amdgcn_mfma_f32_32x32x16_bf16(kf[4],qr[2],C0,0,0,0),   P1[2],P1[3],P1[4],P1[5],     pw2[0]=PKW(P1,0), pw2[1]=PKW(P1,2), pw2); \
    VRD(6); SBAR(); GAPA(C1=__builtin_amdgcn_mfma_f32_32x32x16_bf16(kf[5],qr[2],C1,0,0,0),   P1[6],P1[7],P1[8],P1[9],     pw2[2]=PKW(P1,4), pw2[3]=PKW(P1,6), pw2); \
    VRD(3); SBAR(); GAPA(C0=__builtin_amdgcn_mfma_f32_32x32x16_bf16(kf[6],qr[3],C0,0,0,0),   P1[10],P1[11],P1[12],P1[13], pw3[0]=PKW(P1,8), pw3[1]=PKW(P1,10), pw3); \
    VRD(7); SBAR(); GAPA(C1=__builtin_amdgcn_mfma_f32_32x32x16_bf16(kf[7],qr[3],C1,0,0,0),   P1[14],P1[15],0.f,0.f,       pw3[2]=PKW(P1,12),pw3[3]=PKW(P1,14), pw3); \
    l_reg+=sacc; \
    if(GK){DMA_K((t)+3,sl_cur);} if(GV){DMA_V((t)+1,sl_next);} \
    CMASK(C0,C1,t); \
    { float a=MX3(C0[0],C0[1],C1[0]),b=MX3(C0[2],C0[3],C1[1]); a=MX3(a,C1[2],C1[3]); \
      _Pragma("unroll") for(int r=4;r<16;r+=4){a=MX3(a,C0[r],C0[r+1]);b=MX3(b,C0[r+2],C0[r+3]);a=MX3(a,C1[r],C1[r+1]);b=MX3(b,C1[r+2],C1[r+3]);} \
      float rm=__builtin_fmaxf(a,b); { auto rr=__builtin_amdgcn_permlane32_swap(__float_as_uint(rm),__float_as_uint(rm),false,false); rm=__builtin_fmaxf(__uint_as_float(rr[0]),__uint_as_float(rr[1])); } \
      resc=false; \
      if(__builtin_expect(__any(rm>(float)THRL),0)){ const float dl=__builtin_fmaxf(rm,0.f); mhat+=dl; \
        _Pragma("unroll") for(int r=0;r<16;++r){C0[r]-=dl;C1[r]-=dl;} \
        _Pragma("unroll") for(int r=0;r<16;++r)negm[r]=-mhat; asm volatile("":"+v"(negm)); \
        const float f=__builtin_amdgcn_exp2f(-dl); l_reg*=f; if(hi==0)wsf[r32]=f; resc=true; } } \
    SBAR(); \
    GAPB(o[0]=__builtin_amdgcn_mfma_f32_32x32x16_bf16(PAF(0),VFR(0),o[0],0,0,0), C0,0); \
    GAPB(o[1]=__builtin_amdgcn_mfma_f32_32x32x16_bf16(PAF(0),VFR(4),o[1],0,0,0), C0,4); \
    KRD(GL,0); GAPB(o[0]=__builtin_amdgcn_mfma_f32_32x32x16_bf16(PAF(1),VFR(1),o[0],0,0,0), C0,8); \
    KRD(GL,1); GAPB(o[1]=__builtin_amdgcn_mfma_f32_32x32x16_bf16(PAF(1),VFR(5),o[1],0,0,0), C0,12); \
    KRD(GL,2); GAPB(o[0]=__builtin_amdgcn_mfma_f32_32x32x16_bf16(PAF(2),VFR(2),o[0],0,0,0), C1,0); \
    KRD(GL,3); GAPB(o[1]=__builtin_amdgcn_mfma_f32_32x32x16_bf16(PAF(2),VFR(6),o[1],0,0,0), C1,4); \
    GAPB(o[0]=__builtin_amdgcn_mfma_f32_32x32x16_bf16(PAF(3),VFR(3),o[0],0,0,0), C1,8); \
    GAPB(o[1]=__builtin_amdgcn_mfma_f32_32x32x16_bf16(PAF(3),VFR(7),o[1],0,0,0), C1,12); \
    }while(0)
  int t=1;
  #undef CMASK
  #define CMASK(P0,P1,t) do{}while(0)
  for(;t+5<NT;t+=2){
    STEP(pB0,pB1,pA0,pA1,t,true,true,true);     WAIT_BAR(2); RESC(); ROT();
    STEP(pA0,pA1,pB0,pB1,t+1,true,true,true);   WAIT_BAR(2); RESC(); ROT();
  }
  #undef CMASK
  #define CMASK(P0,P1,t) do{int jb_=(t)-(NT-4); if(jb_>=0)cmask(P0,P1,jb_,qrel,hi);}while(0)
  #define ENDW(tt) do{ if((tt)+3<NT){WAIT_BAR(2);} else if((tt)+2<NT){WAIT_BAR(1);} else {WAIT_BAR(0);} }while(0)
  for(;t+1<NT;t+=2){
    STEP(pB0,pB1,pA0,pA1,t,(t+3<NT),(t+1<NT),(t+1<NT));       ENDW(t);   RESC(); ROT();
    STEP(pA0,pA1,pB0,pB1,t+1,(t+4<NT),(t+2<NT),(t+2<NT));     ENDW(t+1); RESC(); ROT();
  }
  STEP(pB0,pB1,pA0,pA1,NT-1,false,false,false); RESC();
  { float sacc=pB0[0]+pB0[1]; _Pragma("unroll") for(int r=2;r<16;++r)sacc+=pB0[r]; _Pragma("unroll") for(int r=0;r<16;++r)sacc+=pB1[r]; l_reg+=sacc;
    pw0=(u32x4){PKW(pB0,0),PKW(pB0,2),PKW(pB0,4),PKW(pB0,6)};pw1=(u32x4){PKW(pB0,8),PKW(pB0,10),PKW(pB0,12),PKW(pB0,14)};pw2=(u32x4){PKW(pB1,0),PKW(pB1,2),PKW(pB1,4),PKW(pB1,6)};pw3=(u32x4){PKW(pB1,8),PKW(pB1,10),PKW(pB1,12),PKW(pB1,14)};
    SBAR(); pv(o,vb0+sl_cur,PAF(0),PAF(1),PAF(2),PAF(3)); }
  #undef PKW
  #undef PAF
  #undef VFR
  #undef PIN
  #undef MX3
  #undef GAPA
  #undef GAPB
  #undef EX
  #undef VRD
  #undef KRD
  #undef STEP
  #undef ENDW
  {auto rr=__builtin_amdgcn_permlane32_swap(__float_as_uint(l_reg),__float_as_uint(l_reg),false,false);l_reg=__uint_as_float(rr[0])+__uint_as_float(rr[1]);}
  if(hi==0)wsf[32+r32]=l_reg;asm volatile("s_waitcnt lgkmcnt(0)":::"memory");
  float rli[16];
  #pragma unroll
  for(int r=0;r<16;++r)rli[r]=__builtin_amdgcn_rcpf(wsf[32+crow(r,hi)]);
  bf16*Ow=Oh+(long)(q0+wid*QBLK)*DMO;
  { bf16*stg=(bf16*)(shm+LDS_OST)+wid*2048;
    #pragma unroll
    for(int r=0;r<16;++r){const int orow=crow(r,hi);
      #pragma unroll
      for(int d0=0;d0<2;++d0)stg[orow*64+d0*32+r32]=__float2bfloat16(o[d0][r]*rli[r]);}
    asm volatile("s_waitcnt lgkmcnt(0)":::"memory");
    #pragma unroll
    for(int i=0;i<4;++i){const int row=i*8+(lane>>3),ch=lane&7; const u32x4 v=*(const u32x4*)(stg+row*64+ch*8); ATTN_STORE16(Ow+(long)row*DMO+ch*8,v);} }
  asm volatile("s_waitcnt lgkmcnt(0)\n\ts_barrier":::"memory");
  #undef DMA_K
  #undef DMA_V
  #undef CMASK
  #undef START
  #undef RESC
  #undef ROT
}
constexpr int LDS2_K=0, LDS2_V=4*SLOTB, LDS2_WS=LDS2_V+NSLOT*2*SLOTB, LDS2_OST=LDS2_WS+NW*64*4, LDS2_BYTES=LDS2_OST+NW*8192;
__device__ __forceinline__ void pv4(f32x16*o,int vb,bf16x8 pa0,bf16x8 pa1,bf16x8 pa2,bf16x8 pa3){
  #pragma unroll
  for(int d0=0;d0<4;++d0){s16x4 lo[4],hi[4];
    #pragma unroll
    for(int ks=0;ks<4;++ks){
      asm volatile("ds_read_b64_tr_b16 %0,%1 offset:%c2":"=&v"(lo[ks]):"v"(vb),"i"(d0*4096+ks*1024):"memory");
      asm volatile("ds_read_b64_tr_b16 %0,%1 offset:%c2":"=&v"(hi[ks]):"v"(vb),"i"(d0*4096+ks*1024+512):"memory");}
    asm volatile("s_waitcnt lgkmcnt(0)":::"memory");SBAR();
    #define PK(k) (bf16x8){lo[k][0],lo[k][1],lo[k][2],lo[k][3],hi[k][0],hi[k][1],hi[k][2],hi[k][3]}
    o[d0]=__builtin_amdgcn_mfma_f32_32x32x16_bf16(pa0,PK(0),o[d0],0,0,0);
    o[d0]=__builtin_amdgcn_mfma_f32_32x32x16_bf16(pa1,PK(1),o[d0],0,0,0);
    o[d0]=__builtin_amdgcn_mfma_f32_32x32x16_bf16(pa2,PK(2),o[d0],0,0,0);
    o[d0]=__builtin_amdgcn_mfma_f32_32x32x16_bf16(pa3,PK(3),o[d0],0,0,0);
    #undef PK
  }
}
template<int THRL> __device__ __forceinline__ void attn_unit2(int qb,const bf16*Qh,const bf16*__restrict__ Kh,const bf16*__restrict__ Vh,bf16*Oh,char*shm,const int wave,
    bf16x8 (&qr)[4],const int mode,const int nqb,const bf16*nQh,const bf16*nKh,const bf16*nVh){
  const int tid=wave*64+lane_id_opaque(),lane=tid&63,r32=lane&31,hi=lane>>5; const int wid=__builtin_amdgcn_readfirstlane(tid>>6);
  const int q0=qb*QB;
  const bf16*Qw=Qh+(long)(q0+wid*QBLK)*DMI;
  const unsigned lds0=(unsigned)(uintptr_t)shm;
  float*wsf=(float*)(shm+LDS2_WS)+wid*64;
  const bf16*ksrc=Kh+(long)lane*DMI+wid*8;
  const bf16*vsrc=Vh+(long)(16*(wid&3)+(lane>>2))*DMI+(wid>>2)*32+(lane&3)*8;
  const unsigned kdst=lds0+LDS2_K+wid*1024, vdst=lds0+LDS2_V+(wid>>2)*4096+(wid&3)*1024;
  #define DMA_K(t,slot) glds16(ksrc+(long)(t)*KVBLK*DMI,(unsigned)__builtin_amdgcn_readfirstlane(kdst+(slot)))
  #define DMA_V(t,slot) do{ glds16(vsrc+(long)(t)*KVBLK*DMI,(unsigned)__builtin_amdgcn_readfirstlane(vdst+2*(slot))); glds16(vsrc+(long)(t)*KVBLK*DMI+64,(unsigned)__builtin_amdgcn_readfirstlane(vdst+2*(slot)+8192)); }while(0)
  const int vb0=(int)(lds0+LDS2_V)+((lane>>4)&1)*32+(lane&3)*8+(4*hi+((lane&15)>>2))*64;
  const char*Kbase=shm+LDS2_K; bf16x8 kf[8];
  const lds_cptr shm3=(lds_cptr)shm; const lds_cptr kp0=shm3+LDS2_K+hi*1024+r32*16; const lds_cptr vp0=shm3+LDS2_V+((lane>>4)&1)*32+(lane&3)*8+(4*hi+((lane&15)>>2))*64;
  const int NT=(q0+QB)/KVBLK;
  if(!(mode&1)){ DMA_K(0,0);DMA_V(0,0);DMA_K(1,SLOTB);DMA_K(2,2*SLOTB);
    _Pragma("unroll") for(int d0=0;d0<4;++d0)qr[d0]=*reinterpret_cast<const bf16x8*>(&Qw[(long)r32*DMI+d0*16+hi*8]); }
  float zf_=0.f; asm volatile("":"+v"(zf_)); f32x16 zz_; _Pragma("unroll") for(int r=0;r<16;++r)zz_[r]=zf_;
  float mhat=0.f,l_reg=0.f;f32x16 o[4];o[0]=zz_;o[1]=zz_;o[2]=zz_;o[3]=zz_;f32x16 negm=zz_;asm volatile("":"+v"(negm));
  const int qrel=wid*QBLK+r32;
  #define CMASK(P0,P1,t) do{int jb_=(t)-(NT-4); if(jb_>=0)cmask(P0,P1,jb_,qrel,hi);}while(0)
  bool resc=false;
  #define START(P0,P1) do{ const float rm=rowmax(P0,P1); resc=false; \
    { const float dl=rm; mhat=fadd_s(mhat,dl); \
      _Pragma("unroll") for(int r=0;r<16;++r){P0[r]=fsub_s(P0[r],dl);P1[r]=fsub_s(P1[r],dl);} \
      _Pragma("unroll") for(int r=0;r<16;++r)negm[r]=-mhat; asm volatile("":"+v"(negm)); } \
    _Pragma("unroll") for(int r=0;r<16;++r)P0[r]=__builtin_amdgcn_exp2f(P0[r]); }while(0)
  #define RESC() do{ if(resc){ asm volatile("s_waitcnt lgkmcnt(0)":::"memory"); \
      _Pragma("unroll") for(int d_=0;d_<4;++d_) _Pragma("unroll") for(int r=0;r<16;++r)o[d_][r]*=wsf[crow(r,hi)]; } }while(0)
  f32x16 pA0,pA1,pB0,pB1;
  int sl_prev=0,sl_cur=0,sl_next=SLOTB;
  int kc=0,kn=SLOTB,kp=3*SLOTB;
  #define ROT() do{sl_prev=sl_cur;sl_cur=sl_next;sl_next=(sl_next==(NSLOT-1)*SLOTB)?0:sl_next+SLOTB; kp=kc;kc=kn;kn=(kn==3*SLOTB)?0:kn+SLOTB;}while(0)
  WAIT_BAR(4);
  qkt(pA0,pA1,Kbase,qr,negm,r32,hi);asm volatile("s_nop 15\n\ts_nop 7":"+v"(pA0),"+v"(pA1));CMASK(pA0,pA1,0);
  START(pA0,pA1);
  _Pragma("unroll") for(int r=0;r<16;++r)pA1[r]=__builtin_amdgcn_exp2f(pA1[r]);
  DMA_K(3,3*SLOTB);DMA_V(1,SLOTB);
  WAIT_BAR(3);
  ROT();
  kload2(kf,kp0+kc,0); kload2(kf,kp0+kc,1);
  s16x4 vlo[16],vhi[16]; u32x4 pw0,pw1,pw2,pw3;
  #define PKW(P,B) cvtpk_s(P[B],P[B+1])
  #define PAF(k) __builtin_bit_cast(bf16x8,pw##k)
  #define VFR(i) (bf16x8){vlo[i][0],vlo[i][1],vlo[i][2],vlo[i][3],vhi[i][0],vhi[i][1],vhi[i][2],vhi[i][3]}
  #define PIN(x) asm volatile("":"+v"(x))
  #define MX3(a,b,c) __builtin_fmaxf(__builtin_fmaxf((a),(b)),(c))
  #define GAPA(MF,A0,A1,A2,A3,W0,W1,PW) do{ MF; sacc+=A0; sacc+=A1; sacc+=A2; sacc+=A3; PIN(sacc); W0; W1; PIN(PW); SBAR(); }while(0)
  #define EX(v) __builtin_amdgcn_exp2f(v)
  #define GAPB(MF,X,B) do{ MF; X[B]=EX(X[B]); X[B+1]=EX(X[B+1]); PIN(X); SBAR(); }while(0)
  #define VRD(i) do{ vlo[i]=vtr(vp_+(((i)>>2)*4096+((i)&3)*1024)); vhi[i]=vtr(vp_+(((i)>>2)*4096+((i)&3)*1024+512)); }while(0)
  #define STEP(C0,C1,P0,P1,t,GK,GV,GL) do{ SBAR(); \
    const lds_cptr vp_=vp0+2*sl_prev; \
    VRD(0); SBAR(); float sacc=(P0[0]+P0[1]); \
    GAPA(C0=__builtin_amdgcn_mfma_f32_32x32x16_bf16(kf[0],qr[0],negm,0,0,0), P0[2],P0[3],P0[4],P0[5],     pw0[0]=PKW(P0,0), pw0[1]=PKW(P0,2), pw0); \
    VRD(4); kload2(kf,kp0+kc,2); SBAR(); GAPA(C1=__builtin_amdgcn_mfma_f32_32x32x16_bf16(kf[1],qr[0],negm,0,0,0), P0[6],P0[7],P0[8],P0[9],     pw0[2]=PKW(P0,4), pw0[3]=PKW(P0,6), pw0); \
    VRD(1); SBAR(); GAPA(C0=__builtin_amdgcn_mfma_f32_32x32x16_bf16(kf[2],qr[1],C0,0,0,0),   P0[10],P0[11],P0[12],P0[13], pw1[0]=PKW(P0,8), pw1[1]=PKW(P0,10), pw1); \
    VRD(5); kload2(kf,kp0+kc,3); SBAR(); GAPA(C1=__builtin_amdgcn_mfma_f32_32x32x16_bf16(kf[3],qr[1],C1,0,0,0),   P0[14],P0[15],P1[0],P1[1],   pw1[2]=PKW(P0,12),pw1[3]=PKW(P0,14), pw1); \
    VRD(2); SBAR(); GAPA(C0=__builtin_amdgcn_mfma_f32_32x32x16_bf16(kf[4],qr[2],C0,0,0,0),   P1[2],P1[3],P1[4],P1[5],     pw2[0]=PKW(P1,0), pw2[1]=PKW(P1,2), pw2); \
    VRD(6); SBAR(); GAPA(C1=__builtin_amdgcn_mfma_f32_32x32x16_bf16(kf[5],qr[2],C1,0,0,0),   P1[6],P1[7],P1[8],P1[9],     pw2[2]=PKW(P1,4), pw2[3]=PKW(P1,6), pw2); \
    VRD(3); SBAR(); GAPA(C0=__builtin_amdgcn_mfma_f32_32x32x16_bf16(kf[6],qr[3],C0,0,0,0),   P1[10],P1[11],P1[12],P1[13], pw3[0]=PKW(P1,8), pw3[1]=PKW(P1,10), pw3); \
    VRD(7); SBAR(); GAPA(C1=__builtin_amdgcn_mfma_f32_32x32x16_bf16(kf[7],qr[3],C1,0,0,0),   P1[14],P1[15],0.f,0.f,       pw3[2]=PKW(P1,12),pw3[3]=PKW(P1,14), pw3); \
    l_reg+=sacc; \
    if(GK){DMA_K((t)+3,kp);} if(GV){DMA_V((t)+1,sl_next);} \
    CMASK(C0,C1,t); \
    { float a=MX3(C0[0],C0[1],C1[0]),b=MX3(C0[2],C0[3],C1[1]); a=MX3(a,C1[2],C1[3]); \
      _Pragma("unroll") for(int r=4;r<16;r+=4){a=MX3(a,C0[r],C0[r+1]);b=MX3(b,C0[r+2],C0[r+3]);a=MX3(a,C1[r],C1[r+1]);b=MX3(b,C1[r+2],C1[r+3]);} \
      float rm=__builtin_fmaxf(a,b); { auto rr=__builtin_amdgcn_permlane32_swap(__float_as_uint(rm),__float_as_uint(rm),false,false); rm=__builtin_fmaxf(__uint_as_float(rr[0]),__uint_as_float(rr[1])); } \
      resc=false; \
      if(__builtin_expect(__any(rm>(float)THRL),0)){ const float dl=__builtin_fmaxf(rm,0.f); mhat+=dl; \
        _Pragma("unroll") for(int r=0;r<16;++r){C0[r]-=dl;C1[r]-=dl;} \
        _Pragma("unroll") for(int r=0;r<16;++r)negm[r]=-mhat; asm volatile("":"+v"(negm)); \
        const float f=__builtin_amdgcn_exp2f(-dl); l_reg*=f; if(hi==0)wsf[r32]=f; resc=true; } } \
    SBAR(); \
    VRD(8);  SBAR(); GAPB(o[0]=__builtin_amdgcn_mfma_f32_32x32x16_bf16(PAF(0),VFR(0),o[0],0,0,0), C0,0); \
    VRD(12); SBAR(); GAPB(o[1]=__builtin_amdgcn_mfma_f32_32x32x16_bf16(PAF(0),VFR(4),o[1],0,0,0), C0,2); \
    VRD(9);  SBAR(); GAPB(o[0]=__builtin_amdgcn_mfma_f32_32x32x16_bf16(PAF(1),VFR(1),o[0],0,0,0), C0,4); \
    VRD(13); SBAR(); GAPB(o[1]=__builtin_amdgcn_mfma_f32_32x32x16_bf16(PAF(1),VFR(5),o[1],0,0,0), C0,6); \
    VRD(10); SBAR(); GAPB(o[0]=__builtin_amdgcn_mfma_f32_32x32x16_bf16(PAF(2),VFR(2),o[0],0,0,0), C0,8); \
    VRD(14); SBAR(); GAPB(o[1]=__builtin_amdgcn_mfma_f32_32x32x16_bf16(PAF(2),VFR(6),o[1],0,0,0), C0,10); \
    VRD(11); SBAR(); GAPB(o[0]=__builtin_amdgcn_mfma_f32_32x32x16_bf16(PAF(3),VFR(3),o[0],0,0,0), C0,12); \
    VRD(15); SBAR(); GAPB(o[1]=__builtin_amdgcn_mfma_f32_32x32x16_bf16(PAF(3),VFR(7),o[1],0,0,0), C0,14); \
    GAPB(o[2]=__builtin_amdgcn_mfma_f32_32x32x16_bf16(PAF(0),VFR(8),o[2],0,0,0),  C1,0); \
    GAPB(o[3]=__builtin_amdgcn_mfma_f32_32x32x16_bf16(PAF(0),VFR(12),o[3],0,0,0), C1,2); \
    GAPB(o[2]=__builtin_amdgcn_mfma_f32_32x32x16_bf16(PAF(1),VFR(9),o[2],0,0,0),  C1,4); \
    GAPB(o[3]=__builtin_amdgcn_mfma_f32_32x32x16_bf16(PAF(1),VFR(13),o[3],0,0,0), C1,6); \
    GAPB(o[2]=__builtin_amdgcn_mfma_f32_32x32x16_bf16(PAF(2),VFR(10),o[2],0,0,0), C1,8); \
    GAPB(o[3]=__builtin_amdgcn_mfma_f32_32x32x16_bf16(PAF(2),VFR(14),o[3],0,0,0), C1,10); \
    GAPB(o[2]=__builtin_amdgcn_mfma_f32_32x32x16_bf16(PAF(3),VFR(11),o[2],0,0,0), C1,12); \
    GAPB(o[3]=__builtin_amdgcn_mfma_f32_32x32x16_bf16(PAF(3),VFR(15),o[3],0,0,0), C1,14); \
    if(GL){ kload2(kf,kp0+kn,0); kload2(kf,kp0+kn,1); SBAR(); } \
    }while(0)
  int t=1;
  #undef CMASK
  #define CMASK(P0,P1,t) do{}while(0)
  for(;t+5<NT;t+=2){
    STEP(pB0,pB1,pA0,pA1,t,true,true,true);     WAIT_BAR(3); RESC(); ROT();
    STEP(pA0,pA1,pB0,pB1,t+1,true,true,true);   WAIT_BAR(3); RESC(); ROT();
  }
  #undef CMASK
  #define CMASK(P0,P1,t) do{int jb_=(t)-(NT-4); if(jb_>=0)cmask(P0,P1,jb_,qrel,hi);}while(0)
  #define ENDW(tt) do{ if((tt)+3<NT){WAIT_BAR(3);} else if((tt)+2<NT){WAIT_BAR(2);} else {WAIT_BAR(0);} }while(0)
  for(;t+1<NT;t+=2){
    STEP(pB0,pB1,pA0,pA1,t,(t+3<NT),(t+1<NT),(t+1<NT));       ENDW(t);   RESC(); ROT();
    STEP(pA0,pA1,pB0,pB1,t+1,(t+4<NT),(t+2<NT),(t+2<NT));     ENDW(t+1); RESC(); ROT();
  }
  STEP(pB0,pB1,pA0,pA1,NT-1,false,false,false); RESC();
  { float sacc=pB0[0]+pB0[1]; _Pragma("unroll") for(int r=2;r<16;++r)sacc+=pB0[r]; _Pragma("unroll") for(int r=0;r<16;++r)sacc+=pB1[r]; l_reg+=sacc;
    pw0=(u32x4){PKW(pB0,0),PKW(pB0,2),PKW(pB0,4),PKW(pB0,6)};pw1=(u32x4){PKW(pB0,8),PKW(pB0,10),PKW(pB0,12),PKW(pB0,14)};pw2=(u32x4){PKW(pB1,0),PKW(pB1,2),PKW(pB1,4),PKW(pB1,6)};pw3=(u32x4){PKW(pB1,8),PKW(pB1,10),PKW(pB1,12),PKW(pB1,14)};
    SBAR(); pv4(o,vb0+2*sl_cur,PAF(0),PAF(1),PAF(2),PAF(3)); }
  asm volatile("s_waitcnt lgkmcnt(0)\n\ts_barrier":::"memory");
  if(mode&2){ const bf16*nks=nKh+(long)lane*DMI+wid*8; const bf16*nvs=nVh+(long)(16*(wid&3)+(lane>>2))*DMI+(wid>>2)*32+(lane&3)*8;
    glds16(nks,(unsigned)__builtin_amdgcn_readfirstlane(kdst)); glds16(nvs,(unsigned)__builtin_amdgcn_readfirstlane(vdst)); glds16(nvs+64,(unsigned)__builtin_amdgcn_readfirstlane(vdst+8192));
    glds16(nks+(long)KVBLK*DMI,(unsigned)__builtin_amdgcn_readfirstlane(kdst+SLOTB)); glds16(nks+(long)2*KVBLK*DMI,(unsigned)__builtin_amdgcn_readfirstlane(kdst+2*SLOTB));
    const bf16*nQw=nQh+(long)(nqb*QB+wid*QBLK)*DMI;
    _Pragma("unroll") for(int d0=0;d0<4;++d0)qr[d0]=*reinterpret_cast<const bf16x8*>(&nQw[(long)r32*DMI+d0*16+hi*8]); }
  #undef PKW
  #undef PAF
  #undef VFR
  #undef PIN
  #undef MX3
  #undef GAPA
  #undef GAPB
  #undef EX
  #undef VRD
  #undef STEP
  #undef ENDW
  {auto rr=__builtin_amdgcn_permlane32_swap(__float_as_uint(l_reg),__float_as_uint(l_reg),false,false);l_reg=__uint_as_float(rr[0])+__uint_as_float(rr[1]);}
  if(hi==0)wsf[32+r32]=l_reg;asm volatile("s_waitcnt lgkmcnt(0)":::"memory");
  float rli[16];
  #pragma unroll
  for(int r=0;r<16;++r)rli[r]=__builtin_amdgcn_rcpf(wsf[32+crow(r,hi)]);
  bf16*Ow=Oh+(long)(q0+wid*QBLK)*DMO;
  { bf16*stg=(bf16*)(shm+LDS2_OST)+wid*4096;
    #pragma unroll
    for(int r=0;r<16;++r){const int orow=crow(r,hi);
      #pragma unroll
      for(int d0=0;d0<4;++d0)stg[orow*128+d0*32+r32]=__float2bfloat16(o[d0][r]*rli[r]);}
    asm volatile("s_waitcnt lgkmcnt(0)":::"memory");
    #pragma unroll
    for(int i=0;i<8;++i){const int row=i*4+(lane>>4),ch=lane&15; const u32x4 v=*(const u32x4*)(stg+row*128+ch*8); ATTN_STORE16(Ow+(long)row*DMO+ch*8,v);} }
  asm volatile("s_waitcnt lgkmcnt(0)":::"memory");
  #undef DMA_K
  #undef DMA_V
  #undef CMASK
  #undef START
  #undef RESC
  #undef ROT
}
constexpr int ATTN_LDS_BYTES=LDS_BYTES;
#undef SBAR
#undef WAIT_BAR
}

constexpr int NWAVES = 8;
constexpr int NTOK = 32768, DM = 1024, SEQ = 4096, NB = 8, NEXP = 32, TOPK = 4;
constexpr int N_PHASES = 10;
constexpr size_t MiB = 1u << 20;
constexpr size_t WS_CTL = 0, CTL_ZERO_BYTES = 32768;
constexpr size_t WS_MODP = 864 * MiB;
constexpr size_t WS_MODF = 3 * MiB;
constexpr size_t WS_LAM16 = 3 * MiB + 512 * 1024;
constexpr size_t WS_WRH = 3 * MiB + 640 * 1024, WS_WRL = 3 * MiB + 704 * 1024;
constexpr size_t WS_WIN = 4 * MiB;
constexpr size_t WS_WOUT = 8 * MiB;
constexpr size_t WS_WGLU = 10 * MiB;
constexpr size_t WS_WM = 11 * MiB;
constexpr size_t WS_TV = 15 * MiB;
constexpr size_t WS_W1T = 22 * MiB;
constexpr size_t WS_W2T = 150 * MiB;
constexpr size_t WS_H = 214 * MiB;
constexpr size_t WS_Q = 278 * MiB, WS_K = 310 * MiB, WS_V = 342 * MiB;
constexpr size_t WS_UA = 374 * MiB;
constexpr size_t WS_Z = 422 * MiB;
constexpr size_t WS_OB = 454 * MiB;
constexpr size_t WS_MIX = 518 * MiB;
constexpr size_t WS_PTOK = 582 * MiB;
constexpr size_t WS_SLOT = 586 * MiB;
constexpr size_t WS_GATE = 587 * MiB;
constexpr size_t WS_A2 = 278 * MiB;
constexpr size_t WS_Y2 = 590 * MiB;
constexpr size_t WS_X1B = 872 * MiB;
constexpr size_t WS_END = 936 * MiB;
constexpr int MAXTILES = 544;
static_assert(WS_A2 + (size_t)MAXTILES * 256 * 1024 * 2 <= WS_PTOK && WS_Y2 + (size_t)MAXTILES * 256 * 1024 * 2 <= WS_MODP, "ws map");
constexpr int CW_TMO = 0, CW_CNT = 1024  , CW_BAR = 4096;
constexpr int CW_DEP0 = 7680  , CW_DEPB = 7744  ;
constexpr int RING_OFF = 0, RING_BYTES = 131072;
constexpr int VEC_OFF = 132096;
constexpr int BIASL_OFF = 132096;
constexpr int TILE_E_OFF = 140288;
constexpr int TILE0_OFF = 140928;
constexpr int CNTL_OFF = 141056;
constexpr int MOE_T_OFF = 141184;
constexpr int ROWTAB_OFF = 141312;
constexpr int LDSCTL_OFF = 159744, MISC_OFF = LDSCTL_OFF;
constexpr int LDS_BYTES = 163840;

typedef unsigned short bf16;
typedef unsigned v4u __attribute__((ext_vector_type(4)));
typedef unsigned v2u __attribute__((ext_vector_type(2)));
typedef float f32x4 __attribute__((ext_vector_type(4)));
typedef GAS unsigned gu32;
#define RLX_AGENT __ATOMIC_RELAXED, __HIP_MEMORY_SCOPE_AGENT
#define LDS_WAIT() asm volatile("s_waitcnt lgkmcnt(0)" ::: "memory")
#define VM_WAIT() asm volatile("s_waitcnt vmcnt(0)" ::: "memory")
__device__ __forceinline__ unsigned f2bf(float f) { unsigned u = __builtin_bit_cast(unsigned, f); return (u + 0x7fffu + ((u >> 16) & 1u)) >> 16; }
__device__ __forceinline__ unsigned pk2(float lo, float hi) { return f2bf(lo) | (f2bf(hi) << 16); }

#define XB_TMO      128
#define XB_XCNT(j)  (256  + 64 * (j))
#define XB_XSUB(j)  (1280 + 64 * (j))
#define XB_XGEN(j)  (2304 + 64 * (j))
#define XB_TOP      3328
#define XB_TOPGEN   3392
#define XCD_BAR_WORDS 3456
#define XB_SPIN_CAP (1u << 18)
__device__ __forceinline__ unsigned xb_ld(unsigned* p)              { return __hip_atomic_load(p, __ATOMIC_RELAXED, __HIP_MEMORY_SCOPE_AGENT); }
__device__ __forceinline__ unsigned xb_add(unsigned* p, unsigned v) { return __hip_atomic_fetch_add(p, v, __ATOMIC_RELAXED, __HIP_MEMORY_SCOPE_AGENT); }
__device__ __forceinline__ unsigned xb_xcc_id() { return (unsigned)__builtin_amdgcn_s_getreg((3 << 11) | 20) & 0xFu; }
#define XB_SPIN(cond, bar) do { unsigned _sp = 0; while (cond) { __builtin_amdgcn_s_sleep(1); \
    if ((++_sp & 255u) == 0u) { if (xb_ld(&(bar)[XB_TMO])) break; if (_sp > XB_SPIN_CAP) { atomicAdd(&(bar)[XB_TMO], 1u); break; } } } } while (0)
struct XcdBarrier { unsigned* bar; unsigned x; volatile LAS unsigned* st; };
__device__ __forceinline__ XcdBarrier xcd_barrier_post(unsigned* bar, volatile LAS unsigned* st) {
    XcdBarrier b; b.bar = bar; b.x = xb_xcc_id(); b.st = st;
    if (threadIdx.x == 0) (void)xb_add(&bar[XB_XCNT(b.x)], 1u);
    return b;
}
__device__ __forceinline__ void xcd_barrier_complete(unsigned* bar, unsigned x, unsigned& nloc, unsigned& nx) {
    const unsigned G = gridDim.x * gridDim.y * gridDim.z;
    unsigned sum, cnt, mine, sp = 0u;
    for (;;) {
        sum = 0u; cnt = 0u; mine = 0u;
#pragma unroll
        for (unsigned j = 0; j < 16; ++j) { const unsigned c = xb_ld(&bar[XB_XCNT(j)]); sum += c; cnt += (c > 0u) ? 1u : 0u; mine = (j == x) ? c : mine; }
        if (sum == G) break;
        __builtin_amdgcn_s_sleep(1);
        if ((++sp & 255u) == 0u) { if (xb_ld(&bar[XB_TMO])) break; if (sp > XB_SPIN_CAP) { atomicAdd(&bar[XB_TMO], 1u); break; } }
    }
    nloc = mine > 0u ? mine : 1u; nx = cnt > 0u ? cnt : 1u;
}
__device__ __forceinline__ void xcd_barrier(const XcdBarrier& b, const int wave) {
    asm volatile("s_waitcnt vmcnt(0)" ::: "memory");
    __syncthreads();
    if (wave == 0 && lane_id_opaque() == 0) {
        unsigned* bar = b.bar;
        __builtin_amdgcn_s_waitcnt(0);
        unsigned nloc = b.st[0], nx = b.st[1];
        if (nloc == 0u) { xcd_barrier_complete(bar, b.x, nloc, nx); b.st[0] = nloc; b.st[1] = nx; }
        const unsigned old = xb_add(&bar[XB_XSUB(b.x)], 1u);
        const unsigned gen = old / nloc;
        if (old + 1u == (gen + 1u) * nloc) {
            __builtin_amdgcn_fence(__ATOMIC_RELEASE, "agent");
            asm volatile("s_waitcnt vmcnt(0)" ::: "memory");
            const unsigned og = xb_add(&bar[XB_TOP], 1u);
            const unsigned tg = og / nx;
            if (og + 1u == (tg + 1u) * nx) xb_add(&bar[XB_TOPGEN], 1u);
            else XB_SPIN(xb_ld(&bar[XB_TOPGEN]) == tg, bar);
            __builtin_amdgcn_fence(__ATOMIC_ACQUIRE, "agent");
            xb_add(&bar[XB_XGEN(b.x)], 1u);
            asm volatile("s_waitcnt vmcnt(0)" ::: "memory");
        } else {
            XB_SPIN(xb_ld(&bar[XB_XGEN(b.x)]) == gen, bar);
            __builtin_amdgcn_fence(__ATOMIC_ACQUIRE, "agent");
            asm volatile("s_waitcnt vmcnt(0)" ::: "memory");
        }
    }
    __syncthreads();
}

struct Frame {
    LAS unsigned char* lds;
    gu32* ctl;
    int tid, lane, wave, vcu, G;
    float* out; unsigned char* ws;
};
typedef const float* cfptr_t;
__device__ __forceinline__ const float* inp(int i) { const __attribute__((address_space(4))) cfptr_t* kp = (const __attribute__((address_space(4))) cfptr_t*)__builtin_amdgcn_kernarg_segment_ptr(); asm volatile("" : "+s"(kp)); return kp[i]; }
__device__ __forceinline__ float wave_sum(float v) {
#pragma unroll
    for (int o = 1; o < 64; o <<= 1) v += __shfl_xor(v, o);
    return v;
}
__device__ __forceinline__ float wave_max(float v) {
#pragma unroll
    for (int o = 1; o < 64; o <<= 1) v = fmaxf(v, __shfl_xor(v, o));
    return v;
}
__device__ __forceinline__ int wave_min_i(int v) {
#pragma unroll
    for (int o = 1; o < 64; o <<= 1) { const int w = __shfl_xor(v, o); v = w < v ? w : v; }
    return v;
}

#define DPP_F(v, ctrl) __builtin_bit_cast(float, __builtin_amdgcn_update_dpp(__builtin_bit_cast(int, (v)), __builtin_bit_cast(int, (v)), (ctrl), 0xF, 0xF, false))
#define DPP_I(v, ctrl) __builtin_amdgcn_update_dpp((v), (v), (ctrl), 0xF, 0xF, false)
__device__ __forceinline__ float wave_max_u(float v) {
    v = fmaxf(v, DPP_F(v, 0xB1)); v = fmaxf(v, DPP_F(v, 0x4E)); v = fmaxf(v, DPP_F(v, 0x141)); v = fmaxf(v, DPP_F(v, 0x140));
    const int b = __builtin_bit_cast(int, v);
    return fmaxf(fmaxf(__builtin_bit_cast(float, __builtin_amdgcn_readlane(b, 15)), __builtin_bit_cast(float, __builtin_amdgcn_readlane(b, 31))), fmaxf(__builtin_bit_cast(float, __builtin_amdgcn_readlane(b, 47)), __builtin_bit_cast(float, __builtin_amdgcn_readlane(b, 63))));
}
__device__ __forceinline__ int wave_min_iu(int v) {
    int w;
    w = DPP_I(v, 0xB1); v = w < v ? w : v; w = DPP_I(v, 0x4E); v = w < v ? w : v; w = DPP_I(v, 0x141); v = w < v ? w : v; w = DPP_I(v, 0x140); v = w < v ? w : v;
    const int a = __builtin_amdgcn_readlane(v, 15), b = __builtin_amdgcn_readlane(v, 31), c = __builtin_amdgcn_readlane(v, 47), d = __builtin_amdgcn_readlane(v, 63);
    const int ab = a < b ? a : b, cd = c < d ? c : d; return ab < cd ? ab : cd;
}
__device__ __forceinline__ float wave_sum_u(float v) {
    v += DPP_F(v, 0xB1); v += DPP_F(v, 0x4E); v += DPP_F(v, 0x141); v += DPP_F(v, 0x140);
    const int b = __builtin_bit_cast(int, v);
    return (__builtin_bit_cast(float, __builtin_amdgcn_readlane(b, 15)) + __builtin_bit_cast(float, __builtin_amdgcn_readlane(b, 31))) + (__builtin_bit_cast(float, __builtin_amdgcn_readlane(b, 47)) + __builtin_bit_cast(float, __builtin_amdgcn_readlane(b, 63)));
}
struct TrItem { const float* W; bf16* WT; int ldw, ldt; };
__device__ __forceinline__ void tr_dma(const TrItem& d, LAS float* buf, int lane) {
    const int kr = lane >> 3, q = lane & 7;
#pragma unroll
    for (int i = 0; i < 8; ++i) __builtin_amdgcn_global_load_lds((const unsigned*)(d.W + (size_t)(8 * i + kr) * d.ldw + 4 * ((q - i) & 7)), (LAS unsigned*)(buf + i * 256), 16, 0, 2);
}
__device__ __forceinline__ void tr_out(const TrItem& d, const LAS float* buf, int lane) {
    const int c = lane & 7;
#pragma unroll
    for (int j = 0; j < 4; ++j) { const int n = (lane >> 3) + 8 * j; const LAS float* s = buf + (8 * c) * 32 + 4 * (((n >> 2) + c) & 7) + (n & 3);
        if (d.ldt < 0) { const f32x4 a = (f32x4){s[0 * 32], s[1 * 32], s[2 * 32], s[3 * 32]} * pg8::F8_W, e = (f32x4){s[4 * 32], s[5 * 32], s[6 * 32], s[7 * 32]} * pg8::F8_W;
            __builtin_nontemporal_store(pg8::pack8_fp8(a, e), (pg8::i32x2*)((unsigned char*)d.WT + (size_t)n * (size_t)(-d.ldt) + 8 * c)); }
        else { v4u o; o.x = pg8::cvt_pk_bf16(s[0 * 32], s[1 * 32]); o.y = pg8::cvt_pk_bf16(s[2 * 32], s[3 * 32]); o.z = pg8::cvt_pk_bf16(s[4 * 32], s[5 * 32]); o.w = pg8::cvt_pk_bf16(s[6 * 32], s[7 * 32]);
            *(GAS v4u*)(d.WT + (size_t)n * d.ldt + 8 * c) = o; } }
}
__device__ __forceinline__ void dsincos(double x, double& s, double& c) {
    const double k = rint(x * 0.63661977236758134308);
    double r = fma(-k, 1.57079632673412561417e+00, x); r = fma(-k, 6.07710050650619224932e-11, r);
    const int q = ((int)k) & 3; const double r2 = r * r;
    const double sp = r + r * r2 * (-1.66666666666666324348e-01 + r2 * (8.33333333332248946124e-03 + r2 * (-1.98412698298579493134e-04 + r2 * (2.75573137070700676789e-06 + r2 * (-2.50507602534068634195e-08 + r2 * 1.58969099521155010221e-10)))));
    const double cp = 1.0 - 0.5 * r2 + r2 * r2 * (4.16666666666666019037e-02 + r2 * (-1.38888888888741095749e-03 + r2 * (2.48015872894767294178e-05 + r2 * (-2.75573143513906633035e-07 + r2 * (2.08757232129817482790e-09 + r2 * -1.13596475577881948265e-11)))));
    s = (q == 0) ? sp : (q == 1) ? cp : (q == 2) ? -sp : -cp;
    c = (q == 0) ? cp : (q == 1) ? -sp : (q == 2) ? -cp : sp;
}
__device__ __forceinline__ double dexp(double x) {
    const double k = rint(x * 1.44269504088896340736); const double r = fma(-k, 6.93147180369123816490e-01, x) - k * 1.90821492927058770002e-10;
    double p = 1.0 / 6227020800.0;
    p = p * r + 1.0 / 479001600.0; p = p * r + 1.0 / 39916800.0; p = p * r + 1.0 / 3628800.0; p = p * r + 1.0 / 362880.0; p = p * r + 1.0 / 40320.0; p = p * r + 1.0 / 5040.0;
    p = p * r + 1.0 / 720.0; p = p * r + 1.0 / 120.0; p = p * r + 1.0 / 24.0; p = p * r + 1.0 / 6.0; p = p * r + 0.5; p = p * r + 1.0; p = p * r + 1.0;
    return ldexp(p, (int)k);
}
__device__ __forceinline__ void ssm_tables_item(Frame& F, int g, int r) {
    LAS float* pwr = (LAS float*)(F.lds); LAS float* pwi = pwr + 17 * 64;
    LAS float* ccr = pwi + 17 * 64; LAS float* cci = ccr + 1040;
    LAS float* bbr = cci + 1040; LAS float* bbi = bbr + 1024;
    LAS float* kt = bbi + 1024;
    LAS double* lb1 = (LAS double*)(kt + 4096);
    const float* a_re = inp(11); const float* a_im = inp(12); const float* log_dt = inp(13);
    const float* b_re = inp(14); const float* b_im = inp(15); const float* c_re = inp(16); const float* c_im = inp(17); const float* dsk = inp(18);
    const int tid = F.tid;
    const double dtv = dexp((double)log_dt[g]);
    for (int idx = tid; idx < 17 * 64; idx += 512) { const int t = idx >> 6, p = idx & 63;
        const double re = fmin((double)a_re[g * 64 + p], -1e-4), im = (double)a_im[g * 64 + p];
        const double mag = dexp(re * dtv * (double)t); double s, c; dsincos(im * dtv * (double)t, s, c);
        pwr[idx] = (float)(mag * c); pwi[idx] = (float)(mag * s); if (t == 1) { lb1[2 * p] = mag * c - 1.0; lb1[2 * p + 1] = mag * s; } }
    for (int idx = tid; idx < 1024; idx += 512) { const int c = idx >> 6, p = idx & 63; ccr[c * 65 + p] = c_re[(g * 16 + c) * 64 + p]; cci[c * 65 + p] = c_im[(g * 16 + c) * 64 + p]; }
    __syncthreads();
    for (int idx = tid; idx < 1024; idx += 512) { const int p = idx >> 4, c1 = idx & 15;
        const double re = fmin((double)a_re[g * 64 + p], -1e-4), im = (double)a_im[g * 64 + p];
        const double nr = lb1[2 * p], ni = lb1[2 * p + 1], den = re * re + im * im;
        const double qr = (nr * re + ni * im) / den, qi = (ni * re - nr * im) / den;
        const double br = (double)b_re[(g * 64 + p) * 16 + c1], bi = (double)b_im[(g * 64 + p) * 16 + c1];
        bbr[idx] = (float)(qr * br - qi * bi); bbi[idx] = (float)(qr * bi + qi * br); }
    __syncthreads();
    { const int t = tid >> 5, c = (tid >> 1) & 15, h8 = (tid & 1) * 8; float acc[8];
#pragma unroll
      for (int q = 0; q < 8; ++q) acc[q] = 0.f;
      for (int p = 0; p < 64; ++p) { const float cr = ccr[c * 65 + p], ci = cci[c * 65 + p], pr = pwr[t * 64 + p], pi = pwi[t * 64 + p]; const float mr = cr * pr - ci * pi, mi = cr * pi + ci * pr;
          const f32x4 r0 = *(const LAS f32x4*)(bbr + p * 16 + h8), r1 = *(const LAS f32x4*)(bbr + p * 16 + h8 + 4), i0 = *(const LAS f32x4*)(bbi + p * 16 + h8), i1 = *(const LAS f32x4*)(bbi + p * 16 + h8 + 4);
          acc[0] += mr * r0.x - mi * i0.x; acc[1] += mr * r0.y - mi * i0.y; acc[2] += mr * r0.z - mi * i0.z; acc[3] += mr * r0.w - mi * i0.w;
          acc[4] += mr * r1.x - mi * i1.x; acc[5] += mr * r1.y - mi * i1.y; acc[6] += mr * r1.z - mi * i1.z; acc[7] += mr * r1.w - mi * i1.w; }
#pragma unroll
      for (int q = 0; q < 8; ++q) kt[(t * 16 + c) * 16 + h8 + q] = acc[q]; }
    __syncthreads();
    bf16* TV = (bf16*)(F.ws + WS_TV) + (size_t)g * 256 * 384; bf16* WM = (bf16*)(F.ws + WS_WM) + (size_t)g * 256 * 256;
    for (int idx = tid; idx < 32 * 192; idx += 512) { const int row = 32 * r + idx / 192, col = 2 * (idx % 192), s = row >> 4, c = row & 15; float v[2];
#pragma unroll
        for (int q = 0; q < 2; ++q) { const int cq = col + q;
            if (cq < 256) { const int j = cq >> 4, c1 = cq & 15; v[q] = (j <= s) ? kt[((s - j) * 16 + c) * 16 + c1] : 0.f; if (j == s && c == c1) v[q] += dsk[g * 16 + c]; }
            else { const int p = (cq - 256) & 63; const float cr = ccr[c * 65 + p], ci = cci[c * 65 + p], pr = pwr[(s + 1) * 64 + p], pi = pwi[(s + 1) * 64 + p];
                v[q] = (cq < 320) ? (cr * pr - ci * pi) : -(cr * pi + ci * pr); } }
        *(unsigned*)(TV + (size_t)row * 384 + col) = pk2(v[0], v[1]); }
    for (int idx = tid; idx < 16 * 128; idx += 512) { const int row = 16 * r + (idx >> 7), col = 2 * (idx & 127), p = row & 63, ri = row >> 6, j = col >> 4, c1 = col & 15;
        const float pr = pwr[(15 - j) * 64 + p], pi = pwi[(15 - j) * 64 + p]; float v[2];
#pragma unroll
        for (int q = 0; q < 2; ++q) { const float br = bbr[p * 16 + c1 + q], bi = bbi[p * 16 + c1 + q]; v[q] = ri == 0 ? (pr * br - pi * bi) : (pr * bi + pi * br); }
        *(unsigned*)(WM + (size_t)row * 256 + col) = pk2(v[0], v[1]); *(unsigned*)(WM + (size_t)(128 + row) * 256 + col) = 0u; }
    if (r == 0 && tid < 64) { float* L16 = (float*)(F.ws + WS_LAM16) + (g * 64 + tid) * 2; L16[0] = pwr[16 * 64 + tid]; L16[1] = pwi[16 * 64 + tid]; }
    __syncthreads();
}
constexpr int MOD_NKS = 32;
__device__ __forceinline__ void modp_item(Frame& F, int it) {
    const int ng = it % 6, ks = it / 6, tid = F.tid;
    LAS float* cact = (LAS float*)F.lds;
    LAS f32x4* red = (LAS f32x4*)(cact + 256);
    const float* cin = inp(1); const float* w = inp(2);
    if (tid < 256) { const int b = tid >> 5, kk = tid & 31; const float c = cin[b * 1024 + ks * 32 + kk]; cact[tid] = c / (1.0f + __expf(-c)); }
    __syncthreads();
    const int c4 = tid & 255, kq = tid >> 8, col = ng * 1024 + 4 * c4; f32x4 wv[16], acc[8];
#pragma unroll
    for (int i = 0; i < 16; ++i) wv[i] = *(const GAS f32x4*)(w + (size_t)(ks * 32 + kq * 16 + i) * 6144 + col);
#pragma unroll
    for (int b = 0; b < 8; ++b) { acc[b] = (f32x4){0.f, 0.f, 0.f, 0.f};
#pragma unroll
        for (int i = 0; i < 16; ++i) acc[b] += wv[i] * cact[b * 32 + kq * 16 + i]; }
    if (kq == 1) {
#pragma unroll
        for (int b = 0; b < 8; ++b) red[b * 256 + c4] = acc[b]; }
    __syncthreads();
    if (kq == 0) { float* mp = (float*)(F.ws + WS_MODP);
#pragma unroll
        for (int b = 0; b < 8; ++b) *(GAS f32x4*)(mp + (size_t)(ks * 8 + b) * 6144 + col) = acc[b] + red[b * 256 + c4]; }
    __syncthreads();
}
__device__ __forceinline__ float mod_value(Frame& F, const float* b_ada, int b, int n) {
    const float* mp = (const float*)(F.ws + WS_MODP); float v = b_ada[n];
    float t[MOD_NKS];
#pragma unroll
    for (int ks = 0; ks < MOD_NKS; ++ks) t[ks] = mp[(size_t)(ks * 8 + b) * 6144 + n];
#pragma unroll
    for (int ks = 0; ks < MOD_NKS; ++ks) v += t[ks];
    return v;
}
#ifndef TR_HOSTED
#define TR_HOSTED 32768
#endif
constexpr int TR_I_W1 = 32 * 16 * 64, TR_I_W2 = 32 * 16 * 32, TR_I_IN = 16 * 64, TR_I_OUT = 16 * 32, TR_I_GLU = 8 * 16, TR_NITEMS = TR_I_W1 + TR_I_W2 + TR_I_IN + TR_I_OUT + TR_I_GLU;
__device__ __forceinline__ void tr_run(Frame& F, const int lo, const int hi, const int gw, const int NGW) {
    LAS float* scr = (LAS float*)(F.lds + RING_OFF + F.wave * 16384);
    constexpr int I_W1 = TR_I_W1, I_W2 = TR_I_W2, I_IN = TR_I_IN, I_OUT = TR_I_OUT;
    const int NITEMS = hi;
    const float* w1p = inp(25); const float* w2p = inp(27); const float* winp = inp(5); const float* woutp = inp(21); const float* wglup = inp(19);
    bf16* w1t = (bf16*)(F.ws + WS_W1T); bf16* w2t = (bf16*)(F.ws + WS_W2T); bf16* wint = (bf16*)(F.ws + WS_WIN); bf16* woutt = (bf16*)(F.ws + WS_WOUT); bf16* wglut = (bf16*)(F.ws + WS_WGLU);
#define TR_DESC(d, item) do { int r = (item); \
        if (r < I_W1) { const int e = r >> 10, rr = r & 1023, kb = rr >> 6, nb = rr & 63, n0 = 32 * nb, bj = n0 >> 10, rem = n0 & 1023, pn = rem >> 7, jj = rem & 127; \
            d.W = w1p + (size_t)e * 1024 * 2048 + (size_t)(64 * kb) * 2048 + n0; d.WT = (bf16*)((unsigned char*)w1t + (size_t)e * 2048 * 1024 + (size_t)(pn * 256 + bj * 128 + jj) * 1024 + 64 * kb); d.ldw = 2048; d.ldt = -1024; } \
        else if ((r -= I_W1) < I_W2) { const int e = r >> 9, rr = r & 511, kb = rr >> 5, nb = rr & 31; \
            d.W = w2p + (size_t)e * 1024 * 1024 + (size_t)(64 * kb) * 1024 + 32 * nb; d.WT = (bf16*)((unsigned char*)w2t + (size_t)e * 1024 * 1024 + (size_t)(32 * nb) * 1024 + 64 * kb); d.ldw = 1024; d.ldt = -1024; } \
        else if ((r -= I_W2) < I_IN) { const int kb = r >> 6, nb = r & 63; d.W = winp + (size_t)(64 * kb) * 2048 + 32 * nb; d.WT = wint + (size_t)(32 * nb) * 1024 + 64 * kb; d.ldw = 2048; d.ldt = 1024; } \
        else if ((r -= I_IN) < I_OUT) { const int kb = r >> 5, nb = r & 31; d.W = woutp + (size_t)(64 * kb) * 1024 + 32 * nb; d.WT = (bf16*)((unsigned char*)woutt + (size_t)(32 * nb) * 1024 + 64 * kb); d.ldw = 1024; d.ldt = -1024; } \
        else { r -= I_OUT; const int kb = r >> 4, nb = r & 15; d.W = wglup + (size_t)(64 * kb) * 512 + 32 * nb; d.WT = wglut + (size_t)(32 * nb) * 512 + 64 * kb; d.ldw = 512; d.ldt = 512; } } while (0)
    { TrItem dc, dn; int it = lo + gw, par = 0;
      if (it < NITEMS) { TR_DESC(dc, it); tr_dma(dc, scr, F.lane); }
      while (it < NITEMS) { const int nx = it + NGW;
          if (nx < NITEMS) { TR_DESC(dn, nx); tr_dma(dn, scr + (par ^ 1) * 2048, F.lane); asm volatile("s_waitcnt vmcnt(8)" ::: "memory"); }
          else { asm volatile("s_waitcnt vmcnt(0)" ::: "memory"); }
          tr_out(dc, scr + par * 2048, F.lane);
          LDS_WAIT(); asm volatile("" ::: "memory");
          dc = dn; it = nx; par ^= 1; }
      asm volatile("s_waitcnt vmcnt(0)" ::: "memory"); }
}
__device__ __forceinline__ void trq_load(v4u (&r)[8], const TrItem& d, int lane) {
    const int kr = lane >> 3, q = lane & 7;
#pragma unroll
    for (int i = 0; i < 8; ++i) { const float* p = d.W + (size_t)(8 * i) * d.ldw; const unsigned voff = (unsigned)(kr * d.ldw + 4 * ((q - i) & 7)) * 4u;
        asm volatile("global_load_dwordx4 %0, %1, %2 nt" : "=v"(r[i]) : "v"(voff), "s"(p) : "memory"); }
}
__device__ __forceinline__ void tr_run_deep(Frame& F, const int lo, const int hi, const int gw, const int NGW) {
    LAS float* scr = (LAS float*)(F.lds + RING_OFF + F.wave * 16384);
    constexpr int I_W1 = TR_I_W1, I_W2 = TR_I_W2, I_IN = TR_I_IN, I_OUT = TR_I_OUT;
    const float* w1p = inp(25); const float* w2p = inp(27); const float* winp = inp(5); const float* woutp = inp(21); const float* wglup = inp(19);
    bf16* w1t = (bf16*)(F.ws + WS_W1T); bf16* w2t = (bf16*)(F.ws + WS_W2T); bf16* wint = (bf16*)(F.ws + WS_WIN); bf16* woutt = (bf16*)(F.ws + WS_WOUT); bf16* wglut = (bf16*)(F.ws + WS_WGLU);
    if (lo + gw >= hi) return;
    const int n_it = (hi - lo - gw + NGW - 1) / NGW;
#define TRQ_DESC(d, j) do { const int jc_ = (j) < n_it ? (j) : n_it - 1; TR_DESC(d, lo + gw + jc_ * NGW); } while (0)
#define TRQ_STEP(r, d, j, par) do { \
        asm volatile("s_waitcnt vmcnt(16)" : "+v"(r[0]), "+v"(r[1]), "+v"(r[2]), "+v"(r[3]), "+v"(r[4]), "+v"(r[5]), "+v"(r[6]), "+v"(r[7]) :: "memory"); \
        LAS float* buf_ = scr + (par) * 2048; const bool live_ = (j) < n_it; \
        if (live_) { _Pragma("unroll") for (int i_ = 0; i_ < 8; ++i_) *(LAS v4u*)(buf_ + i_ * 256 + F.lane * 4) = r[i_]; } \
        LDS_WAIT(); TrItem dn_; TRQ_DESC(dn_, (j) + 3); trq_load(r, dn_, F.lane); \
        if (live_) tr_out(d, buf_, F.lane); \
        d = dn_; } while (0)
    v4u r0[8], r1[8], r2[8]; TrItem d0, d1, d2;
    TRQ_DESC(d0, 0); trq_load(r0, d0, F.lane); TRQ_DESC(d1, 1); trq_load(r1, d1, F.lane); TRQ_DESC(d2, 2); trq_load(r2, d2, F.lane);
    for (int j = 0; j < n_it; j += 6) {
        TRQ_STEP(r0, d0, j, 0); TRQ_STEP(r1, d1, j + 1, 1); TRQ_STEP(r2, d2, j + 2, 0);
        TRQ_STEP(r0, d0, j + 3, 1); TRQ_STEP(r1, d1, j + 4, 0); TRQ_STEP(r2, d2, j + 5, 1); }
    asm volatile("s_waitcnt vmcnt(0)" : "+v"(r0[0]), "+v"(r0[1]), "+v"(r0[2]), "+v"(r0[3]), "+v"(r0[4]), "+v"(r0[5]), "+v"(r0[6]), "+v"(r0[7]) :: "memory");
    asm volatile("" : "+v"(r1[0]), "+v"(r1[1]), "+v"(r1[2]), "+v"(r1[3]), "+v"(r1[4]), "+v"(r1[5]), "+v"(r1[6]), "+v"(r1[7]) :: "memory");
    asm volatile("" : "+v"(r2[0]), "+v"(r2[1]), "+v"(r2[2]), "+v"(r2[3]), "+v"(r2[4]), "+v"(r2[5]), "+v"(r2[6]), "+v"(r2[7]) :: "memory");
#undef TRQ_STEP
#undef TRQ_DESC
}
#undef TR_DESC
__device__ __forceinline__ void dep_signal(Frame& F, int word);
__device__ __forceinline__ void p0_prologue(Frame& F, int mode = 0) {
    { const float* wr = inp(23); bf16* wh = (bf16*)(F.ws + WS_WRH); bf16* wl = (bf16*)(F.ws + WS_WRL);
      for (int idx = F.vcu * 512 + F.tid; idx < 32768; idx += F.G * 512) { const int k = idx >> 5, e = idx & 31; const float w = wr[idx]; const unsigned hi = f2bf(w);
          wh[e * 1024 + k] = (bf16)hi; wl[e * 1024 + k] = (bf16)f2bf(w - __builtin_bit_cast(float, hi << 16)); } }
    const bool tab_last = (mode == 0) && !(F.vcu & 1);
    if (mode != 2 && mode != 4 && !tab_last) { for (int it = F.vcu; it < 256; it += F.G) ssm_tables_item(F, it >> 3, it & 7); }
    if (mode != 2 && mode != 3) { for (int it = F.vcu; it < 192; it += F.G) modp_item(F, it); }
    if (mode == 0) dep_signal(F, CW_DEP0);
    if (mode == 1 || mode == 3 || mode == 4) return;
    if (F.G == 256) tr_run(F, TR_HOSTED, TR_NITEMS, F.vcu * NWAVES + F.wave, F.G * NWAVES);
    else tr_run(F, 0, TR_NITEMS, F.vcu * NWAVES + F.wave, F.G * NWAVES);
    if (tab_last) { LDS_WAIT(); __syncthreads(); for (int it = F.vcu; it < 256; it += F.G) ssm_tables_item(F, it >> 3, it & 7); }
}
__device__ __forceinline__ void p1_h1(Frame& F) {
    const int bx = blockIdx.x, rows_per = NTOK / F.G, row_base = bx * rows_per, b = row_base >> 12;
    LAS float* vec = (LAS float*)(F.lds + VEC_OFF);
    const float* b_ada = inp(3); const float* n1g = inp(4); const float* xin = inp(0);
    { float mv[4];
#pragma unroll
      for (int q = 0; q < 4; ++q) mv[q] = mod_value(F, b_ada, b, F.tid + 512 * q);
#pragma unroll
      for (int q = 0; q < 4; ++q) { const int n = F.tid + 512 * q; float v = mv[q]; if (n >= 1024) v = (1.0f + v) * n1g[n - 1024]; vec[n] = v; } }
    { const int per = (NB * 6144) / F.G; float* mf = (float*)(F.ws + WS_MODF);
      for (int i = F.tid; i < per; i += 512) { const int idx = bx * per + i; mf[idx] = mod_value(F, b_ada, idx / 6144, idx % 6144); } }
    __syncthreads();
    bf16* H = (bf16*)(F.ws + WS_H);
    for (int r = F.wave; r < rows_per; r += NWAVES) { const size_t row = (size_t)(row_base + r);
        const GAS f32x4* xr = (const GAS f32x4*)(xin + row * DM) + F.lane; f32x4 v[4]; float s = 0.f;
#pragma unroll
        for (int j = 0; j < 4; ++j) { v[j] = __builtin_nontemporal_load((const f32x4*)(xr + 64 * j)); s += (v[j].x * v[j].x + v[j].y * v[j].y) + (v[j].z * v[j].z + v[j].w * v[j].w); }
        const float rs = 1.0f / sqrtf(wave_sum_u(s) * (1.f / DM) + 1e-6f);
        GAS v2u* o8 = (GAS v2u*)(H + row * DM) + F.lane;
#pragma unroll
        for (int j = 0; j < 4; ++j) { const int c = 256 * j + 4 * F.lane; const f32x4 sh = *(LAS f32x4*)(vec + c), sc = *(LAS f32x4*)(vec + 1024 + c); const f32x4 h = v[j] * rs * sc + sh;
            v2u w; w.x = pk2(h.x, h.y); w.y = pk2(h.z, h.w); o8[64 * j] = w; } }
}
__device__ __forceinline__ void p4_combine(Frame& F) {
    const float lam = __expf(wave_sum(inp(6)[F.lane] * inp(7)[F.lane])) - __expf(wave_sum(inp(8)[F.lane] * inp(9)[F.lane])) + 0.2f;
    const bf16* OB = (const bf16*)(F.ws + WS_OB); bf16* MIX = (bf16*)(F.ws + WS_MIX);
    const int h = F.lane >> 4, d0 = (F.lane & 15) * 8; const float* sg = inp(10) + d0;
    float gs[8];
#pragma unroll
    for (int j = 0; j < 8; ++j) gs[j] = sg[j] * 0.8f;
    const int gw = F.vcu * NWAVES + F.wave, NGW = F.G * NWAVES;
    for (int tok = gw; tok < NTOK; tok += NGW) {
        const v4u a0 = *(const GAS v4u*)(OB + (size_t)tok * 1024 + (h * 2) * 128 + d0), a1 = *(const GAS v4u*)(OB + (size_t)tok * 1024 + (h * 2 + 1) * 128 + d0);
        float a[8];
        a[0] = pg8::bf_lo(a0.x) - lam * pg8::bf_lo(a1.x); a[1] = pg8::bf_hi(a0.x) - lam * pg8::bf_hi(a1.x); a[2] = pg8::bf_lo(a0.y) - lam * pg8::bf_lo(a1.y); a[3] = pg8::bf_hi(a0.y) - lam * pg8::bf_hi(a1.y);
        a[4] = pg8::bf_lo(a0.z) - lam * pg8::bf_lo(a1.z); a[5] = pg8::bf_hi(a0.z) - lam * pg8::bf_hi(a1.z); a[6] = pg8::bf_lo(a0.w) - lam * pg8::bf_lo(a1.w); a[7] = pg8::bf_hi(a0.w) - lam * pg8::bf_hi(a1.w);
        float ss = 0.f;
#pragma unroll
        for (int j = 0; j < 8; ++j) ss += a[j] * a[j];
        ss += __shfl_xor(ss, 1); ss += __shfl_xor(ss, 2); ss += __shfl_xor(ss, 4); ss += __shfl_xor(ss, 8);
        const float rs = 1.0f / sqrtf(ss * (1.f / 128.f) + 1e-6f);
        v4u o; o.x = pk2(a[0] * rs * gs[0], a[1] * rs * gs[1]); o.y = pk2(a[2] * rs * gs[2], a[3] * rs * gs[3]); o.z = pk2(a[4] * rs * gs[4], a[5] * rs * gs[5]); o.w = pk2(a[6] * rs * gs[6], a[7] * rs * gs[7]);
        *(GAS v4u*)(MIX + (size_t)tok * 1024 + h * 128 + d0) = o;
    }
}
constexpr int WRB = 2064;
constexpr int SEL_OFF = 140288;
static_assert(4 * 16 * WRB <= VEC_OFF, "router weights in LDS");
__device__ __forceinline__ void ins4(float v, int i, float (&tv)[4], int (&ti)[4]) {
#pragma unroll
    for (int k = 0; k < 4; ++k) { const bool better = v > tv[k] || (v == tv[k] && i < ti[k]); const float ov = tv[k]; const int oi = ti[k]; tv[k] = better ? v : ov; ti[k] = better ? i : oi; v = better ? ov : v; i = better ? oi : i; }
}
__device__ __forceinline__ void p6_fill(Frame& F) {
    const int bx = blockIdx.x, rows_per = NTOK / F.G, row_base = bx * rows_per, b = row_base >> 12;
    LAS float* vec = (LAS float*)(F.lds + VEC_OFF);
    LAS unsigned* hist = (LAS unsigned*)(F.lds + SEL_OFF) + 1536;
    const float* n2g = inp(22); const float* mf = (const float*)(F.ws + WS_MODF) + (size_t)b * 6144;
    __syncthreads();
    { const unsigned char* wsrc = F.ws + WS_WRH;
      v4u wt[16];
#pragma unroll
      for (int i = 0; i < 16; ++i) { const int c = F.tid + 512 * i, row = c >> 7, col = c & 127; wt[i] = *(const GAS v4u*)(wsrc + (size_t)row * 2048 + col * 16); }
#pragma unroll
      for (int i = 0; i < 16; ++i) { const int c = F.tid + 512 * i, row = c >> 7, col = c & 127; *(LAS v4u*)(F.lds + RING_OFF + row * WRB + col * 16) = wt[i]; } }
    for (int n = F.tid; n < 1024; n += 512) { vec[n] = mf[3072 + n]; vec[1024 + n] = (1.0f + mf[4096 + n]) * n2g[n]; }
    if (F.tid < 32) hist[F.tid] = 0u;
    __syncthreads();
}
__device__ __forceinline__ void p6_router(Frame& F, bool dummy = false, bool filled = false) {
    const int bx = blockIdx.x, rows_per = NTOK / F.G, row_base = bx * rows_per;
    LAS float* vec = (LAS float*)(F.lds + VEC_OFF);
    LAS unsigned* sel_e = (LAS unsigned*)(F.lds + SEL_OFF); LAS unsigned* sel_r = sel_e + 512; LAS float* sel_g = (LAS float*)(sel_r + 512); LAS unsigned* hist = (LAS unsigned*)(sel_g + 512); LAS unsigned* base = hist + 32;
    if (!filled) p6_fill(F);
    unsigned char* H = (unsigned char*)(F.ws + WS_H); const bf16* X1 = (const bf16*)(F.ws + WS_X1B);
    int* ptok = (int*)(F.ws + (dummy ? WS_Q : WS_PTOK)); unsigned* slot = (unsigned*)(F.ws + (dummy ? WS_Q + 8 * MiB : WS_SLOT)); float* gate = (float*)(F.ws + (dummy ? WS_Q + 16 * MiB : WS_GATE));
    const int cwc = dummy ? CW_CNT + 2048 : CW_CNT;
    const int t = F.lane & 15, kg = F.lane >> 4;
    for (int r0 = 16 * F.wave; r0 < rows_per; r0 += 16 * NWAVES) { const int tok = row_base + r0 + t;
        const GAS v4u* xp = (const GAS v4u*)(X1 + (size_t)tok * DM + 8 * kg);
        v4u xr[32]; float ss = 0.f;
#pragma unroll
        for (int s = 0; s < 32; ++s) xr[s] = xp[4 * s];
#pragma unroll
        for (int s = 0; s < 32; ++s) { const float x0 = pg8::bf_lo(xr[s].x), x1 = pg8::bf_hi(xr[s].x), x2 = pg8::bf_lo(xr[s].y), x3 = pg8::bf_hi(xr[s].y), x4 = pg8::bf_lo(xr[s].z), x5 = pg8::bf_hi(xr[s].z), x6 = pg8::bf_lo(xr[s].w), x7 = pg8::bf_hi(xr[s].w);
            ss += ((x0 * x0 + x1 * x1) + (x2 * x2 + x3 * x3)) + ((x4 * x4 + x5 * x5) + (x6 * x6 + x7 * x7)); }
        ss += __shfl_xor(ss, 16); ss += __shfl_xor(ss, 32);
        const float rs = 1.0f / sqrtf(ss * (1.f / DM) + 1e-6f);
        f32x4 acc0 = {0.f, 0.f, 0.f, 0.f}, acc1 = {0.f, 0.f, 0.f, 0.f};
        GAS unsigned char* hp = (GAS unsigned char*)(H + (size_t)tok * DM + 8 * kg);
        const LAS unsigned char* wa = F.lds + RING_OFF + t * WRB + 16 * kg;
        const LAS float* vp = vec + 8 * kg;
#pragma unroll
        for (int s = 0; s < 32; ++s) {
            const f32x4 sh0 = *(const LAS f32x4*)(vp), sh1 = *(const LAS f32x4*)(vp + 4), sc0 = *(const LAS f32x4*)(vp + 1024), sc1 = *(const LAS f32x4*)(vp + 1024 + 4);
            v4u xs = xr[s]; asm volatile("" : "+v"(xs));
            const f32x4 xa = {pg8::bf_lo(xs.x), pg8::bf_hi(xs.x), pg8::bf_lo(xs.y), pg8::bf_hi(xs.y)}, xb = {pg8::bf_lo(xs.z), pg8::bf_hi(xs.z), pg8::bf_lo(xs.w), pg8::bf_hi(xs.w)};
            const f32x4 h0 = xa * rs * sc0 + sh0, h1 = xb * rs * sc1 + sh1;
            const pg8::u32x4 bh = pg8::pack8(h0, h1);
            const f32x4 d0 = h0 - (f32x4){pg8::bf_lo(bh.x), pg8::bf_hi(bh.x), pg8::bf_lo(bh.y), pg8::bf_hi(bh.y)}, d1 = h1 - (f32x4){pg8::bf_lo(bh.z), pg8::bf_hi(bh.z), pg8::bf_lo(bh.w), pg8::bf_hi(bh.w)};
            const pg8::u32x4 bl = pg8::pack8(d0, d1);
            *(GAS pg8::i32x2*)(hp + 32 * s) = pg8::pack8_fp8(h0 * pg8::F8_ACT, h1 * pg8::F8_ACT);
            const pg8::bf16x8 Bh = __builtin_bit_cast(pg8::bf16x8, bh), Bl = __builtin_bit_cast(pg8::bf16x8, bl);
            const pg8::bf16x8 Ah0 = *(const LAS pg8::bf16x8*)(wa), Ah1 = *(const LAS pg8::bf16x8*)(wa + 16 * WRB), Al0 = *(const LAS pg8::bf16x8*)(wa + 32 * WRB), Al1 = *(const LAS pg8::bf16x8*)(wa + 48 * WRB);
            acc0 = __builtin_amdgcn_mfma_f32_16x16x32_bf16(Ah0, Bh, acc0, 0, 0, 0); acc1 = __builtin_amdgcn_mfma_f32_16x16x32_bf16(Ah1, Bh, acc1, 0, 0, 0);
            acc0 = __builtin_amdgcn_mfma_f32_16x16x32_bf16(Ah0, Bl, acc0, 0, 0, 0); acc1 = __builtin_amdgcn_mfma_f32_16x16x32_bf16(Ah1, Bl, acc1, 0, 0, 0);
            acc0 = __builtin_amdgcn_mfma_f32_16x16x32_bf16(Al0, Bh, acc0, 0, 0, 0); acc1 = __builtin_amdgcn_mfma_f32_16x16x32_bf16(Al1, Bh, acc1, 0, 0, 0);
            wa += 64; vp += 32;
            asm volatile("" : "+v"(wa), "+v"(vp), "+v"(acc0), "+v"(acc1)); }
        const float* br = inp(24) + 4 * kg;
        float tv[4] = {-INFINITY, -INFINITY, -INFINITY, -INFINITY}; int ti[4] = {99, 99, 99, 99};
#pragma unroll
        for (int r = 0; r < 4; ++r) ins4(acc0[r] + br[r], 4 * kg + r, tv, ti);
#pragma unroll
        for (int r = 0; r < 4; ++r) ins4(acc1[r] + br[16 + r], 16 + 4 * kg + r, tv, ti);
#pragma unroll
        for (int xr_ = 16; xr_ <= 32; xr_ <<= 1) { float ov[4]; int oi[4];
#pragma unroll
            for (int k = 0; k < 4; ++k) { ov[k] = __shfl_xor(tv[k], xr_); oi[k] = __shfl_xor(ti[k], xr_); }
#pragma unroll
            for (int k = 0; k < 4; ++k) ins4(ov[k], oi[k], tv, ti); }
        { const int k = kg;
          const float e1 = __expf(tv[1] - tv[0]), e2 = __expf(tv[2] - tv[0]), e3 = __expf(tv[3] - tv[0]); const float inv = 1.0f / (1.0f + e1 + e2 + e3);
          const int ek = k == 0 ? ti[0] : k == 1 ? ti[1] : k == 2 ? ti[2] : ti[3]; const float gk = (k == 0 ? 1.0f : k == 1 ? e1 : k == 2 ? e2 : e3) * inv;
          const unsigned rank = __hip_atomic_fetch_add(hist + ek, 1u, __ATOMIC_RELAXED, __HIP_MEMORY_SCOPE_WORKGROUP);
          const int q = (r0 + t) * 4 + k; sel_e[q] = (unsigned)ek; sel_r[q] = rank; sel_g[q] = gk; }
    }
    LDS_WAIT(); __syncthreads();
    if (F.tid < 32) base[F.tid] = __hip_atomic_fetch_add((unsigned*)(F.ctl + cwc + 64 * F.tid), hist[F.tid], RLX_AGENT);
    LDS_WAIT(); __syncthreads();
    { const int q = F.tid, tok = row_base + (q >> 2), k = q & 3; const unsigned ek = sel_e[q], pos = base[ek] + sel_r[q];
      ptok[(size_t)ek * NTOK + pos] = tok; slot[(size_t)tok * 4 + k] = (ek << 16) | pos; gate[(size_t)tok * 4 + k] = sel_g[q]; }
}
__device__ __forceinline__ void moe_tables(Frame& F) {
    LAS unsigned char* tile_e = (LAS unsigned char*)(F.lds + TILE_E_OFF); LAS int* tile0 = (LAS int*)(F.lds + TILE0_OFF); LAS int* cntl = (LAS int*)(F.lds + CNTL_OFF); LAS int* Tp = (LAS int*)(F.lds + MOE_T_OFF);
    if (F.tid < 32) { const int c = (int)__hip_atomic_load((unsigned*)(F.ctl + CW_CNT + 64 * F.tid), RLX_AGENT); const int nt = (c + 255) >> 8; int incl = nt;
#pragma unroll
        for (int o = 1; o < 32; o <<= 1) { const int w = __shfl_up(incl, o); if (F.tid >= o) incl += w; }
        const int excl = incl - nt; tile0[F.tid] = excl; cntl[F.tid] = c; if (F.tid == 31) Tp[0] = incl;
        for (int k = 0; k < nt; ++k) tile_e[excl + k] = (unsigned char)F.tid; }
    __syncthreads();
}
struct MoeSched {
    const LAS unsigned char* tile_e; const LAS int* tile0; const LAS unsigned* rowtab; int T, nN, G, c, rev, a_mask, e_mask; size_t tA, tBe, tB;
    __device__ __forceinline__ bool next(int i, pg8::Unit& u) const { const int x = c & 7, y = c >> 3, tpx = 32 / nN, t = (i * 8 + x) * tpx + (y % tpx); if (t >= T) return false; u.pm = rev ? T - 1 - t : t; u.pn = y / tpx; u.e = __builtin_amdgcn_readfirstlane((int)tile_e[u.pm]); return true; }
    __device__ __forceinline__ size_t aoff(const pg8::Unit& u) const { return (size_t)(u.pm & a_mask) * tA; }
    __device__ __forceinline__ size_t boff(const pg8::Unit& u) const { return (size_t)(u.e & e_mask) * tBe + (size_t)u.pn * tB; }
    __device__ __forceinline__ unsigned rowoff(int i, int r) const { return rowtab[i * 256 + r]; }
};
__device__ __forceinline__ void p9_final(Frame& F, bool dummy = false) {
    const int bx = blockIdx.x, rows_per = NTOK / F.G, row_base = bx * rows_per, b = row_base >> 12;
    if (MK_PER_PHASE || dummy) moe_tables(F);
    const LAS int* tile0 = (const LAS int*)(F.lds + TILE0_OFF);
    const float* g2 = (const float*)(F.ws + WS_MODF) + (size_t)b * 6144 + 5120; const float* fg = inp(29);
    const unsigned char* Y2 = (const unsigned char*)(F.ws + WS_Y2); const unsigned* slot = (const unsigned*)(F.ws + WS_SLOT); const float* gate = (const float*)(F.ws + WS_GATE);
    f32x4 g2v[4], fgv[4];
#pragma unroll
    for (int j = 0; j < 4; ++j) { g2v[j] = *(const f32x4*)(g2 + 256 * j + 4 * F.lane); fgv[j] = *(const f32x4*)(fg + 256 * j + 4 * F.lane); }
    for (int r = F.wave; r < rows_per; r += NWAVES) { const int tok = row_base + r;
        f32x4 acc[4];
#pragma unroll
        for (int j = 0; j < 4; ++j) acc[j] = (f32x4){0.f, 0.f, 0.f, 0.f};
#pragma unroll
        for (int k = 0; k < 4; ++k) { const unsigned sw = slot[(size_t)tok * 4 + k]; const float gk = gate[(size_t)tok * 4 + k]; const size_t p = (size_t)tile0[sw >> 16] * 256 + (sw & 0xffffu);
            const GAS int* yr = (const GAS int*)(Y2 + p * 1024) + F.lane; const float g8 = gk * 0.125f; typedef float f32x2 __attribute__((ext_vector_type(2)));
#pragma unroll
            for (int j = 0; j < 4; ++j) { const int w = yr[64 * j]; const f32x2 lo = __builtin_amdgcn_cvt_pk_f32_fp8(w, false), hi = __builtin_amdgcn_cvt_pk_f32_fp8(w, true);
                acc[j].x += g8 * lo.x; acc[j].y += g8 * lo.y; acc[j].z += g8 * hi.x; acc[j].w += g8 * hi.y; } }
        const GAS v2u* xr = (const GAS v2u*)((const bf16*)(F.ws + WS_X1B) + (size_t)tok * DM) + F.lane;
        GAS f32x4* xw = (GAS f32x4*)((dummy ? (float*)(F.ws + WS_A2) : F.out) + (size_t)tok * DM) + F.lane; f32x4 v[4]; float s = 0.f;
#pragma unroll
        for (int j = 0; j < 4; ++j) { const v2u wx = xr[64 * j]; v[j] = (f32x4){pg8::bf_lo(wx.x), pg8::bf_hi(wx.x), pg8::bf_lo(wx.y), pg8::bf_hi(wx.y)} + g2v[j] * acc[j]; s += (v[j].x * v[j].x + v[j].y * v[j].y) + (v[j].z * v[j].z + v[j].w * v[j].w); }
        const float rs = 1.0f / sqrtf(wave_sum_u(s) * (1.f / DM) + 1e-6f);
#pragma unroll
        for (int j = 0; j < 4; ++j) __builtin_nontemporal_store(v[j] * rs * fgv[j], (f32x4*)(xw + 64 * j));
    }
}

__device__ __forceinline__ void dep_signal(Frame& F, int word) {
    asm volatile("s_waitcnt vmcnt(0)" ::: "memory"); __syncthreads();
    if (F.wave == 0 && lane_id_opaque() == 0) { __builtin_amdgcn_fence(__ATOMIC_RELEASE, "agent"); asm volatile("s_waitcnt vmcnt(0)" ::: "memory"); (void)xb_add((unsigned*)(F.ctl + word), 1u); }
}
__device__ __forceinline__ void dep_wait(Frame& F, int word, unsigned need) {
    if (F.wave == 0 && lane_id_opaque() == 0) { unsigned* p = (unsigned*)(F.ctl + word); unsigned* bar = (unsigned*)(F.ctl + CW_BAR); XB_SPIN(xb_ld(p) < need, bar);
        __builtin_amdgcn_fence(__ATOMIC_ACQUIRE, "agent"); asm volatile("s_waitcnt vmcnt(0)" ::: "memory"); }
    __syncthreads();
}
#ifndef P2_NG
#define P2_NG 176
#endif
__device__ __forceinline__ void phase0(Frame& F, unsigned char* lds, unsigned char* ws) { p0_prologue(F);  }
__device__ __forceinline__ void phase1(Frame& F, unsigned char* lds, unsigned char* ws) { dep_wait(F, CW_DEP0, (unsigned)F.G); p1_h1(F);  }
__device__ __forceinline__ void phase2(Frame& F, unsigned char* lds, unsigned char* ws) {
        pg8::Gemm g{(const bf16*)(ws + WS_H), (const bf16*)(ws + WS_WIN), 1024, 1024, 1024}; const bool hosted = (F.G == 256); const int ng = hosted ? P2_NG : F.G;
        pg8::StaticOrder S; S.init(NTOK, 2048, ng, (int)blockIdx.x, 1024, 1024);
        pg8::EpiQKVU E{(bf16*)(ws + WS_Q), (size_t)(WS_K - WS_Q) / 2, (bf16*)(ws + WS_UA), attn_body::C2};
        if ((int)blockIdx.x < ng) pg8::gemm_phase<pg8::EpiQKVU, pg8::StaticOrder, true, false>(F.lds + RING_OFF, g, S, E, F.wave);
        else tr_run(F, 0, TR_HOSTED, ((int)blockIdx.x - ng) * NWAVES + F.wave, (F.G - ng) * NWAVES);

    }
__device__ __forceinline__ void phase4_glu(Frame& F, unsigned char* ws) {
        pg8::Gemm g{(const bf16*)(ws + WS_Z), (const bf16*)(ws + WS_WGLU), 512, 512, 512}; pg8::StaticOrder S; S.init(NTOK, 512, F.G, (int)blockIdx.x, 512, 512);
        { pg8::Unit u; const bool one = (F.G == 256) && S.next(0, u);
          if (one) dep_wait(F, CW_DEPB + 16 * (u.pm >> 4), 32u);
          else { for (int bb = 0; bb < NB; ++bb) dep_wait(F, CW_DEPB + 16 * bb, 32u); } }
        pg8::EpiGLU E{(const bf16*)(ws + WS_Z), (bf16*)(ws + WS_MIX), inp(20)};
        pg8::gemm_phase<pg8::EpiGLU, pg8::StaticOrder, true, false>(F.lds + RING_OFF, g, S, E, F.wave);
        __syncthreads();
    }
__device__ __forceinline__ void phase3(Frame& F, unsigned char* lds, unsigned char* ws) {
        for (int it = F.vcu; it < 256; it += F.G) { const int g = it >> 3, b = it & 7;
            bf16* UAgb = (bf16*)(ws + WS_UA) + (size_t)((g * 8 + b) * 256) * 384;
            { pg8::Gemm gx{UAgb, (const bf16*)(ws + WS_WM) + (size_t)g * 256 * 256, 256, 384, 256}; pg8::SingleUnit S; pg8::EpiX E;
              pg8::gemm_phase<pg8::EpiX, pg8::SingleUnit, false, false>(F.lds + RING_OFF, gx, S, E, F.wave); }
            LDS_WAIT(); __syncthreads();
            {
                const int p = lane_id_opaque(), c0 = F.wave * 32; const float* L16 = (const float*)(ws + WS_LAM16) + (g * 64 + p) * 2; const float lr = L16[0], li = L16[1];
                LAS float* X = (LAS float*)(F.lds + RING_OFF); LAS float* EW = X + 256 * pg8::XS;
                float hr = 0.f, hi2 = 0.f;
#pragma unroll 8
                for (int k = 0; k < 32; ++k) { LAS float* xc = X + (c0 + k) * pg8::XS + p; const float xr = xc[0], xi = xc[64]; xc[0] = hr; xc[64] = hi2;
                    const float nr = lr * hr - li * hi2 + xr, ni = lr * hi2 + li * hr + xi; hr = nr; hi2 = ni; }
                EW[F.wave * 128 + p] = hr; EW[F.wave * 128 + 64 + p] = hi2;
                float qr = lr, qi = li;
#pragma unroll
                for (int sq = 0; sq < 5; ++sq) { const float t = qr * qr - qi * qi; qi = 2.f * qr * qi; qr = t; }
                LDS_WAIT(); __syncthreads();
                float cr = 0.f, ci = 0.f;
                for (int v = 0; v < F.wave; ++v) { const float er = EW[v * 128 + p], ei = EW[v * 128 + 64 + p]; const float nr = qr * cr - qi * ci + er, ni = qr * ci + qi * cr + ei; cr = nr; ci = ni; }
                bf16* hrow = UAgb + (size_t)c0 * 384 + 256 + p; float pr = 1.f, pi = 0.f;
#pragma unroll 8
                for (int k = 0; k < 32; ++k) { const LAS float* xc = X + (c0 + k) * pg8::XS + p; const float hr2 = xc[0] + (pr * cr - pi * ci), hi3 = xc[64] + (pr * ci + pi * cr);
                    hrow[(size_t)k * 384] = (bf16)f2bf(hr2); hrow[(size_t)k * 384 + 64] = (bf16)f2bf(hi3);
                    const float t = pr * lr - pi * li; pi = pr * li + pi * lr; pr = t; }
                VM_WAIT(); if (F.wave == 0) { __builtin_amdgcn_fence(__ATOMIC_ACQUIRE, "agent"); VM_WAIT(); } }
            LDS_WAIT(); __syncthreads();
            { pg8::Gemm gy{UAgb, (const bf16*)(ws + WS_TV) + (size_t)g * 256 * 384, 384, 384, 384}; pg8::SingleUnit S; pg8::EpiY E{(bf16*)(ws + WS_Z), g, b};
              pg8::gemm_phase<pg8::EpiY, pg8::SingleUnit, false, false>(F.lds + RING_OFF, gy, S, E, F.wave); }
            dep_signal(F, CW_DEPB + 16 * b);
        }
        static_assert(attn_body::LDS2_BYTES <= LDSCTL_OFF, "attention LDS vs control words");
        for (int it = F.vcu; it < 256; it += F.G) { const int bh = it >> 3, sdx = it & 7, b = bh >> 2, h = bh & 3;
            attn_body::bf16x8 qfr[4];
            for (int i4 = 0; i4 < 4; ++i4) { const int qb = (i4 >> 1) ? 15 - sdx : sdx;
                { const int m = i4 & 1, hm = h * 2 + m;
                    const attn_body::bf16* q_ = (const attn_body::bf16*)(ws + WS_Q) + (size_t)b * SEQ * 512 + hm * 64; const attn_body::bf16* k_ = (const attn_body::bf16*)(ws + WS_K) + (size_t)b * SEQ * 512 + hm * 64;
                    const attn_body::bf16* v_ = (const attn_body::bf16*)(ws + WS_V) + (size_t)b * SEQ * 512 + h * 128; attn_body::bf16* o_ = (attn_body::bf16*)(ws + WS_OB) + (size_t)b * SEQ * 1024 + hm * 128;
                    const int nm = (i4 + 1) & 1, nhm = h * 2 + nm, nqb = ((i4 + 1) >> 1) ? 15 - sdx : sdx;
                    const attn_body::bf16* nq_ = (const attn_body::bf16*)(ws + WS_Q) + (size_t)b * SEQ * 512 + nhm * 64; const attn_body::bf16* nk_ = (const attn_body::bf16*)(ws + WS_K) + (size_t)b * SEQ * 512 + nhm * 64;
                    asm volatile("" : "+s"(q_), "+s"(k_), "+s"(v_), "+s"(o_), "+s"(nq_), "+s"(nk_));
                    attn_body::attn_unit2<8>(qb, q_, k_, v_, o_, (char*)lds + RING_OFF, F.wave, qfr, (i4 > 0 ? 1 : 0) | (i4 < 3 ? 2 : 0), nqb, nq_, nk_, v_); }
                if (i4 & 1) { VM_WAIT(); __syncthreads();
 const int ln = lane_id_opaque(), t16 = F.wave * 4 + (ln >> 4), d0 = (ln & 15) * 8; const float* sg = inp(10) + d0;
                  const float lam = __expf(wave_sum(inp(6)[ln] * inp(7)[ln])) - __expf(wave_sum(inp(8)[ln] * inp(9)[ln])) + 0.2f;
                  const bf16* OB = (const bf16*)(ws + WS_OB); bf16* MIX = (bf16*)(ws + WS_MIX);
                  v4u a0v[8], a1v[8];
#pragma unroll
                  for (int p = 0; p < 8; ++p) { const size_t tok = (size_t)b * SEQ + qb * 256 + p * 32 + t16; a0v[p] = *(const GAS v4u*)(OB + tok * 1024 + (h * 2) * 128 + d0); a1v[p] = *(const GAS v4u*)(OB + tok * 1024 + (h * 2 + 1) * 128 + d0); }
#pragma unroll
                  for (int p = 0; p < 8; ++p) { const size_t tok = (size_t)b * SEQ + qb * 256 + p * 32 + t16;
                      const v4u a0 = a0v[p], a1 = a1v[p];
                      float a[8];
                      a[0] = pg8::bf_lo(a0.x) - lam * pg8::bf_lo(a1.x); a[1] = pg8::bf_hi(a0.x) - lam * pg8::bf_hi(a1.x); a[2] = pg8::bf_lo(a0.y) - lam * pg8::bf_lo(a1.y); a[3] = pg8::bf_hi(a0.y) - lam * pg8::bf_hi(a1.y);
                      a[4] = pg8::bf_lo(a0.z) - lam * pg8::bf_lo(a1.z); a[5] = pg8::bf_hi(a0.z) - lam * pg8::bf_hi(a1.z); a[6] = pg8::bf_lo(a0.w) - lam * pg8::bf_lo(a1.w); a[7] = pg8::bf_hi(a0.w) - lam * pg8::bf_hi(a1.w);
                      float ss = 0.f;
#pragma unroll
                      for (int j = 0; j < 8; ++j) ss += a[j] * a[j];
                      ss += __shfl_xor(ss, 1); ss += __shfl_xor(ss, 2); ss += __shfl_xor(ss, 4); ss += __shfl_xor(ss, 8);
                      const float rs = 0.8f / sqrtf(ss * (1.f / 128.f) + 1e-6f);
                      const float r4 = rs * 4.0f; const pg8::f32x4 q0 = {a[0] * r4 * sg[0], a[1] * r4 * sg[1], a[2] * r4 * sg[2], a[3] * r4 * sg[3]}, q1 = {a[4] * r4 * sg[4], a[5] * r4 * sg[5], a[6] * r4 * sg[6], a[7] * r4 * sg[7]};
                      *(GAS pg8::i32x2*)((unsigned char*)MIX + tok * 1024 + h * 128 + d0) = pg8::pack8_fp8(q0, q1); } }
            }
        }
        __syncthreads(); phase4_glu(F, ws);
}
__device__ __forceinline__ void phase4(Frame& F, unsigned char* lds, unsigned char* ws) { }
__device__ __forceinline__ void phase5(Frame& F, unsigned char* lds, unsigned char* ws) {
        pg8::Gemm g{(const bf16*)(ws + WS_MIX), (const bf16*)(ws + WS_WOUT), 512, 512, 512}; pg8::StaticOrder S; S.init(NTOK, 1024, F.G, (int)blockIdx.x, 512, 512);
        pg8::EpiOut E{inp(0), (bf16*)(ws + WS_X1B), (const float*)(ws + WS_MODF) + 2048, F.lds + VEC_OFF};
        pg8::gemm_phase<pg8::EpiOut, pg8::StaticOrder, true, false, true>(F.lds + RING_OFF, g, S, E, F.wave);

    }
__device__ __forceinline__ void phase6(Frame& F, unsigned char* lds, unsigned char* ws) { p6_router(F, false, !MK_PER_PHASE);  }
__device__ __forceinline__ void phase7(Frame& F, unsigned char* lds, unsigned char* ws) {
        moe_tables(F);
        MoeSched S; S.tile_e = (const LAS unsigned char*)(F.lds + TILE_E_OFF); S.tile0 = (const LAS int*)(F.lds + TILE0_OFF); S.rowtab = (const LAS unsigned*)(F.lds + ROWTAB_OFF);
        S.T = __builtin_amdgcn_readfirstlane(((const LAS int*)(F.lds + MOE_T_OFF))[0]); S.nN = 8; S.G = F.G; S.c = (int)blockIdx.x; S.rev = 0; S.a_mask = -1; S.e_mask = -1; S.tA = 0; S.tBe = (size_t)2048 * 1024; S.tB = (size_t)256 * 1024;
        { const LAS int* cntl = (const LAS int*)(F.lds + CNTL_OFF); LAS unsigned* rt = (LAS unsigned*)(F.lds + ROWTAB_OFF); const int* ptok = (const int*)(ws + WS_PTOK);
          int tokv[18]; bool live[18];
#pragma unroll
          for (int i = 0; i < 18; ++i) { pg8::Unit u; live[i] = S.next(i, u); tokv[i] = 0;
              if (live[i] && F.tid < 256) { const int e = u.e, pos = (u.pm - S.tile0[e]) * 256 + F.tid; tokv[i] = ptok[(size_t)e * NTOK + (pos < cntl[e] ? pos : 0)]; } }
#pragma unroll
          for (int i = 0; i < 18; ++i) if (live[i] && F.tid < 256) rt[i * 256 + F.tid] = (unsigned)tokv[i] * 1024u; }
        VM_WAIT(); LDS_WAIT(); __syncthreads();
        pg8::Gemm g{(const bf16*)(ws + WS_H), (const bf16*)(ws + WS_W1T), 512, 512, 512};
        pg8::EpiMoe1 E{(unsigned char*)(ws + WS_A2), inp(26), F.lds + BIASL_OFF};
        pg8::gemm_phase<pg8::EpiMoe1, MoeSched, true, true, true>(F.lds + RING_OFF, g, S, E, F.wave);

    }
__device__ __forceinline__ void phase8(Frame& F, unsigned char* lds, unsigned char* ws) {
        if (MK_PER_PHASE) moe_tables(F);
        MoeSched S; S.tile_e = (const LAS unsigned char*)(F.lds + TILE_E_OFF); S.tile0 = (const LAS int*)(F.lds + TILE0_OFF); S.rowtab = (const LAS unsigned*)(F.lds + ROWTAB_OFF);
        S.T = __builtin_amdgcn_readfirstlane(((const LAS int*)(F.lds + MOE_T_OFF))[0]); S.nN = 4; S.G = F.G; S.c = (int)blockIdx.x; S.rev = 1; S.a_mask = -1; S.e_mask = -1; S.tA = (size_t)256 * 1024; S.tBe = (size_t)1024 * 1024; S.tB = (size_t)256 * 1024;
        pg8::Gemm g{(const bf16*)(ws + WS_A2), (const bf16*)(ws + WS_W2T), 512, 512, 512};
        pg8::EpiMoe2 E{(unsigned char*)(ws + WS_Y2), inp(28), -1, F.lds + BIASL_OFF};
        pg8::gemm_phase<pg8::EpiMoe2, MoeSched, true, false, true>(F.lds + RING_OFF, g, S, E, F.wave);

    }
__device__ __forceinline__ void phase9(Frame& F, unsigned char* lds, unsigned char* ws) { p9_final(F); }
__device__ __forceinline__ bool relaunder(Frame& F) { F.lane = lane_id_opaque(); F.tid = F.wave * 64 + F.lane; return true; }
struct Args { const float* in[30]; float* out; unsigned char* ws; int ph_lo, ph_hi; };
__global__ void __launch_bounds__(NWAVES * 64, 2) mega_fwd(Args args) {
    extern __shared__ __attribute__((aligned(16))) unsigned char lds[];
    Frame F;
    F.lds = (LAS unsigned char*)lds;
    F.tid = threadIdx.x; F.lane = F.tid & 63; F.wave = __builtin_amdgcn_readfirstlane(F.tid >> 6);
    F.G = gridDim.x; { const int bx = blockIdx.x; F.vcu = (F.G % 8 == 0) ? (bx % 8) * (F.G / 8) + bx / 8 : bx; }
    F.ws = args.ws; F.out = args.out; F.ctl = (gu32*)(args.ws + WS_CTL);
    volatile LAS unsigned* MISC = (volatile LAS unsigned*)(F.lds + MISC_OFF);
    for (int u = F.tid; u < (LDS_BYTES - LDSCTL_OFF) / 4; u += NWAVES * 64) ((LAS unsigned*)(F.lds + LDSCTL_OFF))[u] = 0u;
    __syncthreads();
    XcdBarrier bar; bar.bar = (unsigned*)(F.ctl + CW_BAR); bar.x = 0; bar.st = nullptr;
    if (!MK_PER_PHASE) bar = xcd_barrier_post((unsigned*)(F.ctl + CW_BAR), MISC + 8);
    const int lo = args.ph_lo, hi = args.ph_hi;
#ifndef MK_MASK
#define MK_MASK 0x3ff
#endif
#define IN(k) (((MK_MASK >> (k)) & 1) && lo <= (k) && (k) < hi && relaunder(F))
#define SEAM(k) do { if (IN(k) && IN((k) + 1)) xcd_barrier(bar, F.wave); } while (0)
    unsigned char* ws = args.ws;

    if (IN(0)) { phase0(F, lds, ws); }
#if MK_DUP == 0
    if (IN(0)) { phase0(F, lds, ws); SEAM(0); }
#endif
    if (IN(1)) { phase1(F, lds, ws); SEAM(1); }
#if MK_DUP == 1
    if (IN(1)) { phase1(F, lds, ws); SEAM(1); }
#endif
    if (IN(2)) { phase2(F, lds, ws); SEAM(2); }
#if MK_DUP == 2
    if (IN(2)) { phase2(F, lds, ws); SEAM(2); }
#endif
#if MK_DUP == 18
    if (IN(2)) { for (int rr = 0; rr < 8; ++rr) { phase2(F, lds, ws); xcd_barrier(bar, F.wave); } }
#endif
    if (IN(3)) { phase3(F, lds, ws); }
#if MK_DUP == 3
    if (IN(3)) { phase3(F, lds, ws); SEAM(3); }
#endif
    if (IN(4)) { phase4(F, lds, ws); SEAM(4); }
#if MK_DUP == 4
    if (IN(4)) { phase4(F, lds, ws); SEAM(4); }
#endif
    if (IN(5)) { phase5(F, lds, ws); if (!MK_PER_PHASE && IN(6)) p6_fill(F); SEAM(5); }
#if MK_DUP == 5
    if (IN(5)) { phase5(F, lds, ws); SEAM(5); }
#endif
#if MK_DUP == 6
    if (IN(6)) { p6_router(F, true); xcd_barrier(bar, F.wave); }
#endif
    if (IN(6)) { phase6(F, lds, ws); SEAM(6); }
    if (IN(7)) { phase7(F, lds, ws); SEAM(7); }
#if MK_DUP == 7
    if (IN(7)) { phase7(F, lds, ws); SEAM(7); }
#endif
    if (IN(8)) { phase8(F, lds, ws); SEAM(8); }
#if MK_DUP == 8
    if (IN(8)) { phase8(F, lds, ws); SEAM(8); }
#endif
#if MK_DUP == 9
    if (IN(9)) { p9_final(F, true); xcd_barrier(bar, F.wave); }
#endif
#if MK_DUP == 16 || MK_DUP == 17
    if (IN(8)) {
        moe_tables(F);
        MoeSched S; S.tile_e = (const LAS unsigned char*)(F.lds + TILE_E_OFF); S.tile0 = (const LAS int*)(F.lds + TILE0_OFF); S.rowtab = (const LAS unsigned*)(F.lds + ROWTAB_OFF);
        S.T = __builtin_amdgcn_readfirstlane(((const LAS int*)(F.lds + MOE_T_OFF))[0]); S.nN = 4; S.G = F.G; S.c = (int)blockIdx.x; S.rev = 1; S.e_mask = (MK_DUP == 16) ? 0 : -1; S.a_mask = (MK_DUP == 16) ? 0 : -1; S.tA = (size_t)256 * 1024; S.tBe = (size_t)1024 * 1024; S.tB = (size_t)256 * 1024;
        pg8::Gemm g{(const bf16*)(ws + WS_A2), (const bf16*)(ws + WS_W2T), 512, 512, 512};
        pg8::EpiMoe2 E{(unsigned char*)(ws + WS_W1T), inp(28), 127};
        pg8::gemm_phase<pg8::EpiMoe2, MoeSched, true, false, true>(F.lds + RING_OFF, g, S, E, F.wave);
        xcd_barrier(bar, F.wave);
    }
#endif
    if (IN(9)) { phase9(F, lds, ws); }
#if MK_DUP == 19
    if (IN(9)) { xcd_barrier(bar, F.wave); phase7(F, lds, ws); }
#endif
#if MK_DUP == 20
    if (IN(9)) { xcd_barrier(bar, F.wave); phase8(F, lds, ws); }
#endif
#if MK_DUP == 10
    if (IN(9)) { xcd_barrier(bar, F.wave); phase0(F, lds, ws); }
#endif
#if MK_DUP == 11
    if (IN(9)) { xcd_barrier(bar, F.wave); p0_prologue(F, 1); }
#endif
#if MK_DUP == 13
    if (IN(9)) { xcd_barrier(bar, F.wave); p0_prologue(F, 3); }
#endif
#if MK_DUP == 14
    if (IN(9)) { xcd_barrier(bar, F.wave); p0_prologue(F, 4); }
#endif
#if MK_DUP == 15
    if (IN(9)) { xcd_barrier(bar, F.wave); }
#endif
#if MK_DUP == 12
    if (IN(9)) { xcd_barrier(bar, F.wave); p0_prologue(F, 2); }
#endif
#undef IN
#undef SEAM
}

extern "C" void kernel_launch(void* const* d_in, const int* in_sizes, int n_in, void* d_out, int out_size, void* d_ws, size_t ws_size, hipStream_t stream) {
    static int grid = 0;
    if (grid == 0) {
        if (n_in != 30 || in_sizes[0] != NTOK * DM || out_size != NTOK * DM || ws_size < WS_END) { fprintf(stderr, "kernel_launch: unexpected shapes (n_in %d, in0 %d, out %d, ws %zu); nothing launched\n", n_in, n_in > 0 ? in_sizes[0] : -1, out_size, ws_size); grid = -1; return; }
        int dev = 0, cus = 0;
        if (hipGetDevice(&dev) != hipSuccess || hipDeviceGetAttribute(&cus, hipDeviceAttributeMultiprocessorCount, dev) != hipSuccess) { fprintf(stderr, "kernel_launch: device query failed\n"); grid = -1; return; }
        if (hipFuncSetAttribute((const void*)mega_fwd, hipFuncAttributeMaxDynamicSharedMemorySize, LDS_BYTES) != hipSuccess) { fprintf(stderr, "kernel_launch: hipFuncSetAttribute failed\n"); grid = -1; return; }
        (void)hipGetLastError();
        grid = cus;
        if (grid != 256) { fprintf(stderr, "kernel_launch: built for a 256-CU device, found %d CUs; nothing launched\n", grid); grid = -1; return; }
    }
    if (grid < 0) return;
    if (hipMemsetAsync((char*)d_ws + WS_CTL, 0, CTL_ZERO_BYTES, stream) != hipSuccess) { fprintf(stderr, "kernel_launch: memset failed\n"); return; }
    Args a{};
    for (int i = 0; i < 30; ++i) a.in[i] = (const float*)d_in[i];
    a.out = (float*)d_out; a.ws = (unsigned char*)d_ws;
#if MK_PER_PHASE
    for (int p = 0; p < N_PHASES; ++p) { a.ph_lo = p; a.ph_hi = p + 1; hipLaunchKernelGGL(mega_fwd, dim3(grid), dim3(NWAVES * 64), LDS_BYTES, stream, a); }
#else
    a.ph_lo = 0; a.ph_hi = N_PHASES; hipLaunchKernelGGL(mega_fwd, dim3(grid), dim3(NWAVES * 64), LDS_BYTES, stream, a);
#endif
    const hipError_t le = hipPeekAtLastError();
    if (le != hipSuccess) fprintf(stderr, "kernel_launch: launch failed: %s\n", hipGetErrorName(le));
}
```
